# Optimizing an MI355X kernel written in HIP

```python
import math
import jax, jax.numpy as jnp
from jax import lax
import numpy as np

D_MODEL = 1024
BATCH = 32
SEQ = 2048
DEPTH = 2

CONV_CH = D_MODEL // 2
CONV_WIDTH = 31
SB_HEADS = 8
SB_HEAD_DIM = 64
SB_WIDTH = SB_HEADS * SB_HEAD_DIM
Q_BLOCK = 128
EV_IN = 2 * CONV_CH + 3 * SB_WIDTH
EV_OUT_IN = CONV_CH + SB_WIDTH
LRU_WIDTH = D_MODEL
LRU_BLOCKS = 8
LRU_BLOCK_SIZE = LRU_WIDTH // LRU_BLOCKS
LRU_CONV_WIDTH = 4
LRU_C = 8.0
N_GROUPS = 4
EXPERTS_PER_GROUP = 4
N_EXPERTS = N_GROUPS * EXPERTS_PER_GROUP
TOP_K = 2
GROUP_SCORE_K = 2
D_FF_EXPERT = 512
MOE_BLOCK = 128

N_EVEN = (DEPTH + 1) // 2
N_ODD = DEPTH // 2
EPS = 1e-6

kernel_name = 'hybrid_conformer_stickbreak_rglru_moe'


def rms_norm(x, g):
    xf = x.astype(jnp.float32)
    y = xf * lax.rsqrt(jnp.mean(xf * xf, axis=-1, keepdims=True) + EPS)
    return (y * g.astype(jnp.float32)).astype(x.dtype)


def layer_norm(x, g, b):
    xf = x.astype(jnp.float32)
    mu = jnp.mean(xf, axis=-1, keepdims=True)
    xc = xf - mu
    var = jnp.mean(xc * xc, axis=-1, keepdims=True)
    y = xc * lax.rsqrt(var + EPS) * g.astype(jnp.float32) + b.astype(jnp.float32)
    return y.astype(x.dtype)


def causal_dwconv(x, w, b):
    width = w.shape[0]
    y = lax.conv_general_dilated(
        x, w[:, None, :].astype(x.dtype), window_strides=(1,),
        padding=[(width - 1, 0)], dimension_numbers=('NWC', 'WIO', 'NWC'),
        feature_group_count=x.shape[-1])
    return y + b.astype(x.dtype)


def stick_breaking_attention(q, k, v):
    seq = q.shape[2]
    scale = 1.0 / math.sqrt(q.shape[-1])
    outs = []
    for blk in range(seq // Q_BLOCK):
        q0 = blk * Q_BLOCK
        end = q0 + Q_BLOCK
        qb = q[:, :, q0:end]
        kb = k[:, :, :end]
        vb = v[:, :, :end]
        z = jnp.einsum('bhqd,bhkd->bhqk', qb, kb).astype(jnp.float32) * scale
        qpos = q0 + jnp.arange(Q_BLOCK)[:, None]
        kpos = jnp.arange(end)[None, :]
        causal = kpos < qpos
        log_1m = jnp.where(causal, jax.nn.log_sigmoid(-z), 0.0)
        between = lax.cumsum(log_1m, axis=3, reverse=True) - log_1m
        wts = jnp.where(causal, jnp.exp(jax.nn.log_sigmoid(z) + between), 0.0)
        outs.append(jnp.einsum('bhqk,bhkd->bhqd', wts.astype(v.dtype), vb))
    return jnp.concatenate(outs, axis=2)


def even_mixer(h, in_w, dw_w, dw_b, ln_g, ln_b, q_g, k_g, out_w):
    bsz, seq, _ = h.shape
    proj = h @ in_w
    a_val, a_gate, q, k, v = jnp.split(
        proj, [CONV_CH, 2 * CONV_CH, 2 * CONV_CH + SB_WIDTH, 2 * CONV_CH + 2 * SB_WIDTH], axis=-1)
    u = a_val * jax.nn.sigmoid(a_gate)
    u = causal_dwconv(u, dw_w, dw_b)
    u = jax.nn.silu(layer_norm(u, ln_g, ln_b))
    def heads(t):
        return t.reshape(bsz, seq, SB_HEADS, SB_HEAD_DIM)
    qh = rms_norm(heads(q), q_g).transpose(0, 2, 1, 3)
    kh = rms_norm(heads(k), k_g).transpose(0, 2, 1, 3)
    vh = heads(v).transpose(0, 2, 1, 3)
    o = stick_breaking_attention(qh, kh, vh).transpose(0, 2, 1, 3).reshape(bsz, seq, SB_WIDTH)
    return jnp.concatenate([u, o], axis=-1) @ out_w


def block_diag_linear(x, w, b):
    nb, bs, _ = w.shape
    xb = x.reshape(x.shape[:-1] + (nb, bs))
    return jnp.einsum('bsnk,nkj->bsnj', xb, w).reshape(x.shape) + b


def lru_combine(earlier, later):
    a1, b1 = earlier
    a2, b2 = later
    return a1 * a2, a2 * b1 + b2


def odd_mixer(h, in_w, conv_w, conv_b, rg_w, rg_b, ig_w, ig_b, lam, out_w):
    proj = h @ in_w
    y_branch, x_branch = jnp.split(proj, 2, axis=-1)
    xc = causal_dwconv(x_branch, conv_w, conv_b)
    r = jax.nn.sigmoid(block_diag_linear(xc, rg_w, rg_b))
    i = jax.nn.sigmoid(block_diag_linear(xc, ig_w, ig_b))
    log_a = LRU_C * r.astype(jnp.float32) * jax.nn.log_sigmoid(lam.astype(jnp.float32))
    a = jnp.exp(log_a)
    mult = jnp.sqrt(-jnp.expm1(2.0 * log_a))
    b_in = mult * (i * xc).astype(jnp.float32)
    _, hseq = lax.associative_scan(lru_combine, (a, b_in), axis=1)
    return (jax.nn.gelu(y_branch) * hseq.astype(h.dtype)) @ out_w


def moe(h2, router_w, router_b, w1, w3, w2):
    n_tok, d = h2.shape
    logits = h2.astype(jnp.float32) @ router_w.astype(jnp.float32)
    scores = jax.nn.sigmoid(logits)
    biased = (scores + router_b.astype(jnp.float32)).reshape(n_tok, N_GROUPS, EXPERTS_PER_GROUP)
    group_score = jnp.sum(lax.top_k(biased, GROUP_SCORE_K)[0], axis=-1)
    gidx = jnp.argmax(group_score, axis=-1)
    in_group = jnp.take_along_axis(biased, gidx[:, None, None], axis=1)[:, 0]
    _, loc = lax.top_k(in_group, TOP_K)
    eid = gidx[:, None] * EXPERTS_PER_GROUP + loc
    sel = jnp.take_along_axis(scores, eid, axis=1)
    gates = (sel / jnp.sum(sel, axis=-1, keepdims=True)).astype(h2.dtype)
    n_asg = n_tok * TOP_K
    flat_e = eid.reshape(n_asg)
    flat_tok = jnp.repeat(jnp.arange(n_tok, dtype=jnp.int32), TOP_K)
    flat_g = gates.reshape(n_asg)
    order = jnp.argsort(flat_e)
    se = flat_e[order]
    stok = flat_tok[order]
    sg = flat_g[order]
    counts = jnp.bincount(flat_e, length=N_EXPERTS)
    starts = jnp.cumsum(counts) - counts
    padded = (counts + MOE_BLOCK - 1) // MOE_BLOCK * MOE_BLOCK
    pad_end = jnp.cumsum(padded)
    pad_start = pad_end - padded
    dest = pad_start[se] + (jnp.arange(n_asg) - starts[se])
    n_blocks = -(-n_asg // MOE_BLOCK) + N_EXPERTS
    buf_len = n_blocks * MOE_BLOCK
    buf_tok = jnp.zeros((buf_len,), jnp.int32).at[dest].set(stok)
    buf_g = jnp.zeros((buf_len,), h2.dtype).at[dest].set(sg)
    blk_e = jnp.minimum(
        jnp.searchsorted(pad_end, jnp.arange(n_blocks) * MOE_BLOCK, side='right'), N_EXPERTS - 1)

    def run_block(args):
        tok, g, e = args
        xb = h2[tok]
        y = (jax.nn.silu(xb @ w1[e]) * (xb @ w3[e])) @ w2[e]
        return y * g[:, None]

    ys = lax.map(run_block, (buf_tok.reshape(n_blocks, MOE_BLOCK),
                             buf_g.reshape(n_blocks, MOE_BLOCK), blk_e))
    return jnp.zeros_like(h2).at[buf_tok].add(ys.reshape(buf_len, d))


def setup_inputs(seed: int = 0) -> dict:
    key = jax.random.key(seed)
    ks = jax.random.split(key, 28)
    f32 = jnp.float32

    def nrm(k, shape, scale):
        return jax.random.normal(k, shape, f32) * scale

    def gain(k, shape):
        return 1.0 + 0.05 * jax.random.normal(k, shape, f32)

    u = jax.random.uniform(ks[24], (N_ODD, LRU_WIDTH), f32, 0.9, 0.999)
    s = u ** (1.0 / LRU_C)
    lam = jnp.log(s) - jnp.log1p(-s)
    return {
        'x': nrm(ks[0], (BATCH, SEQ, D_MODEL), 1.0),
        'c': nrm(ks[1], (BATCH, D_MODEL), 1.0),
        'mod_w': nrm(ks[2], (DEPTH, D_MODEL, 6 * D_MODEL), 0.5 * D_MODEL ** -0.5),
        'mod_b': nrm(ks[3], (DEPTH, 6 * D_MODEL), 0.02),
        'mix_norm_g': gain(ks[4], (DEPTH, D_MODEL)),
        'ffn_norm_g': gain(ks[5], (DEPTH, D_MODEL)),
        'ev_in_w': nrm(ks[6], (N_EVEN, D_MODEL, EV_IN), D_MODEL ** -0.5),
        'ev_dw_w': nrm(ks[7], (N_EVEN, CONV_WIDTH, CONV_CH), CONV_WIDTH ** -0.5),
        'ev_dw_b': nrm(ks[8], (N_EVEN, CONV_CH), 0.02),
        'ev_ln_g': gain(ks[9], (N_EVEN, CONV_CH)),
        'ev_ln_b': nrm(ks[10], (N_EVEN, CONV_CH), 0.02),
        'ev_q_g': gain(ks[11], (N_EVEN, SB_HEAD_DIM)),
        'ev_k_g': gain(ks[12], (N_EVEN, SB_HEAD_DIM)),
        'ev_out_w': nrm(ks[13], (N_EVEN, EV_OUT_IN, D_MODEL), EV_OUT_IN ** -0.5),
        'od_in_w': nrm(ks[14], (N_ODD, D_MODEL, 2 * LRU_WIDTH), D_MODEL ** -0.5),
        'od_conv_w': nrm(ks[15], (N_ODD, LRU_CONV_WIDTH, LRU_WIDTH), LRU_CONV_WIDTH ** -0.5),
        'od_conv_b': nrm(ks[16], (N_ODD, LRU_WIDTH), 0.02),
        'od_rg_w': nrm(ks[17], (N_ODD, LRU_BLOCKS, LRU_BLOCK_SIZE, LRU_BLOCK_SIZE), LRU_BLOCK_SIZE ** -0.5),
        'od_rg_b': nrm(ks[18], (N_ODD, LRU_WIDTH), 0.02),
        'od_ig_w': nrm(ks[19], (N_ODD, LRU_BLOCKS, LRU_BLOCK_SIZE, LRU_BLOCK_SIZE), LRU_BLOCK_SIZE ** -0.5),
        'od_ig_b': nrm(ks[20], (N_ODD, LRU_WIDTH), 0.02),
        'od_lam': lam,
        'od_out_w': nrm(ks[21], (N_ODD, LRU_WIDTH, D_MODEL), LRU_WIDTH ** -0.5),
        'router_w': nrm(ks[22], (D_MODEL, N_EXPERTS), D_MODEL ** -0.5),
        'router_b': nrm(ks[23], (N_EXPERTS,), 0.01),
        'ex_w1': nrm(ks[25], (DEPTH, N_EXPERTS, D_MODEL, D_FF_EXPERT), D_MODEL ** -0.5),
        'ex_w3': nrm(ks[26], (DEPTH, N_EXPERTS, D_MODEL, D_FF_EXPERT), D_MODEL ** -0.5),
        'ex_w2': nrm(ks[27], (DEPTH, N_EXPERTS, D_FF_EXPERT, D_MODEL), D_FF_EXPERT ** -0.5),
    }


def reference(x, c, mod_w, mod_b, mix_norm_g, ffn_norm_g, ev_in_w, ev_dw_w, ev_dw_b,
              ev_ln_g, ev_ln_b, ev_q_g, ev_k_g, ev_out_w, od_in_w, od_conv_w, od_conv_b,
              od_rg_w, od_rg_b, od_ig_w, od_ig_b, od_lam, od_out_w, router_w, router_b,
              ex_w1, ex_w3, ex_w2):
    bsz, seq, d = x.shape
    cond = jax.nn.silu(c)
    for layer in range(DEPTH):
        mod = cond @ mod_w[layer] + mod_b[layer]
        sh1, sc1, g1, sh2, sc2, g2 = [m[:, None, :] for m in jnp.split(mod, 6, axis=-1)]
        h = rms_norm(x, mix_norm_g[layer]) * (1 + sc1) + sh1
        if layer % 2 == 0:
            e = layer // 2
            mix = even_mixer(h, ev_in_w[e], ev_dw_w[e], ev_dw_b[e], ev_ln_g[e], ev_ln_b[e],
                             ev_q_g[e], ev_k_g[e], ev_out_w[e])
        else:
            o = layer // 2
            mix = odd_mixer(h, od_in_w[o], od_conv_w[o], od_conv_b[o], od_rg_w[o], od_rg_b[o],
                            od_ig_w[o], od_ig_b[o], od_lam[o], od_out_w[o])
        x = x + g1 * mix
        h = rms_norm(x, ffn_norm_g[layer]) * (1 + sc2) + sh2
        ffn = moe(h.reshape(bsz * seq, d), router_w, router_b,
                  ex_w1[layer], ex_w3[layer], ex_w2[layer]).reshape(bsz, seq, d)
        x = x + g2 * ffn
    return x
```

```cpp
#include <hip/hip_runtime.h>
#include <cstdio>
#include <cstdint>

#ifndef MK_ONE_LAUNCH
#define MK_ONE_LAUNCH 0
#endif

namespace pg8 {
#define PG8_LAS __attribute__((address_space(3)))
typedef unsigned short bf16_t;
typedef short bf16x8 __attribute__((ext_vector_type(8)));
typedef float f32x4 __attribute__((ext_vector_type(4)));
typedef unsigned u32x4 __attribute__((ext_vector_type(4)));
constexpr int BM = 256, BK = 64, HALF = 128, HTB = HALF * BK * 2  , STAGE_BYTES = 8 * HTB, NXCD = 8, WGM = 8;

__host__ __device__ __forceinline__ int lds_byte(int r, int c) { const int st = (r >> 4) * 2 + (c >> 5), rr = r & 15, cc = c & 31, ob = rr * 64 + cc * 2; return st * 1024 + (ob ^ (((ob >> 9) & 1) << 5)); }
__host__ __device__ __forceinline__ void stage_rc(int b, int& R, int& C) { const int st = b / 1024, sb = b % 1024, swz = sb ^ (((sb >> 9) & 1) << 5); R = (st >> 1) * 16 + swz / 64; C = (st & 1) * 32 + (swz % 64) / 2; }
__host__ __device__ __forceinline__ int perm32(int rho) { const int n = rho >> 4, i = rho & 15; return 8 * (i >> 2) + 4 * n + (i & 3); }

struct Unit { int pm, pn, pb; };
struct Gemm { const bf16_t* A; const bf16_t* Bt; int M, N, K; size_t bstride; };

struct StaticOrder {
    int nM, nN, nwg, G, c;
    __host__ __device__ void init(int M, int N, int G_, int c_) { nM = M / BM; nN = N / BM; nwg = nM * nN; G = G_; c = c_; }
    __host__ __device__ bool next(int i, Unit& u) const {
        const long L = (long)i * G + c; if (L >= nwg) return false;
        int wgid = (int)L; { const int q = nwg / NXCD, r = nwg % NXCD, xcd = wgid % NXCD, off = wgid / NXCD; wgid = (xcd < r ? xcd * (q + 1) : r * (q + 1) + (xcd - r) * q) + off; }
        const int nig = WGM * nN, gid = wgid / nig, fm = gid * WGM, gsz = (nM - fm) < WGM ? (nM - fm) : WGM;
        u.pm = fm + ((wgid % nig) % gsz); u.pn = (wgid % nig) / gsz; u.pb = 0; return true;
    }
    __device__ __forceinline__ void a_ready(const Unit&) const {}
    __device__ __forceinline__ void done(const Unit&) const {}
};

template <class Epi, class Sched, bool ALIGN_EPI = false, bool SP2 = false>
__device__ __forceinline__ void gemm_phase(PG8_LAS unsigned char* lds, const Gemm g, const Sched& S, const Epi& E) {
    int tid_ = threadIdx.x; asm volatile("" : "+v"(tid_));
    const int tid = tid_, wid = __builtin_amdgcn_readfirstlane(tid >> 6), lane = tid & 63, wr = wid >> 2, wc = wid & 3, fr = lane & 15, fq = lane >> 4;
    const int K = g.K, nt = K / BK;
    unsigned voffA[2], voffB[2];
#pragma unroll
    for (int i = 0; i < 2; ++i) { int R, C; stage_rc(tid * 16 + i * 8192, R, C); const int Rb = Epi::PERM ? ((R & ~31) + perm32(R & 31)) : R;
        voffA[i] = (unsigned)(R * K + C) * 2u; voffB[i] = (unsigned)(Rb * K + C) * 2u; }
    const size_t kstep = (size_t)(BK * 2);
    const size_t hstep = (size_t)HALF * K * 2;
    const size_t tstep = 2 * hstep;
    const unsigned ldsw = (unsigned)wid * 1024u;
    const int aoff = lds_byte(wr * 64 + fr, fq * 8), boff = lds_byte(wc * 32 + fr, fq * 8);
#define PG8_SA(b, h) (((b) * 2 + (h)) * HTB)
#define PG8_SB(b, h) ((4 + (b) * 2 + (h)) * HTB)
#define PG8_STAGE(bufoff, gbase, voff) do { _Pragma("unroll") for (int _i = 0; _i < 2; ++_i) \
        __builtin_amdgcn_global_load_lds((const unsigned*)((const char*)(gbase) + (voff)[_i]), (PG8_LAS unsigned*)(lds + (bufoff) + ldsw + _i * 8192), 16, 0, 0); } while (0)
#define PG8_LDA(dst, b, h) do { _Pragma("unroll") for (int m = 0; m < 4; ++m) _Pragma("unroll") for (int k = 0; k < 2; ++k) dst[m][k] = *(const PG8_LAS bf16x8*)(lds + PG8_SA(b, h) + aoff + m * 2048 + k * 1024); } while (0)
#define PG8_LDB(dst, b, h) do { _Pragma("unroll") for (int n = 0; n < 2; ++n) _Pragma("unroll") for (int k = 0; k < 2; ++k) dst[n][k] = *(const PG8_LAS bf16x8*)(lds + PG8_SB(b, h) + boff + n * 2048 + k * 1024); } while (0)
#define PG8_MMA(ai, bj, At, Bt) do { __builtin_amdgcn_s_setprio(1); _Pragma("unroll") for (int m = 0; m < 4; ++m) _Pragma("unroll") for (int n = 0; n < 2; ++n) _Pragma("unroll") for (int k = 0; k < 2; ++k) \
        acc[ai][bj][m][n] = __builtin_amdgcn_mfma_f32_16x16x32_bf16(Bt[n][k], At[m][k], acc[ai][bj][m][n], 0, 0, 0); __builtin_amdgcn_s_setprio(0); } while (0)
#define PG8_WAIT_V(n) asm volatile("s_waitcnt vmcnt(" #n ")" ::: "memory")
#define PG8_WAIT_L(n) asm volatile("s_waitcnt lgkmcnt(" #n ")" ::: "memory")
#define PG8_BAR __builtin_amdgcn_s_barrier()
#define PG8_SCHED __builtin_amdgcn_sched_barrier(0)
    Unit cur, nxt; int ui = 0;
    if (!S.next(0, cur)) return;
    f32x4 acc[2][2][4][2];
#pragma unroll
    for (int a = 0; a < 2; ++a)
#pragma unroll
        for (int b = 0; b < 2; ++b)
#pragma unroll
            for (int m = 0; m < 4; ++m)
#pragma unroll
                for (int n = 0; n < 2; ++n) acc[a][b][m][n] = (f32x4){0.f, 0.f, 0.f, 0.f};
    bf16x8 At[4][2], B0[2][2], B1[2][2];
    const char* cA = (const char*)g.A + (size_t)cur.pm * tstep; const char* cB = (const char*)g.Bt + (size_t)cur.pb * g.bstride + (size_t)cur.pn * tstep;
    S.a_ready(cur);
    if constexpr (SP2) {
        PG8_STAGE(PG8_SB(0, 0), cB, voffB); PG8_STAGE(PG8_SB(0, 1), cB + hstep, voffB); PG8_STAGE(PG8_SA(0, 0), cA, voffA); PG8_STAGE(PG8_SA(0, 1), cA + hstep, voffA);
        if (wr == 1) PG8_BAR;
        PG8_WAIT_V(2); PG8_BAR;
        PG8_STAGE(PG8_SB(1, 0), cB + kstep, voffB); PG8_STAGE(PG8_SA(1, 0), cA + kstep, voffA); PG8_STAGE(PG8_SB(1, 1), cB + hstep + kstep, voffB);
        PG8_WAIT_V(6); PG8_BAR;
    } else {
        PG8_STAGE(PG8_SB(0, 0), cB, voffB); PG8_STAGE(PG8_SA(0, 0), cA, voffA); PG8_STAGE(PG8_SB(0, 1), cB + hstep, voffB); PG8_STAGE(PG8_SA(0, 1), cA + hstep, voffA);
        if (wr == 1) PG8_BAR;
        PG8_WAIT_V(4); PG8_BAR;
        PG8_STAGE(PG8_SB(1, 0), cB + kstep, voffB); PG8_STAGE(PG8_SA(1, 0), cA + kstep, voffA); PG8_STAGE(PG8_SB(1, 1), cB + hstep + kstep, voffB);
        PG8_WAIT_V(6); PG8_BAR;
    }
    for (;;) {
        const bool has_next = S.next(ui + 1, nxt);
        const char* nA = has_next ? (const char*)g.A + (size_t)nxt.pm * tstep : cA; const char* nB = has_next ? (const char*)g.Bt + (size_t)nxt.pb * g.bstride + (size_t)nxt.pn * tstep : cB;
        for (int t = 0; t < nt; t += 2) {
            const bool last = (t == nt - 2);
            const char* a1 = cA + (size_t)(t + 1) * kstep;
            const char* a2 = last ? nA : cA + (size_t)(t + 2) * kstep; const char* b2 = last ? nB : cB + (size_t)(t + 2) * kstep;
            const char* a3 = a2 + kstep; const char* b3 = b2 + kstep;
            if (last && has_next) S.a_ready(nxt);
            if constexpr (SP2) {
            PG8_LDB(B0, 0, 0); PG8_LDB(B1, 0, 1); PG8_SCHED; PG8_LDA(At, 0, 0); PG8_STAGE(PG8_SA(1, 1), a1 + hstep, voffA);
            PG8_WAIT_V(8); PG8_WAIT_L(0); PG8_BAR; PG8_MMA(0, 0, At, B0); PG8_MMA(0, 1, At, B1); PG8_BAR; PG8_SCHED;
            PG8_LDA(At, 0, 1); PG8_STAGE(PG8_SB(0, 0), b2, voffB); PG8_STAGE(PG8_SB(0, 1), b2 + hstep, voffB); PG8_STAGE(PG8_SA(0, 0), a2, voffA);
            PG8_WAIT_V(8); PG8_WAIT_L(0); PG8_BAR; PG8_MMA(1, 0, At, B0); PG8_MMA(1, 1, At, B1); PG8_BAR; PG8_SCHED;
            PG8_LDB(B0, 1, 0); PG8_LDB(B1, 1, 1); PG8_SCHED; PG8_LDA(At, 1, 0); PG8_STAGE(PG8_SA(0, 1), a2 + hstep, voffA);
            PG8_WAIT_V(8); PG8_WAIT_L(0); PG8_BAR; PG8_MMA(0, 0, At, B0); PG8_MMA(0, 1, At, B1); PG8_BAR; PG8_SCHED;
            PG8_LDA(At, 1, 1); PG8_STAGE(PG8_SB(1, 0), b3, voffB); PG8_STAGE(PG8_SB(1, 1), b3 + hstep, voffB); PG8_STAGE(PG8_SA(1, 0), a3, voffA);
            PG8_WAIT_V(8); PG8_WAIT_L(0); PG8_BAR; PG8_MMA(1, 0, At, B0); PG8_MMA(1, 1, At, B1); PG8_BAR; PG8_SCHED;
            } else {
            PG8_LDB(B0, 0, 0); PG8_SCHED; PG8_LDA(At, 0, 0); PG8_STAGE(PG8_SA(1, 1), a1 + hstep, voffA);
            PG8_WAIT_L(8); PG8_BAR; PG8_WAIT_L(0); PG8_MMA(0, 0, At, B0); PG8_BAR; PG8_SCHED;
            PG8_LDB(B1, 0, 1); PG8_STAGE(PG8_SB(0, 0), b2, voffB);
            PG8_BAR; PG8_WAIT_L(0); PG8_MMA(0, 1, At, B1); PG8_BAR;
            PG8_LDA(At, 0, 1); PG8_STAGE(PG8_SA(0, 0), a2, voffA);
            PG8_BAR; PG8_WAIT_L(0); PG8_MMA(1, 0, At, B0); PG8_BAR; PG8_SCHED;
            PG8_STAGE(PG8_SB(0, 1), b2 + hstep, voffB);
            PG8_WAIT_V(6); PG8_BAR; PG8_MMA(1, 1, At, B1); PG8_BAR;
            PG8_LDB(B0, 1, 0); PG8_SCHED; PG8_LDA(At, 1, 0); PG8_STAGE(PG8_SA(0, 1), a2 + hstep, voffA);
            PG8_WAIT_L(8); PG8_BAR; PG8_WAIT_L(0); PG8_MMA(0, 0, At, B0); PG8_BAR; PG8_SCHED;
            PG8_LDB(B1, 1, 1); PG8_STAGE(PG8_SB(1, 0), b3, voffB);
            PG8_BAR; PG8_WAIT_L(0); PG8_MMA(0, 1, At, B1); PG8_BAR;
            PG8_LDA(At, 1, 1); PG8_STAGE(PG8_SA(1, 0), a3, voffA);
            PG8_BAR; PG8_WAIT_L(0); PG8_MMA(1, 0, At, B0); PG8_BAR; PG8_SCHED;
            PG8_STAGE(PG8_SB(1, 1), b3 + hstep, voffB);
            PG8_WAIT_V(6); PG8_BAR; PG8_MMA(1, 1, At, B1); PG8_BAR;
            }
        }
        if constexpr (ALIGN_EPI) { if (wr == 0) PG8_BAR; }
        if constexpr (!Epi::AFTER_DRAIN) { E(acc, cur, wr, wc, fr, fq); S.done(cur); }
        if (!has_next) break;
#pragma unroll
        for (int a = 0; a < 2; ++a)
#pragma unroll
            for (int b = 0; b < 2; ++b)
#pragma unroll
                for (int m = 0; m < 4; ++m)
#pragma unroll
                    for (int n = 0; n < 2; ++n) acc[a][b][m][n] = (f32x4){0.f, 0.f, 0.f, 0.f};
        cur = nxt; cA = nA; cB = nB; ++ui;
        if constexpr (ALIGN_EPI) { if (wr == 1) PG8_BAR; }
    }
    PG8_WAIT_V(0);
    if constexpr (!ALIGN_EPI) { if (wr == 0) PG8_BAR; }
    PG8_BAR;
    if constexpr (Epi::AFTER_DRAIN) { E.fused(acc, cur, wr, wc, fr, fq, lds, wid, lane); S.done(cur); }
#undef PG8_SA
#undef PG8_SB
#undef PG8_STAGE
#undef PG8_LDA
#undef PG8_LDB
#undef PG8_MMA
#undef PG8_WAIT_V
#undef PG8_WAIT_L
#undef PG8_BAR
#undef PG8_SCHED
}
}

constexpr int NB = 32, SEQ = 2048, DM = 1024, T = NB * SEQ;
constexpr int EVIN = 2560, CONVC = 512, CONVW = 31, NHEAD = 8, HD = 64, SBW = 512;
constexpr int NEXP = 16, DFF = 512;
constexpr int MOE_ROWS = 2 * T + NEXP * 256;
constexpr int MOE_TILES = MOE_ROWS / 256;
constexpr float EPS = 1e-6f;
constexpr int NWAVES = 8;

constexpr size_t MiB = 1u << 20;
constexpr size_t WS_CTL = 0, CTL_ZERO_BYTES = 64 * 1024;
constexpr size_t WS_MOD = 1 * MiB;
constexpr size_t WS_META = 3 * MiB;
constexpr size_t META_EID = WS_META, META_GATE = WS_META + 512 * 1024, META_SLOT = WS_META + 1024 * 1024, META_BCNT = WS_META + 1536 * 1024,
                 META_TILEE = META_BCNT + 32 * 1024, META_NT = META_BCNT + 64 * 1024;
constexpr size_t WS_WEVIN = 6 * MiB, WS_WEVOUT = 11 * MiB, WS_WODIN = 13 * MiB, WS_WODOUT = 17 * MiB, WS_WRG = 19 * MiB, WS_WIG = WS_WRG + 512 * 1024;
constexpr size_t WS_W13 = 20 * MiB;
constexpr size_t WS_W2 = 84 * MiB;
constexpr size_t WS_HA = 116 * MiB;
constexpr size_t WS_R1 = 244 * MiB;
constexpr size_t WS_R2 = 508 * MiB;
constexpr size_t WS_END = 640 * MiB;
constexpr int CW_BAR = 4096;

constexpr int RING_BYTES = 131072, LDSCTL_OFF = RING_BYTES, MISC_OFF = LDSCTL_OFF + 320, LDS_BYTES = 147456;

#define GAS __attribute__((address_space(1)))
#define LAS __attribute__((address_space(3)))
typedef unsigned short bf16;
typedef unsigned v4u __attribute__((ext_vector_type(4)));
typedef unsigned v2u __attribute__((ext_vector_type(2)));
typedef float f32x4 __attribute__((ext_vector_type(4)));
typedef float f32x2 __attribute__((ext_vector_type(2)));
typedef float f32x16 __attribute__((ext_vector_type(16)));
typedef short bf16x8 __attribute__((ext_vector_type(8)));
typedef short s16x4 __attribute__((ext_vector_type(4)));
typedef __bf16 bf16x2_t __attribute__((ext_vector_type(2)));
typedef GAS unsigned gu32;
#define RLX_AGENT __ATOMIC_RELAXED, __HIP_MEMORY_SCOPE_AGENT

__device__ __forceinline__ unsigned pk2(float lo, float hi) { f32x2 v = {lo, hi}; bf16x2_t b = __builtin_convertvector(v, bf16x2_t); return __builtin_bit_cast(unsigned, b); }
__device__ __forceinline__ float bflo(unsigned u) { return __uint_as_float(u << 16); }
__device__ __forceinline__ float bfhi(unsigned u) { return __uint_as_float(u & 0xffff0000u); }
__device__ __forceinline__ float bf2f(bf16 b) { return __uint_as_float((unsigned)b << 16); }
__device__ __forceinline__ float fast_exp2(float x) { return __builtin_amdgcn_exp2f(x); }
__device__ __forceinline__ float fast_rcp(float x) { return __builtin_amdgcn_rcpf(x); }
__device__ __forceinline__ float sigmoidf_(float x) { return fast_rcp(1.0f + fast_exp2(-1.4426950408889634f * x)); }
__device__ __forceinline__ float siluf_(float x) { return x * sigmoidf_(x); }
__device__ __forceinline__ float gelu_tanh(float x) { const float u = x + 0.044715f * x * x * x; return x * fast_rcp(1.0f + fast_exp2(-2.3022082f * u)); }
__device__ __forceinline__ float wave_sum(float v) {
#pragma unroll
    for (int o = 1; o < 64; o <<= 1) v += __shfl_xor(v, o);
    return v;
}

#define XB_TMO      128
#define XB_XCNT(j)  (256  + 64 * (j))
#define XB_XSUB(j)  (1280 + 64 * (j))
#define XB_XGEN(j)  (2304 + 64 * (j))
#define XB_TOP      3328
#define XB_TOPGEN   3392
#define XCD_BAR_WORDS 3456
#define XB_SPIN_CAP (1u << 18)

__device__ __forceinline__ unsigned xb_ld(unsigned* p)              { return __hip_atomic_load(p, __ATOMIC_RELAXED, __HIP_MEMORY_SCOPE_AGENT); }
__device__ __forceinline__ unsigned xb_add(unsigned* p, unsigned v) { return __hip_atomic_fetch_add(p, v, __ATOMIC_RELAXED, __HIP_MEMORY_SCOPE_AGENT); }
__device__ __forceinline__ unsigned xb_xcc_id() { return (unsigned)__builtin_amdgcn_s_getreg((3 << 11) | 20) & 0xFu; }
#define XB_SPIN(cond, bar) do { unsigned _sp = 0; while (cond) { __builtin_amdgcn_s_sleep(1); \
    if ((++_sp & 255u) == 0u) { if (xb_ld(&(bar)[XB_TMO])) break; if (_sp > XB_SPIN_CAP) { atomicAdd(&(bar)[XB_TMO], 1u); break; } } } } while (0)

struct XcdBarrier {
    unsigned* bar; unsigned x;
    volatile LAS unsigned* st;
};

__device__ __forceinline__ XcdBarrier xcd_barrier_post(unsigned* bar, volatile LAS unsigned* st) {
    XcdBarrier b; b.bar = bar; b.x = xb_xcc_id(); b.st = st;
    if (threadIdx.x == 0) (void)xb_add(&bar[XB_XCNT(b.x)], 1u);
    return b;
}
__device__ __forceinline__ void xcd_barrier_complete(unsigned* bar, unsigned x, unsigned& nloc, unsigned& nx) {
    const unsigned G = gridDim.x * gridDim.y * gridDim.z;
    unsigned sum, cnt, mine, sp = 0u;
    for (;;) {
        sum = 0u; cnt = 0u; mine = 0u;
#pragma unroll
        for (unsigned j = 0; j < 16; ++j) { const unsigned c = xb_ld(&bar[XB_XCNT(j)]); sum += c; cnt += (c > 0u) ? 1u : 0u; mine = (j == x) ? c : mine; }
        if (sum == G) break;
        __builtin_amdgcn_s_sleep(1);
        if ((++sp & 255u) == 0u) { if (xb_ld(&bar[XB_TMO])) break; if (sp > XB_SPIN_CAP) { atomicAdd(&bar[XB_TMO], 1u); break; } }
    }
    nloc = mine > 0u ? mine : 1u; nx = cnt > 0u ? cnt : 1u;
}

__device__ __forceinline__ void xcd_barrier(const XcdBarrier& b) {
    asm volatile("s_waitcnt vmcnt(0)" ::: "memory");
    __syncthreads();
    if (threadIdx.x == 0) {
        unsigned* bar = b.bar;
        __builtin_amdgcn_s_waitcnt(0);
        unsigned nloc = b.st[0], nx = b.st[1];
        if (nloc == 0u) { xcd_barrier_complete(bar, b.x, nloc, nx); b.st[0] = nloc; b.st[1] = nx; }
        const unsigned old = xb_add(&bar[XB_XSUB(b.x)], 1u);
        const unsigned gen = old / nloc;
        if (old + 1u == (gen + 1u) * nloc) {
            __builtin_amdgcn_fence(__ATOMIC_RELEASE, "agent");
            asm volatile("s_waitcnt vmcnt(0)" ::: "memory");
            const unsigned og = xb_add(&bar[XB_TOP], 1u);
            const unsigned tg = og / nx;
            if (og + 1u == (tg + 1u) * nx) xb_add(&bar[XB_TOPGEN], 1u);
            else XB_SPIN(xb_ld(&bar[XB_TOPGEN]) == tg, bar);
            __builtin_amdgcn_fence(__ATOMIC_ACQUIRE, "agent");
            xb_add(&bar[XB_XGEN(b.x)], 1u);
            asm volatile("s_waitcnt vmcnt(0)" ::: "memory");
        } else {
            XB_SPIN(xb_ld(&bar[XB_XGEN(b.x)]) == gen, bar);
            __builtin_amdgcn_fence(__ATOMIC_ACQUIRE, "agent");
            asm volatile("s_waitcnt vmcnt(0)" ::: "memory");
        }
    }
    __syncthreads();
}


namespace pg8 {
struct EpiEvIn {
    static constexpr bool PERM = true, AFTER_DRAIN = false;
    bf16* U0; bf16* Q; bf16* K; bf16* V; const float* qg; const float* kg;
    __device__ __forceinline__ void operator()(const f32x4 (&acc)[2][2][4][2], const Unit& u, int wr, int wc, int fr, int fq) const {
        const int row0 = u.pm * BM + wr * 64 + fr;
        if (u.pn < 4) {
#pragma unroll
            for (int ai = 0; ai < 2; ++ai)
#pragma unroll
                for (int m = 0; m < 4; ++m) {
                    const size_t row = (size_t)(row0 + ai * HALF + m * 16);
                    const f32x4 v0 = acc[ai][0][m][0], v1 = acc[ai][0][m][1], g0 = acc[ai][1][m][0], g1 = acc[ai][1][m][1];
                    u32x4 w;
                    w.x = pk2(v0[0] * sigmoidf_(g0[0]), v0[1] * sigmoidf_(g0[1])); w.y = pk2(v0[2] * sigmoidf_(g0[2]), v0[3] * sigmoidf_(g0[3]));
                    w.z = pk2(v1[0] * sigmoidf_(g1[0]), v1[1] * sigmoidf_(g1[1])); w.w = pk2(v1[2] * sigmoidf_(g1[2]), v1[3] * sigmoidf_(g1[3]));
                    *(u32x4*)(U0 + row * 512 + u.pn * 128 + wc * 32 + 8 * fq) = w;
                }
        } else if (u.pn < 8) {
            const int sec = (u.pn - 4) >> 1, p = (u.pn - 4) & 1, head = 4 * p + wc;
            const float* gp = sec ? kg : qg; bf16* dst = sec ? K : Q;
            const float scl = sec ? 1.0f : 0.125f * 1.4426950408889634f;
            f32x4 gv[2][2];
#pragma unroll
            for (int bj = 0; bj < 2; ++bj)
#pragma unroll
                for (int n = 0; n < 2; ++n) gv[bj][n] = *(const f32x4*)(gp + 32 * bj + 8 * fq + 4 * n) * scl;
#pragma unroll
            for (int ai = 0; ai < 2; ++ai)
#pragma unroll
                for (int m = 0; m < 4; ++m) {
                    const size_t row = (size_t)(row0 + ai * HALF + m * 16);
                    float ss = 0.f;
#pragma unroll
                    for (int bj = 0; bj < 2; ++bj)
#pragma unroll
                        for (int n = 0; n < 2; ++n) { const f32x4 x = acc[ai][bj][m][n]; ss += (x[0] * x[0] + x[1] * x[1]) + (x[2] * x[2] + x[3] * x[3]); }
                    ss += __shfl_xor(ss, 16); ss += __shfl_xor(ss, 32);
                    const float rstd = __builtin_amdgcn_rsqf(ss * (1.0f / 64.0f) + EPS);
#pragma unroll
                    for (int bj = 0; bj < 2; ++bj) {
                        const f32x4 a = acc[ai][bj][m][0] * rstd * gv[bj][0], b = acc[ai][bj][m][1] * rstd * gv[bj][1];
                        u32x4 w; w.x = pk2(a[0], a[1]); w.y = pk2(a[2], a[3]); w.z = pk2(b[0], b[1]); w.w = pk2(b[2], b[3]);
                        *(u32x4*)(dst + row * 512 + head * 64 + 32 * bj + 8 * fq) = w;
                    }
                }
        } else {
#pragma unroll
            for (int ai = 0; ai < 2; ++ai)
#pragma unroll
                for (int m = 0; m < 4; ++m) {
                    const size_t row = (size_t)(row0 + ai * HALF + m * 16);
#pragma unroll
                    for (int bj = 0; bj < 2; ++bj) {
                        const f32x4 a = acc[ai][bj][m][0], b = acc[ai][bj][m][1];
                        u32x4 w; w.x = pk2(a[0], a[1]); w.y = pk2(a[2], a[3]); w.z = pk2(b[0], b[1]); w.w = pk2(b[2], b[3]);
                        *(u32x4*)(V + row * 512 + (u.pn - 8) * 256 + bj * HALF + wc * 32 + 8 * fq) = w;
                    }
                }
        }
    }
};
struct EpiResid {
    static constexpr bool PERM = false, AFTER_DRAIN = false;
    const float* xin; float* xout; const float* gate;
    __device__ __forceinline__ void operator()(const f32x4 (&acc)[2][2][4][2], const Unit& u, int wr, int wc, int fr, int fq) const {
        const int row0 = u.pm * BM + wr * 64 + fr, col0 = u.pn * BM + wc * 32 + 4 * fq, b = u.pm >> 3;
        f32x4 gv[2][2];
#pragma unroll
        for (int bj = 0; bj < 2; ++bj)
#pragma unroll
            for (int n = 0; n < 2; ++n) gv[bj][n] = *(const f32x4*)(gate + (size_t)b * 6144 + col0 + bj * HALF + n * 16);
#pragma unroll
        for (int ai = 0; ai < 2; ++ai)
#pragma unroll
            for (int m = 0; m < 4; ++m) {
                const size_t off = (size_t)(row0 + ai * HALF + m * 16) * DM + col0;
#pragma unroll
                for (int bj = 0; bj < 2; ++bj)
#pragma unroll
                    for (int n = 0; n < 2; ++n) { const f32x4 xi = *(const f32x4*)(xin + off + bj * HALF + n * 16); *(f32x4*)(xout + off + bj * HALF + n * 16) = xi + gv[bj][n] * acc[ai][bj][m][n]; }
            }
    }
};
struct EpiOdIn {
    static constexpr bool PERM = true, AFTER_DRAIN = false;
    bf16* GY; bf16* XB;
    __device__ __forceinline__ void operator()(const f32x4 (&acc)[2][2][4][2], const Unit& u, int wr, int wc, int fr, int fq) const {
        const int row0 = u.pm * BM + wr * 64 + fr; const bool isy = u.pn < 4;
        bf16* dst = (isy ? GY : XB) + (size_t)(u.pn & 3) * 256 + wc * 32 + 8 * fq;
#pragma unroll
        for (int ai = 0; ai < 2; ++ai)
#pragma unroll
            for (int m = 0; m < 4; ++m) {
                const size_t row = (size_t)(row0 + ai * HALF + m * 16);
#pragma unroll
                for (int bj = 0; bj < 2; ++bj) {
                    f32x4 a = acc[ai][bj][m][0], b = acc[ai][bj][m][1];
                    if (isy) { a = (f32x4){gelu_tanh(a[0]), gelu_tanh(a[1]), gelu_tanh(a[2]), gelu_tanh(a[3])}; b = (f32x4){gelu_tanh(b[0]), gelu_tanh(b[1]), gelu_tanh(b[2]), gelu_tanh(b[3])}; }
                    u32x4 w; w.x = pk2(a[0], a[1]); w.y = pk2(a[2], a[3]); w.z = pk2(b[0], b[1]); w.w = pk2(b[2], b[3]);
                    *(u32x4*)(dst + row * DM + bj * HALF) = w;
                }
            }
    }
};
struct EpiMoeA {
    static constexpr bool PERM = true, AFTER_DRAIN = false;
    bf16* HID;
    __device__ __forceinline__ void operator()(const f32x4 (&acc)[2][2][4][2], const Unit& u, int wr, int wc, int fr, int fq) const {
        const int row0 = u.pm * BM + wr * 64 + fr;
#pragma unroll
        for (int ai = 0; ai < 2; ++ai)
#pragma unroll
            for (int m = 0; m < 4; ++m) {
                const size_t row = (size_t)(row0 + ai * HALF + m * 16);
                const f32x4 a0 = acc[ai][0][m][0], a1 = acc[ai][0][m][1], b0 = acc[ai][1][m][0], b1 = acc[ai][1][m][1];
                u32x4 w;
                w.x = pk2(siluf_(a0[0]) * b0[0], siluf_(a0[1]) * b0[1]); w.y = pk2(siluf_(a0[2]) * b0[2], siluf_(a0[3]) * b0[3]);
                w.z = pk2(siluf_(a1[0]) * b1[0], siluf_(a1[1]) * b1[1]); w.w = pk2(siluf_(a1[2]) * b1[2], siluf_(a1[3]) * b1[3]);
                *(u32x4*)(HID + row * DFF + u.pn * 128 + wc * 32 + 8 * fq) = w;
            }
    }
};
struct EpiMoeB {
    static constexpr bool PERM = true, AFTER_DRAIN = false;
    bf16* Y;
    __device__ __forceinline__ void operator()(const f32x4 (&acc)[2][2][4][2], const Unit& u, int wr, int wc, int fr, int fq) const {
        const int row0 = u.pm * BM + wr * 64 + fr;
#pragma unroll
        for (int ai = 0; ai < 2; ++ai)
#pragma unroll
            for (int m = 0; m < 4; ++m) {
                const size_t row = (size_t)(row0 + ai * HALF + m * 16);
#pragma unroll
                for (int bj = 0; bj < 2; ++bj) {
                    const f32x4 a = acc[ai][bj][m][0], b = acc[ai][bj][m][1];
                    u32x4 w; w.x = pk2(a[0], a[1]); w.y = pk2(a[2], a[3]); w.z = pk2(b[0], b[1]); w.w = pk2(b[2], b[3]);
                    *(u32x4*)(Y + row * DM + u.pn * 256 + bj * HALF + wc * 32 + 8 * fq) = w;
                }
            }
    }
};
struct MoeOrder {
    StaticOrder base; const int* tile_e;
    __device__ __forceinline__ bool next(int i, Unit& u) const { if (!base.next(i, u)) return false; u.pb = tile_e[u.pm]; return true; }
    __device__ __forceinline__ void a_ready(const Unit&) const {}
    __device__ __forceinline__ void done(const Unit&) const {}
};
}

struct Frame {
    LAS unsigned char* lds;
    int tid, lane, wave, vcu, G, bx;
    unsigned char* ws;
};

template <class RowMap>
__device__ __forceinline__ void p0_transpose_item(const float* W, int K, int N, bf16* WT, LAS float* scr, int item, int lane, RowMap rm) {
    const int nblk = N / 32, kb = item / nblk, nb = item % nblk, k0 = 64 * kb, n0 = 32 * nb;
#pragma unroll 8
    for (int i = 0; i < 32; ++i) { const int kk = 2 * i + (lane >> 5); scr[kk * 33 + (lane & 31)] = W[(size_t)(k0 + kk) * N + n0 + (lane & 31)]; }
    asm volatile("s_waitcnt lgkmcnt(0)" ::: "memory");
    const int c = lane & 7;
#pragma unroll
    for (int j = 0; j < 4; ++j) { const int n = (lane >> 3) + 8 * j; const LAS float* s = scr + (8 * c) * 33 + n;
        v4u o; o.x = pk2(s[0 * 33], s[1 * 33]); o.y = pk2(s[2 * 33], s[3 * 33]); o.z = pk2(s[4 * 33], s[5 * 33]); o.w = pk2(s[6 * 33], s[7 * 33]);
        *(GAS v4u*)(WT + (size_t)rm(n0 + n) * K + k0 + 8 * c) = o; }
    asm volatile("s_waitcnt lgkmcnt(0)" ::: "memory");
}
struct RmId { __device__ __forceinline__ int operator()(int n) const { return n; } };
struct RmEvIn { __device__ __forceinline__ int operator()(int n) const {
    if (n < 512) return 256 * (n >> 7) + (n & 127);
    if (n < 1024) { const int m = n - 512; return 256 * (m >> 7) + 128 + (m & 127); }
    if (n < 2048) { const int m = n - 1024, sec = m >> 9, mm = m & 511, p = mm >> 8, r = mm & 255, wc = r >> 6, d = r & 63, bj = d >> 5, j = d & 31;
        return 256 * (4 + 2 * sec + p) + 128 * bj + 32 * wc + j; }
    return n; } };
struct RmGlu { int half; __device__ __forceinline__ int operator()(int n) const { return 256 * (n >> 7) + 128 * half + (n & 127); } };

template <class KAT> __device__ __forceinline__ void p0_prologue(Frame& F, KAT KA) {
#define in KA->in
    LAS float* sc = (LAS float*)F.lds;
    const int w = F.bx, bg = w & 3;
    const float* c = in[1];
    for (int i = F.tid; i < 8 * 1024; i += 512) { const float v = c[(size_t)bg * 8 * 1024 + i]; sc[i] = v / (1.0f + __expf(-v)); }
    __syncthreads();
    if (F.wave < 6) {
        const int chunk = (w >> 2) * 6 + F.wave, l = chunk / 192, cc = chunk % 192, col = cc * 32 + (F.lane & 31), kh = F.lane >> 5;
        const float* W = in[2] + (size_t)l * 1024 * 6144 + col;
        float acc[8];
#pragma unroll
        for (int bb = 0; bb < 8; ++bb) acc[bb] = 0.f;
        for (int k = kh * 512; k < kh * 512 + 512; k += 4) {
            const float w0 = W[(size_t)k * 6144], w1 = W[(size_t)(k + 1) * 6144], w2 = W[(size_t)(k + 2) * 6144], w3 = W[(size_t)(k + 3) * 6144];
#pragma unroll
            for (int bb = 0; bb < 8; ++bb) { const f32x4 s = *(const LAS f32x4*)(sc + bb * 1024 + k); acc[bb] += (s[0] * w0 + s[1] * w1) + (s[2] * w2 + s[3] * w3); }
        }
        float* mod = (float*)(F.ws + WS_MOD);
#pragma unroll
        for (int bb = 0; bb < 8; ++bb) { const float t = acc[bb] + __shfl_xor(acc[bb], 32);
            if (F.lane < 32) mod[((size_t)l * 32 + bg * 8 + bb) * 6144 + col] = t + in[3][(size_t)l * 6144 + col]; }
    }
    __syncthreads();
    LAS float* scr = (LAS float*)(F.lds + 32768 + F.wave * 8448);
    const int gw = F.vcu * NWAVES + F.wave, NGW = F.G * NWAVES;
    bf16* WEVIN = (bf16*)(F.ws + WS_WEVIN); bf16* WEVOUT = (bf16*)(F.ws + WS_WEVOUT); bf16* WODIN = (bf16*)(F.ws + WS_WODIN); bf16* WODOUT = (bf16*)(F.ws + WS_WODOUT);
    bf16* WRG = (bf16*)(F.ws + WS_WRG); bf16* WIG = (bf16*)(F.ws + WS_WIG); bf16* W13 = (bf16*)(F.ws + WS_W13); bf16* W2 = (bf16*)(F.ws + WS_W2);
    constexpr int I_EVIN = 16 * 80, I_SQ = 16 * 32, I_ODIN = 16 * 64, I_W1 = 16 * 16, I_W2 = 8 * 32, I_G = 2 * 4;
    constexpr int NITEMS = I_EVIN + 2 * I_SQ + I_ODIN + 32 * I_W1 * 2 + 32 * I_W2 + 16 * I_G;
    for (int it = gw; it < NITEMS; it += NGW) {
        int r = it;
        if (r < I_EVIN) { p0_transpose_item(in[6], 1024, 2560, WEVIN, scr, r, F.lane, RmEvIn{}); continue; } r -= I_EVIN;
        if (r < I_SQ) { p0_transpose_item(in[13], 1024, 1024, WEVOUT, scr, r, F.lane, RmId{}); continue; } r -= I_SQ;
        if (r < I_ODIN) { p0_transpose_item(in[14], 1024, 2048, WODIN, scr, r, F.lane, RmId{}); continue; } r -= I_ODIN;
        if (r < I_SQ) { p0_transpose_item(in[22], 1024, 1024, WODOUT, scr, r, F.lane, RmId{}); continue; } r -= I_SQ;
        if (r < 32 * I_W1) { const int mat = r / I_W1; p0_transpose_item(in[25] + (size_t)mat * 1024 * 512, 1024, 512, W13 + (size_t)mat * 1024 * 1024, scr, r % I_W1, F.lane, RmGlu{0}); continue; } r -= 32 * I_W1;
        if (r < 32 * I_W1) { const int mat = r / I_W1; p0_transpose_item(in[26] + (size_t)mat * 1024 * 512, 1024, 512, W13 + (size_t)mat * 1024 * 1024, scr, r % I_W1, F.lane, RmGlu{1}); continue; } r -= 32 * I_W1;
        if (r < 32 * I_W2) { const int mat = r / I_W2; p0_transpose_item(in[27] + (size_t)mat * 512 * 1024, 512, 1024, W2 + (size_t)mat * 1024 * 512, scr, r % I_W2, F.lane, RmId{}); continue; } r -= 32 * I_W2;
        { const int mat = r / I_G, which = mat >> 3, blk = mat & 7;
          p0_transpose_item((which ? in[19] : in[17]) + (size_t)blk * 128 * 128, 128, 128, (which ? WIG : WRG) + (size_t)blk * 128 * 128, scr, r % I_G, F.lane, RmId{}); }
    }
#undef in
}

__device__ __forceinline__ void norm_rows(Frame& F, const float* X, bf16* H, const float* ng, const float* modl, int sh_off, int sc_off) {
    const int gw = F.bx * NWAVES + F.wave;
    const int b = gw >> 6;
    f32x4 gm[4], sh[4];
#pragma unroll
    for (int j = 0; j < 4; ++j) { const int k = 256 * j + 4 * F.lane;
        const f32x4 g = *(const f32x4*)(ng + k), s = *(const f32x4*)(modl + (size_t)b * 6144 + sc_off + k);
        gm[j] = g * (s + 1.0f); sh[j] = *(const f32x4*)(modl + (size_t)b * 6144 + sh_off + k); }
    for (int r = 0; r < 32; r += 2) {
        const size_t row = (size_t)gw * 32 + r;
        f32x4 v[2][4]; float ss[2];
#pragma unroll
        for (int q = 0; q < 2; ++q) { ss[q] = 0.f;
#pragma unroll
            for (int j = 0; j < 4; ++j) { v[q][j] = *(const f32x4*)(X + (row + q) * DM + 256 * j + 4 * F.lane); ss[q] += (v[q][j][0] * v[q][j][0] + v[q][j][1] * v[q][j][1]) + (v[q][j][2] * v[q][j][2] + v[q][j][3] * v[q][j][3]); } }
#pragma unroll
        for (int q = 0; q < 2; ++q) {
            const float rstd = 1.0f / sqrtf(wave_sum(ss[q]) * (1.0f / DM) + EPS);
#pragma unroll
            for (int j = 0; j < 4; ++j) { const f32x4 o = v[q][j] * rstd * gm[j] + sh[j];
                v2u w; w.x = pk2(o[0], o[1]); w.y = pk2(o[2], o[3]); *(v2u*)(H + (row + q) * DM + 256 * j + 4 * F.lane) = w; }
        }
    }
}

namespace sba {
constexpr int SLOTB = 8192, L_K = 0, L_V = 2 * SLOTB, L_FLAG = 4 * SLOTB, L_OST = 4 * SLOTB + 256;
__device__ __forceinline__ s16x4 vtr(const LAS unsigned char* p) { typedef short v4i16_t __attribute__((ext_vector_type(4))); return __builtin_bit_cast(s16x4, __builtin_amdgcn_ds_read_tr16_b64_v4i16((LAS v4i16_t*)p)); }
__device__ __forceinline__ void unit(int b, int h, int qb, const bf16* Q, const bf16* K, const bf16* V, bf16* CAT, LAS unsigned char* lds) {
    const int tid = threadIdx.x, lane = tid & 63, r32 = lane & 31, hi = lane >> 5; const int wid = __builtin_amdgcn_readfirstlane(tid >> 6);
    const long rowbase = (long)b * SEQ; const int q0 = qb * 256;
    const bf16* Qw = Q + (rowbase + q0 + wid * 32) * SBW + h * HD;
    const bf16* Kh = K + rowbase * SBW + h * HD; const bf16* Vh = V + rowbase * SBW + h * HD;
    const bf16* ksrc = Kh + (long)lane * SBW + wid * 8;
    const bf16* vsrc = Vh + (long)(16 * (wid & 3) + (lane >> 2)) * SBW + (wid >> 2) * 32 + (lane & 3) * 8;
    LAS unsigned char* kdst = lds + L_K + wid * 1024; LAS unsigned char* vdst = lds + L_V + wid * 1024;
#define SBA_DMA(t, slot) do { __builtin_amdgcn_global_load_lds((const unsigned*)(ksrc + (long)(t) * 64 * SBW), (LAS unsigned*)(kdst + (slot) * SLOTB), 16, 0, 0); \
                              __builtin_amdgcn_global_load_lds((const unsigned*)(vsrc + (long)(t) * 64 * SBW), (LAS unsigned*)(vdst + (slot) * SLOTB), 16, 0, 0); } while (0)
    const LAS unsigned char* kp0 = lds + L_K + hi * 1024 + r32 * 16;
    const LAS unsigned char* vp0 = lds + L_V + ((lane >> 4) & 1) * 32 + (lane & 3) * 8 + (4 * hi + ((lane & 15) >> 2)) * 64;
    volatile LAS unsigned* flags = (volatile LAS unsigned*)(lds + L_FLAG);
    const int NT = (q0 + 256) / 64;
    SBA_DMA(NT - 1, 0);
    bf16x8 qr[4];
#pragma unroll
    for (int d0 = 0; d0 < 4; ++d0) qr[d0] = *(const bf16x8*)(Qw + (long)r32 * SBW + d0 * 16 + hi * 8);
    f32x16 o0 = {}, o1 = {};
    float carry = 1.0f; bool done_w = false;
    const int qrow = q0 + wid * 32 + r32, qmin = q0 + wid * 32;
    for (int it = 0, t = NT - 1; t >= 0; --t, ++it) {
        const int slot = it & 1;
        __syncthreads();
        if (it > 0) { unsigned all = 1u;
#pragma unroll
            for (int w8 = 0; w8 < 8; ++w8) all &= flags[((it - 1) & 1) * 8 + w8];
            if (all) break; }
        if (t > 0) SBA_DMA(t - 1, slot ^ 1);
        const int kbase = 64 * t;
        if (!done_w && kbase < qmin + 31) {
            const LAS unsigned char* kp = kp0 + slot * SLOTB;
            bf16x8 kf[8];
#pragma unroll
            for (int d0 = 0; d0 < 4; ++d0) { kf[2 * d0] = *(const LAS bf16x8*)(kp + d0 * 2048); kf[2 * d0 + 1] = *(const LAS bf16x8*)(kp + d0 * 2048 + 512); }
            f32x16 C0 = {}, C1 = {};
#pragma unroll
            for (int d0 = 0; d0 < 4; ++d0) { C0 = __builtin_amdgcn_mfma_f32_32x32x16_bf16(kf[2 * d0], qr[d0], C0, 0, 0, 0); C1 = __builtin_amdgcn_mfma_f32_32x32x16_bf16(kf[2 * d0 + 1], qr[d0], C1, 0, 0, 0); }
            f32x16 D0, D1;
            const bool partial = (kbase + 64 > qmin);
#pragma unroll
            for (int r = 0; r < 16; ++r) {
                const float s0 = __builtin_fminf(__builtin_fmaxf(C0[r], -120.f), 120.f), s1 = __builtin_fminf(__builtin_fmaxf(C1[r], -120.f), 120.f);
                float e0 = fast_exp2(s0), e1 = fast_exp2(s1);
                float f0 = fast_rcp(1.0f + e0), f1 = fast_rcp(1.0f + e1);
                if (partial) { const int kp_ = kbase + 4 * hi + (r & 3) + 8 * (r >> 2);
                    if (!(kp_ < qrow)) { e0 = 0.f; f0 = 1.f; }
                    if (!(kp_ + 32 < qrow)) { e1 = 0.f; f1 = 1.f; } }
                C0[r] = e0; C1[r] = e1; D0[r] = f0; D1[r] = f1;
            }
            float own[8], par[8], eg[8];
#pragma unroll
            for (int g = 0; g < 4; ++g) {
                D0[4 * g + 2] *= D0[4 * g + 3]; D0[4 * g + 1] *= D0[4 * g + 2]; D0[4 * g] *= D0[4 * g + 1]; own[g] = D0[4 * g];
                D1[4 * g + 2] *= D1[4 * g + 3]; D1[4 * g + 1] *= D1[4 * g + 2]; D1[4 * g] *= D1[4 * g + 1]; own[4 + g] = D1[4 * g];
            }
#pragma unroll
            for (int j = 0; j < 8; ++j) par[j] = __shfl_xor(own[j], 32);
            float sp = carry;
#pragma unroll
            for (int j = 7; j >= 0; --j) { eg[j] = hi ? sp : sp * par[j]; sp *= own[j] * par[j]; }
            carry = sp;
#pragma unroll
            for (int g = 0; g < 4; ++g)
#pragma unroll
                for (int i = 0; i < 4; ++i) { C0[4 * g + i] = (C0[4 * g + i] * D0[4 * g + i]) * eg[g]; C1[4 * g + i] = (C1[4 * g + i] * D1[4 * g + i]) * eg[4 + g]; }
            v4u pw0, pw1, pw2, pw3;
            pw0 = (v4u){pk2(C0[0], C0[1]), pk2(C0[2], C0[3]), pk2(C0[4], C0[5]), pk2(C0[6], C0[7])};
            pw1 = (v4u){pk2(C0[8], C0[9]), pk2(C0[10], C0[11]), pk2(C0[12], C0[13]), pk2(C0[14], C0[15])};
            pw2 = (v4u){pk2(C1[0], C1[1]), pk2(C1[2], C1[3]), pk2(C1[4], C1[5]), pk2(C1[6], C1[7])};
            pw3 = (v4u){pk2(C1[8], C1[9]), pk2(C1[10], C1[11]), pk2(C1[12], C1[13]), pk2(C1[14], C1[15])};
            const LAS unsigned char* vp = vp0 + slot * SLOTB;
#pragma unroll
            for (int d0 = 0; d0 < 2; ++d0) {
                s16x4 lo[4], hh[4];
#pragma unroll
                for (int ks = 0; ks < 4; ++ks) { lo[ks] = vtr(vp + d0 * 4096 + ks * 1024); hh[ks] = vtr(vp + d0 * 4096 + ks * 1024 + 512); }
#define SBA_VF(k) (bf16x8){lo[k][0], lo[k][1], lo[k][2], lo[k][3], hh[k][0], hh[k][1], hh[k][2], hh[k][3]}
                f32x16 oo = d0 ? o1 : o0;
                oo = __builtin_amdgcn_mfma_f32_32x32x16_bf16(__builtin_bit_cast(bf16x8, pw0), SBA_VF(0), oo, 0, 0, 0);
                oo = __builtin_amdgcn_mfma_f32_32x32x16_bf16(__builtin_bit_cast(bf16x8, pw1), SBA_VF(1), oo, 0, 0, 0);
                oo = __builtin_amdgcn_mfma_f32_32x32x16_bf16(__builtin_bit_cast(bf16x8, pw2), SBA_VF(2), oo, 0, 0, 0);
                oo = __builtin_amdgcn_mfma_f32_32x32x16_bf16(__builtin_bit_cast(bf16x8, pw3), SBA_VF(3), oo, 0, 0, 0);
                if (d0) o1 = oo; else o0 = oo;
#undef SBA_VF
            }
            done_w = __all(carry < 1e-30f);
        }
        if (lane == 0) flags[slot * 8 + wid] = done_w ? 1u : 0u;
    }
    {
        LAS bf16* stg = (LAS bf16*)(lds + L_OST) + wid * 2048;
#pragma unroll
        for (int r = 0; r < 16; ++r) { const int orow = (r & 3) + 8 * (r >> 2) + 4 * hi;
            stg[orow * 64 + r32] = (bf16)(pk2(o0[r], 0.f) & 0xffffu); stg[orow * 64 + 32 + r32] = (bf16)(pk2(o1[r], 0.f) & 0xffffu); }
        asm volatile("s_waitcnt lgkmcnt(0)" ::: "memory");
        bf16* Ow = CAT + (rowbase + q0 + wid * 32) * DM + 512 + h * HD;
#pragma unroll
        for (int i = 0; i < 4; ++i) { const int row = i * 8 + (lane >> 3), ch = lane & 7; const v4u v = *(const LAS v4u*)(stg + row * 64 + ch * 8); *(v4u*)(Ow + (long)row * DM + ch * 8) = v; }
    }
    __syncthreads();
#undef SBA_DMA
}
}

__device__ __forceinline__ void conv_unit(Frame& F, int b, int tt, const bf16* U0, bf16* CAT, const float* dw_w, const float* dw_b, const float* ln_g, const float* ln_b) {
    const int t0 = tt * 32;
    LAS unsigned char* tile = F.lds;
    LAS float* resl = (LAS float*)(F.lds + 63488);
    for (int idx = F.tid; idx < 62 * 64; idx += 512) {
        const int ri = idx >> 6, ch = idx & 63, tok = t0 - 30 + ri;
        v4u v = {0u, 0u, 0u, 0u};
        if (tok >= 0) v = *(const v4u*)(U0 + ((size_t)b * SEQ + tok) * CONVC + ch * 8);
        *(LAS v4u*)(tile + ri * 1024 + ch * 16) = v;
    }
    __syncthreads();
    {
        const int cp = F.tid & 255, th = F.tid >> 8;
        float w0[31], w1[31];
#pragma unroll
        for (int k = 0; k < 31; ++k) { const f32x2 wv = *(const f32x2*)(dw_w + k * CONVC + 2 * cp); w0[k] = wv[0]; w1[k] = wv[1]; }
        const f32x2 bias = *(const f32x2*)(dw_b + 2 * cp);
#pragma unroll 1
        for (int og = 0; og < 2; ++og) {
            float a0[8], a1[8];
#pragma unroll
            for (int o = 0; o < 8; ++o) { a0[o] = bias[0]; a1[o] = bias[1]; }
            const LAS unsigned char* tp = tile + (16 * th + 8 * og) * 1024 + cp * 4;
#pragma unroll
            for (int j = 0; j < 38; ++j) {
                const unsigned xin = *(const LAS unsigned*)(tp + j * 1024);
                const float x0 = bflo(xin), x1 = bfhi(xin);
#pragma unroll
                for (int o = 0; o < 8; ++o) { const int k = j - o; if (k >= 0 && k <= 30) { a0[o] += w0[k] * x0; a1[o] += w1[k] * x1; } }
            }
#pragma unroll
            for (int o = 0; o < 8; ++o) *(LAS f32x2*)(resl + (16 * th + 8 * og + o) * 512 + 2 * cp) = (f32x2){a0[o], a1[o]};
        }
    }
    __syncthreads();
    {
        const f32x4 lg0 = *(const f32x4*)(ln_g + 8 * F.lane), lg1 = *(const f32x4*)(ln_g + 8 * F.lane + 4), lb0 = *(const f32x4*)(ln_b + 8 * F.lane), lb1 = *(const f32x4*)(ln_b + 8 * F.lane + 4);
#pragma unroll
        for (int i = 0; i < 4; ++i) {
            const int tk = F.wave * 4 + i;
            const f32x4 v0 = *(const LAS f32x4*)(resl + tk * 512 + 8 * F.lane), v1 = *(const LAS f32x4*)(resl + tk * 512 + 8 * F.lane + 4);
            const float s = wave_sum((v0[0] + v0[1]) + (v0[2] + v0[3]) + (v1[0] + v1[1]) + (v1[2] + v1[3]));
            const float mean = s * (1.0f / CONVC);
            const f32x4 d0 = v0 - mean, d1 = v1 - mean;
            const float q = wave_sum((d0[0] * d0[0] + d0[1] * d0[1]) + (d0[2] * d0[2] + d0[3] * d0[3]) + (d1[0] * d1[0] + d1[1] * d1[1]) + (d1[2] * d1[2] + d1[3] * d1[3]));
            const float rstd = 1.0f / sqrtf(q * (1.0f / CONVC) + EPS);
            const f32x4 y0 = d0 * rstd * lg0 + lb0, y1 = d1 * rstd * lg1 + lb1;
            v4u pw; pw.x = pk2(siluf_(y0[0]), siluf_(y0[1])); pw.y = pk2(siluf_(y0[2]), siluf_(y0[3])); pw.z = pk2(siluf_(y1[0]), siluf_(y1[1])); pw.w = pk2(siluf_(y1[2]), siluf_(y1[3]));
            *(v4u*)(CAT + ((size_t)b * SEQ + t0 + tk) * DM + 8 * F.lane) = pw;
        }
    }
    __syncthreads();
}

__device__ __forceinline__ void lru_unit(Frame& F, int b, int cb, const bf16* GY, const bf16* XB, bf16* CAT2, const bf16* WRG, const bf16* WIG,
                                         const float* conv_w, const float* conv_b, const float* rg_b, const float* ig_b, const float* lam) {
    constexpr int L_XR = 0, L_XC = 17408, L_GY = 34816, L_OUT = 51200;
    LAS unsigned char* lds = F.lds;
    const int lane = F.lane, wv = F.wave, l15 = lane & 15, g4 = lane >> 4;
    const int cl_ = 16 * wv + l15, cglob = cb * 128 + cl_;
    bf16x8 brg[4], big[4];
#pragma unroll
    for (int ks = 0; ks < 4; ++ks) { brg[ks] = *(const bf16x8*)(WRG + ((size_t)cb * 128 + cl_) * 128 + 32 * ks + 8 * g4); big[ks] = *(const bf16x8*)(WIG + ((size_t)cb * 128 + cl_) * 128 + 32 * ks + 8 * g4); }
    const float rb = rg_b[cglob], ib = ig_b[cglob];
    const float lamv = lam[cglob];
    const float cl2 = -8.0f * log1pf(expf(-lamv)) * 1.4426950408889634f;
    const int cp2 = F.tid & 63;
    float cw0[4], cw1[4];
#pragma unroll
    for (int k = 0; k < 4; ++k) { const f32x2 w = *(const f32x2*)(conv_w + k * DM + cb * 128 + 2 * cp2); cw0[k] = w[0]; cw1[k] = w[1]; }
    const f32x2 cbias = *(const f32x2*)(conv_b + cb * 128 + 2 * cp2);
    const size_t rowb = (size_t)b * SEQ;
    v4u px[3], pg[2];
#define LRU_PREFETCH(t0_) do { \
        _Pragma("unroll") for (int i = 0; i < 3; ++i) { const int idx = F.tid + 512 * i; px[i] = (v4u){0u, 0u, 0u, 0u}; \
            if (idx < 67 * 16) { const int ri = idx >> 4, chn = idx & 15, tok = (t0_) - 3 + ri; if (tok >= 0) px[i] = *(const v4u*)(XB + (rowb + tok) * DM + cb * 128 + chn * 8); } } \
        _Pragma("unroll") for (int i = 0; i < 2; ++i) { const int idx = F.tid + 512 * i; const int ri = idx >> 4, chn = idx & 15; pg[i] = *(const v4u*)(GY + (rowb + (t0_) + ri) * DM + cb * 128 + chn * 8); } } while (0)
    LRU_PREFETCH(0);
    float carry = 0.f;
    for (int it = 0; it < SEQ / 64; ++it) {
        const int t0 = it * 64;
#pragma unroll
        for (int i = 0; i < 3; ++i) { const int idx = F.tid + 512 * i; if (idx < 67 * 16) *(LAS v4u*)(lds + L_XR + idx * 16) = px[i]; }
#pragma unroll
        for (int i = 0; i < 2; ++i) { const int idx = F.tid + 512 * i; *(LAS v4u*)(lds + L_GY + idx * 16) = pg[i]; }
        __syncthreads();
        if (it + 1 < SEQ / 64) LRU_PREFETCH(t0 + 64);
        {
            float x0[11], x1[11];
#pragma unroll
            for (int j = 0; j < 11; ++j) { const unsigned xin = *(const LAS unsigned*)(lds + L_XR + (8 * wv + j) * 256 + cp2 * 4); x0[j] = bflo(xin); x1[j] = bfhi(xin); }
#pragma unroll
            for (int o = 0; o < 8; ++o) {
                const float y0 = cbias[0] + (cw0[0] * x0[o] + cw0[1] * x0[o + 1]) + (cw0[2] * x0[o + 2] + cw0[3] * x0[o + 3]);
                const float y1 = cbias[1] + (cw1[0] * x1[o] + cw1[1] * x1[o + 1]) + (cw1[2] * x1[o + 2] + cw1[3] * x1[o + 3]);
                *(LAS unsigned*)(lds + L_XC + (8 * wv + o) * 272 + cp2 * 4) = pk2(y0, y1);
            }
        }
        __syncthreads();
#pragma unroll
        for (int m = 0; m < 4; ++m) {
            f32x4 aR = {0.f, 0.f, 0.f, 0.f}, aI = {0.f, 0.f, 0.f, 0.f};
#pragma unroll
            for (int ks = 0; ks < 4; ++ks) { const bf16x8 af = *(const LAS bf16x8*)(lds + L_XC + (16 * m + l15) * 272 + (32 * ks + 8 * g4) * 2);
                aR = __builtin_amdgcn_mfma_f32_16x16x32_bf16(af, brg[ks], aR, 0, 0, 0); aI = __builtin_amdgcn_mfma_f32_16x16x32_bf16(af, big[ks], aI, 0, 0, 0); }
            float av[4], bv[4], gy[4];
            float A = 1.f, B = 0.f;
#pragma unroll
            for (int r = 0; r < 4; ++r) {
                const int tk = 16 * m + 4 * g4 + r;
                const float xcv = bf2f(*(const LAS bf16*)(lds + L_XC + tk * 272 + cl_ * 2));
                gy[r] = bf2f(*(const LAS bf16*)(lds + L_GY + tk * 256 + cl_ * 2));
                const float rr = sigmoidf_(aR[r] + rb), ii = sigmoidf_(aI[r] + ib);
                const float a = fast_exp2(cl2 * rr);
                const float mult = sqrtf(__builtin_fmaxf(1.0f - a * a, 0.f));
                av[r] = a; bv[r] = mult * ii * xcv;
                B = a * B + bv[r]; A = A * a;
            }
            { const float Ap = __shfl_up(A, 16), Bp = __shfl_up(B, 16); if (g4 >= 1) { B = A * Bp + B; A = A * Ap; } }
            { const float Ap = __shfl_up(A, 32), Bp = __shfl_up(B, 32); if (g4 >= 2) { B = A * Bp + B; A = A * Ap; } }
            const float hend = A * carry + B;
            const float hprev = __shfl_up(hend, 16);
            float hcur = (g4 == 0) ? carry : hprev;
            carry = __shfl(hend, 48 + l15);
#pragma unroll
            for (int r = 0; r < 4; ++r) { hcur = av[r] * hcur + bv[r]; const int tk = 16 * m + 4 * g4 + r;
                *(LAS bf16*)(lds + L_OUT + tk * 256 + cl_ * 2) = (bf16)(pk2(gy[r] * hcur, 0.f) & 0xffffu); }
        }
        __syncthreads();
#pragma unroll
        for (int i = 0; i < 2; ++i) { const int idx = F.tid + 512 * i; const int ri = idx >> 4, chn = idx & 15;
            *(v4u*)(CAT2 + (rowb + t0 + ri) * DM + cb * 128 + chn * 8) = *(const LAS v4u*)(lds + L_OUT + idx * 16); }
    }
    __syncthreads();
#undef LRU_PREFETCH
}

__device__ __forceinline__ void router_phase(Frame& F, const float* X, bf16* H, const float* ng, const float* modl, const float* rw, const float* rbias) {
    LAS float* wrt = (LAS float*)F.lds;
    LAS float* gml = (LAS float*)(F.lds + 65536);
    LAS float* shl = (LAS float*)(F.lds + 69632);
    LAS float* brl = (LAS float*)(F.lds + 73728);
    LAS int* cnt = (LAS int*)(F.lds + 73728 + 64);
    const int w = F.bx, b = w >> 3;
    for (int i = F.tid; i < 16 * 1024; i += 512) { const int k = i >> 4, e = i & 15; wrt[e * 1024 + k] = rw[i]; }
    for (int k = F.tid; k < 1024; k += 512) { gml[k] = ng[k] * (1.0f + modl[(size_t)b * 6144 + 4 * 1024 + k]); shl[k] = modl[(size_t)b * 6144 + 3 * 1024 + k]; }
    if (F.tid < 16) cnt[F.tid] = 0;
    __syncthreads();
    if (F.wave == 0) {
        float acc[16];
#pragma unroll
        for (int e = 0; e < 16; ++e) acc[e] = 0.f;
        for (int k = F.lane; k < 1024; k += 64) { const float s = shl[k];
#pragma unroll
            for (int e = 0; e < 16; ++e) acc[e] += s * wrt[e * 1024 + k]; }
#pragma unroll
        for (int e = 0; e < 16; ++e) { const float t = wave_sum(acc[e]); if (F.lane == 0) brl[e] = t; }
    }
    __syncthreads();
    const int sub = F.lane & 15, rsel = F.lane >> 4;
    int* EID = (int*)(F.ws + META_EID); float* GATE = (float*)(F.ws + META_GATE);
    for (int pass = 0; pass < 8; ++pass) {
        const size_t row = (size_t)w * 256 + F.wave * 32 + pass * 4 + rsel;
        f32x4 xg[16]; float ss = 0.f; float acc[16];
#pragma unroll
        for (int e = 0; e < 16; ++e) acc[e] = 0.f;
#pragma unroll
        for (int c = 0; c < 16; ++c) {
            const int k = 64 * c + 4 * sub;
            const f32x4 x = *(const f32x4*)(X + row * DM + k);
            ss += (x[0] * x[0] + x[1] * x[1]) + (x[2] * x[2] + x[3] * x[3]);
            xg[c] = x * *(const LAS f32x4*)(gml + k);
#pragma unroll
            for (int e = 0; e < 16; ++e) { const f32x4 wv = *(const LAS f32x4*)(wrt + e * 1024 + k); acc[e] += (xg[c][0] * wv[0] + xg[c][1] * wv[1]) + (xg[c][2] * wv[2] + xg[c][3] * wv[3]); }
        }
#pragma unroll
        for (int o = 1; o < 16; o <<= 1) { ss += __shfl_xor(ss, o);
#pragma unroll
            for (int e = 0; e < 16; ++e) acc[e] += __shfl_xor(acc[e], o); }
        const float rstd = 1.0f / sqrtf(ss * (1.0f / DM) + EPS);
#pragma unroll
        for (int c = 0; c < 16; ++c) { const int k = 64 * c + 4 * sub; const f32x4 o = xg[c] * rstd + *(const LAS f32x4*)(shl + k);
            v2u pw; pw.x = pk2(o[0], o[1]); pw.y = pk2(o[2], o[3]); *(v2u*)(H + row * DM + k) = pw; }
        float sc[16], bi[16];
#pragma unroll
        for (int e = 0; e < 16; ++e) { const float lg = acc[e] * rstd + brl[e]; sc[e] = 1.0f / (1.0f + __expf(-lg)); bi[e] = sc[e] + rbias[e]; }
        int gbest = 0; float gsb = -1e30f;
#pragma unroll
        for (int g = 0; g < 4; ++g) {
            float m1 = bi[4 * g], m2 = -1e30f;
#pragma unroll
            for (int i = 1; i < 4; ++i) { const float v = bi[4 * g + i]; if (v > m1) { m2 = m1; m1 = v; } else if (v > m2) m2 = v; }
            const float gs = m1 + m2; if (gs > gsb) { gsb = gs; gbest = g; }
        }
        float v4[4], s4[4];
#pragma unroll
        for (int i = 0; i < 4; ++i) { v4[i] = gbest == 0 ? bi[i] : gbest == 1 ? bi[4 + i] : gbest == 2 ? bi[8 + i] : bi[12 + i]; s4[i] = gbest == 0 ? sc[i] : gbest == 1 ? sc[4 + i] : gbest == 2 ? sc[8 + i] : sc[12 + i]; }
        int i1 = 0;
#pragma unroll
        for (int i = 1; i < 4; ++i) if (v4[i] > v4[i1]) i1 = i;
        int i2 = (i1 == 0) ? 1 : 0;
#pragma unroll
        for (int i = 0; i < 4; ++i) if (i != i1 && i != i2 && v4[i] > v4[i2]) i2 = i;
        const float se1 = i1 == 0 ? s4[0] : i1 == 1 ? s4[1] : i1 == 2 ? s4[2] : s4[3], se2 = i2 == 0 ? s4[0] : i2 == 1 ? s4[1] : i2 == 2 ? s4[2] : s4[3];
        if (sub == 0) {
            const int e1 = 4 * gbest + i1, e2 = 4 * gbest + i2; const float inv = 1.0f / (se1 + se2);
            EID[row * 2] = e1; EID[row * 2 + 1] = e2; GATE[row * 2] = se1 * inv; GATE[row * 2 + 1] = se2 * inv;
            atomicAdd((int*)&cnt[e1], 1); atomicAdd((int*)&cnt[e2], 1);
        }
    }
    __syncthreads();
    if (F.tid < 16) ((int*)(F.ws + META_BCNT))[w * 16 + F.tid] = cnt[F.tid];
    __syncthreads();
}

__device__ __forceinline__ void slot_phase(Frame& F, const bf16* H, bf16* XS) {
    LAS int* cn = (LAS int*)F.lds;
    LAS int* mybase = (LAS int*)(F.lds + 16384);
    LAS int* tot = (LAS int*)(F.lds + 16384 + 64);
    LAS int* cursor = (LAS int*)(F.lds + 16384 + 128);
    const int w = F.bx;
    const int* BC = (const int*)(F.ws + META_BCNT);
    for (int i = F.tid; i < 4096; i += 512) cn[i] = BC[i];
    __syncthreads();
    if (F.tid < 16) { int run = 0, mb = 0; for (int j = 0; j < 256; ++j) { if (j == w) mb = run; run += cn[j * 16 + F.tid]; } mybase[F.tid] = mb; tot[F.tid] = run; }
    __syncthreads();
    if (F.tid == 0) {
        int ps = 0; int* TE = (int*)(F.ws + META_TILEE);
        for (int e = 0; e < 16; ++e) { const int padded = (tot[e] + 255) & ~255; cursor[e] = ps + mybase[e];
            if (w == 0) for (int tl = ps >> 8; tl < (ps + padded) >> 8; ++tl) TE[tl] = e;
            ps += padded; }
        if (w == 0) *(int*)(F.ws + META_NT) = ps >> 8;
    }
    __syncthreads();
    const int* EID = (const int*)(F.ws + META_EID); int* SLOT = (int*)(F.ws + META_SLOT);
    for (int i = 0; i < 32; i += 2) {
        const size_t t0 = (size_t)w * 256 + F.wave * 32 + i;
        int s[2][2];
#pragma unroll
        for (int q = 0; q < 2; ++q) {
            int s0 = 0, s1 = 0;
            if (F.lane == 0) { const int e0 = EID[(t0 + q) * 2], e1 = EID[(t0 + q) * 2 + 1]; s0 = atomicAdd((int*)&cursor[e0], 1); s1 = atomicAdd((int*)&cursor[e1], 1); SLOT[(t0 + q) * 2] = s0; SLOT[(t0 + q) * 2 + 1] = s1; }
            s[q][0] = __builtin_amdgcn_readfirstlane(s0); s[q][1] = __builtin_amdgcn_readfirstlane(s1);
        }
#pragma unroll
        for (int q = 0; q < 2; ++q) {
            const v4u a = *(const v4u*)(H + (t0 + q) * DM + F.lane * 8), c = *(const v4u*)(H + (t0 + q) * DM + 512 + F.lane * 8);
            *(v4u*)(XS + (size_t)s[q][0] * DM + F.lane * 8) = a; *(v4u*)(XS + (size_t)s[q][0] * DM + 512 + F.lane * 8) = c;
            *(v4u*)(XS + (size_t)s[q][1] * DM + F.lane * 8) = a; *(v4u*)(XS + (size_t)s[q][1] * DM + 512 + F.lane * 8) = c;
        }
    }
    __syncthreads();
}

template <bool NEXT>
__device__ __forceinline__ void combine_phase(Frame& F, float* X, const bf16* Y, const float* modl  , bf16* H, const float* ng_next, const float* modn  ) {
    const int gw = F.bx * NWAVES + F.wave, b = gw >> 6;
    const int* SLOT = (const int*)(F.ws + META_SLOT); const float* GATE = (const float*)(F.ws + META_GATE);
    f32x4 g2[4], gm[4], sh[4];
#pragma unroll
    for (int j = 0; j < 4; ++j) { const int k = 256 * j + 4 * F.lane; g2[j] = *(const f32x4*)(modl + (size_t)b * 6144 + 5 * 1024 + k);
        if (NEXT) { const f32x4 g = *(const f32x4*)(ng_next + k), s = *(const f32x4*)(modn + (size_t)b * 6144 + 1 * 1024 + k); gm[j] = g * (s + 1.0f); sh[j] = *(const f32x4*)(modn + (size_t)b * 6144 + k); } }
    for (int r = 0; r < 32; ++r) {
        const size_t row = (size_t)gw * 32 + r;
        const int s0 = SLOT[row * 2], s1 = SLOT[row * 2 + 1]; const float ga = GATE[row * 2], gb = GATE[row * 2 + 1];
        f32x4 v[4]; float ss = 0.f;
#pragma unroll
        for (int j = 0; j < 4; ++j) { const int k = 256 * j + 4 * F.lane;
            const f32x4 x = *(const f32x4*)(X + row * DM + k);
            const v2u ya = *(const v2u*)(Y + (size_t)s0 * DM + k), yb = *(const v2u*)(Y + (size_t)s1 * DM + k);
            f32x4 f; f[0] = ga * bflo(ya.x) + gb * bflo(yb.x); f[1] = ga * bfhi(ya.x) + gb * bfhi(yb.x); f[2] = ga * bflo(ya.y) + gb * bflo(yb.y); f[3] = ga * bfhi(ya.y) + gb * bfhi(yb.y);
            v[j] = x + g2[j] * f;
            *(f32x4*)(X + row * DM + k) = v[j];
            ss += (v[j][0] * v[j][0] + v[j][1] * v[j][1]) + (v[j][2] * v[j][2] + v[j][3] * v[j][3]); }
        if (NEXT) {
            const float rstd = 1.0f / sqrtf(wave_sum(ss) * (1.0f / DM) + EPS);
#pragma unroll
            for (int j = 0; j < 4; ++j) { const f32x4 o = v[j] * rstd * gm[j] + sh[j]; v2u pw; pw.x = pk2(o[0], o[1]); pw.y = pk2(o[2], o[3]); *(v2u*)(H + row * DM + 256 * j + 4 * F.lane) = pw; }
        }
    }
}

constexpr int NPHASE = 18;
struct Args { const float* in[28]; float* out; unsigned char* ws; int ph_lo, ph_hi; };
template <int PLO, int PHI> __global__ void __launch_bounds__(NWAVES * 64, 2) mk_fwd(Args args) {
    extern __shared__ __attribute__((aligned(16))) unsigned char lds_raw[];
    Frame F;
    F.lds = (LAS unsigned char*)lds_raw;
    F.tid = threadIdx.x; F.lane = F.tid & 63; F.wave = __builtin_amdgcn_readfirstlane(F.tid >> 6);
    F.G = gridDim.x; F.bx = blockIdx.x; F.vcu = (F.G % 8 == 0) ? (F.bx % 8) * (F.G / 8) + F.bx / 8 : F.bx;
    F.ws = args.ws;
    volatile LAS unsigned* MISC = (volatile LAS unsigned*)(F.lds + MISC_OFF);
    for (int u = F.tid; u < (LDS_BYTES - LDSCTL_OFF) / 4; u += NWAVES * 64) ((LAS unsigned*)(F.lds + LDSCTL_OFF))[u] = 0u;
    __syncthreads();
#if MK_ONE_LAUNCH
    XcdBarrier bar = xcd_barrier_post((unsigned*)(F.ws + WS_CTL) + CW_BAR, MISC + 8);
#define GRID_BAR() do { XcdBarrier b_ = bar; asm volatile("" : "+s"(b_.bar), "+s"(b_.x)); xcd_barrier(b_); } while (0)
#else
#define GRID_BAR() do {} while (0)
#endif
    constexpr int lo = PLO, hi = PHI;
#ifndef PHASE_MASK
#define PHASE_MASK 0x3ffff
#endif
#define IN(k) ((((PHASE_MASK) >> (k)) & 1) && lo <= (k) && (k) < hi)
#define SEAM(k) do { if (IN(k) && IN((k) + 1)) GRID_BAR(); } while (0)
    typedef const __attribute__((address_space(4))) Args* KArgs; KArgs KA = (KArgs)__builtin_amdgcn_kernarg_segment_ptr();
#define in KA->in
#define PHASE_ENTER() do { KA = (KArgs)__builtin_amdgcn_kernarg_segment_ptr(); asm volatile("" : "+s"(KA)); F.ws = KA->ws; int tid_o = threadIdx.x; asm volatile("" : "+v"(tid_o)); F.tid = tid_o; F.lane = tid_o & 63; F.wave = __builtin_amdgcn_readfirstlane(tid_o >> 6); } while (0)
#define P_MOD ((float*)(F.ws + WS_MOD))
#define P_HA ((bf16*)(F.ws + WS_HA))
#define P_U0 ((bf16*)(F.ws + WS_R1))
#define P_Q (P_U0 + (size_t)T * 512)
#define P_K (P_U0 + (size_t)2 * T * 512)
#define P_V (P_U0 + (size_t)3 * T * 512)
#define P_GY ((bf16*)(F.ws + WS_R1))
#define P_XB (P_GY + (size_t)T * DM)
#define P_XS ((bf16*)(F.ws + WS_R1))
#define P_Y P_XS
#define P_CAT ((bf16*)(F.ws + WS_R2))
#define P_HID P_CAT

    if (IN(0)) { PHASE_ENTER(); p0_prologue(F, KA); } SEAM(0);
    if (IN(1)) { PHASE_ENTER(); norm_rows(F, in[0], P_HA, in[4], P_MOD, 0, 1024); } SEAM(1);
    if (IN(2)) { PHASE_ENTER();
        pg8::Gemm g{P_HA, (const bf16*)(F.ws + WS_WEVIN), T, EVIN, DM, 0}; pg8::StaticOrder S; S.init(T, EVIN, F.G, F.bx);
        pg8::EpiEvIn E{P_U0, P_Q, P_K, P_V, in[11], in[12]};
        pg8::gemm_phase<pg8::EpiEvIn, pg8::StaticOrder, true, true>(F.lds, g, S, E);
    } SEAM(2);
    if (IN(3)) { PHASE_ENTER();
#ifndef NO_ATTN
        { const int bh = F.vcu; for (int qb = 7; qb >= 0; --qb) sba::unit(bh >> 3, bh & 7, qb, P_Q, P_K, P_V, P_CAT, F.lds); }
#endif
#ifndef NO_CONV
        for (int uidx = F.vcu; uidx < NB * (SEQ / 32); uidx += F.G) conv_unit(F, uidx >> 6, uidx & 63, P_U0, P_CAT, in[7], in[8], in[9], in[10]);
#endif
    } SEAM(3);
    if (IN(4)) { PHASE_ENTER();
        pg8::Gemm g{P_CAT, (const bf16*)(F.ws + WS_WEVOUT), T, DM, DM, 0}; pg8::StaticOrder S; S.init(T, DM, F.G, F.bx);
        pg8::EpiResid E{in[0], KA->out, P_MOD + 2 * 1024};
        pg8::gemm_phase<pg8::EpiResid, pg8::StaticOrder, true, true>(F.lds, g, S, E);
    } SEAM(4);
#define MOE_PHASES(layer, p0) \
    if (IN(p0)) { PHASE_ENTER(); router_phase(F, KA->out, P_HA, in[5] + (layer) * DM, P_MOD + (size_t)(layer) * 32 * 6144, in[23], in[24]); } SEAM(p0); \
    if (IN((p0) + 1)) { PHASE_ENTER(); slot_phase(F, P_HA, P_XS); } SEAM((p0) + 1); \
    if (IN((p0) + 2)) { PHASE_ENTER(); \
        const int ntl = *(const int*)(F.ws + META_NT); \
        pg8::Gemm g{P_XS, (const bf16*)(F.ws + WS_W13) + (size_t)(layer) * 16 * 1024 * 1024, ntl * 256, 1024, DM, (size_t)1024 * 1024 * 2}; \
        pg8::MoeOrder S; S.base.init(ntl * 256, 1024, F.G, F.bx); S.tile_e = (const int*)(F.ws + META_TILEE); \
        pg8::EpiMoeA E{P_HID}; \
        pg8::gemm_phase<pg8::EpiMoeA, pg8::MoeOrder, true, true>(F.lds, g, S, E); \
    } SEAM((p0) + 2); \
    if (IN((p0) + 3)) { PHASE_ENTER(); \
        const int ntl = *(const int*)(F.ws + META_NT); \
        pg8::Gemm g{P_HID, (const bf16*)(F.ws + WS_W2) + (size_t)(layer) * 16 * 1024 * 512, ntl * 256, 1024, DFF, (size_t)1024 * 512 * 2}; \
        pg8::MoeOrder S; S.base.init(ntl * 256, 1024, F.G, F.bx); S.tile_e = (const int*)(F.ws + META_TILEE); \
        pg8::EpiMoeB E{P_Y}; \
        pg8::gemm_phase<pg8::EpiMoeB, pg8::MoeOrder, true, true>(F.lds, g, S, E); \
    } SEAM((p0) + 3);

    MOE_PHASES(0, 5)
    if (IN(9)) { PHASE_ENTER(); combine_phase<true>(F, KA->out, P_Y, P_MOD, P_HA, in[4] + DM, P_MOD + (size_t)32 * 6144); } SEAM(9);
    if (IN(10)) { PHASE_ENTER();
        pg8::Gemm g{P_HA, (const bf16*)(F.ws + WS_WODIN), T, 2048, DM, 0}; pg8::StaticOrder S; S.init(T, 2048, F.G, F.bx);
        pg8::EpiOdIn E{P_GY, P_XB};
        pg8::gemm_phase<pg8::EpiOdIn, pg8::StaticOrder, true, true>(F.lds, g, S, E);
    } SEAM(10);
    if (IN(11)) { PHASE_ENTER(); const int u = F.vcu; lru_unit(F, u >> 3, u & 7, P_GY, P_XB, P_CAT, (const bf16*)(F.ws + WS_WRG), (const bf16*)(F.ws + WS_WIG), in[15], in[16], in[18], in[20], in[21]); } SEAM(11);
    if (IN(12)) { PHASE_ENTER();
        pg8::Gemm g{P_CAT, (const bf16*)(F.ws + WS_WODOUT), T, DM, DM, 0}; pg8::StaticOrder S; S.init(T, DM, F.G, F.bx);
        pg8::EpiResid E{KA->out, KA->out, P_MOD + (size_t)32 * 6144 + 2 * 1024};
        pg8::gemm_phase<pg8::EpiResid, pg8::StaticOrder, true, true>(F.lds, g, S, E);
    } SEAM(12);
    MOE_PHASES(1, 13)
    if (IN(17)) { PHASE_ENTER(); combine_phase<false>(F, KA->out, P_Y, P_MOD + (size_t)32 * 6144, P_HA, nullptr, nullptr); }
#undef MOE_PHASES
#undef in
#undef IN
#undef SEAM
}

#if !MK_ONE_LAUNCH
template <int P> static void set_attr_all() { if constexpr (P < NPHASE) { (void)hipFuncSetAttribute((const void*)mk_fwd<P, P + 1>, hipFuncAttributeMaxDynamicSharedMemorySize, LDS_BYTES); set_attr_all<P + 1>(); } }
template <int P> static void launch_all(Args a, int grid, hipStream_t stream) { if constexpr (P < NPHASE) { a.ph_lo = P; a.ph_hi = P + 1; hipLaunchKernelGGL((mk_fwd<P, P + 1>), dim3(grid), dim3(NWAVES * 64), LDS_BYTES, stream, a); launch_all<P + 1>(a, grid, stream); } }
#endif

extern "C" void kernel_launch(void* const* d_in, const int* in_sizes, int n_in, void* d_out, int out_size, void* d_ws, size_t ws_size, hipStream_t stream) {
    static int grid = 0;
    if (grid == 0) {
        if (n_in != 28 || in_sizes[0] != T * DM || out_size != T * DM || ws_size < WS_END) { fprintf(stderr, "kernel_launch: unexpected shapes (n_in %d, in0 %d, out %d, ws %zu); nothing launched\n", n_in, n_in > 0 ? in_sizes[0] : -1, out_size, ws_size); grid = -1; return; }
        int dev = 0, cus = 0;
        if (hipGetDevice(&dev) != hipSuccess || hipDeviceGetAttribute(&cus, hipDeviceAttributeMultiprocessorCount, dev) != hipSuccess) { grid = -1; return; }
#if MK_ONE_LAUNCH
        if (hipFuncSetAttribute((const void*)mk_fwd<0, NPHASE>, hipFuncAttributeMaxDynamicSharedMemorySize, LDS_BYTES) != hipSuccess) { fprintf(stderr, "kernel_launch: hipFuncSetAttribute failed\n"); grid = -1; return; }
        int per_cu = 0;
        if (hipOccupancyMaxActiveBlocksPerMultiprocessor(&per_cu, (const void*)mk_fwd<0, NPHASE>, NWAVES * 64, LDS_BYTES) != hipSuccess || per_cu < 1) fprintf(stderr, "kernel_launch: occupancy query reports %d\n", per_cu);
#else
        set_attr_all<0>();
#endif
        (void)hipGetLastError();
        grid = cus;
        if (grid != 256) { fprintf(stderr, "kernel_launch: built for 256 CUs, device has %d; nothing launched\n", cus); grid = -1; return; }
    }
    if (grid < 0) return;
    (void)hipMemsetAsync((char*)d_ws + WS_CTL, 0, CTL_ZERO_BYTES, stream);
    Args a{};
    for (int i = 0; i < 28; ++i) a.in[i] = (const float*)d_in[i];
    a.out = (float*)d_out; a.ws = (unsigned char*)d_ws;
#if MK_ONE_LAUNCH
    a.ph_lo = 0; a.ph_hi = NPHASE;
    hipLaunchKernelGGL((mk_fwd<0, NPHASE>), dim3(grid), dim3(NWAVES * 64), LDS_BYTES, stream, a);
#else
    launch_all<0>(a, grid, stream);
#endif
}
```

```cpp
#include <hip/hip_runtime.h>
#include <cstdio>
#include <cstdint>

#ifndef MK_ONE_LAUNCH
#define MK_ONE_LAUNCH 1
#endif

namespace pg8 {
#define PG8_LAS __attribute__((address_space(3)))
typedef unsigned short bf16_t;
typedef short bf16x8 __attribute__((ext_vector_type(8)));
typedef float f32x4 __attribute__((ext_vector_type(4)));
typedef unsigned u32x4 __attribute__((ext_vector_type(4)));
constexpr int BM = 256, BK = 64, HALF = 128, HTB = HALF * BK * 2  , STAGE_BYTES = 8 * HTB, NXCD = 8, WGM = 8;

__host__ __device__ __forceinline__ int lds_byte(int r, int c) { const int st = (r >> 4) * 2 + (c >> 5), rr = r & 15, cc = c & 31, ob = rr * 64 + cc * 2; return st * 1024 + (ob ^ (((ob >> 9) & 1) << 5)); }
__host__ __device__ __forceinline__ void stage_rc(int b, int& R, int& C) { const int st = b / 1024, sb = b % 1024, swz = sb ^ (((sb >> 9) & 1) << 5); R = (st >> 1) * 16 + swz / 64; C = (st & 1) * 32 + (swz % 64) / 2; }
__host__ __device__ __forceinline__ int perm32(int rho) { const int n = rho >> 4, i = rho & 15; return 8 * (i >> 2) + 4 * n + (i & 3); }

struct Unit { int pm, pn, pb; };
struct Gemm { const bf16_t* A; const bf16_t* Bt; int M, N, K; size_t bstride; };

struct StaticOrder {
    int nM, nN, nwg, G, c;
    __host__ __device__ void init(int M, int N, int G_, int c_) { nM = M / BM; nN = N / BM; nwg = nM * nN; G = G_; c = c_; }
    __host__ __device__ bool next(int i, Unit& u) const {
        const long L = (long)i * G + c; if (L >= nwg) return false;
        int wgid = (int)L; { const int q = nwg / NXCD, r = nwg % NXCD, xcd = wgid % NXCD, off = wgid / NXCD; wgid = (xcd < r ? xcd * (q + 1) : r * (q + 1) + (xcd - r) * q) + off; }
        const int nig = WGM * nN, gid = wgid / nig, fm = gid * WGM, gsz = (nM - fm) < WGM ? (nM - fm) : WGM;
        u.pm = fm + ((wgid % nig) % gsz); u.pn = (wgid % nig) / gsz; u.pb = 0; return true;
    }
    __device__ __forceinline__ void a_ready(const Unit&) const {}
    __device__ __forceinline__ void done(const Unit&) const {}
};

template <class Epi, class Sched, bool ALIGN_EPI = false, bool SP2 = false>
__device__ __forceinline__ void gemm_phase(PG8_LAS unsigned char* lds, const Gemm g, const Sched& S, const Epi& E) {
    int tid_ = threadIdx.x; asm volatile("" : "+v"(tid_));
    const int tid = tid_, wid = __builtin_amdgcn_readfirstlane(tid >> 6), lane = tid & 63, wr = wid >> 2, wc = wid & 3, fr = lane & 15, fq = lane >> 4;
    const int K = g.K, nt = K / BK;
    unsigned voffA[2], voffB[2];
#pragma unroll
    for (int i = 0; i < 2; ++i) { int R, C; stage_rc(tid * 16 + i * 8192, R, C); const int Rb = Epi::PERM ? ((R & ~31) + perm32(R & 31)) : R;
        voffA[i] = (unsigned)(R * K + C) * 2u; voffB[i] = (unsigned)(Rb * K + C) * 2u; }
    const size_t kstep = (size_t)(BK * 2);
    const size_t hstep = (size_t)HALF * K * 2;
    const size_t tstep = 2 * hstep;
    const unsigned ldsw = (unsigned)wid * 1024u;
    const int aoff = lds_byte(wr * 64 + fr, fq * 8), boff = lds_byte(wc * 32 + fr, fq * 8);
#define PG8_SA(b, h) (((b) * 2 + (h)) * HTB)
#define PG8_SB(b, h) ((4 + (b) * 2 + (h)) * HTB)
#define PG8_STAGE(bufoff, gbase, voff) do { _Pragma("unroll") for (int _i = 0; _i < 2; ++_i) \
        __builtin_amdgcn_global_load_lds((const unsigned*)((const char*)(gbase) + (voff)[_i]), (PG8_LAS unsigned*)(lds + (bufoff) + ldsw + _i * 8192), 16, 0, 0); } while (0)
#define PG8_LDA(dst, b, h) do { _Pragma("unroll") for (int m = 0; m < 4; ++m) _Pragma("unroll") for (int k = 0; k < 2; ++k) dst[m][k] = *(const PG8_LAS bf16x8*)(lds + PG8_SA(b, h) + aoff + m * 2048 + k * 1024); } while (0)
#define PG8_LDB(dst, b, h) do { _Pragma("unroll") for (int n = 0; n < 2; ++n) _Pragma("unroll") for (int k = 0; k < 2; ++k) dst[n][k] = *(const PG8_LAS bf16x8*)(lds + PG8_SB(b, h) + boff + n * 2048 + k * 1024); } while (0)
#define PG8_MMA(ai, bj, At, Bt) do { __builtin_amdgcn_s_setprio(1); _Pragma("unroll") for (int m = 0; m < 4; ++m) _Pragma("unroll") for (int n = 0; n < 2; ++n) _Pragma("unroll") for (int k = 0; k < 2; ++k) \
        acc[ai][bj][m][n] = __builtin_amdgcn_mfma_f32_16x16x32_bf16(Bt[n][k], At[m][k], acc[ai][bj][m][n], 0, 0, 0); __builtin_amdgcn_s_setprio(0); } while (0)
#define PG8_WAIT_V(n) asm volatile("s_waitcnt vmcnt(" #n ")" ::: "memory")
#define PG8_WAIT_L(n) asm volatile("s_waitcnt lgkmcnt(" #n ")" ::: "memory")
#define PG8_BAR __builtin_amdgcn_s_barrier()
#define PG8_SCHED __builtin_amdgcn_sched_barrier(0)
    Unit cur, nxt; int ui = 0;
    if (!S.next(0, cur)) return;
    f32x4 acc[2][2][4][2];
#pragma unroll
    for (int a = 0; a < 2; ++a)
#pragma unroll
        for (int b = 0; b < 2; ++b)
#pragma unroll
            for (int m = 0; m < 4; ++m)
#pragma unroll
                for (int n = 0; n < 2; ++n) acc[a][b][m][n] = (f32x4){0.f, 0.f, 0.f, 0.f};
    bf16x8 At[4][2], B0[2][2], B1[2][2];
    const char* cA = (const char*)g.A + (size_t)cur.pm * tstep; const char* cB = (const char*)g.Bt + (size_t)cur.pb * g.bstride + (size_t)cur.pn * tstep;
    S.a_ready(cur);
    if constexpr (SP2) {
        PG8_STAGE(PG8_SB(0, 0), cB, voffB); PG8_STAGE(PG8_SB(0, 1), cB + hstep, voffB); PG8_STAGE(PG8_SA(0, 0), cA, voffA); PG8_STAGE(PG8_SA(0, 1), cA + hstep, voffA);
        if (wr == 1) PG8_BAR;
        PG8_WAIT_V(2); PG8_BAR;
        PG8_STAGE(PG8_SB(1, 0), cB + kstep, voffB); PG8_STAGE(PG8_SA(1, 0), cA + kstep, voffA); PG8_STAGE(PG8_SB(1, 1), cB + hstep + kstep, voffB);
        PG8_WAIT_V(6); PG8_BAR;
    } else {
        PG8_STAGE(PG8_SB(0, 0), cB, voffB); PG8_STAGE(PG8_SA(0, 0), cA, voffA); PG8_STAGE(PG8_SB(0, 1), cB + hstep, voffB); PG8_STAGE(PG8_SA(0, 1), cA + hstep, voffA);
        if (wr == 1) PG8_BAR;
        PG8_WAIT_V(4); PG8_BAR;
        PG8_STAGE(PG8_SB(1, 0), cB + kstep, voffB); PG8_STAGE(PG8_SA(1, 0), cA + kstep, voffA); PG8_STAGE(PG8_SB(1, 1), cB + hstep + kstep, voffB);
        PG8_WAIT_V(6); PG8_BAR;
    }
    for (;;) {
        const bool has_next = S.next(ui + 1, nxt);
        const char* nA = has_next ? (const char*)g.A + (size_t)nxt.pm * tstep : cA; const char* nB = has_next ? (const char*)g.Bt + (size_t)nxt.pb * g.bstride + (size_t)nxt.pn * tstep : cB;
        for (int t = 0; t < nt; t += 2) {
            const bool last = (t == nt - 2);
            const char* a1 = cA + (size_t)(t + 1) * kstep;
            const char* a2 = last ? nA : cA + (size_t)(t + 2) * kstep; const char* b2 = last ? nB : cB + (size_t)(t + 2) * kstep;
            const char* a3 = a2 + kstep; const char* b3 = b2 + kstep;
            if (last && has_next) S.a_ready(nxt);
            if constexpr (SP2) {
            PG8_LDB(B0, 0, 0); PG8_LDB(B1, 0, 1); PG8_SCHED; PG8_LDA(At, 0, 0); PG8_STAGE(PG8_SA(1, 1), a1 + hstep, voffA);
            PG8_WAIT_V(8); PG8_WAIT_L(0); PG8_BAR; PG8_MMA(0, 0, At, B0); PG8_MMA(0, 1, At, B1); PG8_BAR; PG8_SCHED;
            PG8_LDA(At, 0, 1); PG8_STAGE(PG8_SB(0, 0), b2, voffB); PG8_STAGE(PG8_SB(0, 1), b2 + hstep, voffB); PG8_STAGE(PG8_SA(0, 0), a2, voffA);
            PG8_WAIT_V(8); PG8_WAIT_L(0); PG8_BAR; PG8_MMA(1, 0, At, B0); PG8_MMA(1, 1, At, B1); PG8_BAR; PG8_SCHED;
            PG8_LDB(B0, 1, 0); PG8_LDB(B1, 1, 1); PG8_SCHED; PG8_LDA(At, 1, 0); PG8_STAGE(PG8_SA(0, 1), a2 + hstep, voffA);
            PG8_WAIT_V(8); PG8_WAIT_L(0); PG8_BAR; PG8_MMA(0, 0, At, B0); PG8_MMA(0, 1, At, B1); PG8_BAR; PG8_SCHED;
            PG8_LDA(At, 1, 1); PG8_STAGE(PG8_SB(1, 0), b3, voffB); PG8_STAGE(PG8_SB(1, 1), b3 + hstep, voffB); PG8_STAGE(PG8_SA(1, 0), a3, voffA);
            PG8_WAIT_V(8); PG8_WAIT_L(0); PG8_BAR; PG8_MMA(1, 0, At, B0); PG8_MMA(1, 1, At, B1); PG8_BAR; PG8_SCHED;
            } else {
            PG8_LDB(B0, 0, 0); PG8_SCHED; PG8_LDA(At, 0, 0); PG8_STAGE(PG8_SA(1, 1), a1 + hstep, voffA);
            PG8_WAIT_L(8); PG8_BAR; PG8_WAIT_L(0); PG8_MMA(0, 0, At, B0); PG8_BAR; PG8_SCHED;
            PG8_LDB(B1, 0, 1); PG8_STAGE(PG8_SB(0, 0), b2, voffB);
            PG8_BAR; PG8_WAIT_L(0); PG8_MMA(0, 1, At, B1); PG8_BAR;
            PG8_LDA(At, 0, 1); PG8_STAGE(PG8_SA(0, 0), a2, voffA);
            PG8_BAR; PG8_WAIT_L(0); PG8_MMA(1, 0, At, B0); PG8_BAR; PG8_SCHED;
            PG8_STAGE(PG8_SB(0, 1), b2 + hstep, voffB);
            PG8_WAIT_V(6); PG8_BAR; PG8_MMA(1, 1, At, B1); PG8_BAR;
            PG8_LDB(B0, 1, 0); PG8_SCHED; PG8_LDA(At, 1, 0); PG8_STAGE(PG8_SA(0, 1), a2 + hstep, voffA);
            PG8_WAIT_L(8); PG8_BAR; PG8_WAIT_L(0); PG8_MMA(0, 0, At, B0); PG8_BAR; PG8_SCHED;
            PG8_LDB(B1, 1, 1); PG8_STAGE(PG8_SB(1, 0), b3, voffB);
            PG8_BAR; PG8_WAIT_L(0); PG8_MMA(0, 1, At, B1); PG8_BAR;
            PG8_LDA(At, 1, 1); PG8_STAGE(PG8_SA(1, 0), a3, voffA);
            PG8_BAR; PG8_WAIT_L(0); PG8_MMA(1, 0, At, B0); PG8_BAR; PG8_SCHED;
            PG8_STAGE(PG8_SB(1, 1), b3 + hstep, voffB);
            PG8_WAIT_V(6); PG8_BAR; PG8_MMA(1, 1, At, B1); PG8_BAR;
            }
        }
        if constexpr (ALIGN_EPI) { if (wr == 0) PG8_BAR; }
        if constexpr (!Epi::AFTER_DRAIN) { E(acc, cur, wr, wc, fr, fq); S.done(cur); }
        if (!has_next) break;
#pragma unroll
        for (int a = 0; a < 2; ++a)
#pragma unroll
            for (int b = 0; b < 2; ++b)
#pragma unroll
                for (int m = 0; m < 4; ++m)
#pragma unroll
                    for (int n = 0; n < 2; ++n) acc[a][b][m][n] = (f32x4){0.f, 0.f, 0.f, 0.f};
        cur = nxt; cA = nA; cB = nB; ++ui;
        if constexpr (ALIGN_EPI) { if (wr == 1) PG8_BAR; }
    }
    PG8_WAIT_V(0);
    if constexpr (!ALIGN_EPI) { if (wr == 0) PG8_BAR; }
    PG8_BAR;
    if constexpr (Epi::AFTER_DRAIN) { E.fused(acc, cur, wr, wc, fr, fq, lds, wid, lane); S.done(cur); }
#undef PG8_SA
#undef PG8_SB
#undef PG8_STAGE
#undef PG8_LDA
#undef PG8_LDB
#undef PG8_MMA
#undef PG8_WAIT_V
#undef PG8_WAIT_L
#undef PG8_BAR
#undef PG8_SCHED
}
}

constexpr int NB = 32, SEQ = 2048, DM = 1024, T = NB * SEQ;
constexpr int EVIN = 2560, CONVC = 512, CONVW = 31, NHEAD = 8, HD = 64, SBW = 512;
constexpr int NEXP = 16, DFF = 512;
constexpr int MOE_ROWS = 2 * T + NEXP * 256;
constexpr int MOE_TILES = MOE_ROWS / 256;
constexpr float EPS = 1e-6f;
constexpr int NWAVES = 8;

constexpr size_t MiB = 1u << 20;
constexpr size_t WS_CTL = 0, CTL_ZERO_BYTES = 64 * 1024;
constexpr size_t WS_MOD = 1 * MiB;
constexpr size_t WS_META = 3 * MiB;
constexpr size_t META_EID = WS_META, META_GATE = WS_META + 512 * 1024, META_SLOT = WS_META + 1024 * 1024, META_BCNT = WS_META + 1536 * 1024,
                 META_TILEE = META_BCNT + 32 * 1024, META_NT = META_BCNT + 64 * 1024;
constexpr size_t WS_WEVIN = 6 * MiB, WS_WEVOUT = 11 * MiB, WS_WODIN = 13 * MiB, WS_WODOUT = 17 * MiB, WS_WRG = 19 * MiB, WS_WIG = WS_WRG + 512 * 1024;
constexpr size_t WS_W13 = 20 * MiB;
constexpr size_t WS_W2 = 84 * MiB;
constexpr size_t WS_HA = 116 * MiB;
constexpr size_t WS_R1 = 244 * MiB;
constexpr size_t WS_R2 = 508 * MiB;
constexpr size_t WS_END = 640 * MiB;
constexpr int CW_BAR = 4096;

constexpr int RING_BYTES = 131072, LDSCTL_OFF = RING_BYTES, MISC_OFF = LDSCTL_OFF + 320, LDS_BYTES = 147456;

#define GAS __attribute__((address_space(1)))
#define LAS __attribute__((address_space(3)))
typedef unsigned short bf16;
typedef unsigned v4u __attribute__((ext_vector_type(4)));
typedef unsigned v2u __attribute__((ext_vector_type(2)));
typedef float f32x4 __attribute__((ext_vector_type(4)));
typedef float f32x2 __attribute__((ext_vector_type(2)));
typedef float f32x16 __attribute__((ext_vector_type(16)));
typedef short bf16x8 __attribute__((ext_vector_type(8)));
typedef short s16x4 __attribute__((ext_vector_type(4)));
typedef __bf16 bf16x2_t __attribute__((ext_vector_type(2)));
typedef GAS unsigned gu32;
#define RLX_AGENT __ATOMIC_RELAXED, __HIP_MEMORY_SCOPE_AGENT

__device__ __forceinline__ unsigned pk2(float lo, float hi) { f32x2 v = {lo, hi}; bf16x2_t b = __builtin_convertvector(v, bf16x2_t); return __builtin_bit_cast(unsigned, b); }
__device__ __forceinline__ float bflo(unsigned u) { return __uint_as_float(u << 16); }
__device__ __forceinline__ float bfhi(unsigned u) { return __uint_as_float(u & 0xffff0000u); }
__device__ __forceinline__ float bf2f(bf16 b) { return __uint_as_float((unsigned)b << 16); }
__device__ __forceinline__ float fast_exp2(float x) { return __builtin_amdgcn_exp2f(x); }
__device__ __forceinline__ float fast_rcp(float x) { return __builtin_amdgcn_rcpf(x); }
__device__ __forceinline__ float sigmoidf_(float x) { return fast_rcp(1.0f + fast_exp2(-1.4426950408889634f * x)); }
__device__ __forceinline__ float siluf_(float x) { return x * sigmoidf_(x); }
__device__ __forceinline__ float gelu_tanh(float x) { const float u = x + 0.044715f * x * x * x; return x * fast_rcp(1.0f + fast_exp2(-2.3022082f * u)); }
__device__ __forceinline__ float wave_sum(float v) {
#pragma unroll
    for (int o = 1; o < 64; o <<= 1) v += __shfl_xor(v, o);
    return v;
}

#define XB_TMO      128
#define XB_XCNT(j)  (256  + 64 * (j))
#define XB_XSUB(j)  (1280 + 64 * (j))
#define XB_XGEN(j)  (2304 + 64 * (j))
#define XB_TOP      3328
#define XB_TOPGEN   3392
#define XCD_BAR_WORDS 3456
#define XB_SPIN_CAP (1u << 18)

__device__ __forceinline__ unsigned xb_ld(unsigned* p)              { return __hip_atomic_load(p, __ATOMIC_RELAXED, __HIP_MEMORY_SCOPE_AGENT); }
__device__ __forceinline__ unsigned xb_add(unsigned* p, unsigned v) { return __hip_atomic_fetch_add(p, v, __ATOMIC_RELAXED, __HIP_MEMORY_SCOPE_AGENT); }
__device__ __forceinline__ unsigned xb_xcc_id() { return (unsigned)__builtin_amdgcn_s_getreg((3 << 11) | 20) & 0xFu; }
#define XB_SPIN(cond, bar) do { unsigned _sp = 0; while (cond) { __builtin_amdgcn_s_sleep(1); \
    if ((++_sp & 255u) == 0u) { if (xb_ld(&(bar)[XB_TMO])) break; if (_sp > XB_SPIN_CAP) { atomicAdd(&(bar)[XB_TMO], 1u); break; } } } } while (0)

struct XcdBarrier {
    unsigned* bar; unsigned x;
    volatile LAS unsigned* st;
};

__device__ __forceinline__ XcdBarrier xcd_barrier_post(unsigned* bar, volatile LAS unsigned* st) {
    XcdBarrier b; b.bar = bar; b.x = xb_xcc_id(); b.st = st;
    if (threadIdx.x == 0) (void)xb_add(&bar[XB_XCNT(b.x)], 1u);
    return b;
}
__device__ __forceinline__ void xcd_barrier_complete(unsigned* bar, unsigned x, unsigned& nloc, unsigned& nx) {
    const unsigned G = gridDim.x * gridDim.y * gridDim.z;
    unsigned sum, cnt, mine, sp = 0u;
    for (;;) {
        sum = 0u; cnt = 0u; mine = 0u;
#pragma unroll
        for (unsigned j = 0; j < 16; ++j) { const unsigned c = xb_ld(&bar[XB_XCNT(j)]); sum += c; cnt += (c > 0u) ? 1u : 0u; mine = (j == x) ? c : mine; }
        if (sum == G) break;
        __builtin_amdgcn_s_sleep(1);
        if ((++sp & 255u) == 0u) { if (xb_ld(&bar[XB_TMO])) break; if (sp > XB_SPIN_CAP) { atomicAdd(&bar[XB_TMO], 1u); break; } }
    }
    nloc = mine > 0u ? mine : 1u; nx = cnt > 0u ? cnt : 1u;
}

__device__ __forceinline__ void xcd_barrier(const XcdBarrier& b) {
    asm volatile("s_waitcnt vmcnt(0)" ::: "memory");
    __syncthreads();
    if (threadIdx.x == 0) {
        unsigned* bar = b.bar;
        __builtin_amdgcn_s_waitcnt(0);
        unsigned nloc = b.st[0], nx = b.st[1];
        if (nloc == 0u) { xcd_barrier_complete(bar, b.x, nloc, nx); b.st[0] = nloc; b.st[1] = nx; }
        const unsigned old = xb_add(&bar[XB_XSUB(b.x)], 1u);
        const unsigned gen = old / nloc;
        if (old + 1u == (gen + 1u) * nloc) {
            __builtin_amdgcn_fence(__ATOMIC_RELEASE, "agent");
            asm volatile("s_waitcnt vmcnt(0)" ::: "memory");
            const unsigned og = xb_add(&bar[XB_TOP], 1u);
            const unsigned tg = og / nx;
            if (og + 1u == (tg + 1u) * nx) xb_add(&bar[XB_TOPGEN], 1u);
            else XB_SPIN(xb_ld(&bar[XB_TOPGEN]) == tg, bar);
            __builtin_amdgcn_fence(__ATOMIC_ACQUIRE, "agent");
            xb_add(&bar[XB_XGEN(b.x)], 1u);
            asm volatile("s_waitcnt vmcnt(0)" ::: "memory");
        } else {
            XB_SPIN(xb_ld(&bar[XB_XGEN(b.x)]) == gen, bar);
            __builtin_amdgcn_fence(__ATOMIC_ACQUIRE, "agent");
            asm volatile("s_waitcnt vmcnt(0)" ::: "memory");
        }
    }
    __syncthreads();
}


namespace pg8 {
struct EpiEvIn {
    static constexpr bool PERM = true, AFTER_DRAIN = false;
    bf16* U0; bf16* Q; bf16* K; bf16* V; const float* qg; const float* kg;
    __device__ __forceinline__ void operator()(const f32x4 (&acc)[2][2][4][2], const Unit& u, int wr, int wc, int fr, int fq) const {
        const int row0 = u.pm * BM + wr * 64 + fr;
        if (u.pn < 4) {
#pragma unroll
            for (int ai = 0; ai < 2; ++ai)
#pragma unroll
                for (int m = 0; m < 4; ++m) {
                    const size_t row = (size_t)(row0 + ai * HALF + m * 16);
                    const f32x4 v0 = acc[ai][0][m][0], v1 = acc[ai][0][m][1], g0 = acc[ai][1][m][0], g1 = acc[ai][1][m][1];
                    u32x4 w;
                    w.x = pk2(v0[0] * sigmoidf_(g0[0]), v0[1] * sigmoidf_(g0[1])); w.y = pk2(v0[2] * sigmoidf_(g0[2]), v0[3] * sigmoidf_(g0[3]));
                    w.z = pk2(v1[0] * sigmoidf_(g1[0]), v1[1] * sigmoidf_(g1[1])); w.w = pk2(v1[2] * sigmoidf_(g1[2]), v1[3] * sigmoidf_(g1[3]));
                    *(u32x4*)(U0 + row * 512 + u.pn * 128 + wc * 32 + 8 * fq) = w;
                }
        } else if (u.pn < 8) {
            const int sec = (u.pn - 4) >> 1, p = (u.pn - 4) & 1, head = 4 * p + wc;
            const float* gp = sec ? kg : qg; bf16* dst = sec ? K : Q;
            const float scl = sec ? 1.0f : 0.125f * 1.4426950408889634f;
            f32x4 gv[2][2];
#pragma unroll
            for (int bj = 0; bj < 2; ++bj)
#pragma unroll
                for (int n = 0; n < 2; ++n) gv[bj][n] = *(const f32x4*)(gp + 32 * bj + 8 * fq + 4 * n) * scl;
#pragma unroll
            for (int ai = 0; ai < 2; ++ai)
#pragma unroll
                for (int m = 0; m < 4; ++m) {
                    const size_t row = (size_t)(row0 + ai * HALF + m * 16);
                    float ss = 0.f;
#pragma unroll
                    for (int bj = 0; bj < 2; ++bj)
#pragma unroll
                        for (int n = 0; n < 2; ++n) { const f32x4 x = acc[ai][bj][m][n]; ss += (x[0] * x[0] + x[1] * x[1]) + (x[2] * x[2] + x[3] * x[3]); }
                    ss += __shfl_xor(ss, 16); ss += __shfl_xor(ss, 32);
                    const float rstd = __builtin_amdgcn_rsqf(ss * (1.0f / 64.0f) + EPS);
#pragma unroll
                    for (int bj = 0; bj < 2; ++bj) {
                        const f32x4 a = acc[ai][bj][m][0] * rstd * gv[bj][0], b = acc[ai][bj][m][1] * rstd * gv[bj][1];
                        u32x4 w; w.x = pk2(a[0], a[1]); w.y = pk2(a[2], a[3]); w.z = pk2(b[0], b[1]); w.w = pk2(b[2], b[3]);
                        *(u32x4*)(dst + row * 512 + head * 64 + 32 * bj + 8 * fq) = w;
                    }
                }
        } else {
#pragma unroll
            for (int ai = 0; ai < 2; ++ai)
#pragma unroll
                for (int m = 0; m < 4; ++m) {
                    const size_t row = (size_t)(row0 + ai * HALF + m * 16);
#pragma unroll
                    for (int bj = 0; bj < 2; ++bj) {
                        const f32x4 a = acc[ai][bj][m][0], b = acc[ai][bj][m][1];
                        u32x4 w; w.x = pk2(a[0], a[1]); w.y = pk2(a[2], a[3]); w.z = pk2(b[0], b[1]); w.w = pk2(b[2], b[3]);
                        *(u32x4*)(V + row * 512 + (u.pn - 8) * 256 + bj * HALF + wc * 32 + 8 * fq) = w;
                    }
                }
        }
    }
};
struct EpiResid {
    static constexpr bool PERM = false, AFTER_DRAIN = false;
    const float* xin; float* xout; const float* gate;
    __device__ __forceinline__ void operator()(const f32x4 (&acc)[2][2][4][2], const Unit& u, int wr, int wc, int fr, int fq) const {
        const int row0 = u.pm * BM + wr * 64 + fr, col0 = u.pn * BM + wc * 32 + 4 * fq, b = u.pm >> 3;
        f32x4 gv[2][2];
#pragma unroll
        for (int bj = 0; bj < 2; ++bj)
#pragma unroll
            for (int n = 0; n < 2; ++n) gv[bj][n] = *(const f32x4*)(gate + (size_t)b * 6144 + col0 + bj * HALF + n * 16);
#pragma unroll
        for (int ai = 0; ai < 2; ++ai)
#pragma unroll
            for (int m = 0; m < 4; ++m) {
                const size_t off = (size_t)(row0 + ai * HALF + m * 16) * DM + col0;
#pragma unroll
                for (int bj = 0; bj < 2; ++bj)
#pragma unroll
                    for (int n = 0; n < 2; ++n) { const f32x4 xi = *(const f32x4*)(xin + off + bj * HALF + n * 16); *(f32x4*)(xout + off + bj * HALF + n * 16) = xi + gv[bj][n] * acc[ai][bj][m][n]; }
            }
    }
};
struct EpiOdIn {
    static constexpr bool PERM = true, AFTER_DRAIN = false;
    bf16* GY; bf16* XB;
    __device__ __forceinline__ void operator()(const f32x4 (&acc)[2][2][4][2], const Unit& u, int wr, int wc, int fr, int fq) const {
        const int row0 = u.pm * BM + wr * 64 + fr; const bool isy = u.pn < 4;
        bf16* dst = (isy ? GY : XB) + (size_t)(u.pn & 3) * 256 + wc * 32 + 8 * fq;
#pragma unroll
        for (int ai = 0; ai < 2; ++ai)
#pragma unroll
            for (int m = 0; m < 4; ++m) {
                const size_t row = (size_t)(row0 + ai * HALF + m * 16);
#pragma unroll
                for (int bj = 0; bj < 2; ++bj) {
                    f32x4 a = acc[ai][bj][m][0], b = acc[ai][bj][m][1];
                    if (isy) { a = (f32x4){gelu_tanh(a[0]), gelu_tanh(a[1]), gelu_tanh(a[2]), gelu_tanh(a[3])}; b = (f32x4){gelu_tanh(b[0]), gelu_tanh(b[1]), gelu_tanh(b[2]), gelu_tanh(b[3])}; }
                    u32x4 w; w.x = pk2(a[0], a[1]); w.y = pk2(a[2], a[3]); w.z = pk2(b[0], b[1]); w.w = pk2(b[2], b[3]);
                    *(u32x4*)(dst + row * DM + bj * HALF) = w;
                }
            }
    }
};
struct EpiMoeA {
    static constexpr bool PERM = true, AFTER_DRAIN = false;
    bf16* HID;
    __device__ __forceinline__ void operator()(const f32x4 (&acc)[2][2][4][2], const Unit& u, int wr, int wc, int fr, int fq) const {
        const int row0 = u.pm * BM + wr * 64 + fr;
#pragma unroll
        for (int ai = 0; ai < 2; ++ai)
#pragma unroll
            for (int m = 0; m < 4; ++m) {
                const size_t row = (size_t)(row0 + ai * HALF + m * 16);
                const f32x4 a0 = acc[ai][0][m][0], a1 = acc[ai][0][m][1], b0 = acc[ai][1][m][0], b1 = acc[ai][1][m][1];
                u32x4 w;
                w.x = pk2(siluf_(a0[0]) * b0[0], siluf_(a0[1]) * b0[1]); w.y = pk2(siluf_(a0[2]) * b0[2], siluf_(a0[3]) * b0[3]);
                w.z = pk2(siluf_(a1[0]) * b1[0], siluf_(a1[1]) * b1[1]); w.w = pk2(siluf_(a1[2]) * b1[2], siluf_(a1[3]) * b1[3]);
                *(u32x4*)(HID + row * DFF + u.pn * 128 + wc * 32 + 8 * fq) = w;
            }
    }
};
struct EpiMoeB {
    static constexpr bool PERM = true, AFTER_DRAIN = false;
    bf16* Y;
    __device__ __forceinline__ void operator()(const f32x4 (&acc)[2][2][4][2], const Unit& u, int wr, int wc, int fr, int fq) const {
        const int row0 = u.pm * BM + wr * 64 + fr;
#pragma unroll
        for (int ai = 0; ai < 2; ++ai)
#pragma unroll
            for (int m = 0; m < 4; ++m) {
                const size_t row = (size_t)(row0 + ai * HALF + m * 16);
#pragma unroll
                for (int bj = 0; bj < 2; ++bj) {
                    const f32x4 a = acc[ai][bj][m][0], b = acc[ai][bj][m][1];
                    u32x4 w; w.x = pk2(a[0], a[1]); w.y = pk2(a[2], a[3]); w.z = pk2(b[0], b[1]); w.w = pk2(b[2], b[3]);
                    *(u32x4*)(Y + row * DM + u.pn * 256 + bj * HALF + wc * 32 + 8 * fq) = w;
                }
            }
    }
};
struct MoeOrder {
    StaticOrder base; const int* tile_e;
    __device__ __forceinline__ bool next(int i, Unit& u) const { if (!base.next(i, u)) return false; u.pb = tile_e[u.pm]; return true; }
    __device__ __forceinline__ void a_ready(const Unit&) const {}
    __device__ __forceinline__ void done(const Unit&) const {}
};
}

struct Frame {
    LAS unsigned char* lds;
    int tid, lane, wave, vcu, G, bx;
    unsigned char* ws;
};

template <class RowMap>
__device__ __forceinline__ void p0_transpose_item(const float* W, int K, int N, bf16* WT, LAS float* scr, int item, int lane, RowMap rm) {
    const int nblk = N / 32, kb = item / nblk, nb = item % nblk, k0 = 64 * kb, n0 = 32 * nb;
#pragma unroll 8
    for (int i = 0; i < 32; ++i) { const int kk = 2 * i + (lane >> 5); scr[kk * 33 + (lane & 31)] = W[(size_t)(k0 + kk) * N + n0 + (lane & 31)]; }
    asm volatile("s_waitcnt lgkmcnt(0)" ::: "memory");
    const int c = lane & 7;
#pragma unroll
    for (int j = 0; j < 4; ++j) { const int n = (lane >> 3) + 8 * j; const LAS float* s = scr + (8 * c) * 33 + n;
        v4u o; o.x = pk2(s[0 * 33], s[1 * 33]); o.y = pk2(s[2 * 33], s[3 * 33]); o.z = pk2(s[4 * 33], s[5 * 33]); o.w = pk2(s[6 * 33], s[7 * 33]);
        *(GAS v4u*)(WT + (size_t)rm(n0 + n) * K + k0 + 8 * c) = o; }
    asm volatile("s_waitcnt lgkmcnt(0)" ::: "memory");
}
struct RmId { __device__ __forceinline__ int operator()(int n) const { return n; } };
struct RmEvIn { __device__ __forceinline__ int operator()(int n) const {
    if (n < 512) return 256 * (n >> 7) + (n & 127);
    if (n < 1024) { const int m = n - 512; return 256 * (m >> 7) + 128 + (m & 127); }
    if (n < 2048) { const int m = n - 1024, sec = m >> 9, mm = m & 511, p = mm >> 8, r = mm & 255, wc = r >> 6, d = r & 63, bj = d >> 5, j = d & 31;
        return 256 * (4 + 2 * sec + p) + 128 * bj + 32 * wc + j; }
    return n; } };
struct RmGlu { int half; __device__ __forceinline__ int operator()(int n) const { return 256 * (n >> 7) + 128 * half + (n & 127); } };

template <class KAT> __device__ __forceinline__ void p0_prologue(Frame& F, KAT KA) {
#define in KA->in
    LAS float* sc = (LAS float*)F.lds;
    const int w = F.bx, bg = w & 3;
    const float* c = in[1];
    for (int i = F.tid; i < 8 * 1024; i += 512) { const float v = c[(size_t)bg * 8 * 1024 + i]; sc[i] = v / (1.0f + __expf(-v)); }
    __syncthreads();
    if (F.wave < 6) {
        const int chunk = (w >> 2) * 6 + F.wave, l = chunk / 192, cc = chunk % 192, col = cc * 32 + (F.lane & 31), kh = F.lane >> 5;
        const float* W = in[2] + (size_t)l * 1024 * 6144 + col;
        float acc[8];
#pragma unroll
        for (int bb = 0; bb < 8; ++bb) acc[bb] = 0.f;
        for (int k = kh * 512; k < kh * 512 + 512; k += 4) {
            const float w0 = W[(size_t)k * 6144], w1 = W[(size_t)(k + 1) * 6144], w2 = W[(size_t)(k + 2) * 6144], w3 = W[(size_t)(k + 3) * 6144];
#pragma unroll
            for (int bb = 0; bb < 8; ++bb) { const f32x4 s = *(const LAS f32x4*)(sc + bb * 1024 + k); acc[bb] += (s[0] * w0 + s[1] * w1) + (s[2] * w2 + s[3] * w3); }
        }
        float* mod = (float*)(F.ws + WS_MOD);
#pragma unroll
        for (int bb = 0; bb < 8; ++bb) { const float t = acc[bb] + __shfl_xor(acc[bb], 32);
            if (F.lane < 32) mod[((size_t)l * 32 + bg * 8 + bb) * 6144 + col] = t + in[3][(size_t)l * 6144 + col]; }
    }
    __syncthreads();
    LAS float* scr = (LAS float*)(F.lds + 32768 + F.wave * 8448);
    const int gw = F.vcu * NWAVES + F.wave, NGW = F.G * NWAVES;
    bf16* WEVIN = (bf16*)(F.ws + WS_WEVIN); bf16* WEVOUT = (bf16*)(F.ws + WS_WEVOUT); bf16* WODIN = (bf16*)(F.ws + WS_WODIN); bf16* WODOUT = (bf16*)(F.ws + WS_WODOUT);
    bf16* WRG = (bf16*)(F.ws + WS_WRG); bf16* WIG = (bf16*)(F.ws + WS_WIG); bf16* W13 = (bf16*)(F.ws + WS_W13); bf16* W2 = (bf16*)(F.ws + WS_W2);
    constexpr int I_EVIN = 16 * 80, I_SQ = 16 * 32, I_ODIN = 16 * 64, I_W1 = 16 * 16, I_W2 = 8 * 32, I_G = 2 * 4;
    constexpr int NITEMS = I_EVIN + 2 * I_SQ + I_ODIN + 32 * I_W1 * 2 + 32 * I_W2 + 16 * I_G;
    for (int it = gw; it < NITEMS; it += NGW) {
        int r = it;
        if (r < I_EVIN) { p0_transpose_item(in[6], 1024, 2560, WEVIN, scr, r, F.lane, RmEvIn{}); continue; } r -= I_EVIN;
        if (r < I_SQ) { p0_transpose_item(in[13], 1024, 1024, WEVOUT, scr, r, F.lane, RmId{}); continue; } r -= I_SQ;
        if (r < I_ODIN) { p0_transpose_item(in[14], 1024, 2048, WODIN, scr, r, F.lane, RmId{}); continue; } r -= I_ODIN;
        if (r < I_SQ) { p0_transpose_item(in[22], 1024, 1024, WODOUT, scr, r, F.lane, RmId{}); continue; } r -= I_SQ;
        if (r < 32 * I_W1) { const int mat = r / I_W1; p0_transpose_item(in[25] + (size_t)mat * 1024 * 512, 1024, 512, W13 + (size_t)mat * 1024 * 1024, scr, r % I_W1, F.lane, RmGlu{0}); continue; } r -= 32 * I_W1;
        if (r < 32 * I_W1) { const int mat = r / I_W1; p0_transpose_item(in[26] + (size_t)mat * 1024 * 512, 1024, 512, W13 + (size_t)mat * 1024 * 1024, scr, r % I_W1, F.lane, RmGlu{1}); continue; } r -= 32 * I_W1;
        if (r < 32 * I_W2) { const int mat = r / I_W2; p0_transpose_item(in[27] + (size_t)mat * 512 * 1024, 512, 1024, W2 + (size_t)mat * 1024 * 512, scr, r % I_W2, F.lane, RmId{}); continue; } r -= 32 * I_W2;
        { const int mat = r / I_G, which = mat >> 3, blk = mat & 7;
          p0_transpose_item((which ? in[19] : in[17]) + (size_t)blk * 128 * 128, 128, 128, (which ? WIG : WRG) + (size_t)blk * 128 * 128, scr, r % I_G, F.lane, RmId{}); }
    }
#undef in
}

__device__ __forceinline__ void norm_rows(Frame& F, const float* X, bf16* H, const float* ng, const float* modl, int sh_off, int sc_off) {
    const int gw = F.bx * NWAVES + F.wave;
    const int b = gw >> 6;
    f32x4 gm[4], sh[4];
#pragma unroll
    for (int j = 0; j < 4; ++j) { const int k = 256 * j + 4 * F.lane;
        const f32x4 g = *(const f32x4*)(ng + k), s = *(const f32x4*)(modl + (size_t)b * 6144 + sc_off + k);
        gm[j] = g * (s + 1.0f); sh[j] = *(const f32x4*)(modl + (size_t)b * 6144 + sh_off + k); }
    for (int r = 0; r < 32; r += 2) {
        const size_t row = (size_t)gw * 32 + r;
        f32x4 v[2][4]; float ss[2];
#pragma unroll
        for (int q = 0; q < 2; ++q) { ss[q] = 0.f;
#pragma unroll
            for (int j = 0; j < 4; ++j) { v[q][j] = *(const f32x4*)(X + (row + q) * DM + 256 * j + 4 * F.lane); ss[q] += (v[q][j][0] * v[q][j][0] + v[q][j][1] * v[q][j][1]) + (v[q][j][2] * v[q][j][2] + v[q][j][3] * v[q][j][3]); } }
#pragma unroll
        for (int q = 0; q < 2; ++q) {
            const float rstd = 1.0f / sqrtf(wave_sum(ss[q]) * (1.0f / DM) + EPS);
#pragma unroll
            for (int j = 0; j < 4; ++j) { const f32x4 o = v[q][j] * rstd * gm[j] + sh[j];
                v2u w; w.x = pk2(o[0], o[1]); w.y = pk2(o[2], o[3]); *(v2u*)(H + (row + q) * DM + 256 * j + 4 * F.lane) = w; }
        }
    }
}

namespace sba {
constexpr int SLOTB = 8192, L_K = 0, L_V = 2 * SLOTB, L_FLAG = 4 * SLOTB, L_OST = 4 * SLOTB + 256;
__device__ __forceinline__ s16x4 vtr(const LAS unsigned char* p) { typedef short v4i16_t __attribute__((ext_vector_type(4))); return __builtin_bit_cast(s16x4, __builtin_amdgcn_ds_read_tr16_b64_v4i16((LAS v4i16_t*)p)); }
__device__ __forceinline__ void unit(int b, int h, int qb, const bf16* Q, const bf16* K, const bf16* V, bf16* CAT, LAS unsigned char* lds) {
    const int tid = threadIdx.x, lane = tid & 63, r32 = lane & 31, hi = lane >> 5; const int wid = __builtin_amdgcn_readfirstlane(tid >> 6);
    const long rowbase = (long)b * SEQ; const int q0 = qb * 256;
    const bf16* Qw = Q + (rowbase + q0 + wid * 32) * SBW + h * HD;
    const bf16* Kh = K + rowbase * SBW + h * HD; const bf16* Vh = V + rowbase * SBW + h * HD;
    const bf16* ksrc = Kh + (long)lane * SBW + wid * 8;
    const bf16* vsrc = Vh + (long)(16 * (wid & 3) + (lane >> 2)) * SBW + (wid >> 2) * 32 + (lane & 3) * 8;
    LAS unsigned char* kdst = lds + L_K + wid * 1024; LAS unsigned char* vdst = lds + L_V + wid * 1024;
#define SBA_DMA(t, slot) do { __builtin_amdgcn_global_load_lds((const unsigned*)(ksrc + (long)(t) * 64 * SBW), (LAS unsigned*)(kdst + (slot) * SLOTB), 16, 0, 0); \
                              __builtin_amdgcn_global_load_lds((const unsigned*)(vsrc + (long)(t) * 64 * SBW), (LAS unsigned*)(vdst + (slot) * SLOTB), 16, 0, 0); } while (0)
    const LAS unsigned char* kp0 = lds + L_K + hi * 1024 + r32 * 16;
    const LAS unsigned char* vp0 = lds + L_V + ((lane >> 4) & 1) * 32 + (lane & 3) * 8 + (4 * hi + ((lane & 15) >> 2)) * 64;
    volatile LAS unsigned* flags = (volatile LAS unsigned*)(lds + L_FLAG);
    const int NT = (q0 + 256) / 64;
    SBA_DMA(NT - 1, 0);
    bf16x8 qr[4];
#pragma unroll
    for (int d0 = 0; d0 < 4; ++d0) qr[d0] = *(const bf16x8*)(Qw + (long)r32 * SBW + d0 * 16 + hi * 8);
    f32x16 o0 = {}, o1 = {};
    float carry = 1.0f; bool done_w = false;
    const int qrow = q0 + wid * 32 + r32, qmin = q0 + wid * 32;
    for (int it = 0, t = NT - 1; t >= 0; --t, ++it) {
        const int slot = it & 1;
        __syncthreads();
        if (it > 0) { unsigned all = 1u;
#pragma unroll
            for (int w8 = 0; w8 < 8; ++w8) all &= flags[((it - 1) & 1) * 8 + w8];
            if (all) break; }
        if (t > 0) SBA_DMA(t - 1, slot ^ 1);
        const int kbase = 64 * t;
        if (!done_w && kbase < qmin + 31) {
            const LAS unsigned char* kp = kp0 + slot * SLOTB;
            bf16x8 kf[8];
#pragma unroll
            for (int d0 = 0; d0 < 4; ++d0) { kf[2 * d0] = *(const LAS bf16x8*)(kp + d0 * 2048); kf[2 * d0 + 1] = *(const LAS bf16x8*)(kp + d0 * 2048 + 512); }
            f32x16 C0 = {}, C1 = {};
#pragma unroll
            for (int d0 = 0; d0 < 4; ++d0) { C0 = __builtin_amdgcn_mfma_f32_32x32x16_bf16(kf[2 * d0], qr[d0], C0, 0, 0, 0); C1 = __builtin_amdgcn_mfma_f32_32x32x16_bf16(kf[2 * d0 + 1], qr[d0], C1, 0, 0, 0); }
            f32x16 D0, D1;
            const bool partial = (kbase + 64 > qmin);
#pragma unroll
            for (int r = 0; r < 16; ++r) {
                const float s0 = __builtin_fminf(__builtin_fmaxf(C0[r], -120.f), 120.f), s1 = __builtin_fminf(__builtin_fmaxf(C1[r], -120.f), 120.f);
                float e0 = fast_exp2(s0), e1 = fast_exp2(s1);
                float f0 = fast_rcp(1.0f + e0), f1 = fast_rcp(1.0f + e1);
                if (partial) { const int kp_ = kbase + 4 * hi + (r & 3) + 8 * (r >> 2);
                    if (!(kp_ < qrow)) { e0 = 0.f; f0 = 1.f; }
                    if (!(kp_ + 32 < qrow)) { e1 = 0.f; f1 = 1.f; } }
                C0[r] = e0; C1[r] = e1; D0[r] = f0; D1[r] = f1;
            }
            float own[8], par[8], eg[8];
#pragma unroll
            for (int g = 0; g < 4; ++g) {
                D0[4 * g + 2] *= D0[4 * g + 3]; D0[4 * g + 1] *= D0[4 * g + 2]; D0[4 * g] *= D0[4 * g + 1]; own[g] = D0[4 * g];
                D1[4 * g + 2] *= D1[4 * g + 3]; D1[4 * g + 1] *= D1[4 * g + 2]; D1[4 * g] *= D1[4 * g + 1]; own[4 + g] = D1[4 * g];
            }
#pragma unroll
            for (int j = 0; j < 8; ++j) par[j] = __shfl_xor(own[j], 32);
            float sp = carry;
#pragma unroll
            for (int j = 7; j >= 0; --j) { eg[j] = hi ? sp : sp * par[j]; sp *= own[j] * par[j]; }
            carry = sp;
#pragma unroll
            for (int g = 0; g < 4; ++g)
#pragma unroll
                for (int i = 0; i < 4; ++i) { C0[4 * g + i] = (C0[4 * g + i] * D0[4 * g + i]) * eg[g]; C1[4 * g + i] = (C1[4 * g + i] * D1[4 * g + i]) * eg[4 + g]; }
            v4u pw0, pw1, pw2, pw3;
            pw0 = (v4u){pk2(C0[0], C0[1]), pk2(C0[2], C0[3]), pk2(C0[4], C0[5]), pk2(C0[6], C0[7])};
            pw1 = (v4u){pk2(C0[8], C0[9]), pk2(C0[10], C0[11]), pk2(C0[12], C0[13]), pk2(C0[14], C0[15])};
            pw2 = (v4u){pk2(C1[0], C1[1]), pk2(C1[2], C1[3]), pk2(C1[4], C1[5]), pk2(C1[6], C1[7])};
            pw3 = (v4u){pk2(C1[8], C1[9]), pk2(C1[10], C1[11]), pk2(C1[12], C1[13]), pk2(C1[14], C1[15])};
            const LAS unsigned char* vp = vp0 + slot * SLOTB;
#pragma unroll
            for (int d0 = 0; d0 < 2; ++d0) {
                s16x4 lo[4], hh[4];
#pragma unroll
                for (int ks = 0; ks < 4; ++ks) { lo[ks] = vtr(vp + d0 * 4096 + ks * 1024); hh[ks] = vtr(vp + d0 * 4096 + ks * 1024 + 512); }
#define SBA_VF(k) (bf16x8){lo[k][0], lo[k][1], lo[k][2], lo[k][3], hh[k][0], hh[k][1], hh[k][2], hh[k][3]}
                f32x16 oo = d0 ? o1 : o0;
                oo = __builtin_amdgcn_mfma_f32_32x32x16_bf16(__builtin_bit_cast(bf16x8, pw0), SBA_VF(0), oo, 0, 0, 0);
                oo = __builtin_amdgcn_mfma_f32_32x32x16_bf16(__builtin_bit_cast(bf16x8, pw1), SBA_VF(1), oo, 0, 0, 0);
                oo = __builtin_amdgcn_mfma_f32_32x32x16_bf16(__builtin_bit_cast(bf16x8, pw2), SBA_VF(2), oo, 0, 0, 0);
                oo = __builtin_amdgcn_mfma_f32_32x32x16_bf16(__builtin_bit_cast(bf16x8, pw3), SBA_VF(3), oo, 0, 0, 0);
                if (d0) o1 = oo; else o0 = oo;
#undef SBA_VF
            }
            done_w = __all(carry < 1e-30f);
        }
        if (lane == 0) flags[slot * 8 + wid] = done_w ? 1u : 0u;
    }
    {
        LAS bf16* stg = (LAS bf16*)(lds + L_OST) + wid * 2048;
#pragma unroll
        for (int r = 0; r < 16; ++r) { const int orow = (r & 3) + 8 * (r >> 2) + 4 * hi;
            stg[orow * 64 + r32] = (bf16)(pk2(o0[r], 0.f) & 0xffffu); stg[orow * 64 + 32 + r32] = (bf16)(pk2(o1[r], 0.f) & 0xffffu); }
        asm volatile("s_waitcnt lgkmcnt(0)" ::: "memory");
        bf16* Ow = CAT + (rowbase + q0 + wid * 32) * DM + 512 + h * HD;
#pragma unroll
        for (int i = 0; i < 4; ++i) { const int row = i * 8 + (lane >> 3), ch = lane & 7; const v4u v = *(const LAS v4u*)(stg + row * 64 + ch * 8); *(v4u*)(Ow + (long)row * DM + ch * 8) = v; }
    }
    __syncthreads();
#undef SBA_DMA
}
}

__device__ __forceinline__ void conv_unit(Frame& F, int b, int tt, const bf16* U0, bf16* CAT, const float* dw_w, const float* dw_b, const float* ln_g, const float* ln_b) {
    const int t0 = tt * 32;
    LAS unsigned char* tile = F.lds;
    LAS float* resl = (LAS float*)(F.lds + 63488);
    for (int idx = F.tid; idx < 62 * 64; idx += 512) {
        const int ri = idx >> 6, ch = idx & 63, tok = t0 - 30 + ri;
        v4u v = {0u, 0u, 0u, 0u};
        if (tok >= 0) v = *(const v4u*)(U0 + ((size_t)b * SEQ + tok) * CONVC + ch * 8);
        *(LAS v4u*)(tile + ri * 1024 + ch * 16) = v;
    }
    __syncthreads();
    {
        const int cp = F.tid & 255, th = F.tid >> 8;
        float w0[31], w1[31];
#pragma unroll
        for (int k = 0; k < 31; ++k) { const f32x2 wv = *(const f32x2*)(dw_w + k * CONVC + 2 * cp); w0[k] = wv[0]; w1[k] = wv[1]; }
        const f32x2 bias = *(const f32x2*)(dw_b + 2 * cp);
#pragma unroll 1
        for (int og = 0; og < 2; ++og) {
            float a0[8], a1[8];
#pragma unroll
            for (int o = 0; o < 8; ++o) { a0[o] = bias[0]; a1[o] = bias[1]; }
            const LAS unsigned char* tp = tile + (16 * th + 8 * og) * 1024 + cp * 4;
#pragma unroll
            for (int j = 0; j < 38; ++j) {
                const unsigned xin = *(const LAS unsigned*)(tp + j * 1024);
                const float x0 = bflo(xin), x1 = bfhi(xin);
#pragma unroll
                for (int o = 0; o < 8; ++o) { const int k = j - o; if (k >= 0 && k <= 30) { a0[o] += w0[k] * x0; a1[o] += w1[k] * x1; } }
            }
#pragma unroll
            for (int o = 0; o < 8; ++o) *(LAS f32x2*)(resl + (16 * th + 8 * og + o) * 512 + 2 * cp) = (f32x2){a0[o], a1[o]};
        }
    }
    __syncthreads();
    {
        const f32x4 lg0 = *(const f32x4*)(ln_g + 8 * F.lane), lg1 = *(const f32x4*)(ln_g + 8 * F.lane + 4), lb0 = *(const f32x4*)(ln_b + 8 * F.lane), lb1 = *(const f32x4*)(ln_b + 8 * F.lane + 4);
#pragma unroll
        for (int i = 0; i < 4; ++i) {
            const int tk = F.wave * 4 + i;
            const f32x4 v0 = *(const LAS f32x4*)(resl + tk * 512 + 8 * F.lane), v1 = *(const LAS f32x4*)(resl + tk * 512 + 8 * F.lane + 4);
            const float s = wave_sum((v0[0] + v0[1]) + (v0[2] + v0[3]) + (v1[0] + v1[1]) + (v1[2] + v1[3]));
            const float mean = s * (1.0f / CONVC);
            const f32x4 d0 = v0 - mean, d1 = v1 - mean;
            const float q = wave_sum((d0[0] * d0[0] + d0[1] * d0[1]) + (d0[2] * d0[2] + d0[3] * d0[3]) + (d1[0] * d1[0] + d1[1] * d1[1]) + (d1[2] * d1[2] + d1[3] * d1[3]));
            const float rstd = 1.0f / sqrtf(q * (1.0f / CONVC) + EPS);
            const f32x4 y0 = d0 * rstd * lg0 + lb0, y1 = d1 * rstd * lg1 + lb1;
            v4u pw; pw.x = pk2(siluf_(y0[0]), siluf_(y0[1])); pw.y = pk2(siluf_(y0[2]), siluf_(y0[3])); pw.z = pk2(siluf_(y1[0]), siluf_(y1[1])); pw.w = pk2(siluf_(y1[2]), siluf_(y1[3]));
            *(v4u*)(CAT + ((size_t)b * SEQ + t0 + tk) * DM + 8 * F.lane) = pw;
        }
    }
    __syncthreads();
}

__device__ __forceinline__ void lru_unit(Frame& F, int b, int cb, const bf16* GY, const bf16* XB, bf16* CAT2, const bf16* WRG, const bf16* WIG,
                                         const float* conv_w, const float* conv_b, const float* rg_b, const float* ig_b, const float* lam) {
    constexpr int L_XR = 0, L_XC = 17408, L_GY = 34816, L_OUT = 51200;
    LAS unsigned char* lds = F.lds;
    const int lane = F.lane, wv = F.wave, l15 = lane & 15, g4 = lane >> 4;
    const int cl_ = 16 * wv + l15, cglob = cb * 128 + cl_;
    bf16x8 brg[4], big[4];
#pragma unroll
    for (int ks = 0; ks < 4; ++ks) { brg[ks] = *(const bf16x8*)(WRG + ((size_t)cb * 128 + cl_) * 128 + 32 * ks + 8 * g4); big[ks] = *(const bf16x8*)(WIG + ((size_t)cb * 128 + cl_) * 128 + 32 * ks + 8 * g4); }
    const float rb = rg_b[cglob], ib = ig_b[cglob];
    const float lamv = lam[cglob];
    const float cl2 = -8.0f * log1pf(expf(-lamv)) * 1.4426950408889634f;
    const int cp2 = F.tid & 63;
    float cw0[4], cw1[4];
#pragma unroll
    for (int k = 0; k < 4; ++k) { const f32x2 w = *(const f32x2*)(conv_w + k * DM + cb * 128 + 2 * cp2); cw0[k] = w[0]; cw1[k] = w[1]; }
    const f32x2 cbias = *(const f32x2*)(conv_b + cb * 128 + 2 * cp2);
    const size_t rowb = (size_t)b * SEQ;
    v4u px[3], pg[2];
#define LRU_PREFETCH(t0_) do { \
        _Pragma("unroll") for (int i = 0; i < 3; ++i) { const int idx = F.tid + 512 * i; px[i] = (v4u){0u, 0u, 0u, 0u}; \
            if (idx < 67 * 16) { const int ri = idx >> 4, chn = idx & 15, tok = (t0_) - 3 + ri; if (tok >= 0) px[i] = *(const v4u*)(XB + (rowb + tok) * DM + cb * 128 + chn * 8); } } \
        _Pragma("unroll") for (int i = 0; i < 2; ++i) { const int idx = F.tid + 512 * i; const int ri = idx >> 4, chn = idx & 15; pg[i] = *(const v4u*)(GY + (rowb + (t0_) + ri) * DM + cb * 128 + chn * 8); } } while (0)
    LRU_PREFETCH(0);
    float carry = 0.f;
    for (int it = 0; it < SEQ / 64; ++it) {
        const int t0 = it * 64;
#pragma unroll
        for (int i = 0; i < 3; ++i) { const int idx = F.tid + 512 * i; if (idx < 67 * 16) *(LAS v4u*)(lds + L_XR + idx * 16) = px[i]; }
#pragma unroll
        for (int i = 0; i < 2; ++i) { const int idx = F.tid + 512 * i; *(LAS v4u*)(lds + L_GY + idx * 16) = pg[i]; }
        __syncthreads();
        if (it + 1 < SEQ / 64) LRU_PREFETCH(t0 + 64);
        {
            float x0[11], x1[11];
#pragma unroll
            for (int j = 0; j < 11; ++j) { const unsigned xin = *(const LAS unsigned*)(lds + L_XR + (8 * wv + j) * 256 + cp2 * 4); x0[j] = bflo(xin); x1[j] = bfhi(xin); }
#pragma unroll
            for (int o = 0; o < 8; ++o) {
                const float y0 = cbias[0] + (cw0[0] * x0[o] + cw0[1] * x0[o + 1]) + (cw0[2] * x0[o + 2] + cw0[3] * x0[o + 3]);
                const float y1 = cbias[1] + (cw1[0] * x1[o] + cw1[1] * x1[o + 1]) + (cw1[2] * x1[o + 2] + cw1[3] * x1[o + 3]);
                *(LAS unsigned*)(lds + L_XC + (8 * wv + o) * 272 + cp2 * 4) = pk2(y0, y1);
            }
        }
        __syncthreads();
#pragma unroll
        for (int m = 0; m < 4; ++m) {
            f32x4 aR = {0.f, 0.f, 0.f, 0.f}, aI = {0.f, 0.f, 0.f, 0.f};
#pragma unroll
            for (int ks = 0; ks < 4; ++ks) { const bf16x8 af = *(const LAS bf16x8*)(lds + L_XC + (16 * m + l15) * 272 + (32 * ks + 8 * g4) * 2);
                aR = __builtin_amdgcn_mfma_f32_16x16x32_bf16(af, brg[ks], aR, 0, 0, 0); aI = __builtin_amdgcn_mfma_f32_16x16x32_bf16(af, big[ks], aI, 0, 0, 0); }
            float av[4], bv[4], gy[4];
            float A = 1.f, B = 0.f;
#pragma unroll
            for (int r = 0; r < 4; ++r) {
                const int tk = 16 * m + 4 * g4 + r;
                const float xcv = bf2f(*(const LAS bf16*)(lds + L_XC + tk * 272 + cl_ * 2));
                gy[r] = bf2f(*(const LAS bf16*)(lds + L_GY + tk * 256 + cl_ * 2));
                const float rr = sigmoidf_(aR[r] + rb), ii = sigmoidf_(aI[r] + ib);
                const float a = fast_exp2(cl2 * rr);
                const float mult = sqrtf(__builtin_fmaxf(1.0f - a * a, 0.f));
                av[r] = a; bv[r] = mult * ii * xcv;
                B = a * B + bv[r]; A = A * a;
            }
            { const float Ap = __shfl_up(A, 16), Bp = __shfl_up(B, 16); if (g4 >= 1) { B = A * Bp + B; A = A * Ap; } }
            { const float Ap = __shfl_up(A, 32), Bp = __shfl_up(B, 32); if (g4 >= 2) { B = A * Bp + B; A = A * Ap; } }
            const float hend = A * carry + B;
            const float hprev = __shfl_up(hend, 16);
            float hcur = (g4 == 0) ? carry : hprev;
            carry = __shfl(hend, 48 + l15);
#pragma unroll
            for (int r = 0; r < 4; ++r) { hcur = av[r] * hcur + bv[r]; const int tk = 16 * m + 4 * g4 + r;
                *(LAS bf16*)(lds + L_OUT + tk * 256 + cl_ * 2) = (bf16)(pk2(gy[r] * hcur, 0.f) & 0xffffu); }
        }
        __syncthreads();
#pragma unroll
        for (int i = 0; i < 2; ++i) { const int idx = F.tid + 512 * i; const int ri = idx >> 4, chn = idx & 15;
            *(v4u*)(CAT2 + (rowb + t0 + ri) * DM + cb * 128 + chn * 8) = *(const LAS v4u*)(lds + L_OUT + idx * 16); }
    }
    __syncthreads();
#undef LRU_PREFETCH
}

__device__ __forceinline__ void router_phase(Frame& F, const float* X, bf16* H, const float* ng, const float* modl, const float* rw, const float* rbias) {
    LAS float* wrt = (LAS float*)F.lds;
    LAS float* gml = (LAS float*)(F.lds + 65536);
    LAS float* shl = (LAS float*)(F.lds + 69632);
    LAS float* brl = (LAS float*)(F.lds + 73728);
    LAS int* cnt = (LAS int*)(F.lds + 73728 + 64);
    const int w = F.bx, b = w >> 3;
    for (int i = F.tid; i < 16 * 1024; i += 512) { const int k = i >> 4, e = i & 15; wrt[e * 1024 + k] = rw[i]; }
    for (int k = F.tid; k < 1024; k += 512) { gml[k] = ng[k] * (1.0f + modl[(size_t)b * 6144 + 4 * 1024 + k]); shl[k] = modl[(size_t)b * 6144 + 3 * 1024 + k]; }
    if (F.tid < 16) cnt[F.tid] = 0;
    __syncthreads();
    if (F.wave == 0) {
        float acc[16];
#pragma unroll
        for (int e = 0; e < 16; ++e) acc[e] = 0.f;
        for (int k = F.lane; k < 1024; k += 64) { const float s = shl[k];
#pragma unroll
            for (int e = 0; e < 16; ++e) acc[e] += s * wrt[e * 1024 + k]; }
#pragma unroll
        for (int e = 0; e < 16; ++e) { const float t = wave_sum(acc[e]); if (F.lane == 0) brl[e] = t; }
    }
    __syncthreads();
    const int sub = F.lane & 15, rsel = F.lane >> 4;
    int* EID = (int*)(F.ws + META_EID); float* GATE = (float*)(F.ws + META_GATE);
    for (int pass = 0; pass < 8; ++pass) {
        const size_t row = (size_t)w * 256 + F.wave * 32 + pass * 4 + rsel;
        f32x4 xg[16]; float ss = 0.f; float acc[16];
#pragma unroll
        for (int e = 0; e < 16; ++e) acc[e] = 0.f;
#pragma unroll
        for (int c = 0; c < 16; ++c) {
            const int k = 64 * c + 4 * sub;
            const f32x4 x = *(const f32x4*)(X + row * DM + k);
            ss += (x[0] * x[0] + x[1] * x[1]) + (x[2] * x[2] + x[3] * x[3]);
            xg[c] = x * *(const LAS f32x4*)(gml + k);
#pragma unroll
            for (int e = 0; e < 16; ++e) { const f32x4 wv = *(const LAS f32x4*)(wrt + e * 1024 + k); acc[e] += (xg[c][0] * wv[0] + xg[c][1] * wv[1]) + (xg[c][2] * wv[2] + xg[c][3] * wv[3]); }
        }
#pragma unroll
        for (int o = 1; o < 16; o <<= 1) { ss += __shfl_xor(ss, o);
#pragma unroll
            for (int e = 0; e < 16; ++e) acc[e] += __shfl_xor(acc[e], o); }
        const float rstd = 1.0f / sqrtf(ss * (1.0f / DM) + EPS);
#pragma unroll
        for (int c = 0; c < 16; ++c) { const int k = 64 * c + 4 * sub; const f32x4 o = xg[c] * rstd + *(const LAS f32x4*)(shl + k);
            v2u pw; pw.x = pk2(o[0], o[1]); pw.y = pk2(o[2], o[3]); *(v2u*)(H + row * DM + k) = pw; }
        float sc[16], bi[16];
#pragma unroll
        for (int e = 0; e < 16; ++e) { const float lg = acc[e] * rstd + brl[e]; sc[e] = 1.0f / (1.0f + __expf(-lg)); bi[e] = sc[e] + rbias[e]; }
        int gbest = 0; float gsb = -1e30f;
#pragma unroll
        for (int g = 0; g < 4; ++g) {
            float m1 = bi[4 * g], m2 = -1e30f;
#pragma unroll
            for (int i = 1; i < 4; ++i) { const float v = bi[4 * g + i]; if (v > m1) { m2 = m1; m1 = v; } else if (v > m2) m2 = v; }
            const float gs = m1 + m2; if (gs > gsb) { gsb = gs; gbest = g; }
        }
        float v4[4], s4[4];
#pragma unroll
        for (int i = 0; i < 4; ++i) { v4[i] = gbest == 0 ? bi[i] : gbest == 1 ? bi[4 + i] : gbest == 2 ? bi[8 + i] : bi[12 + i]; s4[i] = gbest == 0 ? sc[i] : gbest == 1 ? sc[4 + i] : gbest == 2 ? sc[8 + i] : sc[12 + i]; }
        int i1 = 0;
#pragma unroll
        for (int i = 1; i < 4; ++i) if (v4[i] > v4[i1]) i1 = i;
        int i2 = (i1 == 0) ? 1 : 0;
#pragma unroll
        for (int i = 0; i < 4; ++i) if (i != i1 && i != i2 && v4[i] > v4[i2]) i2 = i;
        const float se1 = i1 == 0 ? s4[0] : i1 == 1 ? s4[1] : i1 == 2 ? s4[2] : s4[3], se2 = i2 == 0 ? s4[0] : i2 == 1 ? s4[1] : i2 == 2 ? s4[2] : s4[3];
        if (sub == 0) {
            const int e1 = 4 * gbest + i1, e2 = 4 * gbest + i2; const float inv = 1.0f / (se1 + se2);
            EID[row * 2] = e1; EID[row * 2 + 1] = e2; GATE[row * 2] = se1 * inv; GATE[row * 2 + 1] = se2 * inv;
            atomicAdd((int*)&cnt[e1], 1); atomicAdd((int*)&cnt[e2], 1);
        }
    }
    __syncthreads();
    if (F.tid < 16) ((int*)(F.ws + META_BCNT))[w * 16 + F.tid] = cnt[F.tid];
    __syncthreads();
}

__device__ __forceinline__ void slot_phase(Frame& F, const bf16* H, bf16* XS) {
    LAS int* cn = (LAS int*)F.lds;
    LAS int* mybase = (LAS int*)(F.lds + 16384);
    LAS int* tot = (LAS int*)(F.lds + 16384 + 64);
    LAS int* cursor = (LAS int*)(F.lds + 16384 + 128);
    const int w = F.bx;
    const int* BC = (const int*)(F.ws + META_BCNT);
    for (int i = F.tid; i < 4096; i += 512) cn[i] = BC[i];
    __syncthreads();
    if (F.tid < 16) { int run = 0, mb = 0; for (int j = 0; j < 256; ++j) { if (j == w) mb = run; run += cn[j * 16 + F.tid]; } mybase[F.tid] = mb; tot[F.tid] = run; }
    __syncthreads();
    if (F.tid == 0) {
        int ps = 0; int* TE = (int*)(F.ws + META_TILEE);
        for (int e = 0; e < 16; ++e) { const int padded = (tot[e] + 255) & ~255; cursor[e] = ps + mybase[e];
            if (w == 0) for (int tl = ps >> 8; tl < (ps + padded) >> 8; ++tl) TE[tl] = e;
            ps += padded; }
        if (w == 0) *(int*)(F.ws + META_NT) = ps >> 8;
    }
    __syncthreads();
    const int* EID = (const int*)(F.ws + META_EID); int* SLOT = (int*)(F.ws + META_SLOT);
    for (int i = 0; i < 32; i += 2) {
        const size_t t0 = (size_t)w * 256 + F.wave * 32 + i;
        int s[2][2];
#pragma unroll
        for (int q = 0; q < 2; ++q) {
            int s0 = 0, s1 = 0;
            if (F.lane == 0) { const int e0 = EID[(t0 + q) * 2], e1 = EID[(t0 + q) * 2 + 1]; s0 = atomicAdd((int*)&cursor[e0], 1); s1 = atomicAdd((int*)&cursor[e1], 1); SLOT[(t0 + q) * 2] = s0; SLOT[(t0 + q) * 2 + 1] = s1; }
            s[q][0] = __builtin_amdgcn_readfirstlane(s0); s[q][1] = __builtin_amdgcn_readfirstlane(s1);
        }
#pragma unroll
        for (int q = 0; q < 2; ++q) {
            const v4u a = *(const v4u*)(H + (t0 + q) * DM + F.lane * 8), c = *(const v4u*)(H + (t0 + q) * DM + 512 + F.lane * 8);
            *(v4u*)(XS + (size_t)s[q][0] * DM + F.lane * 8) = a; *(v4u*)(XS + (size_t)s[q][0] * DM + 512 + F.lane * 8) = c;
            *(v4u*)(XS + (size_t)s[q][1] * DM + F.lane * 8) = a; *(v4u*)(XS + (size_t)s[q][1] * DM + 512 + F.lane * 8) = c;
        }
    }
    __syncthreads();
}

template <bool NEXT>
__device__ __forceinline__ void combine_phase(Frame& F, float* X, const bf16* Y, const float* modl  , bf16* H, const float* ng_next, const float* modn  ) {
    const int gw = F.bx * NWAVES + F.wave, b = gw >> 6;
    const int* SLOT = (const int*)(F.ws + META_SLOT); const float* GATE = (const float*)(F.ws + META_GATE);
    f32x4 g2[4], gm[4], sh[4];
#pragma unroll
    for (int j = 0; j < 4; ++j) { const int k = 256 * j + 4 * F.lane; g2[j] = *(const f32x4*)(modl + (size_t)b * 6144 + 5 * 1024 + k);
        if (NEXT) { const f32x4 g = *(const f32x4*)(ng_next + k), s = *(const f32x4*)(modn + (size_t)b * 6144 + 1 * 1024 + k); gm[j] = g * (s + 1.0f); sh[j] = *(const f32x4*)(modn + (size_t)b * 6144 + k); } }
    for (int r = 0; r < 32; ++r) {
        const size_t row = (size_t)gw * 32 + r;
        const int s0 = SLOT[row * 2], s1 = SLOT[row * 2 + 1]; const float ga = GATE[row * 2], gb = GATE[row * 2 + 1];
        f32x4 v[4]; float ss = 0.f;
#pragma unroll
        for (int j = 0; j < 4; ++j) { const int k = 256 * j + 4 * F.lane;
            const f32x4 x = *(const f32x4*)(X + row * DM + k);
            const v2u ya = *(const v2u*)(Y + (size_t)s0 * DM + k), yb = *(const v2u*)(Y + (size_t)s1 * DM + k);
            f32x4 f; f[0] = ga * bflo(ya.x) + gb * bflo(yb.x); f[1] = ga * bfhi(ya.x) + gb * bfhi(yb.x); f[2] = ga * bflo(ya.y) + gb * bflo(yb.y); f[3] = ga * bfhi(ya.y) + gb * bfhi(yb.y);
            v[j] = x + g2[j] * f;
            *(f32x4*)(X + row * DM + k) = v[j];
            ss += (v[j][0] * v[j][0] + v[j][1] * v[j][1]) + (v[j][2] * v[j][2] + v[j][3] * v[j][3]); }
        if (NEXT) {
            const float rstd = 1.0f / sqrtf(wave_sum(ss) * (1.0f / DM) + EPS);
#pragma unroll
            for (int j = 0; j < 4; ++j) { const f32x4 o = v[j] * rstd * gm[j] + sh[j]; v2u pw; pw.x = pk2(o[0], o[1]); pw.y = pk2(o[2], o[3]); *(v2u*)(H + row * DM + 256 * j + 4 * F.lane) = pw; }
        }
    }
}

constexpr int NPHASE = 18;
struct Args { const float* in[28]; float* out; unsigned char* ws; int ph_lo, ph_hi; };
template <int PLO, int PHI> __global__ void __launch_bounds__(NWAVES * 64, 2) mk_fwd(Args args) {
    extern __shared__ __attribute__((aligned(16))) unsigned char lds_raw[];
    Frame F;
    F.lds = (LAS unsigned char*)lds_raw;
    F.tid = threadIdx.x; F.lane = F.tid & 63; F.wave = __builtin_amdgcn_readfirstlane(F.tid >> 6);
    F.G = gridDim.x; F.bx = blockIdx.x; F.vcu = (F.G % 8 == 0) ? (F.bx % 8) * (F.G / 8) + F.bx / 8 : F.bx;
    F.ws = args.ws;
    volatile LAS unsigned* MISC = (volatile LAS unsigned*)(F.lds + MISC_OFF);
    for (int u = F.tid; u < (LDS_BYTES - LDSCTL_OFF) / 4; u += NWAVES * 64) ((LAS unsigned*)(F.lds + LDSCTL_OFF))[u] = 0u;
    __syncthreads();
#if MK_ONE_LAUNCH
    XcdBarrier bar = xcd_barrier_post((unsigned*)(F.ws + WS_CTL) + CW_BAR, MISC + 8);
#define GRID_BAR() do { XcdBarrier b_ = bar; asm volatile("" : "+s"(b_.bar), "+s"(b_.x)); xcd_barrier(b_); } while (0)
#else
#define GRID_BAR() do {} while (0)
#endif
    constexpr int lo = PLO, hi = PHI;
#ifndef PHASE_MASK
#define PHASE_MASK 0x3ffff
#endif
#define IN(k) ((((PHASE_MASK) >> (k)) & 1) && lo <= (k) && (k) < hi)
#define SEAM(k) do { if (IN(k) && IN((k) + 1)) GRID_BAR(); } while (0)
    typedef const __attribute__((address_space(4))) Args* KArgs; KArgs KA = (KArgs)__builtin_amdgcn_kernarg_segment_ptr();
#define in KA->in
#define PHASE_ENTER() do { KA = (KArgs)__builtin_amdgcn_kernarg_segment_ptr(); asm volatile("" : "+s"(KA)); F.ws = KA->ws; int tid_o = threadIdx.x; asm volatile("" : "+v"(tid_o)); F.tid = tid_o; F.lane = tid_o & 63; F.wave = __builtin_amdgcn_readfirstlane(tid_o >> 6); } while (0)
#define P_MOD ((float*)(F.ws + WS_MOD))
#define P_HA ((bf16*)(F.ws + WS_HA))
#define P_U0 ((bf16*)(F.ws + WS_R1))
#define P_Q (P_U0 + (size_t)T * 512)
#define P_K (P_U0 + (size_t)2 * T * 512)
#define P_V (P_U0 + (size_t)3 * T * 512)
#define P_GY ((bf16*)(F.ws + WS_R1))
#define P_XB (P_GY + (size_t)T * DM)
#define P_XS ((bf16*)(F.ws + WS_R1))
#define P_Y P_XS
#define P_CAT ((bf16*)(F.ws + WS_R2))
#define P_HID P_CAT

    if (IN(0)) { PHASE_ENTER(); p0_prologue(F, KA); } SEAM(0);
    if (IN(1)) { PHASE_ENTER(); norm_rows(F, in[0], P_HA, in[4], P_MOD, 0, 1024); } SEAM(1);
    if (IN(2)) { PHASE_ENTER();
        pg8::Gemm g{P_HA, (const bf16*)(F.ws + WS_WEVIN), T, EVIN, DM, 0}; pg8::StaticOrder S; S.init(T, EVIN, F.G, F.bx);
        pg8::EpiEvIn E{P_U0, P_Q, P_K, P_V, in[11], in[12]};
        pg8::gemm_phase<pg8::EpiEvIn, pg8::StaticOrder, true, true>(F.lds, g, S, E);
    } SEAM(2);
    if (IN(3)) { PHASE_ENTER();
#ifndef NO_ATTN
        { const int bh = F.vcu; for (int qb = 7; qb >= 0; --qb) sba::unit(bh >> 3, bh & 7, qb, P_Q, P_K, P_V, P_CAT, F.lds); }
#endif
#ifndef NO_CONV
        for (int uidx = F.vcu; uidx < NB * (SEQ / 32); uidx += F.G) conv_unit(F, uidx >> 6, uidx & 63, P_U0, P_CAT, in[7], in[8], in[9], in[10]);
#endif
    } SEAM(3);
    if (IN(4)) { PHASE_ENTER();
        pg8::Gemm g{P_CAT, (const bf16*)(F.ws + WS_WEVOUT), T, DM, DM, 0}; pg8::StaticOrder S; S.init(T, DM, F.G, F.bx);
        pg8::EpiResid E{in[0], KA->out, P_MOD + 2 * 1024};
        pg8::gemm_phase<pg8::EpiResid, pg8::StaticOrder, true, true>(F.lds, g, S, E);
    } SEAM(4);
#define MOE_PHASES(layer, p0) \
    if (IN(p0)) { PHASE_ENTER(); router_phase(F, KA->out, P_HA, in[5] + (layer) * DM, P_MOD + (size_t)(layer) * 32 * 6144, in[23], in[24]); } SEAM(p0); \
    if (IN((p0) + 1)) { PHASE_ENTER(); slot_phase(F, P_HA, P_XS); } SEAM((p0) + 1); \
    if (IN((p0) + 2)) { PHASE_ENTER(); \
        const int ntl = *(const int*)(F.ws + META_NT); \
        pg8::Gemm g{P_XS, (const bf16*)(F.ws + WS_W13) + (size_t)(layer) * 16 * 1024 * 1024, ntl * 256, 1024, DM, (size_t)1024 * 1024 * 2}; \
        pg8::MoeOrder S; S.base.init(ntl * 256, 1024, F.G, F.bx); S.tile_e = (const int*)(F.ws + META_TILEE); \
        pg8::EpiMoeA E{P_HID}; \
        pg8::gemm_phase<pg8::EpiMoeA, pg8::MoeOrder, true, true>(F.lds, g, S, E); \
    } SEAM((p0) + 2); \
    if (IN((p0) + 3)) { PHASE_ENTER(); \
        const int ntl = *(const int*)(F.ws + META_NT); \
        pg8::Gemm g{P_HID, (const bf16*)(F.ws + WS_W2) + (size_t)(layer) * 16 * 1024 * 512, ntl * 256, 1024, DFF, (size_t)1024 * 512 * 2}; \
        pg8::MoeOrder S; S.base.init(ntl * 256, 1024, F.G, F.bx); S.tile_e = (const int*)(F.ws + META_TILEE); \
        pg8::EpiMoeB E{P_Y}; \
        pg8::gemm_phase<pg8::EpiMoeB, pg8::MoeOrder, true, true>(F.lds, g, S, E); \
    } SEAM((p0) + 3);

    MOE_PHASES(0, 5)
    if (IN(9)) { PHASE_ENTER(); combine_phase<true>(F, KA->out, P_Y, P_MOD, P_HA, in[4] + DM, P_MOD + (size_t)32 * 6144); } SEAM(9);
    if (IN(10)) { PHASE_ENTER();
        pg8::Gemm g{P_HA, (const bf16*)(F.ws + WS_WODIN), T, 2048, DM, 0}; pg8::StaticOrder S; S.init(T, 2048, F.G, F.bx);
        pg8::EpiOdIn E{P_GY, P_XB};
        pg8::gemm_phase<pg8::EpiOdIn, pg8::StaticOrder, true, true>(F.lds, g, S, E);
    } SEAM(10);
    if (IN(11)) { PHASE_ENTER(); const int u = F.vcu; lru_unit(F, u >> 3, u & 7, P_GY, P_XB, P_CAT, (const bf16*)(F.ws + WS_WRG), (const bf16*)(F.ws + WS_WIG), in[15], in[16], in[18], in[20], in[21]); } SEAM(11);
    if (IN(12)) { PHASE_ENTER();
        pg8::Gemm g{P_CAT, (const bf16*)(F.ws + WS_WODOUT), T, DM, DM, 0}; pg8::StaticOrder S; S.init(T, DM, F.G, F.bx);
        pg8::EpiResid E{KA->out, KA->out, P_MOD + (size_t)32 * 6144 + 2 * 1024};
        pg8::gemm_phase<pg8::EpiResid, pg8::StaticOrder, true, true>(F.lds, g, S, E);
    } SEAM(12);
    MOE_PHASES(1, 13)
    if (IN(17)) { PHASE_ENTER(); combine_phase<false>(F, KA->out, P_Y, P_MOD + (size_t)32 * 6144, P_HA, nullptr, nullptr); }
#undef MOE_PHASES
#undef in
#undef IN
#undef SEAM
}

#if !MK_ONE_LAUNCH
template <int P> static void set_attr_all() { if constexpr (P < NPHASE) { (void)hipFuncSetAttribute((const void*)mk_fwd<P, P + 1>, hipFuncAttributeMaxDynamicSharedMemorySize, LDS_BYTES); set_attr_all<P + 1>(); } }
template <int P> static void launch_all(Args a, int grid, hipStream_t stream) { if constexpr (P < NPHASE) { a.ph_lo = P; a.ph_hi = P + 1; hipLaunchKernelGGL((mk_fwd<P, P + 1>), dim3(grid), dim3(NWAVES * 64), LDS_BYTES, stream, a); launch_all<P + 1>(a, grid, stream); } }
#endif

extern "C" void kernel_launch(void* const* d_in, const int* in_sizes, int n_in, void* d_out, int out_size, void* d_ws, size_t ws_size, hipStream_t stream) {
    static int grid = 0;
    if (grid == 0) {
        if (n_in != 28 || in_sizes[0] != T * DM || out_size != T * DM || ws_size < WS_END) { fprintf(stderr, "kernel_launch: unexpected shapes (n_in %d, in0 %d, out %d, ws %zu); nothing launched\n", n_in, n_in > 0 ? in_sizes[0] : -1, out_size, ws_size); grid = -1; return; }
        int dev = 0, cus = 0;
        if (hipGetDevice(&dev) != hipSuccess || hipDeviceGetAttribute(&cus, hipDeviceAttributeMultiprocessorCount, dev) != hipSuccess) { grid = -1; return; }
#if MK_ONE_LAUNCH
        if (hipFuncSetAttribute((const void*)mk_fwd<0, NPHASE>, hipFuncAttributeMaxDynamicSharedMemorySize, LDS_BYTES) != hipSuccess) { fprintf(stderr, "kernel_launch: hipFuncSetAttribute failed\n"); grid = -1; return; }
        int per_cu = 0;
        if (hipOccupancyMaxActiveBlocksPerMultiprocessor(&per_cu, (const void*)mk_fwd<0, NPHASE>, NWAVES * 64, LDS_BYTES) != hipSuccess || per_cu < 1) fprintf(stderr, "kernel_launch: occupancy query reports %d\n", per_cu);
#else
        set_attr_all<0>();
#endif
        (void)hipGetLastError();
        grid = cus;
        if (grid != 256) { fprintf(stderr, "kernel_launch: built for 256 CUs, device has %d; nothing launched\n", cus); grid = -1; return; }
    }
    if (grid < 0) return;
    (void)hipMemsetAsync((char*)d_ws + WS_CTL, 0, CTL_ZERO_BYTES, stream);
    Args a{};
    for (int i = 0; i < 28; ++i) a.in[i] = (const float*)d_in[i];
    a.out = (float*)d_out; a.ws = (unsigned char*)d_ws;
#if MK_ONE_LAUNCH
    a.ph_lo = 0; a.ph_hi = NPHASE;
    hipLaunchKernelGGL((mk_fwd<0, NPHASE>), dim3(grid), dim3(NWAVES * 64), LDS_BYTES, stream, a);
#else
    launch_all<0>(a, grid, stream);
#endif
}
```

```cpp
#include <hip/hip_runtime.h>
#include <cstdio>
#include <cstdint>

#ifndef MK_ONE_LAUNCH
#define MK_ONE_LAUNCH 1
#endif

namespace pg8 {
#define PG8_LAS __attribute__((address_space(3)))
typedef unsigned short bf16_t;
typedef short bf16x8 __attribute__((ext_vector_type(8)));
typedef float f32x4 __attribute__((ext_vector_type(4)));
typedef unsigned u32x4 __attribute__((ext_vector_type(4)));
constexpr int BM = 256, BK = 64, HALF = 128, HTB = HALF * BK * 2  , STAGE_BYTES = 8 * HTB, NXCD = 8, WGM = 8;

__host__ __device__ __forceinline__ int lds_byte(int r, int c) { const int st = (r >> 4) * 2 + (c >> 5), rr = r & 15, cc = c & 31, ob = rr * 64 + cc * 2; return st * 1024 + (ob ^ (((ob >> 9) & 1) << 5)); }
__host__ __device__ __forceinline__ void stage_rc(int b, int& R, int& C) { const int st = b / 1024, sb = b % 1024, swz = sb ^ (((sb >> 9) & 1) << 5); R = (st >> 1) * 16 + swz / 64; C = (st & 1) * 32 + (swz % 64) / 2; }
__host__ __device__ __forceinline__ int perm32(int rho) { const int n = rho >> 4, i = rho & 15; return 8 * (i >> 2) + 4 * n + (i & 3); }

struct Unit { int pm, pn, pb; };
struct Gemm { const bf16_t* A; const bf16_t* Bt; int M, N, K; size_t bstride; };

struct StaticOrder {
    static constexpr bool GATHER = false, LAZY_PB = false; const int* tok;
    int nM, nN, nwg, G, c;
    __host__ __device__ void init(int M, int N, int G_, int c_) { nM = M / BM; nN = N / BM; nwg = nM * nN; G = G_; c = c_; }
    __host__ __device__ bool next(int i, Unit& u) const {
        const long L = (long)i * G + c; if (L >= nwg) return false;
        int wgid = (int)L; { const int q = nwg / NXCD, r = nwg % NXCD, xcd = wgid % NXCD, off = wgid / NXCD; wgid = (xcd < r ? xcd * (q + 1) : r * (q + 1) + (xcd - r) * q) + off; }
        const int nig = WGM * nN, gid = wgid / nig, fm = gid * WGM, gsz = (nM - fm) < WGM ? (nM - fm) : WGM;
        u.pm = fm + ((wgid % nig) % gsz); u.pn = (wgid % nig) / gsz; u.pb = 0; return true;
    }
    __device__ __forceinline__ void a_ready(const Unit&) const {}
    __device__ __forceinline__ void done(const Unit&) const {}
};

template <class Epi, class Sched, bool ALIGN_EPI = false, bool SP2 = false>
__device__ __forceinline__ void gemm_phase(PG8_LAS unsigned char* lds, const Gemm g, const Sched& S, const Epi& E) {
    int tid_ = threadIdx.x; asm volatile("" : "+v"(tid_));
    const int tid = tid_, wid = __builtin_amdgcn_readfirstlane(tid >> 6), lane = tid & 63, wr = wid >> 2, wc = wid & 3, fr = lane & 15, fq = lane >> 4;
    const int K = g.K, nt = K / BK;
    unsigned voffA[2], voffB[2];
#pragma unroll
    for (int i = 0; i < 2; ++i) { int R, C; stage_rc(tid * 16 + i * 8192, R, C); const int Rb = Epi::PERM ? ((R & ~31) + perm32(R & 31)) : R;
        voffA[i] = (unsigned)(R * K + C) * 2u; voffB[i] = (unsigned)(Rb * K + C) * 2u; }
    unsigned cvo[2][2], nvo[2][2]; int rowA[2]; unsigned colA[2];
#pragma unroll
    for (int i = 0; i < 2; ++i) { int R, C; stage_rc(tid * 16 + i * 8192, R, C); rowA[i] = R; colA[i] = (unsigned)C * 2u; }
    int ntk[2][2];
#define PG8_LOADTK(u_, tk_) do { const int* _p00 = S.tok + (u_).pm * BM + rowA[0]; const int* _p01 = S.tok + (u_).pm * BM + rowA[1]; const int* _p10 = _p00 + HALF; const int* _p11 = _p01 + HALF; \
        asm volatile("global_load_dword %0, %4, off\n\tglobal_load_dword %1, %5, off\n\tglobal_load_dword %2, %6, off\n\tglobal_load_dword %3, %7, off" \
            : "=&v"(tk_[0][0]), "=&v"(tk_[0][1]), "=&v"(tk_[1][0]), "=&v"(tk_[1][1]) : "v"(_p00), "v"(_p01), "v"(_p10), "v"(_p11) : "memory"); } while (0)
#define PG8_TK2VO(tk_, vo_) do { _Pragma("unroll") for (int _h = 0; _h < 2; ++_h) _Pragma("unroll") for (int _i = 0; _i < 2; ++_i) vo_[_h][_i] = (unsigned)tk_[_h][_i] * (unsigned)(K * 2) + colA[_i]; } while (0)
    const size_t kstep = (size_t)(BK * 2);
    const size_t hstep = (size_t)HALF * K * 2;
    const size_t tstep = 2 * hstep;
    const unsigned ldsw = (unsigned)wid * 1024u;
    const int aoff = lds_byte(wr * 64 + fr, fq * 8), boff = lds_byte(wc * 32 + fr, fq * 8);
#define PG8_SA(b, h) (((b) * 2 + (h)) * HTB)
#define PG8_SB(b, h) ((4 + (b) * 2 + (h)) * HTB)
#define PG8_STAGE(bufoff, gbase, voff) do { _Pragma("unroll") for (int _i = 0; _i < 2; ++_i) \
        __builtin_amdgcn_global_load_lds((const unsigned*)((const char*)(gbase) + (voff)[_i]), (PG8_LAS unsigned*)(lds + (bufoff) + ldsw + _i * 8192), 16, 0, 0); } while (0)
#define PG8_STAGE_A(bufoff, gbase, h, nx) do { if constexpr (Sched::GATHER) { _Pragma("unroll") for (int _i = 0; _i < 2; ++_i) { const unsigned _vo = (nx) ? nvo[h][_i] : cvo[h][_i]; \
        __builtin_amdgcn_global_load_lds((const unsigned*)((const char*)(gbase) + _vo), (PG8_LAS unsigned*)(lds + (bufoff) + ldsw + _i * 8192), 16, 0, 0); } } \
        else { PG8_STAGE(bufoff, (gbase) + (h) * hstep, voffA); } } while (0)
#define PG8_LDA(dst, b, h) do { _Pragma("unroll") for (int m = 0; m < 4; ++m) _Pragma("unroll") for (int k = 0; k < 2; ++k) dst[m][k] = *(const PG8_LAS bf16x8*)(lds + PG8_SA(b, h) + aoff + m * 2048 + k * 1024); } while (0)
#define PG8_LDB(dst, b, h) do { _Pragma("unroll") for (int n = 0; n < 2; ++n) _Pragma("unroll") for (int k = 0; k < 2; ++k) dst[n][k] = *(const PG8_LAS bf16x8*)(lds + PG8_SB(b, h) + boff + n * 2048 + k * 1024); } while (0)
#define PG8_MMA(ai, bj, At, Bt) do { __builtin_amdgcn_s_setprio(1); _Pragma("unroll") for (int m = 0; m < 4; ++m) _Pragma("unroll") for (int n = 0; n < 2; ++n) _Pragma("unroll") for (int k = 0; k < 2; ++k) \
        acc[ai][bj][m][n] = __builtin_amdgcn_mfma_f32_16x16x32_bf16(Bt[n][k], At[m][k], acc[ai][bj][m][n], 0, 0, 0); __builtin_amdgcn_s_setprio(0); } while (0)
#define PG8_WAIT_V(n) asm volatile("s_waitcnt vmcnt(" #n ")" ::: "memory")
#define PG8_WAIT_L(n) asm volatile("s_waitcnt lgkmcnt(" #n ")" ::: "memory")
#define PG8_BAR __builtin_amdgcn_s_barrier()
#define PG8_SCHED __builtin_amdgcn_sched_barrier(0)
    Unit cur, nxt; int ui = 0;
    if (!S.next(0, cur)) return;
    f32x4 acc[2][2][4][2];
#pragma unroll
    for (int a = 0; a < 2; ++a)
#pragma unroll
        for (int b = 0; b < 2; ++b)
#pragma unroll
            for (int m = 0; m < 4; ++m)
#pragma unroll
                for (int n = 0; n < 2; ++n) acc[a][b][m][n] = (f32x4){0.f, 0.f, 0.f, 0.f};
    bf16x8 At[4][2], B0[2][2], B1[2][2];
    const char* cA = (const char*)g.A + (Sched::GATHER ? (size_t)0 : (size_t)cur.pm * tstep); const char* cB = (const char*)g.Bt + (size_t)cur.pb * g.bstride + (size_t)cur.pn * tstep;
    S.a_ready(cur);
    if constexpr (Sched::GATHER) { PG8_LOADTK(cur, ntk); asm volatile("s_waitcnt vmcnt(0)" : "+v"(ntk[0][0]), "+v"(ntk[0][1]), "+v"(ntk[1][0]), "+v"(ntk[1][1]) :: "memory"); PG8_TK2VO(ntk, cvo); }
    if constexpr (SP2) {
        PG8_STAGE(PG8_SB(0, 0), cB, voffB); PG8_STAGE(PG8_SB(0, 1), cB + hstep, voffB); PG8_STAGE_A(PG8_SA(0, 0), cA, 0, false); PG8_STAGE_A(PG8_SA(0, 1), cA, 1, false);
        if (wr == 1) PG8_BAR;
        PG8_WAIT_V(2); PG8_BAR;
        PG8_STAGE(PG8_SB(1, 0), cB + kstep, voffB); PG8_STAGE_A(PG8_SA(1, 0), cA + kstep, 0, false); PG8_STAGE(PG8_SB(1, 1), cB + hstep + kstep, voffB);
        PG8_WAIT_V(6); PG8_BAR;
    } else { static_assert(SP2, "only the SP2 loop is kept"); }
    for (;;) {
        bool has_next; int pbv = 0;
        if constexpr (Sched::LAZY_PB) { has_next = S.next_nopb(ui + 1, nxt);
            if (has_next) { const int* _pp = S.pb_ptr(nxt); asm volatile("global_load_dword %0, %1, off" : "=v"(pbv) : "v"(_pp) : "memory"); } }
        else has_next = S.next(ui + 1, nxt);
        const char* nA = (has_next && !Sched::GATHER) ? (const char*)g.A + (size_t)nxt.pm * tstep : cA;
        if constexpr (Sched::GATHER) { _Pragma("unroll") for (int _h = 0; _h < 2; ++_h) _Pragma("unroll") for (int _i = 0; _i < 2; ++_i) nvo[_h][_i] = cvo[_h][_i]; if (has_next) { PG8_LOADTK(nxt, ntk); } }
 const char* nB = (has_next && !Sched::LAZY_PB) ? (const char*)g.Bt + (size_t)nxt.pb * g.bstride + (size_t)nxt.pn * tstep : cB;
        for (int t = 0; t < nt; t += 2) {
            const bool last = (t == nt - 2);
            const char* a1 = cA + (size_t)(t + 1) * kstep;
            if constexpr (Sched::LAZY_PB) { if (last && has_next) { asm volatile("s_waitcnt vmcnt(8)" : "+v"(pbv) :: "memory"); nxt.pb = __builtin_amdgcn_readfirstlane(pbv);
                nB = (const char*)g.Bt + (size_t)nxt.pb * g.bstride + (size_t)nxt.pn * tstep; } }
            const char* a2 = last ? nA : cA + (size_t)(t + 2) * kstep; const char* b2 = last ? nB : cB + (size_t)(t + 2) * kstep;
            const char* a3 = a2 + kstep; const char* b3 = b2 + kstep;
            if (last && has_next) S.a_ready(nxt);
            if constexpr (Sched::GATHER) { if (last && has_next) {
                asm volatile("s_waitcnt vmcnt(8)" : "+v"(ntk[0][0]), "+v"(ntk[0][1]), "+v"(ntk[1][0]), "+v"(ntk[1][1]) :: "memory"); PG8_TK2VO(ntk, nvo); } }
            if constexpr (SP2) {
            PG8_LDB(B0, 0, 0); PG8_LDB(B1, 0, 1); PG8_SCHED; PG8_LDA(At, 0, 0); PG8_STAGE_A(PG8_SA(1, 1), a1, 1, false);
            PG8_WAIT_V(8); PG8_WAIT_L(0); PG8_BAR; PG8_MMA(0, 0, At, B0); PG8_MMA(0, 1, At, B1); PG8_BAR; PG8_SCHED;
            PG8_LDA(At, 0, 1); PG8_STAGE(PG8_SB(0, 0), b2, voffB); PG8_STAGE(PG8_SB(0, 1), b2 + hstep, voffB); PG8_STAGE_A(PG8_SA(0, 0), a2, 0, last);
            PG8_WAIT_V(8); PG8_WAIT_L(0); PG8_BAR; PG8_MMA(1, 0, At, B0); PG8_MMA(1, 1, At, B1); PG8_BAR; PG8_SCHED;
            PG8_LDB(B0, 1, 0); PG8_LDB(B1, 1, 1); PG8_SCHED; PG8_LDA(At, 1, 0); PG8_STAGE_A(PG8_SA(0, 1), a2, 1, last);
            PG8_WAIT_V(8); PG8_WAIT_L(0); PG8_BAR; PG8_MMA(0, 0, At, B0); PG8_MMA(0, 1, At, B1); PG8_BAR; PG8_SCHED;
            PG8_LDA(At, 1, 1); PG8_STAGE(PG8_SB(1, 0), b3, voffB); PG8_STAGE(PG8_SB(1, 1), b3 + hstep, voffB); PG8_STAGE_A(PG8_SA(1, 0), a3, 0, last);
            PG8_WAIT_V(8); PG8_WAIT_L(0); PG8_BAR; PG8_MMA(1, 0, At, B0); PG8_MMA(1, 1, At, B1); PG8_BAR; PG8_SCHED;
            }
        }
        if constexpr (ALIGN_EPI) { if (wr == 0) PG8_BAR; }
        if constexpr (!Epi::AFTER_DRAIN) { E(acc, cur, wr, wc, fr, fq); S.done(cur); }
        if (!has_next) break;
#pragma unroll
        for (int a = 0; a < 2; ++a)
#pragma unroll
            for (int b = 0; b < 2; ++b)
#pragma unroll
                for (int m = 0; m < 4; ++m)
#pragma unroll
                    for (int n = 0; n < 2; ++n) acc[a][b][m][n] = (f32x4){0.f, 0.f, 0.f, 0.f};
        cur = nxt; cA = nA; cB = nB; ++ui;
        if constexpr (Sched::GATHER) { _Pragma("unroll") for (int _h = 0; _h < 2; ++_h) _Pragma("unroll") for (int _i = 0; _i < 2; ++_i) cvo[_h][_i] = nvo[_h][_i]; }
        if constexpr (ALIGN_EPI) { if (wr == 1) PG8_BAR; }
    }
    PG8_WAIT_V(0);
    if constexpr (!ALIGN_EPI) { if (wr == 0) PG8_BAR; }
    PG8_BAR;
    if constexpr (Epi::AFTER_DRAIN) { E.fused(acc, cur, wr, wc, fr, fq, lds, wid, lane); S.done(cur); }
#undef PG8_SA
#undef PG8_SB
#undef PG8_STAGE
#undef PG8_STAGE_A
#undef PG8_LOADTK
#undef PG8_TK2VO
#undef PG8_LDA
#undef PG8_LDB
#undef PG8_MMA
#undef PG8_WAIT_V
#undef PG8_WAIT_L
#undef PG8_BAR
#undef PG8_SCHED
}
}

constexpr int NB = 32, SEQ = 2048, DM = 1024, T = NB * SEQ;
constexpr int EVIN = 2560, CONVC = 512, CONVW = 31, NHEAD = 8, HD = 64, SBW = 512;
constexpr int NEXP = 16, DFF = 512;
constexpr int MOE_ROWS = 2 * T + NEXP * 256;
constexpr int MOE_TILES = MOE_ROWS / 256;
constexpr float EPS = 1e-6f;
constexpr int NWAVES = 8;

constexpr size_t MiB = 1u << 20;
constexpr size_t WS_CTL = 0, CTL_ZERO_BYTES = 64 * 1024;
constexpr size_t WS_MOD = 1 * MiB;
constexpr size_t WS_META = 3 * MiB;
constexpr size_t META_EID = WS_META, META_GATE = WS_META + 512 * 1024, META_SLOT = WS_META + 1024 * 1024, META_BCNT = WS_META + 1536 * 1024,
                 META_TILEE = META_BCNT + 32 * 1024, META_NT = META_BCNT + 64 * 1024, META_TOK = WS_META + 2048 * 1024;
constexpr size_t WS_WEVIN = 6 * MiB, WS_WEVOUT = 11 * MiB, WS_WODIN = 13 * MiB, WS_WODOUT = 17 * MiB, WS_WRG = 19 * MiB, WS_WIG = WS_WRG + 512 * 1024;
constexpr size_t WS_W13 = 20 * MiB;
constexpr size_t WS_W2 = 84 * MiB;
constexpr size_t WS_HA = 116 * MiB;
constexpr size_t WS_R1 = 244 * MiB;
constexpr size_t WS_R2 = 508 * MiB;
constexpr size_t WS_END = 640 * MiB;
constexpr int CW_BAR = 4096;

constexpr int RING_BYTES = 131072, LDSCTL_OFF = RING_BYTES, MISC_OFF = LDSCTL_OFF + 320, LDS_BYTES = 147456;

#define GAS __attribute__((address_space(1)))
#define LAS __attribute__((address_space(3)))
typedef unsigned short bf16;
typedef unsigned v4u __attribute__((ext_vector_type(4)));
typedef unsigned v2u __attribute__((ext_vector_type(2)));
typedef float f32x4 __attribute__((ext_vector_type(4)));
typedef float f32x2 __attribute__((ext_vector_type(2)));
typedef float f32x16 __attribute__((ext_vector_type(16)));
typedef short bf16x8 __attribute__((ext_vector_type(8)));
typedef short s16x4 __attribute__((ext_vector_type(4)));
typedef __bf16 bf16x2_t __attribute__((ext_vector_type(2)));
typedef GAS unsigned gu32;
#define RLX_AGENT __ATOMIC_RELAXED, __HIP_MEMORY_SCOPE_AGENT

__device__ __forceinline__ unsigned pk2(float lo, float hi) { f32x2 v = {lo, hi}; bf16x2_t b = __builtin_convertvector(v, bf16x2_t); return __builtin_bit_cast(unsigned, b); }
__device__ __forceinline__ float bflo(unsigned u) { return __uint_as_float(u << 16); }
__device__ __forceinline__ float bfhi(unsigned u) { return __uint_as_float(u & 0xffff0000u); }
__device__ __forceinline__ float bf2f(bf16 b) { return __uint_as_float((unsigned)b << 16); }
__device__ __forceinline__ float fast_exp2(float x) { return __builtin_amdgcn_exp2f(x); }
__device__ __forceinline__ float fast_rcp(float x) { return __builtin_amdgcn_rcpf(x); }
__device__ __forceinline__ float sigmoidf_(float x) { return fast_rcp(1.0f + fast_exp2(-1.4426950408889634f * x)); }
__device__ __forceinline__ float siluf_(float x) { return x * sigmoidf_(x); }
__device__ __forceinline__ float gelu_tanh(float x) { const float u = x + 0.044715f * x * x * x; return x * fast_rcp(1.0f + fast_exp2(-2.3022082f * u)); }
__device__ __forceinline__ float wave_sum(float v) {
#pragma unroll
    for (int o = 1; o < 64; o <<= 1) v += __shfl_xor(v, o);
    return v;
}

#define XB_TMO      128
#define XB_XCNT(j)  (256  + 64 * (j))
#define XB_XSUB(j)  (1280 + 64 * (j))
#define XB_XGEN(j)  (2304 + 64 * (j))
#define XB_TOP      3328
#define XB_TOPGEN   3392
#define XCD_BAR_WORDS 3456
#define XB_SPIN_CAP (1u << 18)

__device__ __forceinline__ unsigned xb_ld(unsigned* p)              { return __hip_atomic_load(p, __ATOMIC_RELAXED, __HIP_MEMORY_SCOPE_AGENT); }
__device__ __forceinline__ unsigned xb_add(unsigned* p, unsigned v) { return __hip_atomic_fetch_add(p, v, __ATOMIC_RELAXED, __HIP_MEMORY_SCOPE_AGENT); }
__device__ __forceinline__ unsigned xb_xcc_id() { return (unsigned)__builtin_amdgcn_s_getreg((3 << 11) | 20) & 0xFu; }
#define XB_SPIN(cond, bar) do { unsigned _sp = 0; while (cond) { __builtin_amdgcn_s_sleep(1); \
    if ((++_sp & 255u) == 0u) { if (xb_ld(&(bar)[XB_TMO])) break; if (_sp > XB_SPIN_CAP) { atomicAdd(&(bar)[XB_TMO], 1u); break; } } } } while (0)

struct XcdBarrier {
    unsigned* bar; unsigned x;
    volatile LAS unsigned* st;
};

__device__ __forceinline__ XcdBarrier xcd_barrier_post(unsigned* bar, volatile LAS unsigned* st) {
    XcdBarrier b; b.bar = bar; b.x = xb_xcc_id(); b.st = st;
    if (threadIdx.x == 0) (void)xb_add(&bar[XB_XCNT(b.x)], 1u);
    return b;
}
__device__ __forceinline__ void xcd_barrier_complete(unsigned* bar, unsigned x, unsigned& nloc, unsigned& nx) {
    const unsigned G = gridDim.x * gridDim.y * gridDim.z;
    unsigned sum, cnt, mine, sp = 0u;
    for (;;) {
        sum = 0u; cnt = 0u; mine = 0u;
#pragma unroll
        for (unsigned j = 0; j < 16; ++j) { const unsigned c = xb_ld(&bar[XB_XCNT(j)]); sum += c; cnt += (c > 0u) ? 1u : 0u; mine = (j == x) ? c : mine; }
        if (sum == G) break;
        __builtin_amdgcn_s_sleep(1);
        if ((++sp & 255u) == 0u) { if (xb_ld(&bar[XB_TMO])) break; if (sp > XB_SPIN_CAP) { atomicAdd(&bar[XB_TMO], 1u); break; } }
    }
    nloc = mine > 0u ? mine : 1u; nx = cnt > 0u ? cnt : 1u;
}

__device__ __forceinline__ void xcd_barrier(const XcdBarrier& b) {
    asm volatile("s_waitcnt vmcnt(0)" ::: "memory");
    __syncthreads();
    if (threadIdx.x == 0) {
        unsigned* bar = b.bar;
        __builtin_amdgcn_s_waitcnt(0);
        unsigned nloc = b.st[0], nx = b.st[1];
        if (nloc == 0u) { xcd_barrier_complete(bar, b.x, nloc, nx); b.st[0] = nloc; b.st[1] = nx; }
        const unsigned old = xb_add(&bar[XB_XSUB(b.x)], 1u);
        const unsigned gen = old / nloc;
        if (old + 1u == (gen + 1u) * nloc) {
            __builtin_amdgcn_fence(__ATOMIC_RELEASE, "agent");
            asm volatile("s_waitcnt vmcnt(0)" ::: "memory");
            const unsigned og = xb_add(&bar[XB_TOP], 1u);
            const unsigned tg = og / nx;
            if (og + 1u == (tg + 1u) * nx) xb_add(&bar[XB_TOPGEN], 1u);
            else XB_SPIN(xb_ld(&bar[XB_TOPGEN]) == tg, bar);
            __builtin_amdgcn_fence(__ATOMIC_ACQUIRE, "agent");
            xb_add(&bar[XB_XGEN(b.x)], 1u);
            asm volatile("s_waitcnt vmcnt(0)" ::: "memory");
        } else {
            XB_SPIN(xb_ld(&bar[XB_XGEN(b.x)]) == gen, bar);
            __builtin_amdgcn_fence(__ATOMIC_ACQUIRE, "agent");
            asm volatile("s_waitcnt vmcnt(0)" ::: "memory");
        }
    }
    __syncthreads();
}


namespace pg8 {
struct EpiEvIn {
    static constexpr bool PERM = true, AFTER_DRAIN = false;
    bf16* U0; bf16* Q; bf16* K; bf16* V; const float* qg; const float* kg;
    __device__ __forceinline__ void operator()(const f32x4 (&acc)[2][2][4][2], const Unit& u, int wr, int wc, int fr, int fq) const {
        const int row0 = u.pm * BM + wr * 64 + fr;
        if (u.pn < 4) {
#pragma unroll
            for (int ai = 0; ai < 2; ++ai)
#pragma unroll
                for (int m = 0; m < 4; ++m) {
                    const size_t row = (size_t)(row0 + ai * HALF + m * 16);
                    const f32x4 v0 = acc[ai][0][m][0], v1 = acc[ai][0][m][1], g0 = acc[ai][1][m][0], g1 = acc[ai][1][m][1];
                    u32x4 w;
                    w.x = pk2(v0[0] * sigmoidf_(g0[0]), v0[1] * sigmoidf_(g0[1])); w.y = pk2(v0[2] * sigmoidf_(g0[2]), v0[3] * sigmoidf_(g0[3]));
                    w.z = pk2(v1[0] * sigmoidf_(g1[0]), v1[1] * sigmoidf_(g1[1])); w.w = pk2(v1[2] * sigmoidf_(g1[2]), v1[3] * sigmoidf_(g1[3]));
                    *(u32x4*)(U0 + row * 512 + u.pn * 128 + wc * 32 + 8 * fq) = w;
                }
        } else if (u.pn < 8) {
            const int sec = (u.pn - 4) >> 1, p = (u.pn - 4) & 1, head = 4 * p + wc;
            const float* gp = sec ? kg : qg; bf16* dst = sec ? K : Q;
            const float scl = sec ? 1.0f : 0.125f * 1.4426950408889634f;
            f32x4 gv[2][2];
#pragma unroll
            for (int bj = 0; bj < 2; ++bj)
#pragma unroll
                for (int n = 0; n < 2; ++n) gv[bj][n] = *(const f32x4*)(gp + 32 * bj + 8 * fq + 4 * n) * scl;
#pragma unroll
            for (int ai = 0; ai < 2; ++ai)
#pragma unroll
                for (int m = 0; m < 4; ++m) {
                    const size_t row = (size_t)(row0 + ai * HALF + m * 16);
                    float ss = 0.f;
#pragma unroll
                    for (int bj = 0; bj < 2; ++bj)
#pragma unroll
                        for (int n = 0; n < 2; ++n) { const f32x4 x = acc[ai][bj][m][n]; ss += (x[0] * x[0] + x[1] * x[1]) + (x[2] * x[2] + x[3] * x[3]); }
                    ss += __shfl_xor(ss, 16); ss += __shfl_xor(ss, 32);
                    const float rstd = __builtin_amdgcn_rsqf(ss * (1.0f / 64.0f) + EPS);
#pragma unroll
                    for (int bj = 0; bj < 2; ++bj) {
                        const f32x4 a = acc[ai][bj][m][0] * rstd * gv[bj][0], b = acc[ai][bj][m][1] * rstd * gv[bj][1];
                        u32x4 w; w.x = pk2(a[0], a[1]); w.y = pk2(a[2], a[3]); w.z = pk2(b[0], b[1]); w.w = pk2(b[2], b[3]);
                        *(u32x4*)(dst + row * 512 + head * 64 + 32 * bj + 8 * fq) = w;
                    }
                }
        } else {
#pragma unroll
            for (int ai = 0; ai < 2; ++ai)
#pragma unroll
                for (int m = 0; m < 4; ++m) {
                    const size_t row = (size_t)(row0 + ai * HALF + m * 16);
#pragma unroll
                    for (int bj = 0; bj < 2; ++bj) {
                        const f32x4 a = acc[ai][bj][m][0], b = acc[ai][bj][m][1];
                        u32x4 w; w.x = pk2(a[0], a[1]); w.y = pk2(a[2], a[3]); w.z = pk2(b[0], b[1]); w.w = pk2(b[2], b[3]);
                        *(u32x4*)(V + row * 512 + (u.pn - 8) * 256 + bj * HALF + wc * 32 + 8 * fq) = w;
                    }
                }
        }
    }
};
struct EpiResid {
    static constexpr bool PERM = false, AFTER_DRAIN = false;
    const float* xin; float* xout; const float* gate;
    __device__ __forceinline__ void operator()(const f32x4 (&acc)[2][2][4][2], const Unit& u, int wr, int wc, int fr, int fq) const {
        const int row0 = u.pm * BM + wr * 64 + fr, col0 = u.pn * BM + wc * 32 + 4 * fq, b = u.pm >> 3;
        f32x4 gv[2][2];
#pragma unroll
        for (int bj = 0; bj < 2; ++bj)
#pragma unroll
            for (int n = 0; n < 2; ++n) gv[bj][n] = *(const f32x4*)(gate + (size_t)b * 6144 + col0 + bj * HALF + n * 16);
#pragma unroll
        for (int ai = 0; ai < 2; ++ai)
#pragma unroll
            for (int m = 0; m < 4; ++m) {
                const size_t off = (size_t)(row0 + ai * HALF + m * 16) * DM + col0;
#pragma unroll
                for (int bj = 0; bj < 2; ++bj)
#pragma unroll
                    for (int n = 0; n < 2; ++n) { const f32x4 xi = *(const f32x4*)(xin + off + bj * HALF + n * 16); *(f32x4*)(xout + off + bj * HALF + n * 16) = xi + gv[bj][n] * acc[ai][bj][m][n]; }
            }
    }
};
struct EpiOdIn {
    static constexpr bool PERM = true, AFTER_DRAIN = false;
    bf16* GY; bf16* XB;
    __device__ __forceinline__ void operator()(const f32x4 (&acc)[2][2][4][2], const Unit& u, int wr, int wc, int fr, int fq) const {
        const int row0 = u.pm * BM + wr * 64 + fr; const bool isy = u.pn < 4;
        bf16* dst = (isy ? GY : XB) + (size_t)(u.pn & 3) * 256 + wc * 32 + 8 * fq;
#pragma unroll
        for (int ai = 0; ai < 2; ++ai)
#pragma unroll
            for (int m = 0; m < 4; ++m) {
                const size_t row = (size_t)(row0 + ai * HALF + m * 16);
#pragma unroll
                for (int bj = 0; bj < 2; ++bj) {
                    f32x4 a = acc[ai][bj][m][0], b = acc[ai][bj][m][1];
                    if (isy) { a = (f32x4){gelu_tanh(a[0]), gelu_tanh(a[1]), gelu_tanh(a[2]), gelu_tanh(a[3])}; b = (f32x4){gelu_tanh(b[0]), gelu_tanh(b[1]), gelu_tanh(b[2]), gelu_tanh(b[3])}; }
                    u32x4 w; w.x = pk2(a[0], a[1]); w.y = pk2(a[2], a[3]); w.z = pk2(b[0], b[1]); w.w = pk2(b[2], b[3]);
                    *(u32x4*)(dst + row * DM + bj * HALF) = w;
                }
            }
    }
};
struct EpiMoeA {
    static constexpr bool PERM = true, AFTER_DRAIN = false;
    bf16* HID;
    __device__ __forceinline__ void operator()(const f32x4 (&acc)[2][2][4][2], const Unit& u, int wr, int wc, int fr, int fq) const {
        const int row0 = u.pm * BM + wr * 64 + fr;
#pragma unroll
        for (int ai = 0; ai < 2; ++ai)
#pragma unroll
            for (int m = 0; m < 4; ++m) {
                const size_t row = (size_t)(row0 + ai * HALF + m * 16);
                const f32x4 a0 = acc[ai][0][m][0], a1 = acc[ai][0][m][1], b0 = acc[ai][1][m][0], b1 = acc[ai][1][m][1];
                u32x4 w;
                w.x = pk2(siluf_(a0[0]) * b0[0], siluf_(a0[1]) * b0[1]); w.y = pk2(siluf_(a0[2]) * b0[2], siluf_(a0[3]) * b0[3]);
                w.z = pk2(siluf_(a1[0]) * b1[0], siluf_(a1[1]) * b1[1]); w.w = pk2(siluf_(a1[2]) * b1[2], siluf_(a1[3]) * b1[3]);
                *(u32x4*)(HID + row * DFF + u.pn * 128 + wc * 32 + 8 * fq) = w;
            }
    }
};
struct EpiMoeB {
    static constexpr bool PERM = true, AFTER_DRAIN = false;
    bf16* Y;
    __device__ __forceinline__ void operator()(const f32x4 (&acc)[2][2][4][2], const Unit& u, int wr, int wc, int fr, int fq) const {
        const int row0 = u.pm * BM + wr * 64 + fr;
#pragma unroll
        for (int ai = 0; ai < 2; ++ai)
#pragma unroll
            for (int m = 0; m < 4; ++m) {
                const size_t row = (size_t)(row0 + ai * HALF + m * 16);
#pragma unroll
                for (int bj = 0; bj < 2; ++bj) {
                    const f32x4 a = acc[ai][bj][m][0], b = acc[ai][bj][m][1];
                    u32x4 w; w.x = pk2(a[0], a[1]); w.y = pk2(a[2], a[3]); w.z = pk2(b[0], b[1]); w.w = pk2(b[2], b[3]);
                    *(u32x4*)(Y + row * DM + u.pn * 256 + bj * HALF + wc * 32 + 8 * fq) = w;
                }
            }
    }
};
struct MoeOrder {
    static constexpr bool GATHER = false, LAZY_PB = true; const int* tok;
    StaticOrder base; const int* tile_e;
    __device__ __forceinline__ bool next(int i, Unit& u) const { if (!base.next(i, u)) return false; u.pb = tile_e[u.pm]; return true; }
    __device__ __forceinline__ bool next_nopb(int i, Unit& u) const { return base.next(i, u); }
    __device__ __forceinline__ const int* pb_ptr(const Unit& u) const { return tile_e + u.pm; }
    __device__ __forceinline__ void a_ready(const Unit&) const {}
    __device__ __forceinline__ void done(const Unit&) const {}
};
struct MoeGatherOrder {
    static constexpr bool GATHER = true, LAZY_PB = true; const int* tok;
    StaticOrder base; const int* tile_e;
    __device__ __forceinline__ bool next(int i, Unit& u) const { if (!base.next(i, u)) return false; u.pb = tile_e[u.pm]; return true; }
    __device__ __forceinline__ bool next_nopb(int i, Unit& u) const { return base.next(i, u); }
    __device__ __forceinline__ const int* pb_ptr(const Unit& u) const { return tile_e + u.pm; }
    __device__ __forceinline__ void a_ready(const Unit&) const {}
    __device__ __forceinline__ void done(const Unit&) const {}
};
}

struct Frame {
    LAS unsigned char* lds;
    int tid, lane, wave, vcu, G, bx;
    unsigned char* ws;
};

template <class RowMap>
__device__ __forceinline__ void p0_transpose_item(const float* W, int K, int N, bf16* WT, LAS float* scr, int item, int lane, RowMap rm) {
    const int nblk = N / 32, kb = item / nblk, nb = item % nblk, k0 = 64 * kb, n0 = 32 * nb;
#pragma unroll 8
    for (int i = 0; i < 32; ++i) { const int kk = 2 * i + (lane >> 5); scr[kk * 33 + (lane & 31)] = W[(size_t)(k0 + kk) * N + n0 + (lane & 31)]; }
    asm volatile("s_waitcnt lgkmcnt(0)" ::: "memory");
    const int c = lane & 7;
#pragma unroll
    for (int j = 0; j < 4; ++j) { const int n = (lane >> 3) + 8 * j; const LAS float* s = scr + (8 * c) * 33 + n;
        v4u o; o.x = pk2(s[0 * 33], s[1 * 33]); o.y = pk2(s[2 * 33], s[3 * 33]); o.z = pk2(s[4 * 33], s[5 * 33]); o.w = pk2(s[6 * 33], s[7 * 33]);
        *(GAS v4u*)(WT + (size_t)rm(n0 + n) * K + k0 + 8 * c) = o; }
    asm volatile("s_waitcnt lgkmcnt(0)" ::: "memory");
}
struct RmId { __device__ __forceinline__ int operator()(int n) const { return n; } };
struct RmEvIn { __device__ __forceinline__ int operator()(int n) const {
    if (n < 512) return 256 * (n >> 7) + (n & 127);
    if (n < 1024) { const int m = n - 512; return 256 * (m >> 7) + 128 + (m & 127); }
    if (n < 2048) { const int m = n - 1024, sec = m >> 9, mm = m & 511, p = mm >> 8, r = mm & 255, wc = r >> 6, d = r & 63, bj = d >> 5, j = d & 31;
        return 256 * (4 + 2 * sec + p) + 128 * bj + 32 * wc + j; }
    return n; } };
struct RmGlu { int half; __device__ __forceinline__ int operator()(int n) const { return 256 * (n >> 7) + 128 * half + (n & 127); } };

template <class KAT> __device__ __forceinline__ void p0_prologue(Frame& F, KAT KA) {
#define in KA->in
    LAS float* sc = (LAS float*)F.lds;
    const int w = F.bx, bg = w & 3;
    const float* c = in[1];
    for (int i = F.tid; i < 8 * 1024; i += 512) { const float v = c[(size_t)bg * 8 * 1024 + i]; sc[i] = v / (1.0f + __expf(-v)); }
    __syncthreads();
    if (F.wave < 6) {
        const int chunk = (w >> 2) * 6 + F.wave, l = chunk / 192, cc = chunk % 192, col = cc * 32 + (F.lane & 31), kh = F.lane >> 5;
        const float* W = in[2] + (size_t)l * 1024 * 6144 + col;
        float acc[8];
#pragma unroll
        for (int bb = 0; bb < 8; ++bb) acc[bb] = 0.f;
        for (int k = kh * 512; k < kh * 512 + 512; k += 4) {
            const float w0 = W[(size_t)k * 6144], w1 = W[(size_t)(k + 1) * 6144], w2 = W[(size_t)(k + 2) * 6144], w3 = W[(size_t)(k + 3) * 6144];
#pragma unroll
            for (int bb = 0; bb < 8; ++bb) { const f32x4 s = *(const LAS f32x4*)(sc + bb * 1024 + k); acc[bb] += (s[0] * w0 + s[1] * w1) + (s[2] * w2 + s[3] * w3); }
        }
        float* mod = (float*)(F.ws + WS_MOD);
#pragma unroll
        for (int bb = 0; bb < 8; ++bb) { const float t = acc[bb] + __shfl_xor(acc[bb], 32);
            if (F.lane < 32) mod[((size_t)l * 32 + bg * 8 + bb) * 6144 + col] = t + in[3][(size_t)l * 6144 + col]; }
    }
    __syncthreads();
    LAS float* scr = (LAS float*)(F.lds + 32768 + F.wave * 8448);
    const int gw = F.vcu * NWAVES + F.wave, NGW = F.G * NWAVES;
    bf16* WEVIN = (bf16*)(F.ws + WS_WEVIN); bf16* WEVOUT = (bf16*)(F.ws + WS_WEVOUT); bf16* WODIN = (bf16*)(F.ws + WS_WODIN); bf16* WODOUT = (bf16*)(F.ws + WS_WODOUT);
    bf16* WRG = (bf16*)(F.ws + WS_WRG); bf16* WIG = (bf16*)(F.ws + WS_WIG); bf16* W13 = (bf16*)(F.ws + WS_W13); bf16* W2 = (bf16*)(F.ws + WS_W2);
    constexpr int I_EVIN = 16 * 80, I_SQ = 16 * 32, I_ODIN = 16 * 64, I_W1 = 16 * 16, I_W2 = 8 * 32, I_G = 2 * 4;
    constexpr int NITEMS = I_EVIN + 2 * I_SQ + I_ODIN + 32 * I_W1 * 2 + 32 * I_W2 + 16 * I_G;
    for (int it = gw; it < NITEMS; it += NGW) {
        int r = it;
        if (r < I_EVIN) { p0_transpose_item(in[6], 1024, 2560, WEVIN, scr, r, F.lane, RmEvIn{}); continue; } r -= I_EVIN;
        if (r < I_SQ) { p0_transpose_item(in[13], 1024, 1024, WEVOUT, scr, r, F.lane, RmId{}); continue; } r -= I_SQ;
        if (r < I_ODIN) { p0_transpose_item(in[14], 1024, 2048, WODIN, scr, r, F.lane, RmId{}); continue; } r -= I_ODIN;
        if (r < I_SQ) { p0_transpose_item(in[22], 1024, 1024, WODOUT, scr, r, F.lane, RmId{}); continue; } r -= I_SQ;
        if (r < 32 * I_W1) { const int mat = r / I_W1; p0_transpose_item(in[25] + (size_t)mat * 1024 * 512, 1024, 512, W13 + (size_t)mat * 1024 * 1024, scr, r % I_W1, F.lane, RmGlu{0}); continue; } r -= 32 * I_W1;
        if (r < 32 * I_W1) { const int mat = r / I_W1; p0_transpose_item(in[26] + (size_t)mat * 1024 * 512, 1024, 512, W13 + (size_t)mat * 1024 * 1024, scr, r % I_W1, F.lane, RmGlu{1}); continue; } r -= 32 * I_W1;
        if (r < 32 * I_W2) { const int mat = r / I_W2; p0_transpose_item(in[27] + (size_t)mat * 512 * 1024, 512, 1024, W2 + (size_t)mat * 1024 * 512, scr, r % I_W2, F.lane, RmId{}); continue; } r -= 32 * I_W2;
        { const int mat = r / I_G, which = mat >> 3, blk = mat & 7;
          p0_transpose_item((which ? in[19] : in[17]) + (size_t)blk * 128 * 128, 128, 128, (which ? WIG : WRG) + (size_t)blk * 128 * 128, scr, r % I_G, F.lane, RmId{}); }
    }
#undef in
}

__device__ __forceinline__ void norm_rows(Frame& F, const float* X, bf16* H, const float* ng, const float* modl, int sh_off, int sc_off) {
    const int gw = F.bx * NWAVES + F.wave;
    const int b = gw >> 6;
    f32x4 gm[4], sh[4];
#pragma unroll
    for (int j = 0; j < 4; ++j) { const int k = 256 * j + 4 * F.lane;
        const f32x4 g = *(const f32x4*)(ng + k), s = *(const f32x4*)(modl + (size_t)b * 6144 + sc_off + k);
        gm[j] = g * (s + 1.0f); sh[j] = *(const f32x4*)(modl + (size_t)b * 6144 + sh_off + k); }
    for (int r = 0; r < 32; r += 2) {
        const size_t row = (size_t)gw * 32 + r;
        f32x4 v[2][4]; float ss[2];
#pragma unroll
        for (int q = 0; q < 2; ++q) { ss[q] = 0.f;
#pragma unroll
            for (int j = 0; j < 4; ++j) { v[q][j] = *(const f32x4*)(X + (row + q) * DM + 256 * j + 4 * F.lane); ss[q] += (v[q][j][0] * v[q][j][0] + v[q][j][1] * v[q][j][1]) + (v[q][j][2] * v[q][j][2] + v[q][j][3] * v[q][j][3]); } }
#pragma unroll
        for (int q = 0; q < 2; ++q) {
            const float rstd = 1.0f / sqrtf(wave_sum(ss[q]) * (1.0f / DM) + EPS);
#pragma unroll
            for (int j = 0; j < 4; ++j) { const f32x4 o = v[q][j] * rstd * gm[j] + sh[j];
                v2u w; w.x = pk2(o[0], o[1]); w.y = pk2(o[2], o[3]); *(v2u*)(H + (row + q) * DM + 256 * j + 4 * F.lane) = w; }
        }
    }
}

namespace sba {
constexpr int SLOTB = 8192, L_K = 0, L_V = 2 * SLOTB, L_FLAG = 4 * SLOTB, L_OST = 4 * SLOTB + 256;
__device__ __forceinline__ s16x4 vtr(const LAS unsigned char* p) { typedef short v4i16_t __attribute__((ext_vector_type(4))); return __builtin_bit_cast(s16x4, __builtin_amdgcn_ds_read_tr16_b64_v4i16((LAS v4i16_t*)p)); }
__device__ __forceinline__ void unit(int b, int h, int qb, const bf16* Q, const bf16* K, const bf16* V, bf16* CAT, LAS unsigned char* lds) {
    const int tid = threadIdx.x, lane = tid & 63, r32 = lane & 31, hi = lane >> 5; const int wid = __builtin_amdgcn_readfirstlane(tid >> 6);
    const long rowbase = (long)b * SEQ; const int q0 = qb * 256;
    const bf16* Qw = Q + (rowbase + q0 + wid * 32) * SBW + h * HD;
    const bf16* Kh = K + rowbase * SBW + h * HD; const bf16* Vh = V + rowbase * SBW + h * HD;
    const bf16* ksrc = Kh + (long)lane * SBW + wid * 8;
    const bf16* vsrc = Vh + (long)(16 * (wid & 3) + (lane >> 2)) * SBW + (wid >> 2) * 32 + (lane & 3) * 8;
    LAS unsigned char* kdst = lds + L_K + wid * 1024; LAS unsigned char* vdst = lds + L_V + wid * 1024;
#define SBA_DMA(t, slot) do { __builtin_amdgcn_global_load_lds((const unsigned*)(ksrc + (long)(t) * 64 * SBW), (LAS unsigned*)(kdst + (slot) * SLOTB), 16, 0, 0); \
                              __builtin_amdgcn_global_load_lds((const unsigned*)(vsrc + (long)(t) * 64 * SBW), (LAS unsigned*)(vdst + (slot) * SLOTB), 16, 0, 0); } while (0)
    const LAS unsigned char* kp0 = lds + L_K + hi * 1024 + r32 * 16;
    const LAS unsigned char* vp0 = lds + L_V + ((lane >> 4) & 1) * 32 + (lane & 3) * 8 + (4 * hi + ((lane & 15) >> 2)) * 64;
    volatile LAS unsigned* flags = (volatile LAS unsigned*)(lds + L_FLAG);
    const int NT = (q0 + 256) / 64;
    SBA_DMA(NT - 1, 0);
    bf16x8 qr[4];
#pragma unroll
    for (int d0 = 0; d0 < 4; ++d0) qr[d0] = *(const bf16x8*)(Qw + (long)r32 * SBW + d0 * 16 + hi * 8);
    f32x16 o0 = {}, o1 = {};
    float carry = 1.0f; bool done_w = false;
    const int qrow = q0 + wid * 32 + r32, qmin = q0 + wid * 32;
    for (int it = 0, t = NT - 1; t >= 0; --t, ++it) {
        const int slot = it & 1;
        __syncthreads();
        if (it > 0) { unsigned all = 1u;
#pragma unroll
            for (int w8 = 0; w8 < 8; ++w8) all &= flags[((it - 1) & 1) * 8 + w8];
            if (all) break; }
        if (t > 0) SBA_DMA(t - 1, slot ^ 1);
        const int kbase = 64 * t;
        if (!done_w && kbase < qmin + 31) {
            const LAS unsigned char* kp = kp0 + slot * SLOTB;
            bf16x8 kf[8];
#pragma unroll
            for (int d0 = 0; d0 < 4; ++d0) { kf[2 * d0] = *(const LAS bf16x8*)(kp + d0 * 2048); kf[2 * d0 + 1] = *(const LAS bf16x8*)(kp + d0 * 2048 + 512); }
            f32x16 C0 = {}, C1 = {};
#pragma unroll
            for (int d0 = 0; d0 < 4; ++d0) { C0 = __builtin_amdgcn_mfma_f32_32x32x16_bf16(kf[2 * d0], qr[d0], C0, 0, 0, 0); C1 = __builtin_amdgcn_mfma_f32_32x32x16_bf16(kf[2 * d0 + 1], qr[d0], C1, 0, 0, 0); }
            f32x16 D0, D1;
            const bool partial = (kbase + 64 > qmin);
#pragma unroll
            for (int r = 0; r < 16; ++r) {
                const float s0 = __builtin_fminf(__builtin_fmaxf(C0[r], -120.f), 120.f), s1 = __builtin_fminf(__builtin_fmaxf(C1[r], -120.f), 120.f);
                float e0 = fast_exp2(s0), e1 = fast_exp2(s1);
                float f0 = fast_rcp(1.0f + e0), f1 = fast_rcp(1.0f + e1);
                if (partial) { const int kp_ = kbase + 4 * hi + (r & 3) + 8 * (r >> 2);
                    if (!(kp_ < qrow)) { e0 = 0.f; f0 = 1.f; }
                    if (!(kp_ + 32 < qrow)) { e1 = 0.f; f1 = 1.f; } }
                C0[r] = e0; C1[r] = e1; D0[r] = f0; D1[r] = f1;
            }
            float own[8], par[8], eg[8];
#pragma unroll
            for (int g = 0; g < 4; ++g) {
                D0[4 * g + 2] *= D0[4 * g + 3]; D0[4 * g + 1] *= D0[4 * g + 2]; D0[4 * g] *= D0[4 * g + 1]; own[g] = D0[4 * g];
                D1[4 * g + 2] *= D1[4 * g + 3]; D1[4 * g + 1] *= D1[4 * g + 2]; D1[4 * g] *= D1[4 * g + 1]; own[4 + g] = D1[4 * g];
            }
#pragma unroll
            for (int j = 0; j < 8; ++j) par[j] = __shfl_xor(own[j], 32);
            float sp = carry;
#pragma unroll
            for (int j = 7; j >= 0; --j) { eg[j] = hi ? sp : sp * par[j]; sp *= own[j] * par[j]; }
            carry = sp;
#pragma unroll
            for (int g = 0; g < 4; ++g)
#pragma unroll
                for (int i = 0; i < 4; ++i) { C0[4 * g + i] = (C0[4 * g + i] * D0[4 * g + i]) * eg[g]; C1[4 * g + i] = (C1[4 * g + i] * D1[4 * g + i]) * eg[4 + g]; }
            v4u pw0, pw1, pw2, pw3;
            pw0 = (v4u){pk2(C0[0], C0[1]), pk2(C0[2], C0[3]), pk2(C0[4], C0[5]), pk2(C0[6], C0[7])};
            pw1 = (v4u){pk2(C0[8], C0[9]), pk2(C0[10], C0[11]), pk2(C0[12], C0[13]), pk2(C0[14], C0[15])};
            pw2 = (v4u){pk2(C1[0], C1[1]), pk2(C1[2], C1[3]), pk2(C1[4], C1[5]), pk2(C1[6], C1[7])};
            pw3 = (v4u){pk2(C1[8], C1[9]), pk2(C1[10], C1[11]), pk2(C1[12], C1[13]), pk2(C1[14], C1[15])};
            const LAS unsigned char* vp = vp0 + slot * SLOTB;
#pragma unroll
            for (int d0 = 0; d0 < 2; ++d0) {
                s16x4 lo[4], hh[4];
#pragma unroll
                for (int ks = 0; ks < 4; ++ks) { lo[ks] = vtr(vp + d0 * 4096 + ks * 1024); hh[ks] = vtr(vp + d0 * 4096 + ks * 1024 + 512); }
#define SBA_VF(k) (bf16x8){lo[k][0], lo[k][1], lo[k][2], lo[k][3], hh[k][0], hh[k][1], hh[k][2], hh[k][3]}
                f32x16 oo = d0 ? o1 : o0;
                oo = __builtin_amdgcn_mfma_f32_32x32x16_bf16(__builtin_bit_cast(bf16x8, pw0), SBA_VF(0), oo, 0, 0, 0);
                oo = __builtin_amdgcn_mfma_f32_32x32x16_bf16(__builtin_bit_cast(bf16x8, pw1), SBA_VF(1), oo, 0, 0, 0);
                oo = __builtin_amdgcn_mfma_f32_32x32x16_bf16(__builtin_bit_cast(bf16x8, pw2), SBA_VF(2), oo, 0, 0, 0);
                oo = __builtin_amdgcn_mfma_f32_32x32x16_bf16(__builtin_bit_cast(bf16x8, pw3), SBA_VF(3), oo, 0, 0, 0);
                if (d0) o1 = oo; else o0 = oo;
#undef SBA_VF
            }
            done_w = __all(carry < 1e-30f);
        }
        if (lane == 0) flags[slot * 8 + wid] = done_w ? 1u : 0u;
    }
    {
        LAS bf16* stg = (LAS bf16*)(lds + L_OST) + wid * 2048;
#pragma unroll
        for (int r = 0; r < 16; ++r) { const int orow = (r & 3) + 8 * (r >> 2) + 4 * hi;
            stg[orow * 64 + r32] = (bf16)(pk2(o0[r], 0.f) & 0xffffu); stg[orow * 64 + 32 + r32] = (bf16)(pk2(o1[r], 0.f) & 0xffffu); }
        asm volatile("s_waitcnt lgkmcnt(0)" ::: "memory");
        bf16* Ow = CAT + (rowbase + q0 + wid * 32) * DM + 512 + h * HD;
#pragma unroll
        for (int i = 0; i < 4; ++i) { const int row = i * 8 + (lane >> 3), ch = lane & 7; const v4u v = *(const LAS v4u*)(stg + row * 64 + ch * 8); *(v4u*)(Ow + (long)row * DM + ch * 8) = v; }
    }
    __syncthreads();
#undef SBA_DMA
}
}

__device__ __forceinline__ void conv_unit(Frame& F, int b, int tt, const bf16* U0, bf16* CAT, const float* dw_w, const float* dw_b, const float* ln_g, const float* ln_b) {
    const int t0 = tt * 32;
    LAS unsigned char* tile = F.lds;
    LAS float* resl = (LAS float*)(F.lds + 63488);
    for (int idx = F.tid; idx < 62 * 64; idx += 512) {
        const int ri = idx >> 6, ch = idx & 63, tok = t0 - 30 + ri;
        v4u v = {0u, 0u, 0u, 0u};
        if (tok >= 0) v = *(const v4u*)(U0 + ((size_t)b * SEQ + tok) * CONVC + ch * 8);
        *(LAS v4u*)(tile + ri * 1024 + ch * 16) = v;
    }
    __syncthreads();
    {
        const int cp = F.tid & 255, th = F.tid >> 8;
        float w0[31], w1[31];
#pragma unroll
        for (int k = 0; k < 31; ++k) { const f32x2 wv = *(const f32x2*)(dw_w + k * CONVC + 2 * cp); w0[k] = wv[0]; w1[k] = wv[1]; }
        const f32x2 bias = *(const f32x2*)(dw_b + 2 * cp);
#pragma unroll 1
        for (int og = 0; og < 2; ++og) {
            float a0[8], a1[8];
#pragma unroll
            for (int o = 0; o < 8; ++o) { a0[o] = bias[0]; a1[o] = bias[1]; }
            const LAS unsigned char* tp = tile + (16 * th + 8 * og) * 1024 + cp * 4;
#pragma unroll
            for (int j = 0; j < 38; ++j) {
                const unsigned xin = *(const LAS unsigned*)(tp + j * 1024);
                const float x0 = bflo(xin), x1 = bfhi(xin);
#pragma unroll
                for (int o = 0; o < 8; ++o) { const int k = j - o; if (k >= 0 && k <= 30) { a0[o] += w0[k] * x0; a1[o] += w1[k] * x1; } }
            }
#pragma unroll
            for (int o = 0; o < 8; ++o) *(LAS f32x2*)(resl + (16 * th + 8 * og + o) * 512 + 2 * cp) = (f32x2){a0[o], a1[o]};
        }
    }
    __syncthreads();
    {
        const f32x4 lg0 = *(const f32x4*)(ln_g + 8 * F.lane), lg1 = *(const f32x4*)(ln_g + 8 * F.lane + 4), lb0 = *(const f32x4*)(ln_b + 8 * F.lane), lb1 = *(const f32x4*)(ln_b + 8 * F.lane + 4);
#pragma unroll
        for (int i = 0; i < 4; ++i) {
            const int tk = F.wave * 4 + i;
            const f32x4 v0 = *(const LAS f32x4*)(resl + tk * 512 + 8 * F.lane), v1 = *(const LAS f32x4*)(resl + tk * 512 + 8 * F.lane + 4);
            const float s = wave_sum((v0[0] + v0[1]) + (v0[2] + v0[3]) + (v1[0] + v1[1]) + (v1[2] + v1[3]));
            const float mean = s * (1.0f / CONVC);
            const f32x4 d0 = v0 - mean, d1 = v1 - mean;
            const float q = wave_sum((d0[0] * d0[0] + d0[1] * d0[1]) + (d0[2] * d0[2] + d0[3] * d0[3]) + (d1[0] * d1[0] + d1[1] * d1[1]) + (d1[2] * d1[2] + d1[3] * d1[3]));
            const float rstd = 1.0f / sqrtf(q * (1.0f / CONVC) + EPS);
            const f32x4 y0 = d0 * rstd * lg0 + lb0, y1 = d1 * rstd * lg1 + lb1;
            v4u pw; pw.x = pk2(siluf_(y0[0]), siluf_(y0[1])); pw.y = pk2(siluf_(y0[2]), siluf_(y0[3])); pw.z = pk2(siluf_(y1[0]), siluf_(y1[1])); pw.w = pk2(siluf_(y1[2]), siluf_(y1[3]));
            *(v4u*)(CAT + ((size_t)b * SEQ + t0 + tk) * DM + 8 * F.lane) = pw;
        }
    }
    __syncthreads();
}

__device__ __forceinline__ void lru_unit(Frame& F, int b, int cb, const bf16* GY, const bf16* XB, bf16* CAT2, const bf16* WRG, const bf16* WIG,
                                         const float* conv_w, const float* conv_b, const float* rg_b, const float* ig_b, const float* lam) {
    constexpr int L_XR = 0, L_XC = 17408, L_GY = 34816, L_OUT = 51200;
    LAS unsigned char* lds = F.lds;
    const int lane = F.lane, wv = F.wave, l15 = lane & 15, g4 = lane >> 4;
    const int cl_ = 16 * wv + l15, cglob = cb * 128 + cl_;
    bf16x8 brg[4], big[4];
#pragma unroll
    for (int ks = 0; ks < 4; ++ks) { brg[ks] = *(const bf16x8*)(WRG + ((size_t)cb * 128 + cl_) * 128 + 32 * ks + 8 * g4); big[ks] = *(const bf16x8*)(WIG + ((size_t)cb * 128 + cl_) * 128 + 32 * ks + 8 * g4); }
    const float rb = rg_b[cglob], ib = ig_b[cglob];
    const float lamv = lam[cglob];
    const float cl2 = -8.0f * log1pf(expf(-lamv)) * 1.4426950408889634f;
    const int cp2 = F.tid & 63;
    float cw0[4], cw1[4];
#pragma unroll
    for (int k = 0; k < 4; ++k) { const f32x2 w = *(const f32x2*)(conv_w + k * DM + cb * 128 + 2 * cp2); cw0[k] = w[0]; cw1[k] = w[1]; }
    const f32x2 cbias = *(const f32x2*)(conv_b + cb * 128 + 2 * cp2);
    const size_t rowb = (size_t)b * SEQ;
    v4u px[3], pg[2];
#define LRU_PREFETCH(t0_) do { \
        _Pragma("unroll") for (int i = 0; i < 3; ++i) { const int idx = F.tid + 512 * i; px[i] = (v4u){0u, 0u, 0u, 0u}; \
            if (idx < 67 * 16) { const int ri = idx >> 4, chn = idx & 15, tok = (t0_) - 3 + ri; if (tok >= 0) px[i] = *(const v4u*)(XB + (rowb + tok) * DM + cb * 128 + chn * 8); } } \
        _Pragma("unroll") for (int i = 0; i < 2; ++i) { const int idx = F.tid + 512 * i; const int ri = idx >> 4, chn = idx & 15; pg[i] = *(const v4u*)(GY + (rowb + (t0_) + ri) * DM + cb * 128 + chn * 8); } } while (0)
    LRU_PREFETCH(0);
    float carry = 0.f;
    for (int it = 0; it < SEQ / 64; ++it) {
        const int t0 = it * 64;
#pragma unroll
        for (int i = 0; i < 3; ++i) { const int idx = F.tid + 512 * i; if (idx < 67 * 16) *(LAS v4u*)(lds + L_XR + idx * 16) = px[i]; }
#pragma unroll
        for (int i = 0; i < 2; ++i) { const int idx = F.tid + 512 * i; *(LAS v4u*)(lds + L_GY + idx * 16) = pg[i]; }
        __syncthreads();
        if (it + 1 < SEQ / 64) LRU_PREFETCH(t0 + 64);
        {
            float x0[11], x1[11];
#pragma unroll
            for (int j = 0; j < 11; ++j) { const unsigned xin = *(const LAS unsigned*)(lds + L_XR + (8 * wv + j) * 256 + cp2 * 4); x0[j] = bflo(xin); x1[j] = bfhi(xin); }
#pragma unroll
            for (int o = 0; o < 8; ++o) {
                const float y0 = cbias[0] + (cw0[0] * x0[o] + cw0[1] * x0[o + 1]) + (cw0[2] * x0[o + 2] + cw0[3] * x0[o + 3]);
                const float y1 = cbias[1] + (cw1[0] * x1[o] + cw1[1] * x1[o + 1]) + (cw1[2] * x1[o + 2] + cw1[3] * x1[o + 3]);
                *(LAS unsigned*)(lds + L_XC + (8 * wv + o) * 272 + cp2 * 4) = pk2(y0, y1);
            }
        }
        __syncthreads();
#pragma unroll
        for (int m = 0; m < 4; ++m) {
            f32x4 aR = {0.f, 0.f, 0.f, 0.f}, aI = {0.f, 0.f, 0.f, 0.f};
#pragma unroll
            for (int ks = 0; ks < 4; ++ks) { const bf16x8 af = *(const LAS bf16x8*)(lds + L_XC + (16 * m + l15) * 272 + (32 * ks + 8 * g4) * 2);
                aR = __builtin_amdgcn_mfma_f32_16x16x32_bf16(af, brg[ks], aR, 0, 0, 0); aI = __builtin_amdgcn_mfma_f32_16x16x32_bf16(af, big[ks], aI, 0, 0, 0); }
            float av[4], bv[4], gy[4];
            float A = 1.f, B = 0.f;
#pragma unroll
            for (int r = 0; r < 4; ++r) {
                const int tk = 16 * m + 4 * g4 + r;
                const float xcv = bf2f(*(const LAS bf16*)(lds + L_XC + tk * 272 + cl_ * 2));
                gy[r] = bf2f(*(const LAS bf16*)(lds + L_GY + tk * 256 + cl_ * 2));
                const float rr = sigmoidf_(aR[r] + rb), ii = sigmoidf_(aI[r] + ib);
                const float a = fast_exp2(cl2 * rr);
                const float mult = sqrtf(__builtin_fmaxf(1.0f - a * a, 0.f));
                av[r] = a; bv[r] = mult * ii * xcv;
                B = a * B + bv[r]; A = A * a;
            }
            { const float Ap = __shfl_up(A, 16), Bp = __shfl_up(B, 16); if (g4 >= 1) { B = A * Bp + B; A = A * Ap; } }
            { const float Ap = __shfl_up(A, 32), Bp = __shfl_up(B, 32); if (g4 >= 2) { B = A * Bp + B; A = A * Ap; } }
            const float hend = A * carry + B;
            const float hprev = __shfl_up(hend, 16);
            float hcur = (g4 == 0) ? carry : hprev;
            carry = __shfl(hend, 48 + l15);
#pragma unroll
            for (int r = 0; r < 4; ++r) { hcur = av[r] * hcur + bv[r]; const int tk = 16 * m + 4 * g4 + r;
                *(LAS bf16*)(lds + L_OUT + tk * 256 + cl_ * 2) = (bf16)(pk2(gy[r] * hcur, 0.f) & 0xffffu); }
        }
        __syncthreads();
#pragma unroll
        for (int i = 0; i < 2; ++i) { const int idx = F.tid + 512 * i; const int ri = idx >> 4, chn = idx & 15;
            *(v4u*)(CAT2 + (rowb + t0 + ri) * DM + cb * 128 + chn * 8) = *(const LAS v4u*)(lds + L_OUT + idx * 16); }
    }
    __syncthreads();
#undef LRU_PREFETCH
}

__device__ __forceinline__ void router_phase(Frame& F, const float* X, bf16* H, const float* ng, const float* modl, const float* rw, const float* rbias) {
    LAS float* wrt = (LAS float*)F.lds;
    LAS float* gml = (LAS float*)(F.lds + 65536);
    LAS float* shl = (LAS float*)(F.lds + 69632);
    LAS float* brl = (LAS float*)(F.lds + 73728);
    LAS int* cnt = (LAS int*)(F.lds + 73728 + 64);
    const int w = F.bx, b = w >> 3;
    for (int i = F.tid; i < 16 * 1024; i += 512) { const int k = i >> 4, e = i & 15; wrt[e * 1024 + k] = rw[i]; }
    for (int k = F.tid; k < 1024; k += 512) { gml[k] = ng[k] * (1.0f + modl[(size_t)b * 6144 + 4 * 1024 + k]); shl[k] = modl[(size_t)b * 6144 + 3 * 1024 + k]; }
    if (F.tid < 16) cnt[F.tid] = 0;
    __syncthreads();
    if (F.wave == 0) {
        float acc[16];
#pragma unroll
        for (int e = 0; e < 16; ++e) acc[e] = 0.f;
        for (int k = F.lane; k < 1024; k += 64) { const float s = shl[k];
#pragma unroll
            for (int e = 0; e < 16; ++e) acc[e] += s * wrt[e * 1024 + k]; }
#pragma unroll
        for (int e = 0; e < 16; ++e) { const float t = wave_sum(acc[e]); if (F.lane == 0) brl[e] = t; }
    }
    __syncthreads();
    const int sub = F.lane & 15, rsel = F.lane >> 4;
    int* EID = (int*)(F.ws + META_EID); float* GATE = (float*)(F.ws + META_GATE);
    f32x4 xna[8];
    { const size_t row0 = (size_t)w * 256 + F.wave * 32 + rsel;
#pragma unroll
      for (int c = 0; c < 8; ++c) xna[c] = *(const f32x4*)(X + row0 * DM + 64 * c + 4 * sub); }
    for (int pass = 0; pass < 8; ++pass) {
        const size_t row = (size_t)w * 256 + F.wave * 32 + pass * 4 + rsel;
        f32x4 xg[16]; float ss = 0.f; float acc[16];
#pragma unroll
        for (int c = 0; c < 8; ++c) xg[c] = xna[c];
#pragma unroll
        for (int c = 8; c < 16; ++c) xg[c] = *(const f32x4*)(X + row * DM + 64 * c + 4 * sub);
#pragma unroll
        for (int e = 0; e < 16; ++e) acc[e] = 0.f;
#pragma unroll
        for (int c = 0; c < 16; ++c) {
            if (c == 8) {
                const size_t rown = pass < 7 ? row + 4 : row;
#pragma unroll
                for (int c2 = 0; c2 < 8; ++c2) xna[c2] = *(const f32x4*)(X + rown * DM + 64 * c2 + 4 * sub);
            }
            const int k = 64 * c + 4 * sub;
            const f32x4 x = xg[c];
            ss += (x[0] * x[0] + x[1] * x[1]) + (x[2] * x[2] + x[3] * x[3]);
            xg[c] = x * *(const LAS f32x4*)(gml + k);
#pragma unroll
            for (int e = 0; e < 16; ++e) { const f32x4 wv = *(const LAS f32x4*)(wrt + e * 1024 + k); acc[e] += (xg[c][0] * wv[0] + xg[c][1] * wv[1]) + (xg[c][2] * wv[2] + xg[c][3] * wv[3]); }
        }
#pragma unroll
        for (int o = 1; o < 16; o <<= 1) { ss += __shfl_xor(ss, o);
#pragma unroll
            for (int e = 0; e < 16; ++e) acc[e] += __shfl_xor(acc[e], o); }
        const float rstd = 1.0f / sqrtf(ss * (1.0f / DM) + EPS);
#pragma unroll
        for (int c = 0; c < 16; ++c) { const int k = 64 * c + 4 * sub; const f32x4 o = xg[c] * rstd + *(const LAS f32x4*)(shl + k);
            v2u pw; pw.x = pk2(o[0], o[1]); pw.y = pk2(o[2], o[3]); *(v2u*)(H + row * DM + k) = pw; }
        float sc[16], bi[16];
#pragma unroll
        for (int e = 0; e < 16; ++e) { const float lg = acc[e] * rstd + brl[e]; sc[e] = 1.0f / (1.0f + __expf(-lg)); bi[e] = sc[e] + rbias[e]; }
        int gbest = 0; float gsb = -1e30f;
#pragma unroll
        for (int g = 0; g < 4; ++g) {
            float m1 = bi[4 * g], m2 = -1e30f;
#pragma unroll
            for (int i = 1; i < 4; ++i) { const float v = bi[4 * g + i]; if (v > m1) { m2 = m1; m1 = v; } else if (v > m2) m2 = v; }
            const float gs = m1 + m2; if (gs > gsb) { gsb = gs; gbest = g; }
        }
        float v4[4], s4[4];
#pragma unroll
        for (int i = 0; i < 4; ++i) { v4[i] = gbest == 0 ? bi[i] : gbest == 1 ? bi[4 + i] : gbest == 2 ? bi[8 + i] : bi[12 + i]; s4[i] = gbest == 0 ? sc[i] : gbest == 1 ? sc[4 + i] : gbest == 2 ? sc[8 + i] : sc[12 + i]; }
        int i1 = 0;
#pragma unroll
        for (int i = 1; i < 4; ++i) if (v4[i] > v4[i1]) i1 = i;
        int i2 = (i1 == 0) ? 1 : 0;
#pragma unroll
        for (int i = 0; i < 4; ++i) if (i != i1 && i != i2 && v4[i] > v4[i2]) i2 = i;
        const float se1 = i1 == 0 ? s4[0] : i1 == 1 ? s4[1] : i1 == 2 ? s4[2] : s4[3], se2 = i2 == 0 ? s4[0] : i2 == 1 ? s4[1] : i2 == 2 ? s4[2] : s4[3];
        if (sub == 0) {
            const int e1 = 4 * gbest + i1, e2 = 4 * gbest + i2; const float inv = 1.0f / (se1 + se2);
            EID[row * 2] = e1; EID[row * 2 + 1] = e2; GATE[row * 2] = se1 * inv; GATE[row * 2 + 1] = se2 * inv;
            atomicAdd((int*)&cnt[e1], 1); atomicAdd((int*)&cnt[e2], 1);
        }
    }
    __syncthreads();
    if (F.tid < 16) ((int*)(F.ws + META_BCNT))[w * 16 + F.tid] = cnt[F.tid];
    __syncthreads();
}

__device__ __forceinline__ void slot_phase(Frame& F) {
    LAS int* cn = (LAS int*)F.lds;
    LAS int* mybase = (LAS int*)(F.lds + 16384);
    LAS int* tot = (LAS int*)(F.lds + 16384 + 64);
    LAS int* cursor = (LAS int*)(F.lds + 16384 + 128);
    LAS int* pstart = (LAS int*)(F.lds + 16384 + 192);
    const int w = F.bx;
    const int* BC = (const int*)(F.ws + META_BCNT);
    int* TOK = (int*)(F.ws + META_TOK);
    for (int i = F.tid; i < 4096; i += 512) cn[i] = BC[i];
    __syncthreads();
    if (F.tid < 16) { int run = 0, mb = 0; for (int j = 0; j < 256; ++j) { if (j == w) mb = run; run += cn[j * 16 + F.tid]; } mybase[F.tid] = mb; tot[F.tid] = run; }
    __syncthreads();
    if (F.tid == 0) {
        int ps = 0; int* TE = (int*)(F.ws + META_TILEE);
        for (int e = 0; e < 16; ++e) { const int padded = (tot[e] + 255) & ~255; cursor[e] = ps + mybase[e]; pstart[e] = ps;
            if (w == 0) for (int tl = ps >> 8; tl < (ps + padded) >> 8; ++tl) TE[tl] = e;
            ps += padded; }
        if (w == 0) *(int*)(F.ws + META_NT) = ps >> 8;
    }
    __syncthreads();
    if (w < 16) { const int s0 = pstart[w] + tot[w], s1 = pstart[w] + ((tot[w] + 255) & ~255); for (int sidx = s0 + F.tid; sidx < s1; sidx += 512) TOK[sidx] = 0; }
    const int* EID = (const int*)(F.ws + META_EID); int* SLOT = (int*)(F.ws + META_SLOT);
    if (F.lane < 32) {
        const size_t t = (size_t)w * 256 + F.wave * 32 + F.lane;
        const v2u ev = *(const v2u*)(EID + t * 2); const int ms0 = atomicAdd((int*)&cursor[ev.x], 1), ms1 = atomicAdd((int*)&cursor[ev.y], 1);
        v2u sv; sv.x = (unsigned)ms0; sv.y = (unsigned)ms1; *(v2u*)(SLOT + t * 2) = sv; TOK[ms0] = (int)t; TOK[ms1] = (int)t;
    }
    __syncthreads();
}

template <bool NEXT>
__device__ __forceinline__ void combine_phase(Frame& F, const float* X, float* XO, const bf16* Y, const float* modl  , bf16* H, const float* ng_next, const float* modn  ) {
    const int gw = F.bx * NWAVES + F.wave, b = gw >> 6;
    const int* SLOT = (const int*)(F.ws + META_SLOT); const float* GATE = (const float*)(F.ws + META_GATE);
    f32x4 g2[4], gm[4], sh[4];
#pragma unroll
    for (int j = 0; j < 4; ++j) { const int k = 256 * j + 4 * F.lane; g2[j] = *(const f32x4*)(modl + (size_t)b * 6144 + 5 * 1024 + k);
        if (NEXT) { const f32x4 g = *(const f32x4*)(ng_next + k), s = *(const f32x4*)(modn + (size_t)b * 6144 + 1 * 1024 + k); gm[j] = g * (s + 1.0f); sh[j] = *(const f32x4*)(modn + (size_t)b * 6144 + k); } }
    const size_t rbase = (size_t)gw * 32;
    int ms0 = 0, ms1 = 0; float mg0 = 0.f, mg1 = 0.f;
    if (F.lane < 32) { const v2u sv = *(const v2u*)(SLOT + (rbase + F.lane) * 2); const f32x2 gv = *(const f32x2*)(GATE + (rbase + F.lane) * 2); ms0 = (int)sv.x; ms1 = (int)sv.y; mg0 = gv[0]; mg1 = gv[1]; }
    for (int r0 = 0; r0 < 32; r0 += 4) {
        f32x4 x[4][4]; v2u ya[4][4], yb[4][4]; float ga[4], gb[4];
#pragma unroll
        for (int q = 0; q < 4; ++q) {
            const int s0 = __builtin_amdgcn_readlane(ms0, r0 + q), s1 = __builtin_amdgcn_readlane(ms1, r0 + q);
            ga[q] = __builtin_bit_cast(float, __builtin_amdgcn_readlane(__builtin_bit_cast(int, mg0), r0 + q)); gb[q] = __builtin_bit_cast(float, __builtin_amdgcn_readlane(__builtin_bit_cast(int, mg1), r0 + q));
#pragma unroll
            for (int j = 0; j < 4; ++j) { const int k = 256 * j + 4 * F.lane;
                x[q][j] = *(const f32x4*)(X + (rbase + r0 + q) * DM + k); ya[q][j] = *(const v2u*)(Y + (size_t)s0 * DM + k); yb[q][j] = *(const v2u*)(Y + (size_t)s1 * DM + k); }
        }
        asm volatile("" ::: "memory");
#pragma unroll
        for (int q = 0; q < 4; ++q) {
            const size_t row = rbase + r0 + q; float ss = 0.f; f32x4 v[4];
#pragma unroll
            for (int j = 0; j < 4; ++j) { const int k = 256 * j + 4 * F.lane;
                f32x4 f; f[0] = ga[q] * bflo(ya[q][j].x) + gb[q] * bflo(yb[q][j].x); f[1] = ga[q] * bfhi(ya[q][j].x) + gb[q] * bfhi(yb[q][j].x); f[2] = ga[q] * bflo(ya[q][j].y) + gb[q] * bflo(yb[q][j].y); f[3] = ga[q] * bfhi(ya[q][j].y) + gb[q] * bfhi(yb[q][j].y);
                v[j] = x[q][j] + g2[j] * f;
                *(f32x4*)(XO + row * DM + k) = v[j];
                ss += (v[j][0] * v[j][0] + v[j][1] * v[j][1]) + (v[j][2] * v[j][2] + v[j][3] * v[j][3]); }
            if (NEXT) {
                const float rstd = 1.0f / sqrtf(wave_sum(ss) * (1.0f / DM) + EPS);
#pragma unroll
                for (int j = 0; j < 4; ++j) { const f32x4 o = v[j] * rstd * gm[j] + sh[j]; v2u pw; pw.x = pk2(o[0], o[1]); pw.y = pk2(o[2], o[3]); *(v2u*)(H + row * DM + 256 * j + 4 * F.lane) = pw; }
            }
        }
    }
}

constexpr int NPHASE = 18;
struct Args { const float* in[28]; float* out; unsigned char* ws; int ph_lo, ph_hi; };
template <int PLO, int PHI> __global__ void __launch_bounds__(NWAVES * 64, 2) mk_fwd(Args args) {
    extern __shared__ __attribute__((aligned(16))) unsigned char lds_raw[];
    Frame F;
    F.lds = (LAS unsigned char*)lds_raw;
    F.tid = threadIdx.x; F.lane = F.tid & 63; F.wave = __builtin_amdgcn_readfirstlane(F.tid >> 6);
    F.G = gridDim.x; F.bx = blockIdx.x; F.vcu = (F.G % 8 == 0) ? (F.bx % 8) * (F.G / 8) + F.bx / 8 : F.bx;
    F.ws = args.ws;
    volatile LAS unsigned* MISC = (volatile LAS unsigned*)(F.lds + MISC_OFF);
    for (int u = F.tid; u < (LDS_BYTES - LDSCTL_OFF) / 4; u += NWAVES * 64) ((LAS unsigned*)(F.lds + LDSCTL_OFF))[u] = 0u;
    __syncthreads();
#if MK_ONE_LAUNCH
    XcdBarrier bar = xcd_barrier_post((unsigned*)(F.ws + WS_CTL) + CW_BAR, MISC + 8);
#define GRID_BAR() do { XcdBarrier b_ = bar; asm volatile("" : "+s"(b_.bar), "+s"(b_.x)); xcd_barrier(b_); } while (0)
#else
#define GRID_BAR() do {} while (0)
#endif
    constexpr int lo = PLO, hi = PHI;
#ifndef PHASE_MASK
#define PHASE_MASK 0x3ffff
#endif
#define IN(k) ((((PHASE_MASK) >> (k)) & 1) && lo <= (k) && (k) < hi)
#ifndef PROBE_REP
#define PROBE_REP 0x20000
#endif
#define REPN(k) (((PROBE_REP) >> (k)) & 1)
#define SEAM(k) do { if (IN(k) && IN((k) + 1)) GRID_BAR(); } while (0)
    typedef const __attribute__((address_space(4))) Args* KArgs; KArgs KA = (KArgs)__builtin_amdgcn_kernarg_segment_ptr();
#define in KA->in
#define PHASE_ENTER() do { KA = (KArgs)__builtin_amdgcn_kernarg_segment_ptr(); asm volatile("" : "+s"(KA)); F.ws = KA->ws; int tid_o = threadIdx.x; asm volatile("" : "+v"(tid_o)); F.tid = tid_o; F.lane = tid_o & 63; F.wave = __builtin_amdgcn_readfirstlane(tid_o >> 6); } while (0)
#define P_MOD ((float*)(F.ws + WS_MOD))
#define P_HA ((bf16*)(F.ws + WS_HA))
#define P_U0 ((bf16*)(F.ws + WS_R1))
#define P_Q (P_U0 + (size_t)T * 512)
#define P_K (P_U0 + (size_t)2 * T * 512)
#define P_V (P_U0 + (size_t)3 * T * 512)
#define P_GY ((bf16*)(F.ws + WS_R1))
#define P_XB (P_GY + (size_t)T * DM)
#define P_XS ((bf16*)(F.ws + WS_R1))
#define P_Y P_XS
#define P_CAT ((bf16*)(F.ws + WS_R2))
#define P_HID P_CAT

    if (IN(0)) for (int rep_ = 0; rep_ <= REPN(0); ++rep_) { PHASE_ENTER(); p0_prologue(F, KA); } SEAM(0);
    if (IN(1)) for (int rep_ = 0; rep_ <= REPN(1); ++rep_) { PHASE_ENTER(); norm_rows(F, in[0], P_HA, in[4], P_MOD, 0, 1024); } SEAM(1);
    if (IN(2)) for (int rep_ = 0; rep_ <= REPN(2); ++rep_) { PHASE_ENTER();
        pg8::Gemm g{P_HA, (const bf16*)(F.ws + WS_WEVIN), T, EVIN, DM, 0}; pg8::StaticOrder S; S.init(T, EVIN, F.G, F.bx);
        pg8::EpiEvIn E{P_U0, P_Q, P_K, P_V, in[11], in[12]};
        pg8::gemm_phase<pg8::EpiEvIn, pg8::StaticOrder, true, true>(F.lds, g, S, E);
    } SEAM(2);
    if (IN(3)) for (int rep_ = 0; rep_ <= REPN(3); ++rep_) { PHASE_ENTER();
#ifndef NO_ATTN
        { const int bh = F.vcu; for (int qb = 7; qb >= 0; --qb) sba::unit(bh >> 3, bh & 7, qb, P_Q, P_K, P_V, P_CAT, F.lds); }
#endif
#ifndef NO_CONV
        for (int uidx = F.vcu; uidx < NB * (SEQ / 32); uidx += F.G) conv_unit(F, uidx >> 6, uidx & 63, P_U0, P_CAT, in[7], in[8], in[9], in[10]);
#endif
    } SEAM(3);
    if (IN(4)) for (int rep_ = 0; rep_ <= REPN(4); ++rep_) { PHASE_ENTER();
        pg8::Gemm g{P_CAT, (const bf16*)(F.ws + WS_WEVOUT), T, DM, DM, 0}; pg8::StaticOrder S; S.init(T, DM, F.G, F.bx);
        pg8::EpiResid E{in[0], KA->out, P_MOD + 2 * 1024};
        pg8::gemm_phase<pg8::EpiResid, pg8::StaticOrder, true, true>(F.lds, g, S, E);
    } SEAM(4);
#define MOE_PHASES(layer, p0) \
    if (IN(p0)) for (int rep_ = 0; rep_ <= REPN(p0); ++rep_) { PHASE_ENTER(); router_phase(F, KA->out, P_HA, in[5] + (layer) * DM, P_MOD + (size_t)(layer) * 32 * 6144, in[23], in[24]); } SEAM(p0); \
    if (IN((p0) + 1)) for (int rep_ = 0; rep_ <= REPN((p0) + 1); ++rep_) { PHASE_ENTER(); slot_phase(F); } SEAM((p0) + 1); \
    if (IN((p0) + 2)) for (int rep_ = 0; rep_ <= REPN((p0) + 2); ++rep_) { PHASE_ENTER(); \
        const int ntl = *(const int*)(F.ws + META_NT); \
        pg8::Gemm g{P_HA, (const bf16*)(F.ws + WS_W13) + (size_t)(layer) * 16 * 1024 * 1024, ntl * 256, 1024, DM, (size_t)1024 * 1024 * 2}; \
        pg8::MoeGatherOrder S; S.base.init(ntl * 256, 1024, F.G, F.bx); S.tile_e = (const int*)(F.ws + META_TILEE); S.tok = (const int*)(F.ws + META_TOK); \
        pg8::EpiMoeA E{P_HID}; \
        pg8::gemm_phase<pg8::EpiMoeA, pg8::MoeGatherOrder, true, true>(F.lds, g, S, E); \
    } SEAM((p0) + 2); \
    if (IN((p0) + 3)) for (int rep_ = 0; rep_ <= REPN((p0) + 3); ++rep_) { PHASE_ENTER(); \
        const int ntl = *(const int*)(F.ws + META_NT); \
        pg8::Gemm g{P_HID, (const bf16*)(F.ws + WS_W2) + (size_t)(layer) * 16 * 1024 * 512, ntl * 256, 1024, DFF, (size_t)1024 * 512 * 2}; \
        pg8::MoeOrder S; S.base.init(ntl * 256, 1024, F.G, F.bx); S.tile_e = (const int*)(F.ws + META_TILEE); \
        pg8::EpiMoeB E{P_Y}; \
        pg8::gemm_phase<pg8::EpiMoeB, pg8::MoeOrder, true, true>(F.lds, g, S, E); \
    } SEAM((p0) + 3);

    MOE_PHASES(0, 5)
    if (IN(9)) for (int rep_ = 0; rep_ <= REPN(9); ++rep_) { PHASE_ENTER(); const bool dry = rep_ < REPN(9); combine_phase<true>(F, KA->out, dry ? (float*)(F.ws + WS_END) : KA->out, P_Y, P_MOD, dry ? P_HID : P_HA, in[4] + DM, P_MOD + (size_t)32 * 6144); } SEAM(9);
    if (IN(10)) for (int rep_ = 0; rep_ <= REPN(10); ++rep_) { PHASE_ENTER();
        pg8::Gemm g{P_HA, (const bf16*)(F.ws + WS_WODIN), T, 2048, DM, 0}; pg8::StaticOrder S; S.init(T, 2048, F.G, F.bx);
        pg8::EpiOdIn E{P_GY, P_XB};
        pg8::gemm_phase<pg8::EpiOdIn, pg8::StaticOrder, true, true>(F.lds, g, S, E);
    } SEAM(10);
    if (IN(11)) for (int rep_ = 0; rep_ <= REPN(11); ++rep_) { PHASE_ENTER(); const int u = F.vcu; lru_unit(F, u >> 3, u & 7, P_GY, P_XB, P_CAT, (const bf16*)(F.ws + WS_WRG), (const bf16*)(F.ws + WS_WIG), in[15], in[16], in[18], in[20], in[21]); } SEAM(11);
    if (IN(12)) for (int rep_ = 0; rep_ <= REPN(12); ++rep_) { PHASE_ENTER();
        pg8::Gemm g{P_CAT, (const bf16*)(F.ws + WS_WODOUT), T, DM, DM, 0}; pg8::StaticOrder S; S.init(T, DM, F.G, F.bx);
        pg8::EpiResid E{KA->out, KA->out, P_MOD + (size_t)32 * 6144 + 2 * 1024};
        pg8::gemm_phase<pg8::EpiResid, pg8::StaticOrder, true, true>(F.lds, g, S, E);
    } SEAM(12);
    MOE_PHASES(1, 13)
    if (IN(17)) for (int rep_ = 0; rep_ <= REPN(17); ++rep_) { PHASE_ENTER(); const bool dry = rep_ < REPN(17); combine_phase<false>(F, KA->out, dry ? (float*)(F.ws + WS_END) : KA->out, P_Y, P_MOD + (size_t)32 * 6144, P_HA, nullptr, nullptr); }
#undef MOE_PHASES
#undef in
#undef IN
#undef SEAM
}

#if !MK_ONE_LAUNCH
template <int P> static void set_attr_all() { if constexpr (P < NPHASE) { (void)hipFuncSetAttribute((const void*)mk_fwd<P, P + 1>, hipFuncAttributeMaxDynamicSharedMemorySize, LDS_BYTES); set_attr_all<P + 1>(); } }
template <int P> static void launch_all(Args a, int grid, hipStream_t stream) { if constexpr (P < NPHASE) { a.ph_lo = P; a.ph_hi = P + 1; hipLaunchKernelGGL((mk_fwd<P, P + 1>), dim3(grid), dim3(NWAVES * 64), LDS_BYTES, stream, a); launch_all<P + 1>(a, grid, stream); } }
#endif

extern "C" void kernel_launch(void* const* d_in, const int* in_sizes, int n_in, void* d_out, int out_size, void* d_ws, size_t ws_size, hipStream_t stream) {
    static int grid = 0;
    if (grid == 0) {
        if (n_in != 28 || in_sizes[0] != T * DM || out_size != T * DM || ws_size < WS_END + (size_t)T * DM * 4) { fprintf(stderr, "kernel_launch: unexpected shapes (n_in %d, in0 %d, out %d, ws %zu); nothing launched\n", n_in, n_in > 0 ? in_sizes[0] : -1, out_size, ws_size); grid = -1; return; }
        int dev = 0, cus = 0;
        if (hipGetDevice(&dev) != hipSuccess || hipDeviceGetAttribute(&cus, hipDeviceAttributeMultiprocessorCount, dev) != hipSuccess) { grid = -1; return; }
#if MK_ONE_LAUNCH
        if (hipFuncSetAttribute((const void*)mk_fwd<0, NPHASE>, hipFuncAttributeMaxDynamicSharedMemorySize, LDS_BYTES) != hipSuccess) { fprintf(stderr, "kernel_launch: hipFuncSetAttribute failed\n"); grid = -1; return; }
        int per_cu = 0;
        if (hipOccupancyMaxActiveBlocksPerMultiprocessor(&per_cu, (const void*)mk_fwd<0, NPHASE>, NWAVES * 64, LDS_BYTES) != hipSuccess || per_cu < 1) fprintf(stderr, "kernel_launch: occupancy query reports %d\n", per_cu);
#else
        set_attr_all<0>();
#endif
        (void)hipGetLastError();
        grid = cus;
        if (grid != 256) { fprintf(stderr, "kernel_launch: built for 256 CUs, device has %d; nothing launched\n", cus); grid = -1; return; }
    }
    if (grid < 0) return;
    (void)hipMemsetAsync((char*)d_ws + WS_CTL, 0, CTL_ZERO_BYTES, stream);
    Args a{};
    for (int i = 0; i < 28; ++i) a.in[i] = (const float*)d_in[i];
    a.out = (float*)d_out; a.ws = (unsigned char*)d_ws;
#if MK_ONE_LAUNCH
    a.ph_lo = 0; a.ph_hi = NPHASE;
    hipLaunchKernelGGL((mk_fwd<0, NPHASE>), dim3(grid), dim3(NWAVES * 64), LDS_BYTES, stream, a);
#else
    launch_all<0>(a, grid, stream);
#endif
}
```

```cpp
#include <hip/hip_runtime.h>
#include <cstdio>
#include <cstdint>

#ifndef MK_ONE_LAUNCH
#define MK_ONE_LAUNCH 1
#endif

namespace pg8 {
#define PG8_LAS __attribute__((address_space(3)))
typedef unsigned short bf16_t;
typedef short bf16x8 __attribute__((ext_vector_type(8)));
typedef float f32x4 __attribute__((ext_vector_type(4)));
typedef unsigned u32x4 __attribute__((ext_vector_type(4)));
constexpr int BM = 256, BK = 64, HALF = 128, HTB = HALF * BK * 2  , STAGE_BYTES = 8 * HTB, NXCD = 8, WGM = 8;

__host__ __device__ __forceinline__ int lds_byte(int r, int c) { const int st = (r >> 4) * 2 + (c >> 5), rr = r & 15, cc = c & 31, ob = rr * 64 + cc * 2; return st * 1024 + (ob ^ (((ob >> 9) & 1) << 5)); }
__host__ __device__ __forceinline__ void stage_rc(int b, int& R, int& C) { const int st = b / 1024, sb = b % 1024, swz = sb ^ (((sb >> 9) & 1) << 5); R = (st >> 1) * 16 + swz / 64; C = (st & 1) * 32 + (swz % 64) / 2; }
__host__ __device__ __forceinline__ int perm32(int rho) { const int n = rho >> 4, i = rho & 15; return 8 * (i >> 2) + 4 * n + (i & 3); }

struct Unit { int pm, pn, pb; };
struct Gemm { const bf16_t* A; const bf16_t* Bt; int M, N, K; size_t bstride; };

struct StaticOrder {
    static constexpr bool GATHER = false, LAZY_PB = false; const int* tok;
    int nM, nN, nwg, G, c;
    __host__ __device__ void init(int M, int N, int G_, int c_) { nM = M / BM; nN = N / BM; nwg = nM * nN; G = G_; c = c_; }
    __host__ __device__ bool next(int i, Unit& u) const {
        const long L = (long)i * G + c; if (L >= nwg) return false;
        int wgid = (int)L; { const int q = nwg / NXCD, r = nwg % NXCD, xcd = wgid % NXCD, off = wgid / NXCD; wgid = (xcd < r ? xcd * (q + 1) : r * (q + 1) + (xcd - r) * q) + off; }
        const int nig = WGM * nN, gid = wgid / nig, fm = gid * WGM, gsz = (nM - fm) < WGM ? (nM - fm) : WGM;
        u.pm = fm + ((wgid % nig) % gsz); u.pn = (wgid % nig) / gsz; u.pb = 0; return true;
    }
    __device__ __forceinline__ void a_ready(const Unit&) const {}
    __device__ __forceinline__ void done(const Unit&) const {}
};

template <class Epi, class Sched, bool ALIGN_EPI = false, bool SP2 = false>
__device__ __forceinline__ void gemm_phase(PG8_LAS unsigned char* lds, const Gemm g, const Sched& S, const Epi& E) {
    int tid_ = threadIdx.x; asm volatile("" : "+v"(tid_));
    const int tid = tid_, wid = __builtin_amdgcn_readfirstlane(tid >> 6), lane = tid & 63, wr = wid >> 2, wc = wid & 3, fr = lane & 15, fq = lane >> 4;
    const int K = g.K, nt = K / BK;
    unsigned voffA[2], voffB[2];
#pragma unroll
    for (int i = 0; i < 2; ++i) { int R, C; stage_rc(tid * 16 + i * 8192, R, C); const int Rb = Epi::PERM ? ((R & ~31) + perm32(R & 31)) : R;
        voffA[i] = (unsigned)(R * K + C) * 2u; voffB[i] = (unsigned)(Rb * K + C) * 2u; }
    unsigned cvo[2][2], nvo[2][2]; int rowA[2]; unsigned colA[2];
#pragma unroll
    for (int i = 0; i < 2; ++i) { int R, C; stage_rc(tid * 16 + i * 8192, R, C); rowA[i] = R; colA[i] = (unsigned)C * 2u; }
    int ntk[2][2];
#define PG8_LOADTK(u_, tk_) do { const int* _p00 = S.tok + (u_).pm * BM + rowA[0]; const int* _p01 = S.tok + (u_).pm * BM + rowA[1]; const int* _p10 = _p00 + HALF; const int* _p11 = _p01 + HALF; \
        asm volatile("global_load_dword %0, %4, off\n\tglobal_load_dword %1, %5, off\n\tglobal_load_dword %2, %6, off\n\tglobal_load_dword %3, %7, off" \
            : "=&v"(tk_[0][0]), "=&v"(tk_[0][1]), "=&v"(tk_[1][0]), "=&v"(tk_[1][1]) : "v"(_p00), "v"(_p01), "v"(_p10), "v"(_p11) : "memory"); } while (0)
#define PG8_TK2VO(tk_, vo_) do { _Pragma("unroll") for (int _h = 0; _h < 2; ++_h) _Pragma("unroll") for (int _i = 0; _i < 2; ++_i) vo_[_h][_i] = (unsigned)tk_[_h][_i] * (unsigned)(K * 2) + colA[_i]; } while (0)
    const size_t kstep = (size_t)(BK * 2);
    const size_t hstep = (size_t)HALF * K * 2;
    const size_t tstep = 2 * hstep;
    const unsigned ldsw = (unsigned)wid * 1024u;
    const int aoff = lds_byte(wr * 64 + fr, fq * 8), boff = lds_byte(wc * 32 + fr, fq * 8);
#define PG8_SA(b, h) (((b) * 2 + (h)) * HTB)
#define PG8_SB(b, h) ((4 + (b) * 2 + (h)) * HTB)
#define PG8_STAGE(bufoff, gbase, voff) do { _Pragma("unroll") for (int _i = 0; _i < 2; ++_i) \
        __builtin_amdgcn_global_load_lds((const unsigned*)((const char*)(gbase) + (voff)[_i]), (PG8_LAS unsigned*)(lds + (bufoff) + ldsw + _i * 8192), 16, 0, 0); } while (0)
#define PG8_STAGE_A(bufoff, gbase, h, nx) do { if constexpr (Sched::GATHER) { _Pragma("unroll") for (int _i = 0; _i < 2; ++_i) { const unsigned _vo = (nx) ? nvo[h][_i] : cvo[h][_i]; \
        __builtin_amdgcn_global_load_lds((const unsigned*)((const char*)(gbase) + _vo), (PG8_LAS unsigned*)(lds + (bufoff) + ldsw + _i * 8192), 16, 0, 0); } } \
        else { PG8_STAGE(bufoff, (gbase) + (h) * hstep, voffA); } } while (0)
#define PG8_LDA(dst, b, h) do { _Pragma("unroll") for (int m = 0; m < 4; ++m) _Pragma("unroll") for (int k = 0; k < 2; ++k) dst[m][k] = *(const PG8_LAS bf16x8*)(lds + PG8_SA(b, h) + aoff + m * 2048 + k * 1024); } while (0)
#define PG8_LDB(dst, b, h) do { _Pragma("unroll") for (int n = 0; n < 2; ++n) _Pragma("unroll") for (int k = 0; k < 2; ++k) dst[n][k] = *(const PG8_LAS bf16x8*)(lds + PG8_SB(b, h) + boff + n * 2048 + k * 1024); } while (0)
#define PG8_MMA(ai, bj, At, Bt) do { __builtin_amdgcn_s_setprio(1); _Pragma("unroll") for (int m = 0; m < 4; ++m) _Pragma("unroll") for (int n = 0; n < 2; ++n) _Pragma("unroll") for (int k = 0; k < 2; ++k) \
        acc[ai][bj][m][n] = __builtin_amdgcn_mfma_f32_16x16x32_bf16(Bt[n][k], At[m][k], acc[ai][bj][m][n], 0, 0, 0); __builtin_amdgcn_s_setprio(0); } while (0)
#define PG8_WAIT_V(n) asm volatile("s_waitcnt vmcnt(" #n ")" ::: "memory")
#define PG8_WAIT_L(n) asm volatile("s_waitcnt lgkmcnt(" #n ")" ::: "memory")
#define PG8_BAR __builtin_amdgcn_s_barrier()
#define PG8_SCHED __builtin_amdgcn_sched_barrier(0)
    Unit cur, nxt; int ui = 0;
    if (!S.next(0, cur)) return;
    f32x4 acc[2][2][4][2];
#pragma unroll
    for (int a = 0; a < 2; ++a)
#pragma unroll
        for (int b = 0; b < 2; ++b)
#pragma unroll
            for (int m = 0; m < 4; ++m)
#pragma unroll
                for (int n = 0; n < 2; ++n) acc[a][b][m][n] = (f32x4){0.f, 0.f, 0.f, 0.f};
    bf16x8 At[4][2], B0[2][2], B1[2][2];
    const char* cA = (const char*)g.A + (Sched::GATHER ? (size_t)0 : (size_t)cur.pm * tstep); const char* cB = (const char*)g.Bt + (size_t)cur.pb * g.bstride + (size_t)cur.pn * tstep;
    S.a_ready(cur);
    if constexpr (Sched::GATHER) { PG8_LOADTK(cur, ntk); asm volatile("s_waitcnt vmcnt(0)" : "+v"(ntk[0][0]), "+v"(ntk[0][1]), "+v"(ntk[1][0]), "+v"(ntk[1][1]) :: "memory"); PG8_TK2VO(ntk, cvo); }
    if constexpr (SP2) {
        PG8_STAGE(PG8_SB(0, 0), cB, voffB); PG8_STAGE(PG8_SB(0, 1), cB + hstep, voffB); PG8_STAGE_A(PG8_SA(0, 0), cA, 0, false); PG8_STAGE_A(PG8_SA(0, 1), cA, 1, false);
        if (wr == 1) PG8_BAR;
        PG8_WAIT_V(2); PG8_BAR;
        PG8_STAGE(PG8_SB(1, 0), cB + kstep, voffB); PG8_STAGE_A(PG8_SA(1, 0), cA + kstep, 0, false); PG8_STAGE(PG8_SB(1, 1), cB + hstep + kstep, voffB);
        PG8_WAIT_V(6); PG8_BAR;
    } else { static_assert(SP2, "only the SP2 loop is kept"); }
    for (;;) {
        bool has_next; int pbv = 0;
        if constexpr (Sched::LAZY_PB) { has_next = S.next_nopb(ui + 1, nxt);
            if (has_next) { const int* _pp = S.pb_ptr(nxt); asm volatile("global_load_dword %0, %1, off" : "=v"(pbv) : "v"(_pp) : "memory"); } }
        else has_next = S.next(ui + 1, nxt);
        const char* nA = (has_next && !Sched::GATHER) ? (const char*)g.A + (size_t)nxt.pm * tstep : cA;
        if constexpr (Sched::GATHER) { _Pragma("unroll") for (int _h = 0; _h < 2; ++_h) _Pragma("unroll") for (int _i = 0; _i < 2; ++_i) nvo[_h][_i] = cvo[_h][_i]; if (has_next) { PG8_LOADTK(nxt, ntk); } }
 const char* nB = (has_next && !Sched::LAZY_PB) ? (const char*)g.Bt + (size_t)nxt.pb * g.bstride + (size_t)nxt.pn * tstep : cB;
        for (int t = 0; t < nt; t += 2) {
            const bool last = (t == nt - 2);
            const char* a1 = cA + (size_t)(t + 1) * kstep;
            if constexpr (Sched::LAZY_PB) { if (last && has_next) { asm volatile("s_waitcnt vmcnt(8)" : "+v"(pbv) :: "memory"); nxt.pb = __builtin_amdgcn_readfirstlane(pbv);
                nB = (const char*)g.Bt + (size_t)nxt.pb * g.bstride + (size_t)nxt.pn * tstep; } }
            const char* a2 = last ? nA : cA + (size_t)(t + 2) * kstep; const char* b2 = last ? nB : cB + (size_t)(t + 2) * kstep;
            const char* a3 = a2 + kstep; const char* b3 = b2 + kstep;
            if (last && has_next) S.a_ready(nxt);
            if constexpr (Sched::GATHER) { if (last && has_next) {
                asm volatile("s_waitcnt vmcnt(8)" : "+v"(ntk[0][0]), "+v"(ntk[0][1]), "+v"(ntk[1][0]), "+v"(ntk[1][1]) :: "memory"); PG8_TK2VO(ntk, nvo); } }
            if constexpr (SP2) {
            PG8_LDB(B0, 0, 0); PG8_LDB(B1, 0, 1); PG8_SCHED; PG8_LDA(At, 0, 0); PG8_STAGE_A(PG8_SA(1, 1), a1, 1, false);
            PG8_WAIT_V(8); PG8_WAIT_L(0); PG8_BAR; PG8_MMA(0, 0, At, B0); PG8_MMA(0, 1, At, B1); PG8_BAR; PG8_SCHED;
            PG8_LDA(At, 0, 1); PG8_STAGE(PG8_SB(0, 0), b2, voffB); PG8_STAGE(PG8_SB(0, 1), b2 + hstep, voffB); PG8_STAGE_A(PG8_SA(0, 0), a2, 0, last);
            PG8_WAIT_V(8); PG8_WAIT_L(0); PG8_BAR; PG8_MMA(1, 0, At, B0); PG8_MMA(1, 1, At, B1); PG8_BAR; PG8_SCHED;
            PG8_LDB(B0, 1, 0); PG8_LDB(B1, 1, 1); PG8_SCHED; PG8_LDA(At, 1, 0); PG8_STAGE_A(PG8_SA(0, 1), a2, 1, last);
            PG8_WAIT_V(8); PG8_WAIT_L(0); PG8_BAR; PG8_MMA(0, 0, At, B0); PG8_MMA(0, 1, At, B1); PG8_BAR; PG8_SCHED;
            PG8_LDA(At, 1, 1); PG8_STAGE(PG8_SB(1, 0), b3, voffB); PG8_STAGE(PG8_SB(1, 1), b3 + hstep, voffB); PG8_STAGE_A(PG8_SA(1, 0), a3, 0, last);
            PG8_WAIT_V(8); PG8_WAIT_L(0); PG8_BAR; PG8_MMA(1, 0, At, B0); PG8_MMA(1, 1, At, B1); PG8_BAR; PG8_SCHED;
            }
        }
        if constexpr (ALIGN_EPI) { if (wr == 0) PG8_BAR; }
        if constexpr (!Epi::AFTER_DRAIN) { E(acc, cur, wr, wc, fr, fq); S.done(cur); }
        if (!has_next) break;
#pragma unroll
        for (int a = 0; a < 2; ++a)
#pragma unroll
            for (int b = 0; b < 2; ++b)
#pragma unroll
                for (int m = 0; m < 4; ++m)
#pragma unroll
                    for (int n = 0; n < 2; ++n) acc[a][b][m][n] = (f32x4){0.f, 0.f, 0.f, 0.f};
        cur = nxt; cA = nA; cB = nB; ++ui;
        if constexpr (Sched::GATHER) { _Pragma("unroll") for (int _h = 0; _h < 2; ++_h) _Pragma("unroll") for (int _i = 0; _i < 2; ++_i) cvo[_h][_i] = nvo[_h][_i]; }
        if constexpr (ALIGN_EPI) { if (wr == 1) PG8_BAR; }
    }
    PG8_WAIT_V(0);
    if constexpr (!ALIGN_EPI) { if (wr == 0) PG8_BAR; }
    PG8_BAR;
    if constexpr (Epi::AFTER_DRAIN) { E.fused(acc, cur, wr, wc, fr, fq, lds, wid, lane); S.done(cur); }
#undef PG8_SA
#undef PG8_SB
#undef PG8_STAGE
#undef PG8_STAGE_A
#undef PG8_LOADTK
#undef PG8_TK2VO
#undef PG8_LDA
#undef PG8_LDB
#undef PG8_MMA
#undef PG8_WAIT_V
#undef PG8_WAIT_L
#undef PG8_BAR
#undef PG8_SCHED
}
}

constexpr int NB = 32, SEQ = 2048, DM = 1024, T = NB * SEQ;
constexpr int EVIN = 2560, CONVC = 512, CONVW = 31, NHEAD = 8, HD = 64, SBW = 512;
constexpr int NEXP = 16, DFF = 512;
constexpr int MOE_ROWS = 2 * T + NEXP * 256;
constexpr int MOE_TILES = MOE_ROWS / 256;
constexpr float EPS = 1e-6f;
constexpr int NWAVES = 8;

constexpr size_t MiB = 1u << 20;
constexpr size_t WS_CTL = 0, CTL_ZERO_BYTES = 64 * 1024;
constexpr size_t WS_MOD = 1 * MiB;
constexpr size_t WS_META = 3 * MiB;
constexpr size_t META_EID = WS_META, META_GATE = WS_META + 512 * 1024, META_SLOT = WS_META + 1024 * 1024, META_BCNT = WS_META + 1536 * 1024,
                 META_TILEE = META_BCNT + 32 * 1024, META_NT = META_BCNT + 64 * 1024, META_TOK = WS_META + 2048 * 1024;
constexpr size_t WS_WEVIN = 6 * MiB, WS_WEVOUT = 11 * MiB, WS_WODIN = 13 * MiB, WS_WODOUT = 17 * MiB, WS_WRG = 19 * MiB, WS_WIG = WS_WRG + 512 * 1024;
constexpr size_t WS_W13 = 20 * MiB;
constexpr size_t WS_W2 = 84 * MiB;
constexpr size_t WS_HA = 116 * MiB;
constexpr size_t WS_R1 = 244 * MiB;
constexpr size_t WS_R2 = 508 * MiB;
constexpr size_t WS_END = 640 * MiB;
constexpr int CW_BAR = 4096;

constexpr int RING_BYTES = 131072, LDS_BYTES = 147456, LDSCTL_OFF = LDS_BYTES - 2048, MISC_OFF = LDSCTL_OFF + 320;

#define GAS __attribute__((address_space(1)))
#define LAS __attribute__((address_space(3)))
typedef unsigned short bf16;
typedef unsigned v4u __attribute__((ext_vector_type(4)));
typedef unsigned v2u __attribute__((ext_vector_type(2)));
typedef float f32x4 __attribute__((ext_vector_type(4)));
typedef float f32x2 __attribute__((ext_vector_type(2)));
typedef float f32x16 __attribute__((ext_vector_type(16)));
typedef short bf16x8 __attribute__((ext_vector_type(8)));
typedef short s16x4 __attribute__((ext_vector_type(4)));
typedef __bf16 bf16x2_t __attribute__((ext_vector_type(2)));
typedef GAS unsigned gu32;
#define RLX_AGENT __ATOMIC_RELAXED, __HIP_MEMORY_SCOPE_AGENT

__device__ __forceinline__ unsigned pk2(float lo, float hi) { f32x2 v = {lo, hi}; bf16x2_t b = __builtin_convertvector(v, bf16x2_t); return __builtin_bit_cast(unsigned, b); }
__device__ __forceinline__ float bflo(unsigned u) { return __uint_as_float(u << 16); }
__device__ __forceinline__ float bfhi(unsigned u) { return __uint_as_float(u & 0xffff0000u); }
__device__ __forceinline__ float bf2f(bf16 b) { return __uint_as_float((unsigned)b << 16); }
__device__ __forceinline__ float fast_exp2(float x) { return __builtin_amdgcn_exp2f(x); }
__device__ __forceinline__ float fast_rcp(float x) { return __builtin_amdgcn_rcpf(x); }
__device__ __forceinline__ float sigmoidf_(float x) { return fast_rcp(1.0f + fast_exp2(-1.4426950408889634f * x)); }
__device__ __forceinline__ float siluf_(float x) { return x * sigmoidf_(x); }
__device__ __forceinline__ float gelu_tanh(float x) { const float u = x + 0.044715f * x * x * x; return x * fast_rcp(1.0f + fast_exp2(-2.3022082f * u)); }
__device__ __forceinline__ float wave_sum(float v) {
#pragma unroll
    for (int o = 1; o < 64; o <<= 1) v += __shfl_xor(v, o);
    return v;
}

#define XB_TMO      128
#define XB_XCNT(j)  (256  + 64 * (j))
#define XB_XSUB(j)  (1280 + 64 * (j))
#define XB_XGEN(j)  (2304 + 64 * (j))
#define XB_TOP      3328
#define XB_TOPGEN   3392
#define XCD_BAR_WORDS 3456
#define XB_SPIN_CAP (1u << 18)

__device__ __forceinline__ unsigned xb_ld(unsigned* p)              { return __hip_atomic_load(p, __ATOMIC_RELAXED, __HIP_MEMORY_SCOPE_AGENT); }
__device__ __forceinline__ unsigned xb_add(unsigned* p, unsigned v) { return __hip_atomic_fetch_add(p, v, __ATOMIC_RELAXED, __HIP_MEMORY_SCOPE_AGENT); }
__device__ __forceinline__ unsigned xb_xcc_id() { return (unsigned)__builtin_amdgcn_s_getreg((3 << 11) | 20) & 0xFu; }
#define XB_SPIN(cond, bar) do { unsigned _sp = 0; while (cond) { __builtin_amdgcn_s_sleep(1); \
    if ((++_sp & 255u) == 0u) { if (xb_ld(&(bar)[XB_TMO])) break; if (_sp > XB_SPIN_CAP) { atomicAdd(&(bar)[XB_TMO], 1u); break; } } } } while (0)

struct XcdBarrier {
    unsigned* bar; unsigned x;
    volatile LAS unsigned* st;
};

__device__ __forceinline__ XcdBarrier xcd_barrier_post(unsigned* bar, volatile LAS unsigned* st) {
    XcdBarrier b; b.bar = bar; b.x = xb_xcc_id(); b.st = st;
    if (threadIdx.x == 0) (void)xb_add(&bar[XB_XCNT(b.x)], 1u);
    return b;
}
__device__ __forceinline__ void xcd_barrier_complete(unsigned* bar, unsigned x, unsigned& nloc, unsigned& nx) {
    const unsigned G = gridDim.x * gridDim.y * gridDim.z;
    unsigned sum, cnt, mine, sp = 0u;
    for (;;) {
        sum = 0u; cnt = 0u; mine = 0u;
#pragma unroll
        for (unsigned j = 0; j < 16; ++j) { const unsigned c = xb_ld(&bar[XB_XCNT(j)]); sum += c; cnt += (c > 0u) ? 1u : 0u; mine = (j == x) ? c : mine; }
        if (sum == G) break;
        __builtin_amdgcn_s_sleep(1);
        if ((++sp & 255u) == 0u) { if (xb_ld(&bar[XB_TMO])) break; if (sp > XB_SPIN_CAP) { atomicAdd(&bar[XB_TMO], 1u); break; } }
    }
    nloc = mine > 0u ? mine : 1u; nx = cnt > 0u ? cnt : 1u;
}

__device__ __forceinline__ void xcd_barrier(const XcdBarrier& b) {
    asm volatile("s_waitcnt vmcnt(0)" ::: "memory");
    __syncthreads();
    if (threadIdx.x == 0) {
        unsigned* bar = b.bar;
        __builtin_amdgcn_s_waitcnt(0);
        unsigned nloc = b.st[0], nx = b.st[1];
        if (nloc == 0u) { xcd_barrier_complete(bar, b.x, nloc, nx); b.st[0] = nloc; b.st[1] = nx; }
        const unsigned old = xb_add(&bar[XB_XSUB(b.x)], 1u);
        const unsigned gen = old / nloc;
        if (old + 1u == (gen + 1u) * nloc) {
            __builtin_amdgcn_fence(__ATOMIC_RELEASE, "agent");
            asm volatile("s_waitcnt vmcnt(0)" ::: "memory");
            const unsigned og = xb_add(&bar[XB_TOP], 1u);
            const unsigned tg = og / nx;
            if (og + 1u == (tg + 1u) * nx) xb_add(&bar[XB_TOPGEN], 1u);
            else XB_SPIN(xb_ld(&bar[XB_TOPGEN]) == tg, bar);
            __builtin_amdgcn_fence(__ATOMIC_ACQUIRE, "agent");
            xb_add(&bar[XB_XGEN(b.x)], 1u);
            asm volatile("s_waitcnt vmcnt(0)" ::: "memory");
        } else {
            XB_SPIN(xb_ld(&bar[XB_XGEN(b.x)]) == gen, bar);
            __builtin_amdgcn_fence(__ATOMIC_ACQUIRE, "agent");
            asm volatile("s_waitcnt vmcnt(0)" ::: "memory");
        }
    }
    __syncthreads();
}


namespace pg8 {
struct EpiEvIn {
    static constexpr bool PERM = true, AFTER_DRAIN = false;
    bf16* U0; bf16* Q; bf16* K; bf16* V; const float* qg; const float* kg;
    __device__ __forceinline__ void operator()(const f32x4 (&acc)[2][2][4][2], const Unit& u, int wr, int wc, int fr, int fq) const {
        const int row0 = u.pm * BM + wr * 64 + fr;
        if (u.pn < 4) {
#pragma unroll
            for (int ai = 0; ai < 2; ++ai)
#pragma unroll
                for (int m = 0; m < 4; ++m) {
                    const size_t row = (size_t)(row0 + ai * HALF + m * 16);
                    const f32x4 v0 = acc[ai][0][m][0], v1 = acc[ai][0][m][1], g0 = acc[ai][1][m][0], g1 = acc[ai][1][m][1];
                    u32x4 w;
                    w.x = pk2(v0[0] * sigmoidf_(g0[0]), v0[1] * sigmoidf_(g0[1])); w.y = pk2(v0[2] * sigmoidf_(g0[2]), v0[3] * sigmoidf_(g0[3]));
                    w.z = pk2(v1[0] * sigmoidf_(g1[0]), v1[1] * sigmoidf_(g1[1])); w.w = pk2(v1[2] * sigmoidf_(g1[2]), v1[3] * sigmoidf_(g1[3]));
                    *(u32x4*)(U0 + row * 512 + u.pn * 128 + wc * 32 + 8 * fq) = w;
                }
        } else if (u.pn < 8) {
            const int sec = (u.pn - 4) >> 1, p = (u.pn - 4) & 1, head = 4 * p + wc;
            const float* gp = sec ? kg : qg; bf16* dst = sec ? K : Q;
            const float scl = sec ? 1.0f : 0.125f * 1.4426950408889634f;
            f32x4 gv[2][2];
#pragma unroll
            for (int bj = 0; bj < 2; ++bj)
#pragma unroll
                for (int n = 0; n < 2; ++n) gv[bj][n] = *(const f32x4*)(gp + 32 * bj + 8 * fq + 4 * n) * scl;
#pragma unroll
            for (int ai = 0; ai < 2; ++ai)
#pragma unroll
                for (int m = 0; m < 4; ++m) {
                    const size_t row = (size_t)(row0 + ai * HALF + m * 16);
                    float ss = 0.f;
#pragma unroll
                    for (int bj = 0; bj < 2; ++bj)
#pragma unroll
                        for (int n = 0; n < 2; ++n) { const f32x4 x = acc[ai][bj][m][n]; ss += (x[0] * x[0] + x[1] * x[1]) + (x[2] * x[2] + x[3] * x[3]); }
                    ss += __shfl_xor(ss, 16); ss += __shfl_xor(ss, 32);
                    const float rstd = __builtin_amdgcn_rsqf(ss * (1.0f / 64.0f) + EPS);
#pragma unroll
                    for (int bj = 0; bj < 2; ++bj) {
                        const f32x4 a = acc[ai][bj][m][0] * rstd * gv[bj][0], b = acc[ai][bj][m][1] * rstd * gv[bj][1];
                        u32x4 w; w.x = pk2(a[0], a[1]); w.y = pk2(a[2], a[3]); w.z = pk2(b[0], b[1]); w.w = pk2(b[2], b[3]);
                        *(u32x4*)(dst + row * 512 + head * 64 + 32 * bj + 8 * fq) = w;
                    }
                }
        } else {
#pragma unroll
            for (int ai = 0; ai < 2; ++ai)
#pragma unroll
                for (int m = 0; m < 4; ++m) {
                    const size_t row = (size_t)(row0 + ai * HALF + m * 16);
#pragma unroll
                    for (int bj = 0; bj < 2; ++bj) {
                        const f32x4 a = acc[ai][bj][m][0], b = acc[ai][bj][m][1];
                        u32x4 w; w.x = pk2(a[0], a[1]); w.y = pk2(a[2], a[3]); w.z = pk2(b[0], b[1]); w.w = pk2(b[2], b[3]);
                        *(u32x4*)(V + row * 512 + (u.pn - 8) * 256 + bj * HALF + wc * 32 + 8 * fq) = w;
                    }
                }
        }
    }
};
struct EpiResid {
    static constexpr bool PERM = false, AFTER_DRAIN = false;
    const float* xin; float* xout; const float* gate;
    __device__ __forceinline__ void operator()(const f32x4 (&acc)[2][2][4][2], const Unit& u, int wr, int wc, int fr, int fq) const {
        const int row0 = u.pm * BM + wr * 64 + fr, col0 = u.pn * BM + wc * 32 + 4 * fq, b = u.pm >> 3;
        f32x4 gv[2][2];
#pragma unroll
        for (int bj = 0; bj < 2; ++bj)
#pragma unroll
            for (int n = 0; n < 2; ++n) gv[bj][n] = *(const f32x4*)(gate + (size_t)b * 6144 + col0 + bj * HALF + n * 16);
#pragma unroll
        for (int ai = 0; ai < 2; ++ai)
#pragma unroll
            for (int m = 0; m < 4; ++m) {
                const size_t off = (size_t)(row0 + ai * HALF + m * 16) * DM + col0;
#pragma unroll
                for (int bj = 0; bj < 2; ++bj)
#pragma unroll
                    for (int n = 0; n < 2; ++n) { const f32x4 xi = *(const f32x4*)(xin + off + bj * HALF + n * 16); *(f32x4*)(xout + off + bj * HALF + n * 16) = xi + gv[bj][n] * acc[ai][bj][m][n]; }
            }
    }
};
struct EpiOdIn {
    static constexpr bool PERM = true, AFTER_DRAIN = false;
    bf16* GY; bf16* XB;
    __device__ __forceinline__ void operator()(const f32x4 (&acc)[2][2][4][2], const Unit& u, int wr, int wc, int fr, int fq) const {
        const int row0 = u.pm * BM + wr * 64 + fr; const bool isy = u.pn < 4;
        bf16* dst = (isy ? GY : XB) + (size_t)(u.pn & 3) * 256 + wc * 32 + 8 * fq;
#pragma unroll
        for (int ai = 0; ai < 2; ++ai)
#pragma unroll
            for (int m = 0; m < 4; ++m) {
                const size_t row = (size_t)(row0 + ai * HALF + m * 16);
#pragma unroll
                for (int bj = 0; bj < 2; ++bj) {
                    f32x4 a = acc[ai][bj][m][0], b = acc[ai][bj][m][1];
                    if (isy) { a = (f32x4){gelu_tanh(a[0]), gelu_tanh(a[1]), gelu_tanh(a[2]), gelu_tanh(a[3])}; b = (f32x4){gelu_tanh(b[0]), gelu_tanh(b[1]), gelu_tanh(b[2]), gelu_tanh(b[3])}; }
                    u32x4 w; w.x = pk2(a[0], a[1]); w.y = pk2(a[2], a[3]); w.z = pk2(b[0], b[1]); w.w = pk2(b[2], b[3]);
                    *(u32x4*)(dst + row * DM + bj * HALF) = w;
                }
            }
    }
};
struct EpiMoeA {
    static constexpr bool PERM = true, AFTER_DRAIN = false;
    bf16* HID;
    __device__ __forceinline__ void operator()(const f32x4 (&acc)[2][2][4][2], const Unit& u, int wr, int wc, int fr, int fq) const {
        const int row0 = u.pm * BM + wr * 64 + fr;
#pragma unroll
        for (int ai = 0; ai < 2; ++ai)
#pragma unroll
            for (int m = 0; m < 4; ++m) {
                const size_t row = (size_t)(row0 + ai * HALF + m * 16);
                const f32x4 a0 = acc[ai][0][m][0], a1 = acc[ai][0][m][1], b0 = acc[ai][1][m][0], b1 = acc[ai][1][m][1];
                u32x4 w;
                w.x = pk2(siluf_(a0[0]) * b0[0], siluf_(a0[1]) * b0[1]); w.y = pk2(siluf_(a0[2]) * b0[2], siluf_(a0[3]) * b0[3]);
                w.z = pk2(siluf_(a1[0]) * b1[0], siluf_(a1[1]) * b1[1]); w.w = pk2(siluf_(a1[2]) * b1[2], siluf_(a1[3]) * b1[3]);
                *(u32x4*)(HID + row * DFF + u.pn * 128 + wc * 32 + 8 * fq) = w;
            }
    }
};
struct EpiMoeB {
    static constexpr bool PERM = true, AFTER_DRAIN = false;
    bf16* Y;
    __device__ __forceinline__ void operator()(const f32x4 (&acc)[2][2][4][2], const Unit& u, int wr, int wc, int fr, int fq) const {
        const int row0 = u.pm * BM + wr * 64 + fr;
#pragma unroll
        for (int ai = 0; ai < 2; ++ai)
#pragma unroll
            for (int m = 0; m < 4; ++m) {
                const size_t row = (size_t)(row0 + ai * HALF + m * 16);
#pragma unroll
                for (int bj = 0; bj < 2; ++bj) {
                    const f32x4 a = acc[ai][bj][m][0], b = acc[ai][bj][m][1];
                    u32x4 w; w.x = pk2(a[0], a[1]); w.y = pk2(a[2], a[3]); w.z = pk2(b[0], b[1]); w.w = pk2(b[2], b[3]);
                    *(u32x4*)(Y + row * DM + u.pn * 256 + bj * HALF + wc * 32 + 8 * fq) = w;
                }
            }
    }
};
struct MoeOrder {
    static constexpr bool GATHER = false, LAZY_PB = true; const int* tok;
    StaticOrder base; const int* tile_e;
    __device__ __forceinline__ bool next(int i, Unit& u) const { if (!base.next(i, u)) return false; u.pb = tile_e[u.pm]; return true; }
    __device__ __forceinline__ bool next_nopb(int i, Unit& u) const { return base.next(i, u); }
    __device__ __forceinline__ const int* pb_ptr(const Unit& u) const { return tile_e + u.pm; }
    __device__ __forceinline__ void a_ready(const Unit&) const {}
    __device__ __forceinline__ void done(const Unit&) const {}
};
struct MoeGatherOrder {
    static constexpr bool GATHER = true, LAZY_PB = true; const int* tok;
    StaticOrder base; const int* tile_e;
    __device__ __forceinline__ bool next(int i, Unit& u) const { if (!base.next(i, u)) return false; u.pb = tile_e[u.pm]; return true; }
    __device__ __forceinline__ bool next_nopb(int i, Unit& u) const { return base.next(i, u); }
    __device__ __forceinline__ const int* pb_ptr(const Unit& u) const { return tile_e + u.pm; }
    __device__ __forceinline__ void a_ready(const Unit&) const {}
    __device__ __forceinline__ void done(const Unit&) const {}
};
}

struct Frame {
    LAS unsigned char* lds;
    int tid, lane, wave, vcu, G, bx;
    unsigned char* ws;
};

template <class RowMap>
__device__ __forceinline__ void p0_transpose_item(const float* W, int K, int N, bf16* WT, LAS float* scr, int item, int lane, RowMap rm) {
    const int nblk = N / 64, kb = item / nblk, nb = item % nblk, k0 = 64 * kb, n0 = 64 * nb;
    f32x4 v[16];
#pragma unroll
    for (int i = 0; i < 16; ++i) v[i] = *(const f32x4*)(W + (size_t)(k0 + 4 * i + (lane >> 4)) * N + n0 + 4 * (lane & 15));
#pragma unroll
    for (int i = 0; i < 16; ++i) { LAS float* d = scr + (4 * i + (lane >> 4)) * 65 + 4 * (lane & 15); d[0] = v[i][0]; d[1] = v[i][1]; d[2] = v[i][2]; d[3] = v[i][3]; }
    asm volatile("s_waitcnt lgkmcnt(0)" ::: "memory");
    const int c = lane & 7;
#pragma unroll
    for (int j = 0; j < 8; ++j) { const int n = (lane >> 3) + 8 * j; const LAS float* sp = scr + (8 * c) * 65 + n;
        v4u o; o.x = pk2(sp[0 * 65], sp[1 * 65]); o.y = pk2(sp[2 * 65], sp[3 * 65]); o.z = pk2(sp[4 * 65], sp[5 * 65]); o.w = pk2(sp[6 * 65], sp[7 * 65]);
        *(GAS v4u*)(WT + (size_t)rm(n0 + n) * K + k0 + 8 * c) = o; }
    asm volatile("s_waitcnt lgkmcnt(0)" ::: "memory");
}
struct RmId { __device__ __forceinline__ int operator()(int n) const { return n; } };
struct RmEvIn { __device__ __forceinline__ int operator()(int n) const {
    if (n < 512) return 256 * (n >> 7) + (n & 127);
    if (n < 1024) { const int m = n - 512; return 256 * (m >> 7) + 128 + (m & 127); }
    if (n < 2048) { const int m = n - 1024, sec = m >> 9, mm = m & 511, p = mm >> 8, r = mm & 255, wc = r >> 6, d = r & 63, bj = d >> 5, j = d & 31;
        return 256 * (4 + 2 * sec + p) + 128 * bj + 32 * wc + j; }
    return n; } };
struct RmGlu { int half; __device__ __forceinline__ int operator()(int n) const { return 256 * (n >> 7) + 128 * half + (n & 127); } };

template <class KAT> __device__ __forceinline__ void p0_prologue(Frame& F, KAT KA) {
#define in KA->in
    LAS float* sc = (LAS float*)F.lds;
    const int w = F.bx, bg = w & 3;
    const float* c = in[1];
    for (int i = F.tid; i < 8 * 1024; i += 512) { const float v = c[(size_t)bg * 8 * 1024 + i]; sc[i] = v / (1.0f + __expf(-v)); }
    __syncthreads();
    if (F.wave < 6) {
        const int chunk = (w >> 2) * 6 + F.wave, l = chunk / 192, cc = chunk % 192, col = cc * 32 + (F.lane & 31), kh = F.lane >> 5;
        const float* W = in[2] + (size_t)l * 1024 * 6144 + col;
        float acc[8];
#pragma unroll
        for (int bb = 0; bb < 8; ++bb) acc[bb] = 0.f;
        for (int k = kh * 512; k < kh * 512 + 512; k += 16) {
            float wv[16];
#pragma unroll
            for (int q = 0; q < 16; ++q) wv[q] = W[(size_t)(k + q) * 6144];
#pragma unroll
            for (int q4 = 0; q4 < 4; ++q4)
#pragma unroll
                for (int bb = 0; bb < 8; ++bb) { const f32x4 s = *(const LAS f32x4*)(sc + bb * 1024 + k + 4 * q4); acc[bb] += (s[0] * wv[4 * q4] + s[1] * wv[4 * q4 + 1]) + (s[2] * wv[4 * q4 + 2] + s[3] * wv[4 * q4 + 3]); }
        }
        float* mod = (float*)(F.ws + WS_MOD);
#pragma unroll
        for (int bb = 0; bb < 8; ++bb) { const float t = acc[bb] + __shfl_xor(acc[bb], 32);
            if (F.lane < 32) mod[((size_t)l * 32 + bg * 8 + bb) * 6144 + col] = t + in[3][(size_t)l * 6144 + col]; }
    }
    __syncthreads();
    LAS float* scr = (LAS float*)(F.lds + F.wave * 16640);
    const int gw = F.vcu * NWAVES + F.wave, NGW = F.G * NWAVES;
    bf16* WEVIN = (bf16*)(F.ws + WS_WEVIN); bf16* WEVOUT = (bf16*)(F.ws + WS_WEVOUT); bf16* WODIN = (bf16*)(F.ws + WS_WODIN); bf16* WODOUT = (bf16*)(F.ws + WS_WODOUT);
    bf16* WRG = (bf16*)(F.ws + WS_WRG); bf16* WIG = (bf16*)(F.ws + WS_WIG); bf16* W13 = (bf16*)(F.ws + WS_W13); bf16* W2 = (bf16*)(F.ws + WS_W2);
    constexpr int I_EVIN = 16 * 40, I_SQ = 16 * 16, I_ODIN = 16 * 32, I_W1 = 16 * 8, I_W2 = 8 * 16, I_G = 2 * 2;
    constexpr int NITEMS = I_EVIN + 2 * I_SQ + I_ODIN + 32 * I_W1 * 2 + 32 * I_W2 + 16 * I_G;
    for (int it = gw; it < NITEMS; it += NGW) {
        int r = it;
        if (r < I_EVIN) { p0_transpose_item(in[6], 1024, 2560, WEVIN, scr, r, F.lane, RmEvIn{}); continue; } r -= I_EVIN;
        if (r < I_SQ) { p0_transpose_item(in[13], 1024, 1024, WEVOUT, scr, r, F.lane, RmId{}); continue; } r -= I_SQ;
        if (r < I_ODIN) { p0_transpose_item(in[14], 1024, 2048, WODIN, scr, r, F.lane, RmId{}); continue; } r -= I_ODIN;
        if (r < I_SQ) { p0_transpose_item(in[22], 1024, 1024, WODOUT, scr, r, F.lane, RmId{}); continue; } r -= I_SQ;
        if (r < 32 * I_W1) { const int mat = r / I_W1; p0_transpose_item(in[25] + (size_t)mat * 1024 * 512, 1024, 512, W13 + (size_t)mat * 1024 * 1024, scr, r % I_W1, F.lane, RmGlu{0}); continue; } r -= 32 * I_W1;
        if (r < 32 * I_W1) { const int mat = r / I_W1; p0_transpose_item(in[26] + (size_t)mat * 1024 * 512, 1024, 512, W13 + (size_t)mat * 1024 * 1024, scr, r % I_W1, F.lane, RmGlu{1}); continue; } r -= 32 * I_W1;
        if (r < 32 * I_W2) { const int mat = r / I_W2; p0_transpose_item(in[27] + (size_t)mat * 512 * 1024, 512, 1024, W2 + (size_t)mat * 1024 * 512, scr, r % I_W2, F.lane, RmId{}); continue; } r -= 32 * I_W2;
        { const int mat = r / I_G, which = mat >> 3, blk = mat & 7;
          p0_transpose_item((which ? in[19] : in[17]) + (size_t)blk * 128 * 128, 128, 128, (which ? WIG : WRG) + (size_t)blk * 128 * 128, scr, r % I_G, F.lane, RmId{}); }
    }
#undef in
}

__device__ __forceinline__ void norm_rows(Frame& F, const float* X, bf16* H, const float* ng, const float* modl, int sh_off, int sc_off) {
    const int gw = F.bx * NWAVES + F.wave;
    const int b = gw >> 6;
    f32x4 gm[4], sh[4];
#pragma unroll
    for (int j = 0; j < 4; ++j) { const int k = 256 * j + 4 * F.lane;
        const f32x4 g = *(const f32x4*)(ng + k), s = *(const f32x4*)(modl + (size_t)b * 6144 + sc_off + k);
        gm[j] = g * (s + 1.0f); sh[j] = *(const f32x4*)(modl + (size_t)b * 6144 + sh_off + k); }
    for (int r = 0; r < 32; r += 4) {
        const size_t row = (size_t)gw * 32 + r;
        f32x4 v[4][4]; float ss[4];
#pragma unroll
        for (int q = 0; q < 4; ++q)
#pragma unroll
            for (int j = 0; j < 4; ++j) v[q][j] = *(const f32x4*)(X + (row + q) * DM + 256 * j + 4 * F.lane);
#pragma unroll
        for (int q = 0; q < 4; ++q) { ss[q] = 0.f;
#pragma unroll
            for (int j = 0; j < 4; ++j) ss[q] += (v[q][j][0] * v[q][j][0] + v[q][j][1] * v[q][j][1]) + (v[q][j][2] * v[q][j][2] + v[q][j][3] * v[q][j][3]); }
#pragma unroll
        for (int q = 0; q < 4; ++q) {
            const float rstd = 1.0f / sqrtf(wave_sum(ss[q]) * (1.0f / DM) + EPS);
#pragma unroll
            for (int j = 0; j < 4; ++j) { const f32x4 o = v[q][j] * rstd * gm[j] + sh[j];
                v2u w; w.x = pk2(o[0], o[1]); w.y = pk2(o[2], o[3]); *(v2u*)(H + (row + q) * DM + 256 * j + 4 * F.lane) = w; }
        }
    }
}

namespace sba {
constexpr int SLOTB = 8192, L_K = 0, L_V = 2 * SLOTB, L_FLAG = 4 * SLOTB, L_OST = 4 * SLOTB + 256;
__device__ __forceinline__ s16x4 vtr(const LAS unsigned char* p) { typedef short v4i16_t __attribute__((ext_vector_type(4))); return __builtin_bit_cast(s16x4, __builtin_amdgcn_ds_read_tr16_b64_v4i16((LAS v4i16_t*)p)); }
__device__ __forceinline__ void unit(int b, int h, int qb, const bf16* Q, const bf16* K, const bf16* V, bf16* CAT, LAS unsigned char* lds) {
    const int tid = threadIdx.x, lane = tid & 63, r32 = lane & 31, hi = lane >> 5; const int wid = __builtin_amdgcn_readfirstlane(tid >> 6);
    const long rowbase = (long)b * SEQ; const int q0 = qb * 256;
    const bf16* Qw = Q + (rowbase + q0 + wid * 32) * SBW + h * HD;
    const bf16* Kh = K + rowbase * SBW + h * HD; const bf16* Vh = V + rowbase * SBW + h * HD;
    const bf16* ksrc = Kh + (long)lane * SBW + wid * 8;
    const bf16* vsrc = Vh + (long)(16 * (wid & 3) + (lane >> 2)) * SBW + (wid >> 2) * 32 + (lane & 3) * 8;
    LAS unsigned char* kdst = lds + L_K + wid * 1024; LAS unsigned char* vdst = lds + L_V + wid * 1024;
#define SBA_DMA(t, slot) do { __builtin_amdgcn_global_load_lds((const unsigned*)(ksrc + (long)(t) * 64 * SBW), (LAS unsigned*)(kdst + (slot) * SLOTB), 16, 0, 0); \
                              __builtin_amdgcn_global_load_lds((const unsigned*)(vsrc + (long)(t) * 64 * SBW), (LAS unsigned*)(vdst + (slot) * SLOTB), 16, 0, 0); } while (0)
    const LAS unsigned char* kp0 = lds + L_K + hi * 1024 + r32 * 16;
    const LAS unsigned char* vp0 = lds + L_V + ((lane >> 4) & 1) * 32 + (lane & 3) * 8 + (4 * hi + ((lane & 15) >> 2)) * 64;
    volatile LAS unsigned* flags = (volatile LAS unsigned*)(lds + L_FLAG);
    const int NT = (q0 + 256) / 64;
    SBA_DMA(NT - 1, 0);
    bf16x8 qr[4];
#pragma unroll
    for (int d0 = 0; d0 < 4; ++d0) qr[d0] = *(const bf16x8*)(Qw + (long)r32 * SBW + d0 * 16 + hi * 8);
    f32x16 o0 = {}, o1 = {};
    float carry = 1.0f; bool done_w = false;
    const int qrow = q0 + wid * 32 + r32, qmin = q0 + wid * 32;
    for (int it = 0, t = NT - 1; t >= 0; --t, ++it) {
        const int slot = it & 1;
        __syncthreads();
        if (it > 0) { unsigned all = 1u;
#pragma unroll
            for (int w8 = 0; w8 < 8; ++w8) all &= flags[((it - 1) & 1) * 8 + w8];
            if (all) break; }
        if (t > 0) SBA_DMA(t - 1, slot ^ 1);
        const int kbase = 64 * t;
        if (!done_w && kbase < qmin + 31) {
            const LAS unsigned char* kp = kp0 + slot * SLOTB;
            bf16x8 kf[8];
#pragma unroll
            for (int d0 = 0; d0 < 4; ++d0) { kf[2 * d0] = *(const LAS bf16x8*)(kp + d0 * 2048); kf[2 * d0 + 1] = *(const LAS bf16x8*)(kp + d0 * 2048 + 512); }
            f32x16 C0 = {}, C1 = {};
#pragma unroll
            for (int d0 = 0; d0 < 4; ++d0) { C0 = __builtin_amdgcn_mfma_f32_32x32x16_bf16(kf[2 * d0], qr[d0], C0, 0, 0, 0); C1 = __builtin_amdgcn_mfma_f32_32x32x16_bf16(kf[2 * d0 + 1], qr[d0], C1, 0, 0, 0); }
            f32x16 D0, D1;
            const bool partial = (kbase + 64 > qmin);
#pragma unroll
            for (int r = 0; r < 16; ++r) {
                const float s0 = __builtin_fminf(__builtin_fmaxf(C0[r], -120.f), 120.f), s1 = __builtin_fminf(__builtin_fmaxf(C1[r], -120.f), 120.f);
                float e0 = fast_exp2(s0), e1 = fast_exp2(s1);
                float f0 = fast_rcp(1.0f + e0), f1 = fast_rcp(1.0f + e1);
                if (partial) { const int kp_ = kbase + 4 * hi + (r & 3) + 8 * (r >> 2);
                    if (!(kp_ < qrow)) { e0 = 0.f; f0 = 1.f; }
                    if (!(kp_ + 32 < qrow)) { e1 = 0.f; f1 = 1.f; } }
                C0[r] = e0; C1[r] = e1; D0[r] = f0; D1[r] = f1;
            }
            float own[8], par[8], eg[8];
#pragma unroll
            for (int g = 0; g < 4; ++g) {
                D0[4 * g + 2] *= D0[4 * g + 3]; D0[4 * g + 1] *= D0[4 * g + 2]; D0[4 * g] *= D0[4 * g + 1]; own[g] = D0[4 * g];
                D1[4 * g + 2] *= D1[4 * g + 3]; D1[4 * g + 1] *= D1[4 * g + 2]; D1[4 * g] *= D1[4 * g + 1]; own[4 + g] = D1[4 * g];
            }
#pragma unroll
            for (int j = 0; j < 8; ++j) par[j] = __shfl_xor(own[j], 32);
            float sp = carry;
#pragma unroll
            for (int j = 7; j >= 0; --j) { eg[j] = hi ? sp : sp * par[j]; sp *= own[j] * par[j]; }
            carry = sp;
#pragma unroll
            for (int g = 0; g < 4; ++g)
#pragma unroll
                for (int i = 0; i < 4; ++i) { C0[4 * g + i] = (C0[4 * g + i] * D0[4 * g + i]) * eg[g]; C1[4 * g + i] = (C1[4 * g + i] * D1[4 * g + i]) * eg[4 + g]; }
            v4u pw0, pw1, pw2, pw3;
            pw0 = (v4u){pk2(C0[0], C0[1]), pk2(C0[2], C0[3]), pk2(C0[4], C0[5]), pk2(C0[6], C0[7])};
            pw1 = (v4u){pk2(C0[8], C0[9]), pk2(C0[10], C0[11]), pk2(C0[12], C0[13]), pk2(C0[14], C0[15])};
            pw2 = (v4u){pk2(C1[0], C1[1]), pk2(C1[2], C1[3]), pk2(C1[4], C1[5]), pk2(C1[6], C1[7])};
            pw3 = (v4u){pk2(C1[8], C1[9]), pk2(C1[10], C1[11]), pk2(C1[12], C1[13]), pk2(C1[14], C1[15])};
            const LAS unsigned char* vp = vp0 + slot * SLOTB;
#pragma unroll
            for (int d0 = 0; d0 < 2; ++d0) {
                s16x4 lo[4], hh[4];
#pragma unroll
                for (int ks = 0; ks < 4; ++ks) { lo[ks] = vtr(vp + d0 * 4096 + ks * 1024); hh[ks] = vtr(vp + d0 * 4096 + ks * 1024 + 512); }
#define SBA_VF(k) (bf16x8){lo[k][0], lo[k][1], lo[k][2], lo[k][3], hh[k][0], hh[k][1], hh[k][2], hh[k][3]}
                f32x16 oo = d0 ? o1 : o0;
                oo = __builtin_amdgcn_mfma_f32_32x32x16_bf16(__builtin_bit_cast(bf16x8, pw0), SBA_VF(0), oo, 0, 0, 0);
                oo = __builtin_amdgcn_mfma_f32_32x32x16_bf16(__builtin_bit_cast(bf16x8, pw1), SBA_VF(1), oo, 0, 0, 0);
                oo = __builtin_amdgcn_mfma_f32_32x32x16_bf16(__builtin_bit_cast(bf16x8, pw2), SBA_VF(2), oo, 0, 0, 0);
                oo = __builtin_amdgcn_mfma_f32_32x32x16_bf16(__builtin_bit_cast(bf16x8, pw3), SBA_VF(3), oo, 0, 0, 0);
                if (d0) o1 = oo; else o0 = oo;
#undef SBA_VF
            }
            done_w = __all(carry < 1e-30f);
        }
        if (lane == 0) flags[slot * 8 + wid] = done_w ? 1u : 0u;
    }
    {
        LAS bf16* stg = (LAS bf16*)(lds + L_OST) + wid * 2048;
#pragma unroll
        for (int r = 0; r < 16; ++r) { const int orow = (r & 3) + 8 * (r >> 2) + 4 * hi;
            stg[orow * 64 + r32] = (bf16)(pk2(o0[r], 0.f) & 0xffffu); stg[orow * 64 + 32 + r32] = (bf16)(pk2(o1[r], 0.f) & 0xffffu); }
        asm volatile("s_waitcnt lgkmcnt(0)" ::: "memory");
        bf16* Ow = CAT + (rowbase + q0 + wid * 32) * DM + 512 + h * HD;
#pragma unroll
        for (int i = 0; i < 4; ++i) { const int row = i * 8 + (lane >> 3), ch = lane & 7; const v4u v = *(const LAS v4u*)(stg + row * 64 + ch * 8); *(v4u*)(Ow + (long)row * DM + ch * 8) = v; }
    }
    __syncthreads();
#undef SBA_DMA
}
}

__device__ __forceinline__ void conv_prefetch(Frame& F, v4u (&pf)[8], int uidx, const bf16* U0) {
    const int b = uidx >> 6, t0 = (uidx & 63) * 32;
#pragma unroll
    for (int i = 0; i < 8; ++i) { const int idx = F.tid + 512 * i; const int ri = idx >> 6, ch = idx & 63, tok = t0 - 30 + ri;
        pf[i] = (v4u){0u, 0u, 0u, 0u};
        if (idx < 62 * 64 && tok >= 0) pf[i] = *(const v4u*)(U0 + ((size_t)b * SEQ + tok) * CONVC + ch * 8); }
}
__device__ __forceinline__ void conv_phase(Frame& F, const bf16* U0, bf16* CAT, const float* dw_w, const float* dw_b, const float* ln_g, const float* ln_b) {
    LAS unsigned char* tile = F.lds;
    LAS float* resl = (LAS float*)(F.lds + 63488);
    v4u pf[8];
    const int nunits = NB * (SEQ / 32);
    if (F.vcu < nunits) conv_prefetch(F, pf, F.vcu, U0);
    for (int uidx = F.vcu; uidx < nunits; uidx += F.G) {
        const int b = uidx >> 6, t0 = (uidx & 63) * 32;
#pragma unroll
        for (int i = 0; i < 8; ++i) { const int idx = F.tid + 512 * i; if (idx < 62 * 64) *(LAS v4u*)(tile + idx * 16) = pf[i]; }
        __syncthreads();
        if (uidx + F.G < nunits) conv_prefetch(F, pf, uidx + F.G, U0);
        {
            const int cp = F.tid & 255, th = F.tid >> 8;
            float w0[31], w1[31];
#pragma unroll
            for (int k = 0; k < 31; ++k) { const f32x2 wv = *(const f32x2*)(dw_w + k * CONVC + 2 * cp); w0[k] = wv[0]; w1[k] = wv[1]; }
            const f32x2 bias = *(const f32x2*)(dw_b + 2 * cp);
#pragma unroll 1
            for (int og = 0; og < 2; ++og) {
                float a0[8], a1[8];
#pragma unroll
                for (int o = 0; o < 8; ++o) { a0[o] = bias[0]; a1[o] = bias[1]; }
                const LAS unsigned char* tp = tile + (16 * th + 8 * og) * 1024 + cp * 4;
#pragma unroll
                for (int j = 0; j < 38; ++j) {
                    const unsigned xin = *(const LAS unsigned*)(tp + j * 1024);
                    const float x0 = bflo(xin), x1 = bfhi(xin);
#pragma unroll
                    for (int o = 0; o < 8; ++o) { const int k = j - o; if (k >= 0 && k <= 30) { a0[o] += w0[k] * x0; a1[o] += w1[k] * x1; } }
                }
#pragma unroll
                for (int o = 0; o < 8; ++o) *(LAS f32x2*)(resl + (16 * th + 8 * og + o) * 512 + 2 * cp) = (f32x2){a0[o], a1[o]};
            }
        }
        __syncthreads();
        {
            const f32x4 lg0 = *(const f32x4*)(ln_g + 8 * F.lane), lg1 = *(const f32x4*)(ln_g + 8 * F.lane + 4), lb0 = *(const f32x4*)(ln_b + 8 * F.lane), lb1 = *(const f32x4*)(ln_b + 8 * F.lane + 4);
#pragma unroll
            for (int i = 0; i < 4; ++i) {
                const int tk = F.wave * 4 + i;
                const f32x4 v0 = *(const LAS f32x4*)(resl + tk * 512 + 8 * F.lane), v1 = *(const LAS f32x4*)(resl + tk * 512 + 8 * F.lane + 4);
                const float sm = wave_sum((v0[0] + v0[1]) + (v0[2] + v0[3]) + (v1[0] + v1[1]) + (v1[2] + v1[3]));
                const float mean = sm * (1.0f / CONVC);
                const f32x4 d0 = v0 - mean, d1 = v1 - mean;
                const float q = wave_sum((d0[0] * d0[0] + d0[1] * d0[1]) + (d0[2] * d0[2] + d0[3] * d0[3]) + (d1[0] * d1[0] + d1[1] * d1[1]) + (d1[2] * d1[2] + d1[3] * d1[3]));
                const float rstd = 1.0f / sqrtf(q * (1.0f / CONVC) + EPS);
                const f32x4 y0 = d0 * rstd * lg0 + lb0, y1 = d1 * rstd * lg1 + lb1;
                v4u pw; pw.x = pk2(siluf_(y0[0]), siluf_(y0[1])); pw.y = pk2(siluf_(y0[2]), siluf_(y0[3])); pw.z = pk2(siluf_(y1[0]), siluf_(y1[1])); pw.w = pk2(siluf_(y1[2]), siluf_(y1[3]));
                *(v4u*)(CAT + ((size_t)b * SEQ + t0 + tk) * DM + 8 * F.lane) = pw;
            }
        }
        __syncthreads();
    }
}

__device__ __forceinline__ void lru_unit(Frame& F, int b, int cb, const bf16* GY, const bf16* XB, bf16* CAT2, const bf16* WRG, const bf16* WIG,
                                         const float* conv_w, const float* conv_b, const float* rg_b, const float* ig_b, const float* lam) {
    constexpr int L_XR = 0, L_XC = 17408, L_GY = 34816, L_OUT = 51200;
    LAS unsigned char* lds = F.lds;
    const int lane = F.lane, wv = F.wave, l15 = lane & 15, g4 = lane >> 4;
    const int cl_ = 16 * wv + l15, cglob = cb * 128 + cl_;
    bf16x8 brg[4], big[4];
#pragma unroll
    for (int ks = 0; ks < 4; ++ks) { brg[ks] = *(const bf16x8*)(WRG + ((size_t)cb * 128 + cl_) * 128 + 32 * ks + 8 * g4); big[ks] = *(const bf16x8*)(WIG + ((size_t)cb * 128 + cl_) * 128 + 32 * ks + 8 * g4); }
    const float rb = rg_b[cglob], ib = ig_b[cglob];
    const float lamv = lam[cglob];
    const float cl2 = -8.0f * log1pf(expf(-lamv)) * 1.4426950408889634f;
    const int cp2 = F.tid & 63;
    float cw0[4], cw1[4];
#pragma unroll
    for (int k = 0; k < 4; ++k) { const f32x2 w = *(const f32x2*)(conv_w + k * DM + cb * 128 + 2 * cp2); cw0[k] = w[0]; cw1[k] = w[1]; }
    const f32x2 cbias = *(const f32x2*)(conv_b + cb * 128 + 2 * cp2);
    const size_t rowb = (size_t)b * SEQ;
    v4u px[3], pg[2];
#define LRU_PREFETCH(t0_) do { \
        _Pragma("unroll") for (int i = 0; i < 3; ++i) { const int idx = F.tid + 512 * i; px[i] = (v4u){0u, 0u, 0u, 0u}; \
            if (idx < 67 * 16) { const int ri = idx >> 4, chn = idx & 15, tok = (t0_) - 3 + ri; if (tok >= 0) px[i] = *(const v4u*)(XB + (rowb + tok) * DM + cb * 128 + chn * 8); } } \
        _Pragma("unroll") for (int i = 0; i < 2; ++i) { const int idx = F.tid + 512 * i; const int ri = idx >> 4, chn = idx & 15; pg[i] = *(const v4u*)(GY + (rowb + (t0_) + ri) * DM + cb * 128 + chn * 8); } } while (0)
    LRU_PREFETCH(0);
    float carry = 0.f;
    for (int it = 0; it < SEQ / 64; ++it) {
        const int t0 = it * 64;
#pragma unroll
        for (int i = 0; i < 3; ++i) { const int idx = F.tid + 512 * i; if (idx < 67 * 16) *(LAS v4u*)(lds + L_XR + idx * 16) = px[i]; }
#pragma unroll
        for (int i = 0; i < 2; ++i) { const int idx = F.tid + 512 * i; *(LAS v4u*)(lds + L_GY + idx * 16) = pg[i]; }
        __syncthreads();
        if (it + 1 < SEQ / 64) LRU_PREFETCH(t0 + 64);
        {
            float x0[11], x1[11];
#pragma unroll
            for (int j = 0; j < 11; ++j) { const unsigned xin = *(const LAS unsigned*)(lds + L_XR + (8 * wv + j) * 256 + cp2 * 4); x0[j] = bflo(xin); x1[j] = bfhi(xin); }
#pragma unroll
            for (int o = 0; o < 8; ++o) {
                const float y0 = cbias[0] + (cw0[0] * x0[o] + cw0[1] * x0[o + 1]) + (cw0[2] * x0[o + 2] + cw0[3] * x0[o + 3]);
                const float y1 = cbias[1] + (cw1[0] * x1[o] + cw1[1] * x1[o + 1]) + (cw1[2] * x1[o + 2] + cw1[3] * x1[o + 3]);
                *(LAS unsigned*)(lds + L_XC + (8 * wv + o) * 272 + cp2 * 4) = pk2(y0, y1);
            }
        }
        __syncthreads();
        float av[4][4], bv[4][4], gy[4][4], Ae[4], Be[4], At[4], Bt[4];
#pragma unroll
        for (int m = 0; m < 4; ++m) {
            f32x4 aR = {0.f, 0.f, 0.f, 0.f}, aI = {0.f, 0.f, 0.f, 0.f};
#pragma unroll
            for (int ks = 0; ks < 4; ++ks) { const bf16x8 af = *(const LAS bf16x8*)(lds + L_XC + (16 * m + l15) * 272 + (32 * ks + 8 * g4) * 2);
                aR = __builtin_amdgcn_mfma_f32_16x16x32_bf16(af, brg[ks], aR, 0, 0, 0); aI = __builtin_amdgcn_mfma_f32_16x16x32_bf16(af, big[ks], aI, 0, 0, 0); }
            float A = 1.f, B = 0.f;
#pragma unroll
            for (int r = 0; r < 4; ++r) {
                const int tk = 16 * m + 4 * g4 + r;
                const float xcv = bf2f(*(const LAS bf16*)(lds + L_XC + tk * 272 + cl_ * 2));
                gy[m][r] = bf2f(*(const LAS bf16*)(lds + L_GY + tk * 256 + cl_ * 2));
                const float rr = sigmoidf_(aR[r] + rb), ii = sigmoidf_(aI[r] + ib);
                const float a = fast_exp2(cl2 * rr);
                const float mult = sqrtf(__builtin_fmaxf(1.0f - a * a, 0.f));
                av[m][r] = a; bv[m][r] = mult * ii * xcv;
                B = a * B + bv[m][r]; A = A * a;
            }
            { const float Ap = __shfl_up(A, 16), Bp = __shfl_up(B, 16); if (g4 >= 1) { B = A * Bp + B; A = A * Ap; } }
            { const float Ap = __shfl_up(A, 32), Bp = __shfl_up(B, 32); if (g4 >= 2) { B = A * Bp + B; A = A * Ap; } }
            { const float Ap = __shfl_up(A, 16), Bp = __shfl_up(B, 16); Ae[m] = (g4 == 0) ? 1.f : Ap; Be[m] = (g4 == 0) ? 0.f : Bp; }
            At[m] = __shfl(A, 48 + l15); Bt[m] = __shfl(B, 48 + l15);
        }
#pragma unroll
        for (int m = 0; m < 4; ++m) {
            float hcur = Ae[m] * carry + Be[m];
            carry = At[m] * carry + Bt[m];
#pragma unroll
            for (int r = 0; r < 4; ++r) { hcur = av[m][r] * hcur + bv[m][r]; const int tk = 16 * m + 4 * g4 + r;
                *(LAS bf16*)(lds + L_OUT + tk * 256 + cl_ * 2) = (bf16)(pk2(gy[m][r] * hcur, 0.f) & 0xffffu); }
        }
        __syncthreads();
#pragma unroll
        for (int i = 0; i < 2; ++i) { const int idx = F.tid + 512 * i; const int ri = idx >> 4, chn = idx & 15;
            *(v4u*)(CAT2 + (rowb + t0 + ri) * DM + cb * 128 + chn * 8) = *(const LAS v4u*)(lds + L_OUT + idx * 16); }
    }
    __syncthreads();
#undef LRU_PREFETCH
}

__device__ __forceinline__ void router_phase(Frame& F, const float* X, bf16* H, const float* ng, const float* modl, const float* rw, const float* rbias) {
    constexpr int WSTR = 2064;
    LAS unsigned char* whi = F.lds;
    LAS unsigned char* wlo = F.lds + 16 * WSTR;
    LAS float* gml = (LAS float*)(F.lds + 67584);
    LAS float* shl = (LAS float*)(F.lds + 71680);
    LAS float* brl = (LAS float*)(F.lds + 75776);
    LAS int* cnt = (LAS int*)(F.lds + 75776 + 64);
    LAS float* pbr = (LAS float*)(F.lds + 75776 + 128);
    LAS float* exl = (LAS float*)(F.lds + 77824);
    LAS float* exs = (LAS float*)(F.lds + 77824 + 16384);
    const int w = F.bx, b = w >> 3;
    for (int i = F.tid; i < 16 * 1024; i += 512) { const int k = i >> 4, e = i & 15; const float v = rw[i]; const unsigned hb = pk2(v, 0.f) & 0xffffu; const float lo = v - bflo(hb);
        *(LAS bf16*)(whi + e * WSTR + k * 2) = (bf16)hb; *(LAS bf16*)(wlo + e * WSTR + k * 2) = (bf16)(pk2(lo, 0.f) & 0xffffu); }
    for (int k = F.tid; k < 1024; k += 512) { gml[k] = ng[k] * (1.0f + modl[(size_t)b * 6144 + 4 * 1024 + k]); shl[k] = modl[(size_t)b * 6144 + 3 * 1024 + k]; }
    if (F.tid < 16) cnt[F.tid] = 0;
    __syncthreads();
    {
        float acc[16];
#pragma unroll
        for (int e = 0; e < 16; ++e) acc[e] = 0.f;
#pragma unroll
        for (int i = 0; i < 2; ++i) { const int k = 128 * F.wave + 64 * i + F.lane; const float sv = shl[k];
#pragma unroll
            for (int q = 0; q < 4; ++q) { const f32x4 wv = *(const f32x4*)(rw + k * 16 + 4 * q); acc[4 * q] += sv * wv[0]; acc[4 * q + 1] += sv * wv[1]; acc[4 * q + 2] += sv * wv[2]; acc[4 * q + 3] += sv * wv[3]; } }
#pragma unroll
        for (int e = 0; e < 16; ++e) { const float t = wave_sum(acc[e]); if (F.lane == 0) pbr[F.wave * 16 + e] = t; }
    }
    __syncthreads();
    if (F.tid < 16) { float t = 0.f;
#pragma unroll
        for (int q = 0; q < 8; ++q) t += pbr[q * 16 + F.tid]; brl[F.tid] = t; }
    __syncthreads();
    const int r16 = F.lane & 15, kq = F.lane >> 4, g = F.wave >> 2, kp = F.wave & 3;
    int* EID = (int*)(F.ws + META_EID); float* GATE = (float*)(F.ws + META_GATE);
    f32x4 xn[8][2];
    { const size_t row0 = (size_t)w * 256 + 16 * g + r16;
#pragma unroll
      for (int cc = 0; cc < 8; ++cc) { const int col = 256 * kp + 32 * cc + 8 * kq; xn[cc][0] = *(const f32x4*)(X + row0 * DM + col); xn[cc][1] = *(const f32x4*)(X + row0 * DM + col + 4); } }
    for (int pass = 0; pass < 8; ++pass) {
        const int buf = pass & 1;
        const size_t row = (size_t)w * 256 + 32 * pass + 16 * g + r16;
        f32x4 xg[8][2]; float ss = 0.f; f32x4 acc = {0.f, 0.f, 0.f, 0.f};
#pragma unroll
        for (int cc = 0; cc < 8; ++cc) {
            const int col = 256 * kp + 32 * cc + 8 * kq;
            const f32x4 x0 = xn[cc][0], x1 = xn[cc][1];
            ss += (x0[0] * x0[0] + x0[1] * x0[1]) + (x0[2] * x0[2] + x0[3] * x0[3]) + (x1[0] * x1[0] + x1[1] * x1[1]) + (x1[2] * x1[2] + x1[3] * x1[3]);
            const f32x4 a0 = x0 * *(const LAS f32x4*)(gml + col), a1 = x1 * *(const LAS f32x4*)(gml + col + 4);
            xg[cc][0] = a0; xg[cc][1] = a1;
            v4u hi; hi.x = pk2(a0[0], a0[1]); hi.y = pk2(a0[2], a0[3]); hi.z = pk2(a1[0], a1[1]); hi.w = pk2(a1[2], a1[3]);
            v4u lo; lo.x = pk2(a0[0] - bflo(hi.x), a0[1] - bfhi(hi.x)); lo.y = pk2(a0[2] - bflo(hi.y), a0[3] - bfhi(hi.y)); lo.z = pk2(a1[0] - bflo(hi.z), a1[1] - bfhi(hi.z)); lo.w = pk2(a1[2] - bflo(hi.w), a1[3] - bfhi(hi.w));
            const bf16x8 bh = *(const LAS bf16x8*)(whi + r16 * WSTR + col * 2), bl = *(const LAS bf16x8*)(wlo + r16 * WSTR + col * 2);
            acc = __builtin_amdgcn_mfma_f32_16x16x32_bf16(__builtin_bit_cast(bf16x8, hi), bh, acc, 0, 0, 0);
            acc = __builtin_amdgcn_mfma_f32_16x16x32_bf16(__builtin_bit_cast(bf16x8, lo), bh, acc, 0, 0, 0);
            acc = __builtin_amdgcn_mfma_f32_16x16x32_bf16(__builtin_bit_cast(bf16x8, hi), bl, acc, 0, 0, 0);
        }
        {
            const size_t rown = pass < 7 ? row + 32 : row;
#pragma unroll
            for (int cc = 0; cc < 8; ++cc) { const int col = 256 * kp + 32 * cc + 8 * kq; xn[cc][0] = *(const f32x4*)(X + rown * DM + col); xn[cc][1] = *(const f32x4*)(X + rown * DM + col + 4); }
        }
        ss += __shfl_xor(ss, 16); ss += __shfl_xor(ss, 32);
        { LAS float* ep = exl + (((buf * 2 + g) * 4 + kp) * 16) * 16;
#pragma unroll
          for (int rg = 0; rg < 4; ++rg) ep[(4 * kq + rg) * 16 + r16] = acc[rg];
          if (kq == 0) exs[((buf * 2 + g) * 4 + kp) * 16 + r16] = ss; }
        __syncthreads();
        float sst = 0.f;
#pragma unroll
        for (int q = 0; q < 4; ++q) sst += exs[((buf * 2 + g) * 4 + q) * 16 + r16];
        const float rstd = 1.0f / sqrtf(sst * (1.0f / DM) + EPS);
#pragma unroll
        for (int cc = 0; cc < 8; ++cc) { const int col = 256 * kp + 32 * cc + 8 * kq;
            const f32x4 o0 = xg[cc][0] * rstd + *(const LAS f32x4*)(shl + col), o1 = xg[cc][1] * rstd + *(const LAS f32x4*)(shl + col + 4);
            v4u pw; pw.x = pk2(o0[0], o0[1]); pw.y = pk2(o0[2], o0[3]); pw.z = pk2(o1[0], o1[1]); pw.w = pk2(o1[2], o1[3]);
            *(v4u*)(H + row * DM + col) = pw; }
        if (kp == 0 && kq == 0) {
            float sc[16], bi[16];
#pragma unroll
            for (int e4 = 0; e4 < 4; ++e4) { f32x4 t = {0.f, 0.f, 0.f, 0.f};
#pragma unroll
                for (int q = 0; q < 4; ++q) t += *(const LAS f32x4*)(exl + ((((buf * 2 + g) * 4 + q) * 16) + r16) * 16 + 4 * e4);
#pragma unroll
                for (int i = 0; i < 4; ++i) { const int e = 4 * e4 + i; const float lg = t[i] * rstd + brl[e]; sc[e] = 1.0f / (1.0f + __expf(-lg)); bi[e] = sc[e] + rbias[e]; } }
            int gbest = 0; float gsb = -1e30f;
#pragma unroll
            for (int gg = 0; gg < 4; ++gg) {
                float m1 = bi[4 * gg], m2 = -1e30f;
#pragma unroll
                for (int i = 1; i < 4; ++i) { const float v = bi[4 * gg + i]; if (v > m1) { m2 = m1; m1 = v; } else if (v > m2) m2 = v; }
                const float gs = m1 + m2; if (gs > gsb) { gsb = gs; gbest = gg; }
            }
            float v4[4], s4[4];
#pragma unroll
            for (int i = 0; i < 4; ++i) { v4[i] = gbest == 0 ? bi[i] : gbest == 1 ? bi[4 + i] : gbest == 2 ? bi[8 + i] : bi[12 + i]; s4[i] = gbest == 0 ? sc[i] : gbest == 1 ? sc[4 + i] : gbest == 2 ? sc[8 + i] : sc[12 + i]; }
            int i1 = 0;
#pragma unroll
            for (int i = 1; i < 4; ++i) if (v4[i] > v4[i1]) i1 = i;
            int i2 = (i1 == 0) ? 1 : 0;
#pragma unroll
            for (int i = 0; i < 4; ++i) if (i != i1 && i != i2 && v4[i] > v4[i2]) i2 = i;
            const float se1 = i1 == 0 ? s4[0] : i1 == 1 ? s4[1] : i1 == 2 ? s4[2] : s4[3], se2 = i2 == 0 ? s4[0] : i2 == 1 ? s4[1] : i2 == 2 ? s4[2] : s4[3];
            const int e1 = 4 * gbest + i1, e2 = 4 * gbest + i2; const float inv = 1.0f / (se1 + se2);
            EID[row * 2] = e1; EID[row * 2 + 1] = e2; GATE[row * 2] = se1 * inv; GATE[row * 2 + 1] = se2 * inv;
            atomicAdd((int*)&cnt[e1], 1); atomicAdd((int*)&cnt[e2], 1);
        }
    }
    __syncthreads();
    if (F.tid < 16) ((int*)(F.ws + META_BCNT))[w * 16 + F.tid] = cnt[F.tid];
    __syncthreads();
}

__device__ __forceinline__ void slot_phase(Frame& F) {
    LAS int* cn = (LAS int*)F.lds;
    LAS int* mybase = (LAS int*)(F.lds + 16384);
    LAS int* tot = (LAS int*)(F.lds + 16384 + 64);
    LAS int* cursor = (LAS int*)(F.lds + 16384 + 128);
    LAS int* pstart = (LAS int*)(F.lds + 16384 + 192);
    const int w = F.bx;
    const int* BC = (const int*)(F.ws + META_BCNT);
    int* TOK = (int*)(F.ws + META_TOK);
    for (int i = F.tid; i < 4096; i += 512) cn[i] = BC[i];
    __syncthreads();
    if (F.tid < 16) { int run = 0, mb = 0; for (int j = 0; j < 256; ++j) { if (j == w) mb = run; run += cn[j * 16 + F.tid]; } mybase[F.tid] = mb; tot[F.tid] = run; }
    __syncthreads();
    if (F.tid == 0) {
        int ps = 0; int* TE = (int*)(F.ws + META_TILEE);
        for (int e = 0; e < 16; ++e) { const int padded = (tot[e] + 255) & ~255; cursor[e] = ps + mybase[e]; pstart[e] = ps;
            if (w == 0) for (int tl = ps >> 8; tl < (ps + padded) >> 8; ++tl) TE[tl] = e;
            ps += padded; }
        if (w == 0) *(int*)(F.ws + META_NT) = ps >> 8;
    }
    __syncthreads();
    if (w < 16) { const int s0 = pstart[w] + tot[w], s1 = pstart[w] + ((tot[w] + 255) & ~255); for (int sidx = s0 + F.tid; sidx < s1; sidx += 512) TOK[sidx] = 0; }
    const int* EID = (const int*)(F.ws + META_EID); int* SLOT = (int*)(F.ws + META_SLOT);
    if (F.lane < 32) {
        const size_t t = (size_t)w * 256 + F.wave * 32 + F.lane;
        const v2u ev = *(const v2u*)(EID + t * 2); const int ms0 = atomicAdd((int*)&cursor[ev.x], 1), ms1 = atomicAdd((int*)&cursor[ev.y], 1);
        v2u sv; sv.x = (unsigned)ms0; sv.y = (unsigned)ms1; *(v2u*)(SLOT + t * 2) = sv; TOK[ms0] = (int)t; TOK[ms1] = (int)t;
    }
    __syncthreads();
}

template <bool NEXT>
__device__ __forceinline__ void combine_phase(Frame& F, const float* X, float* XO, const bf16* Y, const float* modl  , bf16* H, const float* ng_next, const float* modn  ) {
    const int gw = F.bx * NWAVES + F.wave, b = gw >> 6;
    const int* SLOT = (const int*)(F.ws + META_SLOT); const float* GATE = (const float*)(F.ws + META_GATE);
    f32x4 g2[4], gm[4], sh[4];
#pragma unroll
    for (int j = 0; j < 4; ++j) { const int k = 256 * j + 4 * F.lane; g2[j] = *(const f32x4*)(modl + (size_t)b * 6144 + 5 * 1024 + k);
        if (NEXT) { const f32x4 g = *(const f32x4*)(ng_next + k), s = *(const f32x4*)(modn + (size_t)b * 6144 + 1 * 1024 + k); gm[j] = g * (s + 1.0f); sh[j] = *(const f32x4*)(modn + (size_t)b * 6144 + k); } }
    const size_t rbase = (size_t)gw * 32;
    int ms0 = 0, ms1 = 0; float mg0 = 0.f, mg1 = 0.f;
    if (F.lane < 32) { const v2u sv = *(const v2u*)(SLOT + (rbase + F.lane) * 2); const f32x2 gv = *(const f32x2*)(GATE + (rbase + F.lane) * 2); ms0 = (int)sv.x; ms1 = (int)sv.y; mg0 = gv[0]; mg1 = gv[1]; }
    for (int r0 = 0; r0 < 32; r0 += 4) {
        f32x4 x[4][4]; v2u ya[4][4], yb[4][4]; float ga[4], gb[4];
#pragma unroll
        for (int q = 0; q < 4; ++q) {
            const int s0 = __builtin_amdgcn_readlane(ms0, r0 + q), s1 = __builtin_amdgcn_readlane(ms1, r0 + q);
            ga[q] = __builtin_bit_cast(float, __builtin_amdgcn_readlane(__builtin_bit_cast(int, mg0), r0 + q)); gb[q] = __builtin_bit_cast(float, __builtin_amdgcn_readlane(__builtin_bit_cast(int, mg1), r0 + q));
#pragma unroll
            for (int j = 0; j < 4; ++j) { const int k = 256 * j + 4 * F.lane;
                x[q][j] = *(const f32x4*)(X + (rbase + r0 + q) * DM + k); ya[q][j] = *(const v2u*)(Y + (size_t)s0 * DM + k); yb[q][j] = *(const v2u*)(Y + (size_t)s1 * DM + k); }
        }
        asm volatile("" ::: "memory");
#pragma unroll
        for (int q = 0; q < 4; ++q) {
            const size_t row = rbase + r0 + q; float ss = 0.f; f32x4 v[4];
#pragma unroll
            for (int j = 0; j < 4; ++j) { const int k = 256 * j + 4 * F.lane;
                f32x4 f; f[0] = ga[q] * bflo(ya[q][j].x) + gb[q] * bflo(yb[q][j].x); f[1] = ga[q] * bfhi(ya[q][j].x) + gb[q] * bfhi(yb[q][j].x); f[2] = ga[q] * bflo(ya[q][j].y) + gb[q] * bflo(yb[q][j].y); f[3] = ga[q] * bfhi(ya[q][j].y) + gb[q] * bfhi(yb[q][j].y);
                v[j] = x[q][j] + g2[j] * f;
                *(f32x4*)(XO + row * DM + k) = v[j];
                ss += (v[j][0] * v[j][0] + v[j][1] * v[j][1]) + (v[j][2] * v[j][2] + v[j][3] * v[j][3]); }
            if (NEXT) {
                const float rstd = 1.0f / sqrtf(wave_sum(ss) * (1.0f / DM) + EPS);
#pragma unroll
                for (int j = 0; j < 4; ++j) { const f32x4 o = v[j] * rstd * gm[j] + sh[j]; v2u pw; pw.x = pk2(o[0], o[1]); pw.y = pk2(o[2], o[3]); *(v2u*)(H + row * DM + 256 * j + 4 * F.lane) = pw; }
            }
        }
    }
}

constexpr int NPHASE = 18;
struct Args { const float* in[28]; float* out; unsigned char* ws; int ph_lo, ph_hi; };
template <int PLO, int PHI> __global__ void __launch_bounds__(NWAVES * 64, 2) mk_fwd(Args args) {
    extern __shared__ __attribute__((aligned(16))) unsigned char lds_raw[];
    Frame F;
    F.lds = (LAS unsigned char*)lds_raw;
    F.tid = threadIdx.x; F.lane = F.tid & 63; F.wave = __builtin_amdgcn_readfirstlane(F.tid >> 6);
    F.G = gridDim.x; F.bx = blockIdx.x; F.vcu = (F.G % 8 == 0) ? (F.bx % 8) * (F.G / 8) + F.bx / 8 : F.bx;
    F.ws = args.ws;
    volatile LAS unsigned* MISC = (volatile LAS unsigned*)(F.lds + MISC_OFF);
    for (int u = F.tid; u < (LDS_BYTES - LDSCTL_OFF) / 4; u += NWAVES * 64) ((LAS unsigned*)(F.lds + LDSCTL_OFF))[u] = 0u;
    __syncthreads();
#if MK_ONE_LAUNCH
    XcdBarrier bar = xcd_barrier_post((unsigned*)(F.ws + WS_CTL) + CW_BAR, MISC + 8);
#define GRID_BAR() do { XcdBarrier b_ = bar; asm volatile("" : "+s"(b_.bar), "+s"(b_.x)); xcd_barrier(b_); } while (0)
#else
#define GRID_BAR() do {} while (0)
#endif
    constexpr int lo = PLO, hi = PHI;
#ifndef PHASE_MASK
#define PHASE_MASK 0x3ffff
#endif
#define IN(k) ((((PHASE_MASK) >> (k)) & 1) && lo <= (k) && (k) < hi)
#ifndef PROBE_REP
#define PROBE_REP 0
#endif
#define REPN(k) (((PROBE_REP) >> (k)) & 1)
#define SEAM(k) do { if (IN(k) && IN((k) + 1)) GRID_BAR(); } while (0)
    typedef const __attribute__((address_space(4))) Args* KArgs; KArgs KA = (KArgs)__builtin_amdgcn_kernarg_segment_ptr();
#define in KA->in
#define PHASE_ENTER() do { KA = (KArgs)__builtin_amdgcn_kernarg_segment_ptr(); asm volatile("" : "+s"(KA)); F.ws = KA->ws; int tid_o = threadIdx.x; asm volatile("" : "+v"(tid_o)); F.tid = tid_o; F.lane = tid_o & 63; F.wave = __builtin_amdgcn_readfirstlane(tid_o >> 6); } while (0)
#define P_MOD ((float*)(F.ws + WS_MOD))
#define P_HA ((bf16*)(F.ws + WS_HA))
#define P_U0 ((bf16*)(F.ws + WS_R1))
#define P_Q (P_U0 + (size_t)T * 512)
#define P_K (P_U0 + (size_t)2 * T * 512)
#define P_V (P_U0 + (size_t)3 * T * 512)
#define P_GY ((bf16*)(F.ws + WS_R1))
#define P_XB (P_GY + (size_t)T * DM)
#define P_XS ((bf16*)(F.ws + WS_R1))
#define P_Y P_XS
#define P_CAT ((bf16*)(F.ws + WS_R2))
#define P_HID P_CAT

    if (IN(0)) for (int rep_ = 0; rep_ <= REPN(0); ++rep_) { PHASE_ENTER(); p0_prologue(F, KA); } SEAM(0);
    if (IN(1)) for (int rep_ = 0; rep_ <= REPN(1); ++rep_) { PHASE_ENTER(); norm_rows(F, in[0], P_HA, in[4], P_MOD, 0, 1024); } SEAM(1);
    if (IN(2)) for (int rep_ = 0; rep_ <= REPN(2); ++rep_) { PHASE_ENTER();
        pg8::Gemm g{P_HA, (const bf16*)(F.ws + WS_WEVIN), T, EVIN, DM, 0}; pg8::StaticOrder S; S.init(T, EVIN, F.G, F.bx);
        pg8::EpiEvIn E{P_U0, P_Q, P_K, P_V, in[11], in[12]};
        pg8::gemm_phase<pg8::EpiEvIn, pg8::StaticOrder, true, true>(F.lds, g, S, E);
    } SEAM(2);
    if (IN(3)) for (int rep_ = 0; rep_ <= REPN(3); ++rep_) { PHASE_ENTER();
#ifndef NO_ATTN
        for (int ra_ = 0; ra_ <= REPN(18); ++ra_) { const int bh = F.vcu; for (int qb = 7; qb >= 0; --qb) sba::unit(bh >> 3, bh & 7, qb, P_Q, P_K, P_V, P_CAT, F.lds); }
#endif
#ifndef NO_CONV
        for (int rc_ = 0; rc_ <= REPN(19); ++rc_) conv_phase(F, P_U0, P_CAT, in[7], in[8], in[9], in[10]);
#endif
    } SEAM(3);
    if (IN(4)) for (int rep_ = 0; rep_ <= REPN(4); ++rep_) { PHASE_ENTER();
        pg8::Gemm g{P_CAT, (const bf16*)(F.ws + WS_WEVOUT), T, DM, DM, 0}; pg8::StaticOrder S; S.init(T, DM, F.G, F.bx);
        pg8::EpiResid E{in[0], KA->out, P_MOD + 2 * 1024};
        pg8::gemm_phase<pg8::EpiResid, pg8::StaticOrder, true, true>(F.lds, g, S, E);
    } SEAM(4);
#define MOE_PHASES(layer, p0) \
    if (IN(p0)) for (int rep_ = 0; rep_ <= REPN(p0); ++rep_) { PHASE_ENTER(); router_phase(F, KA->out, P_HA, in[5] + (layer) * DM, P_MOD + (size_t)(layer) * 32 * 6144, in[23], in[24]); } SEAM(p0); \
    if (IN((p0) + 1)) for (int rep_ = 0; rep_ <= REPN((p0) + 1); ++rep_) { PHASE_ENTER(); slot_phase(F); } SEAM((p0) + 1); \
    if (IN((p0) + 2)) for (int rep_ = 0; rep_ <= REPN((p0) + 2); ++rep_) { PHASE_ENTER(); \
        const int ntl = *(const int*)(F.ws + META_NT); \
        pg8::Gemm g{P_HA, (const bf16*)(F.ws + WS_W13) + (size_t)(layer) * 16 * 1024 * 1024, ntl * 256, 1024, DM, (size_t)1024 * 1024 * 2}; \
        pg8::MoeGatherOrder S; S.base.init(ntl * 256, 1024, F.G, F.bx); S.tile_e = (const int*)(F.ws + META_TILEE); S.tok = (const int*)(F.ws + META_TOK); \
        pg8::EpiMoeA E{P_HID}; \
        pg8::gemm_phase<pg8::EpiMoeA, pg8::MoeGatherOrder, true, true>(F.lds, g, S, E); \
    } SEAM((p0) + 2); \
    if (IN((p0) + 3)) for (int rep_ = 0; rep_ <= REPN((p0) + 3); ++rep_) { PHASE_ENTER(); \
        const int ntl = *(const int*)(F.ws + META_NT); \
        pg8::Gemm g{P_HID, (const bf16*)(F.ws + WS_W2) + (size_t)(layer) * 16 * 1024 * 512, ntl * 256, 1024, DFF, (size_t)1024 * 512 * 2}; \
        pg8::MoeOrder S; S.base.init(ntl * 256, 1024, F.G, F.bx); S.tile_e = (const int*)(F.ws + META_TILEE); \
        pg8::EpiMoeB E{P_Y}; \
        pg8::gemm_phase<pg8::EpiMoeB, pg8::MoeOrder, true, true>(F.lds, g, S, E); \
    } SEAM((p0) + 3);

    MOE_PHASES(0, 5)
    if (IN(9)) for (int rep_ = 0; rep_ <= REPN(9); ++rep_) { PHASE_ENTER(); const bool dry = rep_ < REPN(9); combine_phase<true>(F, KA->out, dry ? (float*)(F.ws + WS_END) : KA->out, P_Y, P_MOD, dry ? P_HID : P_HA, in[4] + DM, P_MOD + (size_t)32 * 6144); } SEAM(9);
    if (IN(10)) for (int rep_ = 0; rep_ <= REPN(10); ++rep_) { PHASE_ENTER();
        pg8::Gemm g{P_HA, (const bf16*)(F.ws + WS_WODIN), T, 2048, DM, 0}; pg8::StaticOrder S; S.init(T, 2048, F.G, F.bx);
        pg8::EpiOdIn E{P_GY, P_XB};
        pg8::gemm_phase<pg8::EpiOdIn, pg8::StaticOrder, true, true>(F.lds, g, S, E);
    } SEAM(10);
    if (IN(11)) for (int rep_ = 0; rep_ <= REPN(11); ++rep_) { PHASE_ENTER(); const int u = F.vcu; lru_unit(F, u >> 3, u & 7, P_GY, P_XB, P_CAT, (const bf16*)(F.ws + WS_WRG), (const bf16*)(F.ws + WS_WIG), in[15], in[16], in[18], in[20], in[21]); } SEAM(11);
    if (IN(12)) for (int rep_ = 0; rep_ <= REPN(12); ++rep_) { PHASE_ENTER();
        pg8::Gemm g{P_CAT, (const bf16*)(F.ws + WS_WODOUT), T, DM, DM, 0}; pg8::StaticOrder S; S.init(T, DM, F.G, F.bx);
        pg8::EpiResid E{KA->out, KA->out, P_MOD + (size_t)32 * 6144 + 2 * 1024};
        pg8::gemm_phase<pg8::EpiResid, pg8::StaticOrder, true, true>(F.lds, g, S, E);
    } SEAM(12);
    MOE_PHASES(1, 13)
    if (IN(17)) for (int rep_ = 0; rep_ <= REPN(17); ++rep_) { PHASE_ENTER(); const bool dry = rep_ < REPN(17); combine_phase<false>(F, KA->out, dry ? (float*)(F.ws + WS_END) : KA->out, P_Y, P_MOD + (size_t)32 * 6144, P_HA, nullptr, nullptr); }
#undef MOE_PHASES
#undef in
#undef IN
#undef SEAM
}

#if !MK_ONE_LAUNCH
template <int P> static void set_attr_all() { if constexpr (P < NPHASE) { (void)hipFuncSetAttribute((const void*)mk_fwd<P, P + 1>, hipFuncAttributeMaxDynamicSharedMemorySize, LDS_BYTES); set_attr_all<P + 1>(); } }
template <int P> static void launch_all(Args a, int grid, hipStream_t stream) { if constexpr (P < NPHASE) { a.ph_lo = P; a.ph_hi = P + 1; hipLaunchKernelGGL((mk_fwd<P, P + 1>), dim3(grid), dim3(NWAVES * 64), LDS_BYTES, stream, a); launch_all<P + 1>(a, grid, stream); } }
#endif

extern "C" void kernel_launch(void* const* d_in, const int* in_sizes, int n_in, void* d_out, int out_size, void* d_ws, size_t ws_size, hipStream_t stream) {
    static int grid = 0;
    if (grid == 0) {
        if (n_in != 28 || in_sizes[0] != T * DM || out_size != T * DM || ws_size < WS_END + (size_t)T * DM * 4) { fprintf(stderr, "kernel_launch: unexpected shapes (n_in %d, in0 %d, out %d, ws %zu); nothing launched\n", n_in, n_in > 0 ? in_sizes[0] : -1, out_size, ws_size); grid = -1; return; }
        int dev = 0, cus = 0;
        if (hipGetDevice(&dev) != hipSuccess || hipDeviceGetAttribute(&cus, hipDeviceAttributeMultiprocessorCount, dev) != hipSuccess) { grid = -1; return; }
#if MK_ONE_LAUNCH
        if (hipFuncSetAttribute((const void*)mk_fwd<0, NPHASE>, hipFuncAttributeMaxDynamicSharedMemorySize, LDS_BYTES) != hipSuccess) { fprintf(stderr, "kernel_launch: hipFuncSetAttribute failed\n"); grid = -1; return; }
        int per_cu = 0;
        if (hipOccupancyMaxActiveBlocksPerMultiprocessor(&per_cu, (const void*)mk_fwd<0, NPHASE>, NWAVES * 64, LDS_BYTES) != hipSuccess || per_cu < 1) fprintf(stderr, "kernel_launch: occupancy query reports %d\n", per_cu);
#else
        set_attr_all<0>();
#endif
        (void)hipGetLastError();
        grid = cus;
        if (grid != 256) { fprintf(stderr, "kernel_launch: built for 256 CUs, device has %d; nothing launched\n", cus); grid = -1; return; }
    }
    if (grid < 0) return;
    (void)hipMemsetAsync((char*)d_ws + WS_CTL, 0, CTL_ZERO_BYTES, stream);
    Args a{};
    for (int i = 0; i < 28; ++i) a.in[i] = (const float*)d_in[i];
    a.out = (float*)d_out; a.ws = (unsigned char*)d_ws;
#if MK_ONE_LAUNCH
    a.ph_lo = 0; a.ph_hi = NPHASE;
    hipLaunchKernelGGL((mk_fwd<0, NPHASE>), dim3(grid), dim3(NWAVES * 64), LDS_BYTES, stream, a);
#else
    launch_all<0>(a, grid, stream);
#endif
}
```

```cpp
#include <hip/hip_runtime.h>
#include <cstdio>
#include <cstdint>

#ifndef MK_ONE_LAUNCH
#define MK_ONE_LAUNCH 1
#endif

namespace pg8 {
#define PG8_LAS __attribute__((address_space(3)))
typedef unsigned short bf16_t;
typedef short bf16x8 __attribute__((ext_vector_type(8)));
typedef float f32x4 __attribute__((ext_vector_type(4)));
typedef unsigned u32x4 __attribute__((ext_vector_type(4)));
constexpr int BM = 256, BK = 64, HALF = 128, HTB = HALF * BK * 2  , STAGE_BYTES = 8 * HTB, NXCD = 8, WGM = 8;

__host__ __device__ __forceinline__ int lds_byte(int r, int c) { const int st = (r >> 4) * 2 + (c >> 5), rr = r & 15, cc = c & 31, ob = rr * 64 + cc * 2; return st * 1024 + (ob ^ (((ob >> 9) & 1) << 5)); }
__host__ __device__ __forceinline__ void stage_rc(int b, int& R, int& C) { const int st = b / 1024, sb = b % 1024, swz = sb ^ (((sb >> 9) & 1) << 5); R = (st >> 1) * 16 + swz / 64; C = (st & 1) * 32 + (swz % 64) / 2; }
__host__ __device__ __forceinline__ int perm32(int rho) { const int n = rho >> 4, i = rho & 15; return 8 * (i >> 2) + 4 * n + (i & 3); }

struct Unit { int pm, pn, pb; };
struct Gemm { const bf16_t* A; const bf16_t* Bt; int M, N, K; size_t bstride; };

struct StaticOrder {
    static constexpr bool GATHER = false, LAZY_PB = false; const int* tok;
    int nM, nN, nwg, G, c;
    __host__ __device__ void init(int M, int N, int G_, int c_) { nM = M / BM; nN = N / BM; nwg = nM * nN; G = G_; c = c_; }
    __host__ __device__ bool next(int i, Unit& u) const {
        const long L = (long)i * G + c; if (L >= nwg) return false;
        int wgid = (int)L; { const int q = nwg / NXCD, r = nwg % NXCD, xcd = wgid % NXCD, off = wgid / NXCD; wgid = (xcd < r ? xcd * (q + 1) : r * (q + 1) + (xcd - r) * q) + off; }
        const int nig = WGM * nN, gid = wgid / nig, fm = gid * WGM, gsz = (nM - fm) < WGM ? (nM - fm) : WGM;
        u.pm = fm + ((wgid % nig) % gsz); u.pn = (wgid % nig) / gsz; u.pb = 0; return true;
    }
    __device__ __forceinline__ void a_ready(const Unit&) const {}
    __device__ __forceinline__ void done(const Unit&) const {}
};

template <class Epi, class Sched, bool ALIGN_EPI = false, bool SP2 = false, bool FP8 = false>
__device__ __forceinline__ void gemm_phase(PG8_LAS unsigned char* lds, const Gemm g, const Sched& S, const Epi& E) {
    int tid_ = threadIdx.x; asm volatile("" : "+v"(tid_));
    const int tid = tid_, wid = __builtin_amdgcn_readfirstlane(tid >> 6), lane = tid & 63, wr = wid >> 2, wc = wid & 3, fr = lane & 15, fq = lane >> 4;
    int K_ = g.K; asm volatile("" : "+s"(K_));
    const int K = K_, nt = K / BK;
    unsigned voffA[2], voffB[2];
#pragma unroll
    for (int i = 0; i < 2; ++i) { int R, C; stage_rc(tid * 16 + i * 8192, R, C); const int Rb = Epi::PERM ? ((R & ~31) + perm32(R & 31)) : R;
        voffA[i] = (unsigned)(R * K + C) * 2u; voffB[i] = (unsigned)(Rb * K + C) * 2u; }
    unsigned cvo[2][2], nvo[2][2]; int rowA[2]; unsigned colA[2];
#pragma unroll
    for (int i = 0; i < 2; ++i) { int R, C; stage_rc(tid * 16 + i * 8192, R, C); rowA[i] = R; colA[i] = (unsigned)C * 2u; }
    int ntk[2][2];
#define PG8_LOADTK(u_, tk_) do { const int* _p00 = S.tok + (u_).pm * BM + rowA[0]; const int* _p01 = S.tok + (u_).pm * BM + rowA[1]; const int* _p10 = _p00 + HALF; const int* _p11 = _p01 + HALF; \
        asm volatile("global_load_dword %0, %4, off\n\tglobal_load_dword %1, %5, off\n\tglobal_load_dword %2, %6, off\n\tglobal_load_dword %3, %7, off" \
            : "=&v"(tk_[0][0]), "=&v"(tk_[0][1]), "=&v"(tk_[1][0]), "=&v"(tk_[1][1]) : "v"(_p00), "v"(_p01), "v"(_p10), "v"(_p11) : "memory"); } while (0)
#define PG8_TK2VO(tk_, vo_) do { _Pragma("unroll") for (int _h = 0; _h < 2; ++_h) _Pragma("unroll") for (int _i = 0; _i < 2; ++_i) vo_[_h][_i] = (unsigned)tk_[_h][_i] * (unsigned)(K * 2) + colA[_i]; } while (0)
    const size_t kstep = (size_t)(BK * 2);
    const size_t hstep = (size_t)HALF * K * 2;
    const size_t tstep = 2 * hstep;
    const unsigned ldsw = (unsigned)wid * 1024u;
    constexpr int PSTR = FP8 ? 16 : 1024;
    const int aoff = FP8 ? lds_byte(wr * 64 + fr, (fq & 1) * 16) + (fq >> 1) * 1024 : lds_byte(wr * 64 + fr, fq * 8);
    const int boff = FP8 ? lds_byte(wc * 32 + fr, (fq & 1) * 16) + (fq >> 1) * 1024 : lds_byte(wc * 32 + fr, fq * 8);
#define PG8_SA(b, h) (((b) * 2 + (h)) * HTB)
#define PG8_SB(b, h) ((4 + (b) * 2 + (h)) * HTB)
#define PG8_STAGE(bufoff, gbase, voff) do { _Pragma("unroll") for (int _i = 0; _i < 2; ++_i) \
        __builtin_amdgcn_global_load_lds((const unsigned*)((const char*)(gbase) + (voff)[_i]), (PG8_LAS unsigned*)(lds + (bufoff) + ldsw + _i * 8192), 16, 0, 0); } while (0)
#define PG8_STAGE_A(bufoff, gbase, h, nx) do { if constexpr (Sched::GATHER) { _Pragma("unroll") for (int _i = 0; _i < 2; ++_i) { const unsigned _vo = (nx) ? nvo[h][_i] : cvo[h][_i]; \
        __builtin_amdgcn_global_load_lds((const unsigned*)((const char*)(gbase) + _vo), (PG8_LAS unsigned*)(lds + (bufoff) + ldsw + _i * 8192), 16, 0, 0); } } \
        else { PG8_STAGE(bufoff, (gbase) + (h) * hstep, voffA); } } while (0)
    const PG8_LAS unsigned char* const ldsA = lds + aoff;
    const PG8_LAS unsigned char* const ldsB = lds + 4 * HTB + boff;
#define PG8_LD32(p_) __builtin_shufflevector(*(const PG8_LAS v4i_*)(p_), *(const PG8_LAS v4i_*)((p_) + PSTR), 0, 1, 2, 3, 4, 5, 6, 7)
#define PG8_LDA(dst, b, h) do { if constexpr (FP8) { _Pragma("unroll") for (int m = 0; m < 4; ++m) dst##8[m] = PG8_LD32(ldsA + PG8_SA(b, h) + m * 2048); } \
    else { _Pragma("unroll") for (int m = 0; m < 4; ++m) _Pragma("unroll") for (int k = 0; k < 2; ++k) dst[m][k] = *(const PG8_LAS bf16x8*)(ldsA + PG8_SA(b, h) + m * 2048 + k * PSTR); } } while (0)
#define PG8_LDB(dst, b, h) do { if constexpr (FP8) { _Pragma("unroll") for (int n = 0; n < 2; ++n) dst##8[n] = PG8_LD32(ldsB + (PG8_SB(b, h) - 4 * HTB) + n * 2048); } \
    else { _Pragma("unroll") for (int n = 0; n < 2; ++n) _Pragma("unroll") for (int k = 0; k < 2; ++k) dst[n][k] = *(const PG8_LAS bf16x8*)(ldsB + (PG8_SB(b, h) - 4 * HTB) + n * 2048 + k * PSTR); } } while (0)
#define PG8_MMA(ai, bj, At, Bt) do { __builtin_amdgcn_s_setprio(1); \
        if constexpr (FP8) { _Pragma("unroll") for (int m = 0; m < 4; ++m) _Pragma("unroll") for (int n = 0; n < 2; ++n) \
            asm volatile("v_mfma_scale_f32_16x16x128_f8f6f4 %0, %1, %2, %0, %3, %3 op_sel_hi:[0,0,0]" : "+v"(acc[ai][bj][m][n]) : "v"(Bt##8[n]), "v"(At##8[m]), "v"(sc8)); } \
        else { _Pragma("unroll") for (int m = 0; m < (FP8 ? 1 : 4); ++m) _Pragma("unroll") for (int n = 0; n < 2; ++n) _Pragma("unroll") for (int k = 0; k < 2; ++k) \
            acc[ai][bj][m][n] = __builtin_amdgcn_mfma_f32_16x16x32_bf16(Bt[n][k], At[m][k], acc[ai][bj][m][n], 0, 0, 0); } \
        __builtin_amdgcn_s_setprio(0); } while (0)
#define PG8_WAIT_V(n) asm volatile("s_waitcnt vmcnt(" #n ")" ::: "memory")
#define PG8_WAIT_L(n) asm volatile("s_waitcnt lgkmcnt(" #n ")" ::: "memory")
#define PG8_BAR __builtin_amdgcn_s_barrier()
#define PG8_SCHED __builtin_amdgcn_sched_barrier(0)
    Unit cur, nxt; int ui = 0;
    if (!S.next(0, cur)) return;
    f32x4 acc[2][2][4][2];
#pragma unroll
    for (int a = 0; a < 2; ++a)
#pragma unroll
        for (int b = 0; b < 2; ++b)
#pragma unroll
            for (int m = 0; m < 4; ++m)
#pragma unroll
                for (int n = 0; n < 2; ++n) acc[a][b][m][n] = (f32x4){0.f, 0.f, 0.f, 0.f};
    typedef int v4i_ __attribute__((ext_vector_type(4))); typedef int v8i_ __attribute__((ext_vector_type(8)));
    bf16x8 At[FP8 ? 1 : 4][2], B0[2][2], B1[2][2];
    v8i_ At8[FP8 ? 4 : 1], B08[2], B18[2];
    const int sc8 = 0x7f7f7f7f;
    const char* cA = (const char*)g.A + (Sched::GATHER ? (size_t)0 : (size_t)cur.pm * tstep); const char* cB = (const char*)g.Bt + (size_t)cur.pb * g.bstride + (size_t)cur.pn * tstep;
    S.a_ready(cur);
    if constexpr (Sched::GATHER) { PG8_LOADTK(cur, ntk); asm volatile("s_waitcnt vmcnt(0)" : "+v"(ntk[0][0]), "+v"(ntk[0][1]), "+v"(ntk[1][0]), "+v"(ntk[1][1]) :: "memory"); PG8_TK2VO(ntk, cvo); }
    if constexpr (SP2) {
        PG8_STAGE(PG8_SB(0, 0), cB, voffB); PG8_STAGE(PG8_SB(0, 1), cB + hstep, voffB); PG8_STAGE_A(PG8_SA(0, 0), cA, 0, false); PG8_STAGE_A(PG8_SA(0, 1), cA, 1, false);
        if (wr == 1) PG8_BAR;
        PG8_WAIT_V(2); PG8_BAR;
        PG8_STAGE(PG8_SB(1, 0), cB + kstep, voffB); PG8_STAGE_A(PG8_SA(1, 0), cA + kstep, 0, false); PG8_STAGE(PG8_SB(1, 1), cB + hstep + kstep, voffB);
        PG8_WAIT_V(6); PG8_BAR;
    } else { static_assert(SP2, "only the SP2 loop is kept"); }
    for (;;) {
        bool has_next; int pbv = 0;
        if constexpr (Sched::LAZY_PB) { has_next = S.next_nopb(ui + 1, nxt);
            if (has_next) { const int* _pp = S.pb_ptr(nxt); asm volatile("global_load_dword %0, %1, off" : "=v"(pbv) : "v"(_pp) : "memory"); } }
        else has_next = S.next(ui + 1, nxt);
        const char* nA = (has_next && !Sched::GATHER) ? (const char*)g.A + (size_t)nxt.pm * tstep : cA;
        if constexpr (Sched::GATHER) { _Pragma("unroll") for (int _h = 0; _h < 2; ++_h) _Pragma("unroll") for (int _i = 0; _i < 2; ++_i) nvo[_h][_i] = cvo[_h][_i]; if (has_next) { PG8_LOADTK(nxt, ntk); } }
 const char* nB = (has_next && !Sched::LAZY_PB) ? (const char*)g.Bt + (size_t)nxt.pb * g.bstride + (size_t)nxt.pn * tstep : cB;
        for (int t = 0; t < nt; t += 2) {
            const bool last = (t == nt - 2);
            const char* a1 = cA + (size_t)(t + 1) * kstep;
            if constexpr (Sched::LAZY_PB) { if (last && has_next) { asm volatile("s_waitcnt vmcnt(8)" : "+v"(pbv) :: "memory"); nxt.pb = __builtin_amdgcn_readfirstlane(pbv);
                nB = (const char*)g.Bt + (size_t)nxt.pb * g.bstride + (size_t)nxt.pn * tstep; } }
            const char* a2 = last ? nA : cA + (size_t)(t + 2) * kstep; const char* b2 = last ? nB : cB + (size_t)(t + 2) * kstep;
            const char* a3 = a2 + kstep; const char* b3 = b2 + kstep;
            if (last && has_next) S.a_ready(nxt);
            if constexpr (Sched::GATHER) { if (last && has_next) {
                asm volatile("s_waitcnt vmcnt(8)" : "+v"(ntk[0][0]), "+v"(ntk[0][1]), "+v"(ntk[1][0]), "+v"(ntk[1][1]) :: "memory"); PG8_TK2VO(ntk, nvo); } }
            if constexpr (SP2) {
            PG8_LDB(B0, 0, 0); PG8_LDB(B1, 0, 1); PG8_SCHED; PG8_LDA(At, 0, 0); PG8_STAGE_A(PG8_SA(1, 1), a1, 1, false);
            PG8_WAIT_V(8); PG8_WAIT_L(0); PG8_BAR; PG8_MMA(0, 0, At, B0); PG8_MMA(0, 1, At, B1); PG8_BAR; PG8_SCHED;
            PG8_LDA(At, 0, 1); PG8_STAGE(PG8_SB(0, 0), b2, voffB); PG8_STAGE(PG8_SB(0, 1), b2 + hstep, voffB); PG8_STAGE_A(PG8_SA(0, 0), a2, 0, last);
            PG8_WAIT_V(8); PG8_WAIT_L(0); PG8_BAR; PG8_MMA(1, 0, At, B0); PG8_MMA(1, 1, At, B1); PG8_BAR; PG8_SCHED;
            PG8_LDB(B0, 1, 0); PG8_LDB(B1, 1, 1); PG8_SCHED; PG8_LDA(At, 1, 0); PG8_STAGE_A(PG8_SA(0, 1), a2, 1, last);
            PG8_WAIT_V(8); PG8_WAIT_L(0); PG8_BAR; PG8_MMA(0, 0, At, B0); PG8_MMA(0, 1, At, B1); PG8_BAR; PG8_SCHED;
            PG8_LDA(At, 1, 1); PG8_STAGE(PG8_SB(1, 0), b3, voffB); PG8_STAGE(PG8_SB(1, 1), b3 + hstep, voffB); PG8_STAGE_A(PG8_SA(1, 0), a3, 0, last);
            PG8_WAIT_V(8); PG8_WAIT_L(0); PG8_BAR; PG8_MMA(1, 0, At, B0); PG8_MMA(1, 1, At, B1); PG8_BAR; PG8_SCHED;
            }
        }
        if constexpr (ALIGN_EPI) { if (wr == 0) PG8_BAR; }
        if constexpr (FP8) asm volatile("s_nop 15\n\ts_nop 15" ::: "memory");
        if constexpr (!Epi::AFTER_DRAIN) { E(acc, cur, wr, wc, fr, fq); S.done(cur); }
        if (!has_next) break;
#pragma unroll
        for (int a = 0; a < 2; ++a)
#pragma unroll
            for (int b = 0; b < 2; ++b)
#pragma unroll
                for (int m = 0; m < 4; ++m)
#pragma unroll
                    for (int n = 0; n < 2; ++n) acc[a][b][m][n] = (f32x4){0.f, 0.f, 0.f, 0.f};
        cur = nxt; cA = nA; cB = nB; ++ui;
        if constexpr (Sched::GATHER) { _Pragma("unroll") for (int _h = 0; _h < 2; ++_h) _Pragma("unroll") for (int _i = 0; _i < 2; ++_i) cvo[_h][_i] = nvo[_h][_i]; }
        if constexpr (ALIGN_EPI) { if (wr == 1) PG8_BAR; }
    }
    PG8_WAIT_V(0);
    if constexpr (!ALIGN_EPI) { if (wr == 0) PG8_BAR; }
    PG8_BAR;
    if constexpr (Epi::AFTER_DRAIN) { E.fused(acc, cur, wr, wc, fr, fq, lds, wid, lane); S.done(cur); }
#undef PG8_SA
#undef PG8_SB
#undef PG8_STAGE
#undef PG8_STAGE_A
#undef PG8_LOADTK
#undef PG8_TK2VO
#undef PG8_LD32
#undef PG8_LDA
#undef PG8_LDB
#undef PG8_MMA
#undef PG8_WAIT_V
#undef PG8_WAIT_L
#undef PG8_BAR
#undef PG8_SCHED
}
}

constexpr int NB = 32, SEQ = 2048, DM = 1024, T = NB * SEQ;
constexpr int EVIN = 2560, CONVC = 512, CONVW = 31, NHEAD = 8, HD = 64, SBW = 512;
constexpr int NEXP = 16, DFF = 512;
constexpr int MOE_ROWS = 2 * T + NEXP * 256;
constexpr int MOE_TILES = MOE_ROWS / 256;
constexpr float EPS = 1e-6f;
constexpr int NWAVES = 8;

constexpr size_t MiB = 1u << 20;
constexpr size_t WS_CTL = 0, CTL_ZERO_BYTES = 64 * 1024;
constexpr size_t WS_MOD = 1 * MiB;
constexpr size_t WS_META = 3 * MiB;
constexpr size_t META_EID = WS_META, META_GATE = WS_META + 512 * 1024, META_SLOT = WS_META + 1024 * 1024, META_BCNT = WS_META + 1536 * 1024,
                 META_TILEE = META_BCNT + 32 * 1024, META_NT = META_BCNT + 64 * 1024, META_TOK = WS_META + 2048 * 1024;
constexpr size_t WS_WEVIN = 6 * MiB, WS_WEVOUT = 11 * MiB, WS_WODIN = 13 * MiB, WS_WODOUT = 17 * MiB, WS_WRG = 19 * MiB, WS_WIG = WS_WRG + 512 * 1024;
constexpr size_t WS_W13 = 20 * MiB;
constexpr size_t WS_W2 = 84 * MiB;
constexpr size_t WS_HA = 116 * MiB;
constexpr size_t WS_R1 = 244 * MiB;
constexpr size_t WS_R2 = 508 * MiB;
constexpr size_t WS_END = 640 * MiB;
constexpr int CW_BAR = 4096;

constexpr int RING_BYTES = 131072, LDS_BYTES = 147456, LDSCTL_OFF = LDS_BYTES - 2048, MISC_OFF = LDSCTL_OFF + 320;

#define GAS __attribute__((address_space(1)))
#define LAS __attribute__((address_space(3)))
typedef unsigned short bf16;
typedef unsigned v4u __attribute__((ext_vector_type(4)));
typedef unsigned v2u __attribute__((ext_vector_type(2)));
typedef float f32x4 __attribute__((ext_vector_type(4)));
typedef float f32x2 __attribute__((ext_vector_type(2)));
typedef float f32x16 __attribute__((ext_vector_type(16)));
typedef short bf16x8 __attribute__((ext_vector_type(8)));
typedef short s16x4 __attribute__((ext_vector_type(4)));
typedef __bf16 bf16x2_t __attribute__((ext_vector_type(2)));
typedef GAS unsigned gu32;
#define RLX_AGENT __ATOMIC_RELAXED, __HIP_MEMORY_SCOPE_AGENT

__device__ __forceinline__ unsigned pk2(float lo, float hi) { f32x2 v = {lo, hi}; bf16x2_t b = __builtin_convertvector(v, bf16x2_t); return __builtin_bit_cast(unsigned, b); }
__device__ __forceinline__ unsigned pk4_fp8(float a, float b, float c, float d) { int r = __builtin_amdgcn_cvt_pk_fp8_f32(a, b, 0, false); r = __builtin_amdgcn_cvt_pk_fp8_f32(c, d, r, true); return (unsigned)r; }
__device__ __forceinline__ float bflo(unsigned u) { return __uint_as_float(u << 16); }
__device__ __forceinline__ float bfhi(unsigned u) { return __uint_as_float(u & 0xffff0000u); }
__device__ __forceinline__ float bf2f(bf16 b) { return __uint_as_float((unsigned)b << 16); }
__device__ __forceinline__ float fast_exp2(float x) { return __builtin_amdgcn_exp2f(x); }
__device__ __forceinline__ float fast_rcp(float x) { return __builtin_amdgcn_rcpf(x); }
__device__ __forceinline__ float sigmoidf_(float x) { return fast_rcp(1.0f + fast_exp2(-1.4426950408889634f * x)); }
__device__ __forceinline__ float siluf_(float x) { return x * sigmoidf_(x); }
__device__ __forceinline__ float gelu_tanh(float x) { const float u = x + 0.044715f * x * x * x; return x * fast_rcp(1.0f + fast_exp2(-2.3022082f * u)); }
__device__ __forceinline__ float wave_sum(float v) {
#pragma unroll
    for (int o = 1; o < 64; o <<= 1) v += __shfl_xor(v, o);
    return v;
}

#define XB_TMO      128
#define XB_XCNT(j)  (256  + 64 * (j))
#define XB_XSUB(j)  (1280 + 64 * (j))
#define XB_XGEN(j)  (2304 + 64 * (j))
#define XB_TOP      3328
#define XB_TOPGEN   3392
#define XCD_BAR_WORDS 3456
#define XB_SPIN_CAP (1u << 18)

__device__ __forceinline__ unsigned xb_ld(unsigned* p)              { return __hip_atomic_load(p, __ATOMIC_RELAXED, __HIP_MEMORY_SCOPE_AGENT); }
__device__ __forceinline__ unsigned xb_add(unsigned* p, unsigned v) { return __hip_atomic_fetch_add(p, v, __ATOMIC_RELAXED, __HIP_MEMORY_SCOPE_AGENT); }
__device__ __forceinline__ unsigned xb_xcc_id() { return (unsigned)__builtin_amdgcn_s_getreg((3 << 11) | 20) & 0xFu; }
#define XB_SPIN(cond, bar) do { unsigned _sp = 0; while (cond) { __builtin_amdgcn_s_sleep(1); \
    if ((++_sp & 255u) == 0u) { if (xb_ld(&(bar)[XB_TMO])) break; if (_sp > XB_SPIN_CAP) { atomicAdd(&(bar)[XB_TMO], 1u); break; } } } } while (0)

struct XcdBarrier {
    unsigned* bar; unsigned x;
    volatile LAS unsigned* st;
};

__device__ __forceinline__ XcdBarrier xcd_barrier_post(unsigned* bar, volatile LAS unsigned* st) {
    XcdBarrier b; b.bar = bar; b.x = xb_xcc_id(); b.st = st;
    if (threadIdx.x == 0) (void)xb_add(&bar[XB_XCNT(b.x)], 1u);
    return b;
}
__device__ __forceinline__ void xcd_barrier_complete(unsigned* bar, unsigned x, unsigned& nloc, unsigned& nx) {
    const unsigned G = gridDim.x * gridDim.y * gridDim.z;
    unsigned sum, cnt, mine, sp = 0u;
    for (;;) {
        sum = 0u; cnt = 0u; mine = 0u;
#pragma unroll
        for (unsigned j = 0; j < 16; ++j) { const unsigned c = xb_ld(&bar[XB_XCNT(j)]); sum += c; cnt += (c > 0u) ? 1u : 0u; mine = (j == x) ? c : mine; }
        if (sum == G) break;
        __builtin_amdgcn_s_sleep(1);
        if ((++sp & 255u) == 0u) { if (xb_ld(&bar[XB_TMO])) break; if (sp > XB_SPIN_CAP) { atomicAdd(&bar[XB_TMO], 1u); break; } }
    }
    nloc = mine > 0u ? mine : 1u; nx = cnt > 0u ? cnt : 1u;
}

__device__ __forceinline__ void xcd_barrier(const XcdBarrier& b) {
    asm volatile("s_waitcnt vmcnt(0)" ::: "memory");
    __syncthreads();
    if (threadIdx.x == 0) {
        unsigned* bar = b.bar;
        __builtin_amdgcn_s_waitcnt(0);
        unsigned nloc = b.st[0], nx = b.st[1];
        if (nloc == 0u) { xcd_barrier_complete(bar, b.x, nloc, nx); b.st[0] = nloc; b.st[1] = nx; }
        const unsigned old = xb_add(&bar[XB_XSUB(b.x)], 1u);
        const unsigned gen = old / nloc;
        if (old + 1u == (gen + 1u) * nloc) {
            __builtin_amdgcn_fence(__ATOMIC_RELEASE, "agent");
            asm volatile("s_waitcnt vmcnt(0)" ::: "memory");
            const unsigned og = xb_add(&bar[XB_TOP], 1u);
            const unsigned tg = og / nx;
            if (og + 1u == (tg + 1u) * nx) xb_add(&bar[XB_TOPGEN], 1u);
            else XB_SPIN(xb_ld(&bar[XB_TOPGEN]) == tg, bar);
            __builtin_amdgcn_fence(__ATOMIC_ACQUIRE, "agent");
            xb_add(&bar[XB_XGEN(b.x)], 1u);
            asm volatile("s_waitcnt vmcnt(0)" ::: "memory");
        } else {
            XB_SPIN(xb_ld(&bar[XB_XGEN(b.x)]) == gen, bar);
            __builtin_amdgcn_fence(__ATOMIC_ACQUIRE, "agent");
            asm volatile("s_waitcnt vmcnt(0)" ::: "memory");
        }
    }
    __syncthreads();
}


namespace pg8 {
struct EpiEvIn {
    static constexpr bool PERM = true, AFTER_DRAIN = false;
    bf16* U0; bf16* Q; bf16* K; bf16* V; const float* qg; const float* kg;
    __device__ __forceinline__ void operator()(const f32x4 (&acc)[2][2][4][2], const Unit& u, int wr, int wc, int fr, int fq) const {
        const int row0 = u.pm * BM + wr * 64 + fr;
        if (u.pn < 4) {
#pragma unroll
            for (int ai = 0; ai < 2; ++ai)
#pragma unroll
                for (int m = 0; m < 4; ++m) {
                    const size_t row = (size_t)(row0 + ai * HALF + m * 16);
                    const f32x4 v0 = acc[ai][0][m][0], v1 = acc[ai][0][m][1], g0 = acc[ai][1][m][0], g1 = acc[ai][1][m][1];
                    u32x4 w;
                    w.x = pk2(v0[0] * sigmoidf_(g0[0]), v0[1] * sigmoidf_(g0[1])); w.y = pk2(v0[2] * sigmoidf_(g0[2]), v0[3] * sigmoidf_(g0[3]));
                    w.z = pk2(v1[0] * sigmoidf_(g1[0]), v1[1] * sigmoidf_(g1[1])); w.w = pk2(v1[2] * sigmoidf_(g1[2]), v1[3] * sigmoidf_(g1[3]));
                    *(u32x4*)(U0 + row * 512 + u.pn * 128 + wc * 32 + 8 * fq) = w;
                }
        } else if (u.pn < 8) {
            const int sec = (u.pn - 4) >> 1, p = (u.pn - 4) & 1, head = 4 * p + wc;
            const float* gp = sec ? kg : qg; bf16* dst = sec ? K : Q;
            const float scl = sec ? 1.0f : 0.125f * 1.4426950408889634f;
            f32x4 gv[2][2];
#pragma unroll
            for (int bj = 0; bj < 2; ++bj)
#pragma unroll
                for (int n = 0; n < 2; ++n) gv[bj][n] = *(const f32x4*)(gp + 32 * bj + 8 * fq + 4 * n) * scl;
#pragma unroll
            for (int ai = 0; ai < 2; ++ai)
#pragma unroll
                for (int m = 0; m < 4; ++m) {
                    const size_t row = (size_t)(row0 + ai * HALF + m * 16);
                    float ss = 0.f;
#pragma unroll
                    for (int bj = 0; bj < 2; ++bj)
#pragma unroll
                        for (int n = 0; n < 2; ++n) { const f32x4 x = acc[ai][bj][m][n]; ss += (x[0] * x[0] + x[1] * x[1]) + (x[2] * x[2] + x[3] * x[3]); }
                    ss += __shfl_xor(ss, 16); ss += __shfl_xor(ss, 32);
                    const float rstd = __builtin_amdgcn_rsqf(ss * (1.0f / 64.0f) + EPS);
#pragma unroll
                    for (int bj = 0; bj < 2; ++bj) {
                        const f32x4 a = acc[ai][bj][m][0] * rstd * gv[bj][0], b = acc[ai][bj][m][1] * rstd * gv[bj][1];
                        u32x4 w; w.x = pk2(a[0], a[1]); w.y = pk2(a[2], a[3]); w.z = pk2(b[0], b[1]); w.w = pk2(b[2], b[3]);
                        *(u32x4*)(dst + row * 512 + head * 64 + 32 * bj + 8 * fq) = w;
                    }
                }
        } else {
#pragma unroll
            for (int ai = 0; ai < 2; ++ai)
#pragma unroll
                for (int m = 0; m < 4; ++m) {
                    const size_t row = (size_t)(row0 + ai * HALF + m * 16);
#pragma unroll
                    for (int bj = 0; bj < 2; ++bj) {
                        const f32x4 a = acc[ai][bj][m][0], b = acc[ai][bj][m][1];
                        u32x4 w; w.x = pk2(a[0], a[1]); w.y = pk2(a[2], a[3]); w.z = pk2(b[0], b[1]); w.w = pk2(b[2], b[3]);
                        *(u32x4*)(V + row * 512 + (u.pn - 8) * 256 + bj * HALF + wc * 32 + 8 * fq) = w;
                    }
                }
        }
    }
};
struct EpiResid {
    static constexpr bool PERM = false, AFTER_DRAIN = false;
    const float* xin; float* xout; const float* gate;
    __device__ __forceinline__ void operator()(const f32x4 (&acc)[2][2][4][2], const Unit& u, int wr, int wc, int fr, int fq) const {
        const int row0 = u.pm * BM + wr * 64 + fr, col0 = u.pn * BM + wc * 32 + 4 * fq, b = u.pm >> 3;
        f32x4 gv[2][2];
#pragma unroll
        for (int bj = 0; bj < 2; ++bj)
#pragma unroll
            for (int n = 0; n < 2; ++n) gv[bj][n] = *(const f32x4*)(gate + (size_t)b * 6144 + col0 + bj * HALF + n * 16);
#pragma unroll
        for (int ai = 0; ai < 2; ++ai)
#pragma unroll
            for (int m = 0; m < 4; ++m) {
                const size_t off = (size_t)(row0 + ai * HALF + m * 16) * DM + col0;
#pragma unroll
                for (int bj = 0; bj < 2; ++bj)
#pragma unroll
                    for (int n = 0; n < 2; ++n) { const f32x4 xi = *(const f32x4*)(xin + off + bj * HALF + n * 16); *(f32x4*)(xout + off + bj * HALF + n * 16) = xi + gv[bj][n] * acc[ai][bj][m][n]; }
            }
    }
};
struct EpiOdIn {
    static constexpr bool PERM = true, AFTER_DRAIN = false;
    bf16* GY; bf16* XB;
    __device__ __forceinline__ void operator()(const f32x4 (&acc)[2][2][4][2], const Unit& u, int wr, int wc, int fr, int fq) const {
        const int row0 = u.pm * BM + wr * 64 + fr; const bool isy = u.pn < 4;
        bf16* dst = (isy ? GY : XB) + (size_t)(u.pn & 3) * 256 + wc * 32 + 8 * fq;
#pragma unroll
        for (int ai = 0; ai < 2; ++ai)
#pragma unroll
            for (int m = 0; m < 4; ++m) {
                const size_t row = (size_t)(row0 + ai * HALF + m * 16);
#pragma unroll
                for (int bj = 0; bj < 2; ++bj) {
                    f32x4 a = acc[ai][bj][m][0], b = acc[ai][bj][m][1];
                    if (isy) { a = (f32x4){gelu_tanh(a[0]), gelu_tanh(a[1]), gelu_tanh(a[2]), gelu_tanh(a[3])}; b = (f32x4){gelu_tanh(b[0]), gelu_tanh(b[1]), gelu_tanh(b[2]), gelu_tanh(b[3])}; }
                    u32x4 w; w.x = pk2(a[0], a[1]); w.y = pk2(a[2], a[3]); w.z = pk2(b[0], b[1]); w.w = pk2(b[2], b[3]);
                    *(u32x4*)(dst + row * DM + bj * HALF) = w;
                }
            }
    }
};
struct EpiMoeA {
    static constexpr bool PERM = true, AFTER_DRAIN = false;
    bf16* HID;
    __device__ __forceinline__ void operator()(const f32x4 (&acc)[2][2][4][2], const Unit& u, int wr, int wc, int fr, int fq) const {
        const int row0 = u.pm * BM + wr * 64 + fr;
#pragma unroll
        for (int ai = 0; ai < 2; ++ai)
#pragma unroll
            for (int m = 0; m < 4; ++m) {
                const size_t row = (size_t)(row0 + ai * HALF + m * 16);
                const f32x4 a0 = acc[ai][0][m][0], a1 = acc[ai][0][m][1], b0 = acc[ai][1][m][0], b1 = acc[ai][1][m][1];
                u32x4 w;
                (void)w; constexpr float S = 1.0f / 32.0f, S4 = 4.0f / 32.0f;
                v2u w8; w8.x = pk4_fp8(siluf_(a0[0] * S) * (b0[0] * S4), siluf_(a0[1] * S) * (b0[1] * S4), siluf_(a0[2] * S) * (b0[2] * S4), siluf_(a0[3] * S) * (b0[3] * S4));
                w8.y = pk4_fp8(siluf_(a1[0] * S) * (b1[0] * S4), siluf_(a1[1] * S) * (b1[1] * S4), siluf_(a1[2] * S) * (b1[2] * S4), siluf_(a1[3] * S) * (b1[3] * S4));
                *(v2u*)((unsigned char*)HID + row * DFF + u.pn * 128 + wc * 32 + 8 * fq) = w8;
            }
    }
};
struct EpiMoeB {
    static constexpr bool PERM = true, AFTER_DRAIN = false;
    bf16* Y;
    __device__ __forceinline__ void operator()(const f32x4 (&acc)[2][2][4][2], const Unit& u, int wr, int wc, int fr, int fq) const {
        const int row0 = u.pm * BM + wr * 64 + fr;
#pragma unroll
        for (int ai = 0; ai < 2; ++ai)
#pragma unroll
            for (int m = 0; m < 4; ++m) {
                const size_t row = (size_t)(row0 + ai * HALF + m * 16);
#pragma unroll
                for (int bj = 0; bj < 2; ++bj) {
                    const f32x4 a = acc[ai][bj][m][0] * (1.0f / 128.0f), b = acc[ai][bj][m][1] * (1.0f / 128.0f);
                    u32x4 w; w.x = pk2(a[0], a[1]); w.y = pk2(a[2], a[3]); w.z = pk2(b[0], b[1]); w.w = pk2(b[2], b[3]);
                    *(u32x4*)(Y + row * DM + u.pn * 256 + bj * HALF + wc * 32 + 8 * fq) = w;
                }
            }
    }
};
struct MoeOrder {
    static constexpr bool GATHER = false, LAZY_PB = true; const int* tok;
    StaticOrder base; const int* tile_e;
    __device__ __forceinline__ bool next(int i, Unit& u) const { if (!base.next(i, u)) return false; u.pb = tile_e[u.pm]; return true; }
    __device__ __forceinline__ bool next_nopb(int i, Unit& u) const { return base.next(i, u); }
    __device__ __forceinline__ const int* pb_ptr(const Unit& u) const { return tile_e + u.pm; }
    __device__ __forceinline__ void a_ready(const Unit&) const {}
    __device__ __forceinline__ void done(const Unit&) const {}
};
struct MoeGatherOrder {
    static constexpr bool GATHER = true, LAZY_PB = true; const int* tok;
    StaticOrder base; const int* tile_e;
    __device__ __forceinline__ bool next(int i, Unit& u) const { if (!base.next(i, u)) return false; u.pb = tile_e[u.pm]; return true; }
    __device__ __forceinline__ bool next_nopb(int i, Unit& u) const { return base.next(i, u); }
    __device__ __forceinline__ const int* pb_ptr(const Unit& u) const { return tile_e + u.pm; }
    __device__ __forceinline__ void a_ready(const Unit&) const {}
    __device__ __forceinline__ void done(const Unit&) const {}
};
}

struct Frame {
    LAS unsigned char* lds;
    int tid, lane, wave, vcu, G, bx;
    unsigned char* ws;
};

template <bool OUT8 = false, class RowMap>
__device__ __forceinline__ void p0_transpose_item(const float* W, int K, int N, bf16* WT, LAS float* scr, int item, int lane, RowMap rm) {
    const int nblk = N / 64, kb = item / nblk, nb = item % nblk, k0 = 64 * kb, n0 = 64 * nb;
    f32x4 v[16];
#pragma unroll
    for (int i = 0; i < 16; ++i) v[i] = *(const f32x4*)(W + (size_t)(k0 + 4 * i + (lane >> 4)) * N + n0 + 4 * (lane & 15));
#pragma unroll
    for (int i = 0; i < 16; ++i) { LAS float* d = scr + (4 * i + (lane >> 4)) * 65 + 4 * (lane & 15); d[0] = v[i][0]; d[1] = v[i][1]; d[2] = v[i][2]; d[3] = v[i][3]; }
    asm volatile("s_waitcnt lgkmcnt(0)" ::: "memory");
    const int c = lane & 7;
#pragma unroll
    for (int j = 0; j < 8; ++j) { const int n = (lane >> 3) + 8 * j; const LAS float* sp = scr + (8 * c) * 65 + n;
        if constexpr (OUT8) { v2u o; o.x = pk4_fp8(sp[0 * 65] * 32.f, sp[1 * 65] * 32.f, sp[2 * 65] * 32.f, sp[3 * 65] * 32.f); o.y = pk4_fp8(sp[4 * 65] * 32.f, sp[5 * 65] * 32.f, sp[6 * 65] * 32.f, sp[7 * 65] * 32.f);
            *(GAS v2u*)((unsigned char*)WT + (size_t)rm(n0 + n) * K + k0 + 8 * c) = o; }
        else { v4u o; o.x = pk2(sp[0 * 65], sp[1 * 65]); o.y = pk2(sp[2 * 65], sp[3 * 65]); o.z = pk2(sp[4 * 65], sp[5 * 65]); o.w = pk2(sp[6 * 65], sp[7 * 65]);
            *(GAS v4u*)(WT + (size_t)rm(n0 + n) * K + k0 + 8 * c) = o; } }
    asm volatile("s_waitcnt lgkmcnt(0)" ::: "memory");
}
struct RmId { __device__ __forceinline__ int operator()(int n) const { return n; } };
struct RmEvIn { __device__ __forceinline__ int operator()(int n) const {
    if (n < 512) return 256 * (n >> 7) + (n & 127);
    if (n < 1024) { const int m = n - 512; return 256 * (m >> 7) + 128 + (m & 127); }
    if (n < 2048) { const int m = n - 1024, sec = m >> 9, mm = m & 511, p = mm >> 8, r = mm & 255, wc = r >> 6, d = r & 63, bj = d >> 5, j = d & 31;
        return 256 * (4 + 2 * sec + p) + 128 * bj + 32 * wc + j; }
    return n; } };
struct RmGlu { int half; __device__ __forceinline__ int operator()(int n) const { return 256 * (n >> 7) + 128 * half + (n & 127); } };

template <class KAT> __device__ __forceinline__ void p0_prologue(Frame& F, KAT KA) {
#define in KA->in
    LAS float* sc = (LAS float*)F.lds;
    const int w = F.bx, bg = w & 3;
    const float* c = in[1];
    for (int i = F.tid; i < 8 * 1024; i += 512) { const float v = c[(size_t)bg * 8 * 1024 + i]; sc[i] = v / (1.0f + __expf(-v)); }
    __syncthreads();
    if (F.wave < 6) {
        const int chunk = (w >> 2) * 6 + F.wave, l = chunk / 192, cc = chunk % 192, col = cc * 32 + (F.lane & 31), kh = F.lane >> 5;
        const float* W = in[2] + (size_t)l * 1024 * 6144 + col;
        float acc[8];
#pragma unroll
        for (int bb = 0; bb < 8; ++bb) acc[bb] = 0.f;
        for (int k = kh * 512; k < kh * 512 + 512; k += 16) {
            float wv[16];
#pragma unroll
            for (int q = 0; q < 16; ++q) wv[q] = W[(size_t)(k + q) * 6144];
#pragma unroll
            for (int q4 = 0; q4 < 4; ++q4)
#pragma unroll
                for (int bb = 0; bb < 8; ++bb) { const f32x4 s = *(const LAS f32x4*)(sc + bb * 1024 + k + 4 * q4); acc[bb] += (s[0] * wv[4 * q4] + s[1] * wv[4 * q4 + 1]) + (s[2] * wv[4 * q4 + 2] + s[3] * wv[4 * q4 + 3]); }
        }
        float* mod = (float*)(F.ws + WS_MOD);
#pragma unroll
        for (int bb = 0; bb < 8; ++bb) { const float t = acc[bb] + __shfl_xor(acc[bb], 32);
            if (F.lane < 32) mod[((size_t)l * 32 + bg * 8 + bb) * 6144 + col] = t + in[3][(size_t)l * 6144 + col]; }
    }
    __syncthreads();
    LAS float* scr = (LAS float*)(F.lds + F.wave * 16640);
    const int gw = F.vcu * NWAVES + F.wave, NGW = F.G * NWAVES;
    bf16* WEVIN = (bf16*)(F.ws + WS_WEVIN); bf16* WEVOUT = (bf16*)(F.ws + WS_WEVOUT); bf16* WODIN = (bf16*)(F.ws + WS_WODIN); bf16* WODOUT = (bf16*)(F.ws + WS_WODOUT);
    bf16* WRG = (bf16*)(F.ws + WS_WRG); bf16* WIG = (bf16*)(F.ws + WS_WIG); bf16* W13 = (bf16*)(F.ws + WS_W13); bf16* W2 = (bf16*)(F.ws + WS_W2);
    constexpr int I_EVIN = 16 * 40, I_SQ = 16 * 16, I_ODIN = 16 * 32, I_W1 = 16 * 8, I_W2 = 8 * 16, I_G = 2 * 2;
    constexpr int NITEMS = I_EVIN + 2 * I_SQ + I_ODIN + 32 * I_W1 * 2 + 32 * I_W2 + 16 * I_G;
    for (int it = gw; it < NITEMS; it += NGW) {
        int r = it;
        if (r < I_EVIN) { p0_transpose_item(in[6], 1024, 2560, WEVIN, scr, r, F.lane, RmEvIn{}); continue; } r -= I_EVIN;
        if (r < I_SQ) { p0_transpose_item(in[13], 1024, 1024, WEVOUT, scr, r, F.lane, RmId{}); continue; } r -= I_SQ;
        if (r < I_ODIN) { p0_transpose_item(in[14], 1024, 2048, WODIN, scr, r, F.lane, RmId{}); continue; } r -= I_ODIN;
        if (r < I_SQ) { p0_transpose_item(in[22], 1024, 1024, WODOUT, scr, r, F.lane, RmId{}); continue; } r -= I_SQ;
        if (r < 32 * I_W1) { const int mat = r / I_W1; p0_transpose_item<true>(in[25] + (size_t)mat * 1024 * 512, 1024, 512, (bf16*)((unsigned char*)W13 + (size_t)mat * 1024 * 1024), scr, r % I_W1, F.lane, RmGlu{0}); continue; } r -= 32 * I_W1;
        if (r < 32 * I_W1) { const int mat = r / I_W1; p0_transpose_item<true>(in[26] + (size_t)mat * 1024 * 512, 1024, 512, (bf16*)((unsigned char*)W13 + (size_t)mat * 1024 * 1024), scr, r % I_W1, F.lane, RmGlu{1}); continue; } r -= 32 * I_W1;
        if (r < 32 * I_W2) { const int mat = r / I_W2; p0_transpose_item<true>(in[27] + (size_t)mat * 512 * 1024, 512, 1024, (bf16*)((unsigned char*)W2 + (size_t)mat * 1024 * 512), scr, r % I_W2, F.lane, RmId{}); continue; } r -= 32 * I_W2;
        { const int mat = r / I_G, which = mat >> 3, blk = mat & 7;
          p0_transpose_item((which ? in[19] : in[17]) + (size_t)blk * 128 * 128, 128, 128, (which ? WIG : WRG) + (size_t)blk * 128 * 128, scr, r % I_G, F.lane, RmId{}); }
    }
#undef in
}

__device__ __forceinline__ void norm_rows(Frame& F, const float* X, bf16* H, const float* ng, const float* modl, int sh_off, int sc_off) {
    const int gw = F.bx * NWAVES + F.wave;
    const int b = gw >> 6;
    f32x4 gm[4], sh[4];
#pragma unroll
    for (int j = 0; j < 4; ++j) { const int k = 256 * j + 4 * F.lane;
        const f32x4 g = *(const f32x4*)(ng + k), s = *(const f32x4*)(modl + (size_t)b * 6144 + sc_off + k);
        gm[j] = g * (s + 1.0f); sh[j] = *(const f32x4*)(modl + (size_t)b * 6144 + sh_off + k); }
    for (int r = 0; r < 32; r += 4) {
        const size_t row = (size_t)gw * 32 + r;
        f32x4 v[4][4]; float ss[4];
#pragma unroll
        for (int q = 0; q < 4; ++q)
#pragma unroll
            for (int j = 0; j < 4; ++j) v[q][j] = *(const f32x4*)(X + (row + q) * DM + 256 * j + 4 * F.lane);
#pragma unroll
        for (int q = 0; q < 4; ++q) { ss[q] = 0.f;
#pragma unroll
            for (int j = 0; j < 4; ++j) ss[q] += (v[q][j][0] * v[q][j][0] + v[q][j][1] * v[q][j][1]) + (v[q][j][2] * v[q][j][2] + v[q][j][3] * v[q][j][3]); }
#pragma unroll
        for (int q = 0; q < 4; ++q) {
            const float rstd = 1.0f / sqrtf(wave_sum(ss[q]) * (1.0f / DM) + EPS);
#pragma unroll
            for (int j = 0; j < 4; ++j) { const f32x4 o = v[q][j] * rstd * gm[j] + sh[j];
                v2u w; w.x = pk2(o[0], o[1]); w.y = pk2(o[2], o[3]); *(v2u*)(H + (row + q) * DM + 256 * j + 4 * F.lane) = w; }
        }
    }
}

namespace sba {
constexpr int SLOTB = 8192, L_K = 0, L_V = 2 * SLOTB, L_FLAG = 4 * SLOTB, L_OST = 4 * SLOTB + 256;
__device__ __forceinline__ s16x4 vtr(const LAS unsigned char* p) { typedef short v4i16_t __attribute__((ext_vector_type(4))); return __builtin_bit_cast(s16x4, __builtin_amdgcn_ds_read_tr16_b64_v4i16((LAS v4i16_t*)p)); }
__device__ __forceinline__ void unit(int b, int h, int qb, const bf16* Q, const bf16* K, const bf16* V, bf16* CAT, LAS unsigned char* lds) {
    const int tid = threadIdx.x, lane = tid & 63, r32 = lane & 31, hi = lane >> 5; const int wid = __builtin_amdgcn_readfirstlane(tid >> 6);
    const long rowbase = (long)b * SEQ; const int q0 = qb * 256;
    const bf16* Qw = Q + (rowbase + q0 + wid * 32) * SBW + h * HD;
    const bf16* Kh = K + rowbase * SBW + h * HD; const bf16* Vh = V + rowbase * SBW + h * HD;
    const bf16* ksrc = Kh + (long)lane * SBW + wid * 8;
    const bf16* vsrc = Vh + (long)(16 * (wid & 3) + (lane >> 2)) * SBW + (wid >> 2) * 32 + (lane & 3) * 8;
    LAS unsigned char* kdst = lds + L_K + wid * 1024; LAS unsigned char* vdst = lds + L_V + wid * 1024;
#define SBA_DMA(t, slot) do { __builtin_amdgcn_global_load_lds((const unsigned*)(ksrc + (long)(t) * 64 * SBW), (LAS unsigned*)(kdst + (slot) * SLOTB), 16, 0, 0); \
                              __builtin_amdgcn_global_load_lds((const unsigned*)(vsrc + (long)(t) * 64 * SBW), (LAS unsigned*)(vdst + (slot) * SLOTB), 16, 0, 0); } while (0)
    const LAS unsigned char* kp0 = lds + L_K + hi * 1024 + r32 * 16;
    const LAS unsigned char* vp0 = lds + L_V + ((lane >> 4) & 1) * 32 + (lane & 3) * 8 + (4 * hi + ((lane & 15) >> 2)) * 64;
    volatile LAS unsigned* flags = (volatile LAS unsigned*)(lds + L_FLAG);
    const int NT = (q0 + 256) / 64;
    SBA_DMA(NT - 1, 0);
    bf16x8 qr[4];
#pragma unroll
    for (int d0 = 0; d0 < 4; ++d0) qr[d0] = *(const bf16x8*)(Qw + (long)r32 * SBW + d0 * 16 + hi * 8);
    f32x16 o0 = {}, o1 = {};
    float carry = 1.0f; bool done_w = false;
    const int qrow = q0 + wid * 32 + r32, qmin = q0 + wid * 32;
    for (int it = 0, t = NT - 1; t >= 0; --t, ++it) {
        const int slot = it & 1;
        __syncthreads();
        if (it > 0) { unsigned all = 1u;
#pragma unroll
            for (int w8 = 0; w8 < 8; ++w8) all &= flags[((it - 1) & 1) * 8 + w8];
            if (all) break; }
        if (t > 0) SBA_DMA(t - 1, slot ^ 1);
        const int kbase = 64 * t;
        if (!done_w && kbase < qmin + 31) {
            const LAS unsigned char* kp = kp0 + slot * SLOTB;
            bf16x8 kf[8];
#pragma unroll
            for (int d0 = 0; d0 < 4; ++d0) { kf[2 * d0] = *(const LAS bf16x8*)(kp + d0 * 2048); kf[2 * d0 + 1] = *(const LAS bf16x8*)(kp + d0 * 2048 + 512); }
            f32x16 C0 = {}, C1 = {};
#pragma unroll
            for (int d0 = 0; d0 < 4; ++d0) { C0 = __builtin_amdgcn_mfma_f32_32x32x16_bf16(kf[2 * d0], qr[d0], C0, 0, 0, 0); C1 = __builtin_amdgcn_mfma_f32_32x32x16_bf16(kf[2 * d0 + 1], qr[d0], C1, 0, 0, 0); }
            f32x16 D0, D1;
            const bool partial = (kbase + 64 > qmin);
#pragma unroll
            for (int r = 0; r < 16; ++r) {
                const float s0 = __builtin_fminf(__builtin_fmaxf(C0[r], -120.f), 120.f), s1 = __builtin_fminf(__builtin_fmaxf(C1[r], -120.f), 120.f);
                float e0 = fast_exp2(s0), e1 = fast_exp2(s1);
                float f0 = fast_rcp(1.0f + e0), f1 = fast_rcp(1.0f + e1);
                if (partial) { const int kp_ = kbase + 4 * hi + (r & 3) + 8 * (r >> 2);
                    if (!(kp_ < qrow)) { e0 = 0.f; f0 = 1.f; }
                    if (!(kp_ + 32 < qrow)) { e1 = 0.f; f1 = 1.f; } }
                C0[r] = e0; C1[r] = e1; D0[r] = f0; D1[r] = f1;
            }
            float own[8], par[8], eg[8];
#pragma unroll
            for (int g = 0; g < 4; ++g) {
                D0[4 * g + 2] *= D0[4 * g + 3]; D0[4 * g + 1] *= D0[4 * g + 2]; D0[4 * g] *= D0[4 * g + 1]; own[g] = D0[4 * g];
                D1[4 * g + 2] *= D1[4 * g + 3]; D1[4 * g + 1] *= D1[4 * g + 2]; D1[4 * g] *= D1[4 * g + 1]; own[4 + g] = D1[4 * g];
            }
#pragma unroll
            for (int j = 0; j < 8; ++j) par[j] = __shfl_xor(own[j], 32);
            float sp = carry;
#pragma unroll
            for (int j = 7; j >= 0; --j) { eg[j] = hi ? sp : sp * par[j]; sp *= own[j] * par[j]; }
            carry = sp;
#pragma unroll
            for (int g = 0; g < 4; ++g)
#pragma unroll
                for (int i = 0; i < 4; ++i) { C0[4 * g + i] = (C0[4 * g + i] * D0[4 * g + i]) * eg[g]; C1[4 * g + i] = (C1[4 * g + i] * D1[4 * g + i]) * eg[4 + g]; }
            v4u pw0, pw1, pw2, pw3;
            pw0 = (v4u){pk2(C0[0], C0[1]), pk2(C0[2], C0[3]), pk2(C0[4], C0[5]), pk2(C0[6], C0[7])};
            pw1 = (v4u){pk2(C0[8], C0[9]), pk2(C0[10], C0[11]), pk2(C0[12], C0[13]), pk2(C0[14], C0[15])};
            pw2 = (v4u){pk2(C1[0], C1[1]), pk2(C1[2], C1[3]), pk2(C1[4], C1[5]), pk2(C1[6], C1[7])};
            pw3 = (v4u){pk2(C1[8], C1[9]), pk2(C1[10], C1[11]), pk2(C1[12], C1[13]), pk2(C1[14], C1[15])};
            const LAS unsigned char* vp = vp0 + slot * SLOTB;
#pragma unroll
            for (int d0 = 0; d0 < 2; ++d0) {
                s16x4 lo[4], hh[4];
#pragma unroll
                for (int ks = 0; ks < 4; ++ks) { lo[ks] = vtr(vp + d0 * 4096 + ks * 1024); hh[ks] = vtr(vp + d0 * 4096 + ks * 1024 + 512); }
#define SBA_VF(k) (bf16x8){lo[k][0], lo[k][1], lo[k][2], lo[k][3], hh[k][0], hh[k][1], hh[k][2], hh[k][3]}
                f32x16 oo = d0 ? o1 : o0;
                oo = __builtin_amdgcn_mfma_f32_32x32x16_bf16(__builtin_bit_cast(bf16x8, pw0), SBA_VF(0), oo, 0, 0, 0);
                oo = __builtin_amdgcn_mfma_f32_32x32x16_bf16(__builtin_bit_cast(bf16x8, pw1), SBA_VF(1), oo, 0, 0, 0);
                oo = __builtin_amdgcn_mfma_f32_32x32x16_bf16(__builtin_bit_cast(bf16x8, pw2), SBA_VF(2), oo, 0, 0, 0);
                oo = __builtin_amdgcn_mfma_f32_32x32x16_bf16(__builtin_bit_cast(bf16x8, pw3), SBA_VF(3), oo, 0, 0, 0);
                if (d0) o1 = oo; else o0 = oo;
#undef SBA_VF
            }
            done_w = __all(carry < 1e-30f);
        }
        if (lane == 0) flags[slot * 8 + wid] = done_w ? 1u : 0u;
    }
    {
        LAS bf16* stg = (LAS bf16*)(lds + L_OST) + wid * 2048;
#pragma unroll
        for (int r = 0; r < 16; ++r) { const int orow = (r & 3) + 8 * (r >> 2) + 4 * hi;
            stg[orow * 64 + r32] = (bf16)(pk2(o0[r], 0.f) & 0xffffu); stg[orow * 64 + 32 + r32] = (bf16)(pk2(o1[r], 0.f) & 0xffffu); }
        asm volatile("s_waitcnt lgkmcnt(0)" ::: "memory");
        bf16* Ow = CAT + (rowbase + q0 + wid * 32) * DM + 512 + h * HD;
#pragma unroll
        for (int i = 0; i < 4; ++i) { const int row = i * 8 + (lane >> 3), ch = lane & 7; const v4u v = *(const LAS v4u*)(stg + row * 64 + ch * 8); *(v4u*)(Ow + (long)row * DM + ch * 8) = v; }
    }
    __syncthreads();
#undef SBA_DMA
}
}

__device__ __forceinline__ void conv_prefetch(Frame& F, v4u (&pf)[8], int uidx, const bf16* U0) {
    const int b = uidx >> 6, t0 = (uidx & 63) * 32;
#pragma unroll
    for (int i = 0; i < 8; ++i) { const int idx = F.tid + 512 * i; const int ri = idx >> 6, ch = idx & 63, tok = t0 - 30 + ri;
        pf[i] = (v4u){0u, 0u, 0u, 0u};
        if (idx < 62 * 64 && tok >= 0) pf[i] = *(const v4u*)(U0 + ((size_t)b * SEQ + tok) * CONVC + ch * 8); }
}
__device__ __forceinline__ void conv_phase(Frame& F, const bf16* U0, bf16* CAT, const float* dw_w, const float* dw_b, const float* ln_g, const float* ln_b) {
    LAS unsigned char* tile = F.lds;
    LAS float* resl = (LAS float*)(F.lds + 63488);
    v4u pf[8];
    const int nunits = NB * (SEQ / 32);
    if (F.vcu < nunits) conv_prefetch(F, pf, F.vcu, U0);
    for (int uidx = F.vcu; uidx < nunits; uidx += F.G) {
        const int b = uidx >> 6, t0 = (uidx & 63) * 32;
#pragma unroll
        for (int i = 0; i < 8; ++i) { const int idx = F.tid + 512 * i; if (idx < 62 * 64) *(LAS v4u*)(tile + idx * 16) = pf[i]; }
        __syncthreads();
        if (uidx + F.G < nunits) conv_prefetch(F, pf, uidx + F.G, U0);
        {
            const int cp = F.tid & 255, th = F.tid >> 8;
            float w0[31], w1[31];
#pragma unroll
            for (int k = 0; k < 31; ++k) { const f32x2 wv = *(const f32x2*)(dw_w + k * CONVC + 2 * cp); w0[k] = wv[0]; w1[k] = wv[1]; }
            const f32x2 bias = *(const f32x2*)(dw_b + 2 * cp);
#pragma unroll 1
            for (int og = 0; og < 2; ++og) {
                float a0[8], a1[8];
#pragma unroll
                for (int o = 0; o < 8; ++o) { a0[o] = bias[0]; a1[o] = bias[1]; }
                const LAS unsigned char* tp = tile + (16 * th + 8 * og) * 1024 + cp * 4;
#pragma unroll
                for (int j = 0; j < 38; ++j) {
                    const unsigned xin = *(const LAS unsigned*)(tp + j * 1024);
                    const float x0 = bflo(xin), x1 = bfhi(xin);
#pragma unroll
                    for (int o = 0; o < 8; ++o) { const int k = j - o; if (k >= 0 && k <= 30) { a0[o] += w0[k] * x0; a1[o] += w1[k] * x1; } }
                }
#pragma unroll
                for (int o = 0; o < 8; ++o) *(LAS f32x2*)(resl + (16 * th + 8 * og + o) * 512 + 2 * cp) = (f32x2){a0[o], a1[o]};
            }
        }
        __syncthreads();
        {
            const f32x4 lg0 = *(const f32x4*)(ln_g + 8 * F.lane), lg1 = *(const f32x4*)(ln_g + 8 * F.lane + 4), lb0 = *(const f32x4*)(ln_b + 8 * F.lane), lb1 = *(const f32x4*)(ln_b + 8 * F.lane + 4);
#pragma unroll
            for (int i = 0; i < 4; ++i) {
                const int tk = F.wave * 4 + i;
                const f32x4 v0 = *(const LAS f32x4*)(resl + tk * 512 + 8 * F.lane), v1 = *(const LAS f32x4*)(resl + tk * 512 + 8 * F.lane + 4);
                const float sm = wave_sum((v0[0] + v0[1]) + (v0[2] + v0[3]) + (v1[0] + v1[1]) + (v1[2] + v1[3]));
                const float mean = sm * (1.0f / CONVC);
                const f32x4 d0 = v0 - mean, d1 = v1 - mean;
                const float q = wave_sum((d0[0] * d0[0] + d0[1] * d0[1]) + (d0[2] * d0[2] + d0[3] * d0[3]) + (d1[0] * d1[0] + d1[1] * d1[1]) + (d1[2] * d1[2] + d1[3] * d1[3]));
                const float rstd = 1.0f / sqrtf(q * (1.0f / CONVC) + EPS);
                const f32x4 y0 = d0 * rstd * lg0 + lb0, y1 = d1 * rstd * lg1 + lb1;
                v4u pw; pw.x = pk2(siluf_(y0[0]), siluf_(y0[1])); pw.y = pk2(siluf_(y0[2]), siluf_(y0[3])); pw.z = pk2(siluf_(y1[0]), siluf_(y1[1])); pw.w = pk2(siluf_(y1[2]), siluf_(y1[3]));
                *(v4u*)(CAT + ((size_t)b * SEQ + t0 + tk) * DM + 8 * F.lane) = pw;
            }
        }
        __syncthreads();
    }
}

__device__ __forceinline__ void lru_unit(Frame& F, int b, int cb, const bf16* GY, const bf16* XB, bf16* CAT2, const bf16* WRG, const bf16* WIG,
                                         const float* conv_w, const float* conv_b, const float* rg_b, const float* ig_b, const float* lam) {
    constexpr int L_XR = 0, L_XC = 17408, L_GY = 34816, L_OUT = 51200;
    LAS unsigned char* lds = F.lds;
    const int lane = F.lane, wv = F.wave, l15 = lane & 15, g4 = lane >> 4;
    const int cl_ = 16 * wv + l15, cglob = cb * 128 + cl_;
    bf16x8 brg[4], big[4];
#pragma unroll
    for (int ks = 0; ks < 4; ++ks) { brg[ks] = *(const bf16x8*)(WRG + ((size_t)cb * 128 + cl_) * 128 + 32 * ks + 8 * g4); big[ks] = *(const bf16x8*)(WIG + ((size_t)cb * 128 + cl_) * 128 + 32 * ks + 8 * g4); }
    const float rb = rg_b[cglob], ib = ig_b[cglob];
    const float lamv = lam[cglob];
    const float cl2 = -8.0f * log1pf(expf(-lamv)) * 1.4426950408889634f;
    const int cp2 = F.tid & 63;
    float cw0[4], cw1[4];
#pragma unroll
    for (int k = 0; k < 4; ++k) { const f32x2 w = *(const f32x2*)(conv_w + k * DM + cb * 128 + 2 * cp2); cw0[k] = w[0]; cw1[k] = w[1]; }
    const f32x2 cbias = *(const f32x2*)(conv_b + cb * 128 + 2 * cp2);
    const size_t rowb = (size_t)b * SEQ;
    v4u px[3], pg[2];
#define LRU_PREFETCH(t0_) do { \
        _Pragma("unroll") for (int i = 0; i < 3; ++i) { const int idx = F.tid + 512 * i; px[i] = (v4u){0u, 0u, 0u, 0u}; \
            if (idx < 67 * 16) { const int ri = idx >> 4, chn = idx & 15, tok = (t0_) - 3 + ri; if (tok >= 0) px[i] = *(const v4u*)(XB + (rowb + tok) * DM + cb * 128 + chn * 8); } } \
        _Pragma("unroll") for (int i = 0; i < 2; ++i) { const int idx = F.tid + 512 * i; const int ri = idx >> 4, chn = idx & 15; pg[i] = *(const v4u*)(GY + (rowb + (t0_) + ri) * DM + cb * 128 + chn * 8); } } while (0)
    LRU_PREFETCH(0);
    float carry = 0.f;
    for (int it = 0; it < SEQ / 64; ++it) {
        const int t0 = it * 64;
#pragma unroll
        for (int i = 0; i < 3; ++i) { const int idx = F.tid + 512 * i; if (idx < 67 * 16) *(LAS v4u*)(lds + L_XR + idx * 16) = px[i]; }
#pragma unroll
        for (int i = 0; i < 2; ++i) { const int idx = F.tid + 512 * i; *(LAS v4u*)(lds + L_GY + idx * 16) = pg[i]; }
        __syncthreads();
        if (it + 1 < SEQ / 64) LRU_PREFETCH(t0 + 64);
        {
            float x0[11], x1[11];
#pragma unroll
            for (int j = 0; j < 11; ++j) { const unsigned xin = *(const LAS unsigned*)(lds + L_XR + (8 * wv + j) * 256 + cp2 * 4); x0[j] = bflo(xin); x1[j] = bfhi(xin); }
#pragma unroll
            for (int o = 0; o < 8; ++o) {
                const float y0 = cbias[0] + (cw0[0] * x0[o] + cw0[1] * x0[o + 1]) + (cw0[2] * x0[o + 2] + cw0[3] * x0[o + 3]);
                const float y1 = cbias[1] + (cw1[0] * x1[o] + cw1[1] * x1[o + 1]) + (cw1[2] * x1[o + 2] + cw1[3] * x1[o + 3]);
                *(LAS unsigned*)(lds + L_XC + (8 * wv + o) * 272 + cp2 * 4) = pk2(y0, y1);
            }
        }
        __syncthreads();
        float av[4][4], bv[4][4], gy[4][4], Ae[4], Be[4], At[4], Bt[4];
#pragma unroll
        for (int m = 0; m < 4; ++m) {
            f32x4 aR = {0.f, 0.f, 0.f, 0.f}, aI = {0.f, 0.f, 0.f, 0.f};
#pragma unroll
            for (int ks = 0; ks < 4; ++ks) { const bf16x8 af = *(const LAS bf16x8*)(lds + L_XC + (16 * m + l15) * 272 + (32 * ks + 8 * g4) * 2);
                aR = __builtin_amdgcn_mfma_f32_16x16x32_bf16(af, brg[ks], aR, 0, 0, 0); aI = __builtin_amdgcn_mfma_f32_16x16x32_bf16(af, big[ks], aI, 0, 0, 0); }
            float A = 1.f, B = 0.f;
#pragma unroll
            for (int r = 0; r < 4; ++r) {
                const int tk = 16 * m + 4 * g4 + r;
                const float xcv = bf2f(*(const LAS bf16*)(lds + L_XC + tk * 272 + cl_ * 2));
                gy[m][r] = bf2f(*(const LAS bf16*)(lds + L_GY + tk * 256 + cl_ * 2));
                const float rr = sigmoidf_(aR[r] + rb), ii = sigmoidf_(aI[r] + ib);
                const float a = fast_exp2(cl2 * rr);
                const float mult = sqrtf(__builtin_fmaxf(1.0f - a * a, 0.f));
                av[m][r] = a; bv[m][r] = mult * ii * xcv;
                B = a * B + bv[m][r]; A = A * a;
            }
            { const float Ap = __shfl_up(A, 16), Bp = __shfl_up(B, 16); if (g4 >= 1) { B = A * Bp + B; A = A * Ap; } }
            { const float Ap = __shfl_up(A, 32), Bp = __shfl_up(B, 32); if (g4 >= 2) { B = A * Bp + B; A = A * Ap; } }
            { const float Ap = __shfl_up(A, 16), Bp = __shfl_up(B, 16); Ae[m] = (g4 == 0) ? 1.f : Ap; Be[m] = (g4 == 0) ? 0.f : Bp; }
            At[m] = __shfl(A, 48 + l15); Bt[m] = __shfl(B, 48 + l15);
        }
#pragma unroll
        for (int m = 0; m < 4; ++m) {
            float hcur = Ae[m] * carry + Be[m];
            carry = At[m] * carry + Bt[m];
#pragma unroll
            for (int r = 0; r < 4; ++r) { hcur = av[m][r] * hcur + bv[m][r]; const int tk = 16 * m + 4 * g4 + r;
                *(LAS bf16*)(lds + L_OUT + tk * 256 + cl_ * 2) = (bf16)(pk2(gy[m][r] * hcur, 0.f) & 0xffffu); }
        }
        __syncthreads();
#pragma unroll
        for (int i = 0; i < 2; ++i) { const int idx = F.tid + 512 * i; const int ri = idx >> 4, chn = idx & 15;
            *(v4u*)(CAT2 + (rowb + t0 + ri) * DM + cb * 128 + chn * 8) = *(const LAS v4u*)(lds + L_OUT + idx * 16); }
    }
    __syncthreads();
#undef LRU_PREFETCH
}

__device__ __forceinline__ void router_phase(Frame& F, const float* X, bf16* H, const float* ng, const float* modl, const float* rw, const float* rbias) {
    constexpr int WSTR = 2064;
    LAS unsigned char* whi = F.lds;
    LAS unsigned char* wlo = F.lds + 16 * WSTR;
    LAS float* gml = (LAS float*)(F.lds + 67584);
    LAS float* shl = (LAS float*)(F.lds + 71680);
    LAS float* brl = (LAS float*)(F.lds + 75776);
    LAS int* cnt = (LAS int*)(F.lds + 75776 + 64);
    LAS float* pbr = (LAS float*)(F.lds + 75776 + 128);
    LAS float* exl = (LAS float*)(F.lds + 77824);
    LAS float* exs = (LAS float*)(F.lds + 77824 + 16384);
    const int w = F.bx, b = w >> 3;
    for (int i = F.tid; i < 16 * 1024; i += 512) { const int k = i >> 4, e = i & 15; const float v = rw[i]; const unsigned hb = pk2(v, 0.f) & 0xffffu; const float lo = v - bflo(hb);
        *(LAS bf16*)(whi + e * WSTR + k * 2) = (bf16)hb; *(LAS bf16*)(wlo + e * WSTR + k * 2) = (bf16)(pk2(lo, 0.f) & 0xffffu); }
    for (int k = F.tid; k < 1024; k += 512) { gml[k] = ng[k] * (1.0f + modl[(size_t)b * 6144 + 4 * 1024 + k]); shl[k] = modl[(size_t)b * 6144 + 3 * 1024 + k]; }
    if (F.tid < 16) cnt[F.tid] = 0;
    __syncthreads();
    {
        float acc[16];
#pragma unroll
        for (int e = 0; e < 16; ++e) acc[e] = 0.f;
#pragma unroll
        for (int i = 0; i < 2; ++i) { const int k = 128 * F.wave + 64 * i + F.lane; const float sv = shl[k];
#pragma unroll
            for (int q = 0; q < 4; ++q) { const f32x4 wv = *(const f32x4*)(rw + k * 16 + 4 * q); acc[4 * q] += sv * wv[0]; acc[4 * q + 1] += sv * wv[1]; acc[4 * q + 2] += sv * wv[2]; acc[4 * q + 3] += sv * wv[3]; } }
#pragma unroll
        for (int e = 0; e < 16; ++e) { const float t = wave_sum(acc[e]); if (F.lane == 0) pbr[F.wave * 16 + e] = t; }
    }
    __syncthreads();
    if (F.tid < 16) { float t = 0.f;
#pragma unroll
        for (int q = 0; q < 8; ++q) t += pbr[q * 16 + F.tid]; brl[F.tid] = t; }
    __syncthreads();
    const int r16 = F.lane & 15, kq = F.lane >> 4, g = F.wave >> 2, kp = F.wave & 3;
    int* EID = (int*)(F.ws + META_EID); float* GATE = (float*)(F.ws + META_GATE);
    f32x4 xn[8][2];
    { const size_t row0 = (size_t)w * 256 + 16 * g + r16;
#pragma unroll
      for (int cc = 0; cc < 8; ++cc) { const int col = 256 * kp + 32 * cc + 8 * kq; xn[cc][0] = *(const f32x4*)(X + row0 * DM + col); xn[cc][1] = *(const f32x4*)(X + row0 * DM + col + 4); } }
    for (int pass = 0; pass < 8; ++pass) {
        const int buf = pass & 1;
        const size_t row = (size_t)w * 256 + 32 * pass + 16 * g + r16;
        f32x4 xg[8][2]; float ss = 0.f; f32x4 acc = {0.f, 0.f, 0.f, 0.f};
#pragma unroll
        for (int cc = 0; cc < 8; ++cc) {
            const int col = 256 * kp + 32 * cc + 8 * kq;
            const f32x4 x0 = xn[cc][0], x1 = xn[cc][1];
            ss += (x0[0] * x0[0] + x0[1] * x0[1]) + (x0[2] * x0[2] + x0[3] * x0[3]) + (x1[0] * x1[0] + x1[1] * x1[1]) + (x1[2] * x1[2] + x1[3] * x1[3]);
            const f32x4 a0 = x0 * *(const LAS f32x4*)(gml + col), a1 = x1 * *(const LAS f32x4*)(gml + col + 4);
            xg[cc][0] = a0; xg[cc][1] = a1;
            v4u hi; hi.x = pk2(a0[0], a0[1]); hi.y = pk2(a0[2], a0[3]); hi.z = pk2(a1[0], a1[1]); hi.w = pk2(a1[2], a1[3]);
            v4u lo; lo.x = pk2(a0[0] - bflo(hi.x), a0[1] - bfhi(hi.x)); lo.y = pk2(a0[2] - bflo(hi.y), a0[3] - bfhi(hi.y)); lo.z = pk2(a1[0] - bflo(hi.z), a1[1] - bfhi(hi.z)); lo.w = pk2(a1[2] - bflo(hi.w), a1[3] - bfhi(hi.w));
            const bf16x8 bh = *(const LAS bf16x8*)(whi + r16 * WSTR + col * 2), bl = *(const LAS bf16x8*)(wlo + r16 * WSTR + col * 2);
            acc = __builtin_amdgcn_mfma_f32_16x16x32_bf16(__builtin_bit_cast(bf16x8, hi), bh, acc, 0, 0, 0);
            acc = __builtin_amdgcn_mfma_f32_16x16x32_bf16(__builtin_bit_cast(bf16x8, lo), bh, acc, 0, 0, 0);
            acc = __builtin_amdgcn_mfma_f32_16x16x32_bf16(__builtin_bit_cast(bf16x8, hi), bl, acc, 0, 0, 0);
        }
        {
            const size_t rown = pass < 7 ? row + 32 : row;
#pragma unroll
            for (int cc = 0; cc < 8; ++cc) { const int col = 256 * kp + 32 * cc + 8 * kq; xn[cc][0] = *(const f32x4*)(X + rown * DM + col); xn[cc][1] = *(const f32x4*)(X + rown * DM + col + 4); }
        }
        ss += __shfl_xor(ss, 16); ss += __shfl_xor(ss, 32);
        { LAS float* ep = exl + (((buf * 2 + g) * 4 + kp) * 16) * 16;
#pragma unroll
          for (int rg = 0; rg < 4; ++rg) ep[(4 * kq + rg) * 16 + r16] = acc[rg];
          if (kq == 0) exs[((buf * 2 + g) * 4 + kp) * 16 + r16] = ss; }
        __syncthreads();
        float sst = 0.f;
#pragma unroll
        for (int q = 0; q < 4; ++q) sst += exs[((buf * 2 + g) * 4 + q) * 16 + r16];
        const float rstd = 1.0f / sqrtf(sst * (1.0f / DM) + EPS);
#pragma unroll
        for (int cc = 0; cc < 8; ++cc) { const int col = 256 * kp + 32 * cc + 8 * kq;
            const f32x4 o0 = xg[cc][0] * rstd + *(const LAS f32x4*)(shl + col), o1 = xg[cc][1] * rstd + *(const LAS f32x4*)(shl + col + 4);
            v2u pw; pw.x = pk4_fp8(o0[0], o0[1], o0[2], o0[3]); pw.y = pk4_fp8(o1[0], o1[1], o1[2], o1[3]);
            *(v2u*)((unsigned char*)H + row * DM + col) = pw; }
        if (kp == 0 && kq == 0) {
            float sc[16], bi[16];
#pragma unroll
            for (int e4 = 0; e4 < 4; ++e4) { f32x4 t = {0.f, 0.f, 0.f, 0.f};
#pragma unroll
                for (int q = 0; q < 4; ++q) t += *(const LAS f32x4*)(exl + ((((buf * 2 + g) * 4 + q) * 16) + r16) * 16 + 4 * e4);
#pragma unroll
                for (int i = 0; i < 4; ++i) { const int e = 4 * e4 + i; const float lg = t[i] * rstd + brl[e]; sc[e] = 1.0f / (1.0f + __expf(-lg)); bi[e] = sc[e] + rbias[e]; } }
            int gbest = 0; float gsb = -1e30f;
#pragma unroll
            for (int gg = 0; gg < 4; ++gg) {
                float m1 = bi[4 * gg], m2 = -1e30f;
#pragma unroll
                for (int i = 1; i < 4; ++i) { const float v = bi[4 * gg + i]; if (v > m1) { m2 = m1; m1 = v; } else if (v > m2) m2 = v; }
                const float gs = m1 + m2; if (gs > gsb) { gsb = gs; gbest = gg; }
            }
            float v4[4], s4[4];
#pragma unroll
            for (int i = 0; i < 4; ++i) { v4[i] = gbest == 0 ? bi[i] : gbest == 1 ? bi[4 + i] : gbest == 2 ? bi[8 + i] : bi[12 + i]; s4[i] = gbest == 0 ? sc[i] : gbest == 1 ? sc[4 + i] : gbest == 2 ? sc[8 + i] : sc[12 + i]; }
            int i1 = 0;
#pragma unroll
            for (int i = 1; i < 4; ++i) if (v4[i] > v4[i1]) i1 = i;
            int i2 = (i1 == 0) ? 1 : 0;
#pragma unroll
            for (int i = 0; i < 4; ++i) if (i != i1 && i != i2 && v4[i] > v4[i2]) i2 = i;
            const float se1 = i1 == 0 ? s4[0] : i1 == 1 ? s4[1] : i1 == 2 ? s4[2] : s4[3], se2 = i2 == 0 ? s4[0] : i2 == 1 ? s4[1] : i2 == 2 ? s4[2] : s4[3];
            const int e1 = 4 * gbest + i1, e2 = 4 * gbest + i2; const float inv = 1.0f / (se1 + se2);
            EID[row * 2] = e1; EID[row * 2 + 1] = e2; GATE[row * 2] = se1 * inv; GATE[row * 2 + 1] = se2 * inv;
            atomicAdd((int*)&cnt[e1], 1); atomicAdd((int*)&cnt[e2], 1);
        }
    }
    __syncthreads();
    if (F.tid < 16) ((int*)(F.ws + META_BCNT))[w * 16 + F.tid] = cnt[F.tid];
    __syncthreads();
}

__device__ __forceinline__ void slot_phase(Frame& F) {
    LAS int* cn = (LAS int*)F.lds;
    LAS int* mybase = (LAS int*)(F.lds + 16384);
    LAS int* tot = (LAS int*)(F.lds + 16384 + 64);
    LAS int* cursor = (LAS int*)(F.lds + 16384 + 128);
    LAS int* pstart = (LAS int*)(F.lds + 16384 + 192);
    const int w = F.bx;
    const int* BC = (const int*)(F.ws + META_BCNT);
    int* TOK = (int*)(F.ws + META_TOK);
    for (int i = F.tid; i < 4096; i += 512) cn[i] = BC[i];
    __syncthreads();
    if (F.tid < 16) { int run = 0, mb = 0; for (int j = 0; j < 256; ++j) { if (j == w) mb = run; run += cn[j * 16 + F.tid]; } mybase[F.tid] = mb; tot[F.tid] = run; }
    __syncthreads();
    if (F.tid == 0) {
        int ps = 0; int* TE = (int*)(F.ws + META_TILEE);
        for (int e = 0; e < 16; ++e) { const int padded = (tot[e] + 255) & ~255; cursor[e] = ps + mybase[e]; pstart[e] = ps;
            if (w == 0) for (int tl = ps >> 8; tl < (ps + padded) >> 8; ++tl) TE[tl] = e;
            ps += padded; }
        if (w == 0) *(int*)(F.ws + META_NT) = ps >> 8;
    }
    __syncthreads();
    if (w < 16) { const int s0 = pstart[w] + tot[w], s1 = pstart[w] + ((tot[w] + 255) & ~255); for (int sidx = s0 + F.tid; sidx < s1; sidx += 512) TOK[sidx] = 0; }
    const int* EID = (const int*)(F.ws + META_EID); int* SLOT = (int*)(F.ws + META_SLOT);
    if (F.lane < 32) {
        const size_t t = (size_t)w * 256 + F.wave * 32 + F.lane;
        const v2u ev = *(const v2u*)(EID + t * 2); const int ms0 = atomicAdd((int*)&cursor[ev.x], 1), ms1 = atomicAdd((int*)&cursor[ev.y], 1);
        v2u sv; sv.x = (unsigned)ms0; sv.y = (unsigned)ms1; *(v2u*)(SLOT + t * 2) = sv; TOK[ms0] = (int)t; TOK[ms1] = (int)t;
    }
    __syncthreads();
}

template <bool NEXT>
__device__ __forceinline__ void combine_phase(Frame& F, const float* X, float* XO, const bf16* Y, const float* modl  , bf16* H, const float* ng_next, const float* modn  ) {
    const int gw = F.bx * NWAVES + F.wave, b = gw >> 6;
    const int* SLOT = (const int*)(F.ws + META_SLOT); const float* GATE = (const float*)(F.ws + META_GATE);
    f32x4 g2[4], gm[4], sh[4];
#pragma unroll
    for (int j = 0; j < 4; ++j) { const int k = 256 * j + 4 * F.lane; g2[j] = *(const f32x4*)(modl + (size_t)b * 6144 + 5 * 1024 + k);
        if (NEXT) { const f32x4 g = *(const f32x4*)(ng_next + k), s = *(const f32x4*)(modn + (size_t)b * 6144 + 1 * 1024 + k); gm[j] = g * (s + 1.0f); sh[j] = *(const f32x4*)(modn + (size_t)b * 6144 + k); } }
    const size_t rbase = (size_t)gw * 32;
    int ms0 = 0, ms1 = 0; float mg0 = 0.f, mg1 = 0.f;
    if (F.lane < 32) { const v2u sv = *(const v2u*)(SLOT + (rbase + F.lane) * 2); const f32x2 gv = *(const f32x2*)(GATE + (rbase + F.lane) * 2); ms0 = (int)sv.x; ms1 = (int)sv.y; mg0 = gv[0]; mg1 = gv[1]; }
    for (int r0 = 0; r0 < 32; r0 += 4) {
        f32x4 x[4][4]; v2u ya[4][4], yb[4][4]; float ga[4], gb[4];
#pragma unroll
        for (int q = 0; q < 4; ++q) {
            const int s0 = __builtin_amdgcn_readlane(ms0, r0 + q), s1 = __builtin_amdgcn_readlane(ms1, r0 + q);
            ga[q] = __builtin_bit_cast(float, __builtin_amdgcn_readlane(__builtin_bit_cast(int, mg0), r0 + q)); gb[q] = __builtin_bit_cast(float, __builtin_amdgcn_readlane(__builtin_bit_cast(int, mg1), r0 + q));
#pragma unroll
            for (int j = 0; j < 4; ++j) { const int k = 256 * j + 4 * F.lane;
                x[q][j] = *(const f32x4*)(X + (rbase + r0 + q) * DM + k); ya[q][j] = *(const v2u*)(Y + (size_t)s0 * DM + k); yb[q][j] = *(const v2u*)(Y + (size_t)s1 * DM + k); }
        }
        asm volatile("" ::: "memory");
#pragma unroll
        for (int q = 0; q < 4; ++q) {
            const size_t row = rbase + r0 + q; float ss = 0.f; f32x4 v[4];
#pragma unroll
            for (int j = 0; j < 4; ++j) { const int k = 256 * j + 4 * F.lane;
                f32x4 f; f[0] = ga[q] * bflo(ya[q][j].x) + gb[q] * bflo(yb[q][j].x); f[1] = ga[q] * bfhi(ya[q][j].x) + gb[q] * bfhi(yb[q][j].x); f[2] = ga[q] * bflo(ya[q][j].y) + gb[q] * bflo(yb[q][j].y); f[3] = ga[q] * bfhi(ya[q][j].y) + gb[q] * bfhi(yb[q][j].y);
                v[j] = x[q][j] + g2[j] * f;
                *(f32x4*)(XO + row * DM + k) = v[j];
                ss += (v[j][0] * v[j][0] + v[j][1] * v[j][1]) + (v[j][2] * v[j][2] + v[j][3] * v[j][3]); }
            if (NEXT) {
                const float rstd = 1.0f / sqrtf(wave_sum(ss) * (1.0f / DM) + EPS);
#pragma unroll
                for (int j = 0; j < 4; ++j) { const f32x4 o = v[j] * rstd * gm[j] + sh[j]; v2u pw; pw.x = pk2(o[0], o[1]); pw.y = pk2(o[2], o[3]); *(v2u*)(H + row * DM + 256 * j + 4 * F.lane) = pw; }
            }
        }
    }
}

constexpr int NPHASE = 18;
struct Args { const float* in[28]; float* out; unsigned char* ws; int ph_lo, ph_hi; };
template <int PLO, int PHI> __global__ void __launch_bounds__(NWAVES * 64, 2) mk_fwd(Args args) {
    extern __shared__ __attribute__((aligned(16))) unsigned char lds_raw[];
    Frame F;
    F.lds = (LAS unsigned char*)lds_raw;
    F.tid = threadIdx.x; F.lane = F.tid & 63; F.wave = __builtin_amdgcn_readfirstlane(F.tid >> 6);
    F.G = gridDim.x; F.bx = blockIdx.x; F.vcu = (F.G % 8 == 0) ? (F.bx % 8) * (F.G / 8) + F.bx / 8 : F.bx;
    F.ws = args.ws;
    volatile LAS unsigned* MISC = (volatile LAS unsigned*)(F.lds + MISC_OFF);
    for (int u = F.tid; u < (LDS_BYTES - LDSCTL_OFF) / 4; u += NWAVES * 64) ((LAS unsigned*)(F.lds + LDSCTL_OFF))[u] = 0u;
    __syncthreads();
#if MK_ONE_LAUNCH
    XcdBarrier bar = xcd_barrier_post((unsigned*)(F.ws + WS_CTL) + CW_BAR, MISC + 8);
#define GRID_BAR() do { XcdBarrier b_ = bar; asm volatile("" : "+s"(b_.bar), "+s"(b_.x)); xcd_barrier(b_); } while (0)
#else
#define GRID_BAR() do {} while (0)
#endif
    constexpr int lo = PLO, hi = PHI;
#ifndef PHASE_MASK
#define PHASE_MASK 0x3ffff
#endif
#define IN(k) ((((PHASE_MASK) >> (k)) & 1) && lo <= (k) && (k) < hi)
#ifndef PROBE_REP
#define PROBE_REP 0
#endif
#define REPN(k) (((PROBE_REP) >> (k)) & 1)
#define SEAM(k) do { if (IN(k) && IN((k) + 1)) GRID_BAR(); } while (0)
    typedef const __attribute__((address_space(4))) Args* KArgs; KArgs KA = (KArgs)__builtin_amdgcn_kernarg_segment_ptr();
#define in KA->in
#define PHASE_ENTER() do { KA = (KArgs)__builtin_amdgcn_kernarg_segment_ptr(); asm volatile("" : "+s"(KA)); F.ws = KA->ws; int tid_o = threadIdx.x; asm volatile("" : "+v"(tid_o)); F.tid = tid_o; F.lane = tid_o & 63; F.wave = __builtin_amdgcn_readfirstlane(tid_o >> 6); } while (0)
#define P_MOD ((float*)(F.ws + WS_MOD))
#define P_HA ((bf16*)(F.ws + WS_HA))
#define P_U0 ((bf16*)(F.ws + WS_R1))
#define P_Q (P_U0 + (size_t)T * 512)
#define P_K (P_U0 + (size_t)2 * T * 512)
#define P_V (P_U0 + (size_t)3 * T * 512)
#define P_GY ((bf16*)(F.ws + WS_R1))
#define P_XB (P_GY + (size_t)T * DM)
#define P_XS ((bf16*)(F.ws + WS_R1))
#define P_Y P_XS
#define P_CAT ((bf16*)(F.ws + WS_R2))
#define P_HID P_CAT

    if (IN(0)) for (int rep_ = 0; rep_ <= REPN(0); ++rep_) { PHASE_ENTER(); p0_prologue(F, KA); } SEAM(0);
    if (IN(1)) for (int rep_ = 0; rep_ <= REPN(1); ++rep_) { PHASE_ENTER(); norm_rows(F, in[0], P_HA, in[4], P_MOD, 0, 1024); } SEAM(1);
    if (IN(2)) for (int rep_ = 0; rep_ <= REPN(2); ++rep_) { PHASE_ENTER();
        pg8::Gemm g{P_HA, (const bf16*)(F.ws + WS_WEVIN), T, EVIN, DM, 0}; pg8::StaticOrder S; S.init(T, EVIN, F.G, F.bx);
        pg8::EpiEvIn E{P_U0, P_Q, P_K, P_V, in[11], in[12]};
        pg8::gemm_phase<pg8::EpiEvIn, pg8::StaticOrder, true, true>(F.lds, g, S, E);
    } SEAM(2);
    if (IN(3)) for (int rep_ = 0; rep_ <= REPN(3); ++rep_) { PHASE_ENTER();
#ifndef NO_ATTN
        for (int ra_ = 0; ra_ <= REPN(18); ++ra_) { const int bh = F.vcu; for (int qb = 7; qb >= 0; --qb) sba::unit(bh >> 3, bh & 7, qb, P_Q, P_K, P_V, P_CAT, F.lds); }
#endif
#ifndef NO_CONV
        for (int rc_ = 0; rc_ <= REPN(19); ++rc_) conv_phase(F, P_U0, P_CAT, in[7], in[8], in[9], in[10]);
#endif
    } SEAM(3);
    if (IN(4)) for (int rep_ = 0; rep_ <= REPN(4); ++rep_) { PHASE_ENTER();
        pg8::Gemm g{P_CAT, (const bf16*)(F.ws + WS_WEVOUT), T, DM, DM, 0}; pg8::StaticOrder S; S.init(T, DM, F.G, F.bx);
        pg8::EpiResid E{in[0], KA->out, P_MOD + 2 * 1024};
        pg8::gemm_phase<pg8::EpiResid, pg8::StaticOrder, true, true>(F.lds, g, S, E);
    } SEAM(4);
#define MOE_PHASES(layer, p0) \
    if (IN(p0)) for (int rep_ = 0; rep_ <= REPN(p0); ++rep_) { PHASE_ENTER(); router_phase(F, KA->out, P_HA, in[5] + (layer) * DM, P_MOD + (size_t)(layer) * 32 * 6144, in[23], in[24]); } SEAM(p0); \
    if (IN((p0) + 1)) for (int rep_ = 0; rep_ <= REPN((p0) + 1); ++rep_) { PHASE_ENTER(); slot_phase(F); } SEAM((p0) + 1); \
    if (IN((p0) + 2)) for (int rep_ = 0; rep_ <= REPN((p0) + 2); ++rep_) { PHASE_ENTER(); \
        const int ntl = *(const int*)(F.ws + META_NT); \
        pg8::Gemm g{P_HA, (const bf16*)(F.ws + WS_W13 + (size_t)(layer) * 16 * 1024 * 1024), ntl * 256, 1024, DM / 2, (size_t)1024 * 1024}; \
        pg8::MoeGatherOrder S; S.base.init(ntl * 256, 1024, F.G, F.bx); S.tile_e = (const int*)(F.ws + META_TILEE); S.tok = (const int*)(F.ws + META_TOK); \
        pg8::EpiMoeA E{P_HID}; \
        pg8::gemm_phase<pg8::EpiMoeA, pg8::MoeGatherOrder, true, true, true>(F.lds, g, S, E); \
    } SEAM((p0) + 2); \
    if (IN((p0) + 3)) for (int rep_ = 0; rep_ <= REPN((p0) + 3); ++rep_) { PHASE_ENTER(); \
        const int ntl = *(const int*)(F.ws + META_NT); \
        pg8::Gemm g{P_HID, (const bf16*)(F.ws + WS_W2 + (size_t)(layer) * 16 * 1024 * 512), ntl * 256, 1024, DFF / 2, (size_t)1024 * 512}; \
        pg8::MoeOrder S; S.base.init(ntl * 256, 1024, F.G, F.bx); S.tile_e = (const int*)(F.ws + META_TILEE); \
        pg8::EpiMoeB E{P_Y}; \
        pg8::gemm_phase<pg8::EpiMoeB, pg8::MoeOrder, true, true, true>(F.lds, g, S, E); \
    } SEAM((p0) + 3);

    MOE_PHASES(0, 5)
    if (IN(9)) for (int rep_ = 0; rep_ <= REPN(9); ++rep_) { PHASE_ENTER(); const bool dry = rep_ < REPN(9); combine_phase<true>(F, KA->out, dry ? (float*)(F.ws + WS_END) : KA->out, P_Y, P_MOD, dry ? P_HID : P_HA, in[4] + DM, P_MOD + (size_t)32 * 6144); } SEAM(9);
    if (IN(10)) for (int rep_ = 0; rep_ <= REPN(10); ++rep_) { PHASE_ENTER();
        pg8::Gemm g{P_HA, (const bf16*)(F.ws + WS_WODIN), T, 2048, DM, 0}; pg8::StaticOrder S; S.init(T, 2048, F.G, F.bx);
        pg8::EpiOdIn E{P_GY, P_XB};
        pg8::gemm_phase<pg8::EpiOdIn, pg8::StaticOrder, true, true>(F.lds, g, S, E);
    } SEAM(10);
    if (IN(11)) for (int rep_ = 0; rep_ <= REPN(11); ++rep_) { PHASE_ENTER(); const int u = F.vcu; lru_unit(F, u >> 3, u & 7, P_GY, P_XB, P_CAT, (const bf16*)(F.ws + WS_WRG), (const bf16*)(F.ws + WS_WIG), in[15], in[16], in[18], in[20], in[21]); } SEAM(11);
    if (IN(12)) for (int rep_ = 0; rep_ <= REPN(12); ++rep_) { PHASE_ENTER();
        pg8::Gemm g{P_CAT, (const bf16*)(F.ws + WS_WODOUT), T, DM, DM, 0}; pg8::StaticOrder S; S.init(T, DM, F.G, F.bx);
        pg8::EpiResid E{KA->out, KA->out, P_MOD + (size_t)32 * 6144 + 2 * 1024};
        pg8::gemm_phase<pg8::EpiResid, pg8::StaticOrder, true, true>(F.lds, g, S, E);
    } SEAM(12);
    MOE_PHASES(1, 13)
    if (IN(17)) for (int rep_ = 0; rep_ <= REPN(17); ++rep_) { PHASE_ENTER(); const bool dry = rep_ < REPN(17); combine_phase<false>(F, KA->out, dry ? (float*)(F.ws + WS_END) : KA->out, P_Y, P_MOD + (size_t)32 * 6144, P_HA, nullptr, nullptr); }
#undef MOE_PHASES
#undef in
#undef IN
#undef SEAM
}

#if !MK_ONE_LAUNCH
template <int P> static void set_attr_all() { if constexpr (P < NPHASE) { (void)hipFuncSetAttribute((const void*)mk_fwd<P, P + 1>, hipFuncAttributeMaxDynamicSharedMemorySize, LDS_BYTES); set_attr_all<P + 1>(); } }
template <int P> static void launch_all(Args a, int grid, hipStream_t stream) { if constexpr (P < NPHASE) { a.ph_lo = P; a.ph_hi = P + 1; hipLaunchKernelGGL((mk_fwd<P, P + 1>), dim3(grid), dim3(NWAVES * 64), LDS_BYTES, stream, a); launch_all<P + 1>(a, grid, stream); } }
#endif

extern "C" void kernel_launch(void* const* d_in, const int* in_sizes, int n_in, void* d_out, int out_size, void* d_ws, size_t ws_size, hipStream_t stream) {
    static int grid = 0;
    if (grid == 0) {
        if (n_in != 28 || in_sizes[0] != T * DM || out_size != T * DM || ws_size < WS_END + (size_t)T * DM * 4) { fprintf(stderr, "kernel_launch: unexpected shapes (n_in %d, in0 %d, out %d, ws %zu); nothing launched\n", n_in, n_in > 0 ? in_sizes[0] : -1, out_size, ws_size); grid = -1; return; }
        int dev = 0, cus = 0;
        if (hipGetDevice(&dev) != hipSuccess || hipDeviceGetAttribute(&cus, hipDeviceAttributeMultiprocessorCount, dev) != hipSuccess) { grid = -1; return; }
#if MK_ONE_LAUNCH
        if (hipFuncSetAttribute((const void*)mk_fwd<0, NPHASE>, hipFuncAttributeMaxDynamicSharedMemorySize, LDS_BYTES) != hipSuccess) { fprintf(stderr, "kernel_launch: hipFuncSetAttribute failed\n"); grid = -1; return; }
        int per_cu = 0;
        if (hipOccupancyMaxActiveBlocksPerMultiprocessor(&per_cu, (const void*)mk_fwd<0, NPHASE>, NWAVES * 64, LDS_BYTES) != hipSuccess || per_cu < 1) fprintf(stderr, "kernel_launch: occupancy query reports %d\n", per_cu);
#else
        set_attr_all<0>();
#endif
        (void)hipGetLastError();
        grid = cus;
        if (grid != 256) { fprintf(stderr, "kernel_launch: built for 256 CUs, device has %d; nothing launched\n", cus); grid = -1; return; }
    }
    if (grid < 0) return;
    (void)hipMemsetAsync((char*)d_ws + WS_CTL, 0, CTL_ZERO_BYTES, stream);
    Args a{};
    for (int i = 0; i < 28; ++i) a.in[i] = (const float*)d_in[i];
    a.out = (float*)d_out; a.ws = (unsigned char*)d_ws;
#if MK_ONE_LAUNCH
    a.ph_lo = 0; a.ph_hi = NPHASE;
    hipLaunchKernelGGL((mk_fwd<0, NPHASE>), dim3(grid), dim3(NWAVES * 64), LDS_BYTES, stream, a);
#else
    launch_all<0>(a, grid, stream);
#endif
}
```

```cpp
#include <hip/hip_runtime.h>
#include <cstdio>
#include <cstdint>

#ifndef MK_ONE_LAUNCH
#define MK_ONE_LAUNCH 1
#endif
#ifndef FP8_OUT
#define FP8_OUT 0
#endif
#ifndef FP8_IN0
#define FP8_IN0 1
#endif
#ifndef FP8_IN1
#define FP8_IN1 1
#endif

namespace pg8 {
#define PG8_LAS __attribute__((address_space(3)))
typedef unsigned short bf16_t;
typedef short bf16x8 __attribute__((ext_vector_type(8)));
typedef float f32x4 __attribute__((ext_vector_type(4)));
typedef unsigned u32x4 __attribute__((ext_vector_type(4)));
constexpr int BM = 256, BK = 64, HALF = 128, HTB = HALF * BK * 2  , STAGE_BYTES = 8 * HTB, NXCD = 8, WGM = 8;

__host__ __device__ __forceinline__ int lds_byte(int r, int c) { const int st = (r >> 4) * 2 + (c >> 5), rr = r & 15, cc = c & 31, ob = rr * 64 + cc * 2; return st * 1024 + (ob ^ (((ob >> 9) & 1) << 5)); }
__host__ __device__ __forceinline__ void stage_rc(int b, int& R, int& C) { const int st = b / 1024, sb = b % 1024, swz = sb ^ (((sb >> 9) & 1) << 5); R = (st >> 1) * 16 + swz / 64; C = (st & 1) * 32 + (swz % 64) / 2; }
__host__ __device__ __forceinline__ int perm32(int rho) { const int n = rho >> 4, i = rho & 15; return 8 * (i >> 2) + 4 * n + (i & 3); }

struct Unit { int pm, pn, pb; };
struct Gemm { const bf16_t* A; const bf16_t* Bt; int M, N, K; size_t bstride; };

struct StaticOrder {
    static constexpr bool GATHER = false, LAZY_PB = false; const int* tok;
    int nM, nN, nwg, G, c;
    __host__ __device__ void init(int M, int N, int G_, int c_) { nM = M / BM; nN = N / BM; nwg = nM * nN; G = G_; c = c_; }
    __host__ __device__ bool next(int i, Unit& u) const {
        const long L = (long)i * G + c; if (L >= nwg) return false;
        int wgid = (int)L; { const int q = nwg / NXCD, r = nwg % NXCD, xcd = wgid % NXCD, off = wgid / NXCD; wgid = (xcd < r ? xcd * (q + 1) : r * (q + 1) + (xcd - r) * q) + off; }
        const int nig = WGM * nN, gid = wgid / nig, fm = gid * WGM, gsz = (nM - fm) < WGM ? (nM - fm) : WGM;
        u.pm = fm + ((wgid % nig) % gsz); u.pn = (wgid % nig) / gsz; u.pb = 0; return true;
    }
    __device__ __forceinline__ void a_ready(const Unit&) const {}
    __device__ __forceinline__ void done(const Unit&) const {}
};

template <class Epi, class Sched, bool ALIGN_EPI = false, bool SP2 = false, bool FP8 = false>
__device__ __forceinline__ void gemm_phase(PG8_LAS unsigned char* lds, const Gemm g, const Sched& S, const Epi& E) {
    int tid_ = threadIdx.x; asm volatile("" : "+v"(tid_));
    const int tid = tid_, wid = __builtin_amdgcn_readfirstlane(tid >> 6), lane = tid & 63, wr = wid >> 2, wc = wid & 3, fr = lane & 15, fq = lane >> 4;
    int K_ = g.K; asm volatile("" : "+s"(K_));
    const int K = K_, nt = K / BK;
    unsigned voffA[2], voffB[2];
#pragma unroll
    for (int i = 0; i < 2; ++i) { int R, C; stage_rc(tid * 16 + i * 8192, R, C); const int Rb = Epi::PERM ? ((R & ~31) + perm32(R & 31)) : R;
        voffA[i] = (unsigned)(R * K + C) * 2u; voffB[i] = (unsigned)(Rb * K + C) * 2u; }
    unsigned cvo[2][2], nvo[2][2]; int rowA[2]; unsigned colA[2];
#pragma unroll
    for (int i = 0; i < 2; ++i) { int R, C; stage_rc(tid * 16 + i * 8192, R, C); rowA[i] = R; colA[i] = (unsigned)C * 2u; }
    int ntk[2][2];
#define PG8_LOADTK(u_, tk_) do { const int* _p00 = S.tok + (u_).pm * BM + rowA[0]; const int* _p01 = S.tok + (u_).pm * BM + rowA[1]; const int* _p10 = _p00 + HALF; const int* _p11 = _p01 + HALF; \
        asm volatile("global_load_dword %0, %4, off\n\tglobal_load_dword %1, %5, off\n\tglobal_load_dword %2, %6, off\n\tglobal_load_dword %3, %7, off" \
            : "=&v"(tk_[0][0]), "=&v"(tk_[0][1]), "=&v"(tk_[1][0]), "=&v"(tk_[1][1]) : "v"(_p00), "v"(_p01), "v"(_p10), "v"(_p11) : "memory"); } while (0)
#define PG8_TK2VO(tk_, vo_) do { _Pragma("unroll") for (int _h = 0; _h < 2; ++_h) _Pragma("unroll") for (int _i = 0; _i < 2; ++_i) vo_[_h][_i] = (unsigned)tk_[_h][_i] * (unsigned)(K * 2) + colA[_i]; } while (0)
    const size_t kstep = (size_t)(BK * 2);
    const size_t hstep = (size_t)HALF * K * 2;
    const size_t tstep = 2 * hstep;
    const unsigned ldsw = (unsigned)wid * 1024u;
    constexpr int PSTR = FP8 ? 16 : 1024;
    const int aoff = FP8 ? lds_byte(wr * 64 + fr, (fq & 1) * 16) + (fq >> 1) * 1024 : lds_byte(wr * 64 + fr, fq * 8);
    const int boff = FP8 ? lds_byte(wc * 32 + fr, (fq & 1) * 16) + (fq >> 1) * 1024 : lds_byte(wc * 32 + fr, fq * 8);
#define PG8_SA(b, h) (((b) * 2 + (h)) * HTB)
#define PG8_SB(b, h) ((4 + (b) * 2 + (h)) * HTB)
#define PG8_STAGE(bufoff, gbase, voff) do { _Pragma("unroll") for (int _i = 0; _i < 2; ++_i) \
        __builtin_amdgcn_global_load_lds((const unsigned*)((const char*)(gbase) + (voff)[_i]), (PG8_LAS unsigned*)(lds + (bufoff) + ldsw + _i * 8192), 16, 0, 0); } while (0)
#define PG8_STAGE_A(bufoff, gbase, h, nx) do { if constexpr (Sched::GATHER) { _Pragma("unroll") for (int _i = 0; _i < 2; ++_i) { const unsigned _vo = (nx) ? nvo[h][_i] : cvo[h][_i]; \
        __builtin_amdgcn_global_load_lds((const unsigned*)((const char*)(gbase) + _vo), (PG8_LAS unsigned*)(lds + (bufoff) + ldsw + _i * 8192), 16, 0, 0); } } \
        else { PG8_STAGE(bufoff, (gbase) + (h) * hstep, voffA); } } while (0)
    const PG8_LAS unsigned char* const ldsA = lds + aoff;
    const PG8_LAS unsigned char* const ldsB = lds + 4 * HTB + boff;
#define PG8_LD32(p_) __builtin_shufflevector(*(const PG8_LAS v4i_*)(p_), *(const PG8_LAS v4i_*)((p_) + PSTR), 0, 1, 2, 3, 4, 5, 6, 7)
#define PG8_LDA(dst, b, h) do { if constexpr (FP8) { _Pragma("unroll") for (int m = 0; m < 4; ++m) dst##8[m] = PG8_LD32(ldsA + PG8_SA(b, h) + m * 2048); } \
    else { _Pragma("unroll") for (int m = 0; m < 4; ++m) _Pragma("unroll") for (int k = 0; k < 2; ++k) dst[m][k] = *(const PG8_LAS bf16x8*)(ldsA + PG8_SA(b, h) + m * 2048 + k * PSTR); } } while (0)
#define PG8_LDB(dst, b, h) do { if constexpr (FP8) { _Pragma("unroll") for (int n = 0; n < 2; ++n) dst##8[n] = PG8_LD32(ldsB + (PG8_SB(b, h) - 4 * HTB) + n * 2048); } \
    else { _Pragma("unroll") for (int n = 0; n < 2; ++n) _Pragma("unroll") for (int k = 0; k < 2; ++k) dst[n][k] = *(const PG8_LAS bf16x8*)(ldsB + (PG8_SB(b, h) - 4 * HTB) + n * 2048 + k * PSTR); } } while (0)
#define PG8_MMA(ai, bj, At, Bt) do { __builtin_amdgcn_s_setprio(1); \
        if constexpr (FP8) { _Pragma("unroll") for (int m = 0; m < 4; ++m) _Pragma("unroll") for (int n = 0; n < 2; ++n) \
            asm volatile("v_mfma_scale_f32_16x16x128_f8f6f4 %0, %1, %2, %0, %3, %3 op_sel_hi:[0,0,0]" : "+v"(acc[ai][bj][m][n]) : "v"(Bt##8[n]), "v"(At##8[m]), "v"(sc8)); } \
        else { _Pragma("unroll") for (int m = 0; m < (FP8 ? 1 : 4); ++m) _Pragma("unroll") for (int n = 0; n < 2; ++n) _Pragma("unroll") for (int k = 0; k < 2; ++k) \
            acc[ai][bj][m][n] = __builtin_amdgcn_mfma_f32_16x16x32_bf16(Bt[n][k], At[m][k], acc[ai][bj][m][n], 0, 0, 0); } \
        __builtin_amdgcn_s_setprio(0); } while (0)
#define PG8_WAIT_V(n) asm volatile("s_waitcnt vmcnt(" #n ")" ::: "memory")
#define PG8_WAIT_L(n) asm volatile("s_waitcnt lgkmcnt(" #n ")" ::: "memory")
#define PG8_BAR __builtin_amdgcn_s_barrier()
#define PG8_SCHED __builtin_amdgcn_sched_barrier(0)
    Unit cur, nxt; int ui = 0;
    if (!S.next(0, cur)) return;
    f32x4 acc[2][2][4][2];
#pragma unroll
    for (int a = 0; a < 2; ++a)
#pragma unroll
        for (int b = 0; b < 2; ++b)
#pragma unroll
            for (int m = 0; m < 4; ++m)
#pragma unroll
                for (int n = 0; n < 2; ++n) acc[a][b][m][n] = (f32x4){0.f, 0.f, 0.f, 0.f};
    typedef int v4i_ __attribute__((ext_vector_type(4))); typedef int v8i_ __attribute__((ext_vector_type(8)));
    bf16x8 At[FP8 ? 1 : 4][2], B0[2][2], B1[2][2];
    v8i_ At8[FP8 ? 4 : 1], B08[2], B18[2];
    const int sc8 = 0x7f7f7f7f;
    const char* cA = (const char*)g.A + (Sched::GATHER ? (size_t)0 : (size_t)cur.pm * tstep); const char* cB = (const char*)g.Bt + (size_t)cur.pb * g.bstride + (size_t)cur.pn * tstep;
    S.a_ready(cur);
    if constexpr (Sched::GATHER) { PG8_LOADTK(cur, ntk); asm volatile("s_waitcnt vmcnt(0)" : "+v"(ntk[0][0]), "+v"(ntk[0][1]), "+v"(ntk[1][0]), "+v"(ntk[1][1]) :: "memory"); PG8_TK2VO(ntk, cvo); }
    if constexpr (SP2) {
        PG8_STAGE(PG8_SB(0, 0), cB, voffB); PG8_STAGE(PG8_SB(0, 1), cB + hstep, voffB); PG8_STAGE_A(PG8_SA(0, 0), cA, 0, false); PG8_STAGE_A(PG8_SA(0, 1), cA, 1, false);
        if (wr == 1) PG8_BAR;
        PG8_WAIT_V(2); PG8_BAR;
        PG8_STAGE(PG8_SB(1, 0), cB + kstep, voffB); PG8_STAGE_A(PG8_SA(1, 0), cA + kstep, 0, false); PG8_STAGE(PG8_SB(1, 1), cB + hstep + kstep, voffB);
        PG8_WAIT_V(6); PG8_BAR;
    } else { static_assert(SP2, "only the SP2 loop is kept"); }
    for (;;) {
        bool has_next; int pbv = 0;
        if constexpr (Sched::LAZY_PB) { has_next = S.next_nopb(ui + 1, nxt);
            if (has_next) { const int* _pp = S.pb_ptr(nxt); asm volatile("global_load_dword %0, %1, off" : "=v"(pbv) : "v"(_pp) : "memory"); } }
        else has_next = S.next(ui + 1, nxt);
        const char* nA = (has_next && !Sched::GATHER) ? (const char*)g.A + (size_t)nxt.pm * tstep : cA;
        if constexpr (Sched::GATHER) { _Pragma("unroll") for (int _h = 0; _h < 2; ++_h) _Pragma("unroll") for (int _i = 0; _i < 2; ++_i) nvo[_h][_i] = cvo[_h][_i]; if (has_next) { PG8_LOADTK(nxt, ntk); } }
 const char* nB = (has_next && !Sched::LAZY_PB) ? (const char*)g.Bt + (size_t)nxt.pb * g.bstride + (size_t)nxt.pn * tstep : cB;
        for (int t = 0; t < nt; t += 2) {
            const bool last = (t == nt - 2);
            const char* a1 = cA + (size_t)(t + 1) * kstep;
            if constexpr (Sched::LAZY_PB) { if (last && has_next) { asm volatile("s_waitcnt vmcnt(8)" : "+v"(pbv) :: "memory"); nxt.pb = __builtin_amdgcn_readfirstlane(pbv);
                nB = (const char*)g.Bt + (size_t)nxt.pb * g.bstride + (size_t)nxt.pn * tstep; } }
            const char* a2 = last ? nA : cA + (size_t)(t + 2) * kstep; const char* b2 = last ? nB : cB + (size_t)(t + 2) * kstep;
            const char* a3 = a2 + kstep; const char* b3 = b2 + kstep;
            if (last && has_next) S.a_ready(nxt);
            if constexpr (Sched::GATHER) { if (last && has_next) {
                asm volatile("s_waitcnt vmcnt(8)" : "+v"(ntk[0][0]), "+v"(ntk[0][1]), "+v"(ntk[1][0]), "+v"(ntk[1][1]) :: "memory"); PG8_TK2VO(ntk, nvo); } }
            if constexpr (SP2) {
            PG8_LDB(B0, 0, 0); PG8_LDB(B1, 0, 1); PG8_SCHED; PG8_LDA(At, 0, 0); PG8_STAGE_A(PG8_SA(1, 1), a1, 1, false);
            PG8_WAIT_V(8); PG8_WAIT_L(0); PG8_BAR; PG8_MMA(0, 0, At, B0); PG8_MMA(0, 1, At, B1); PG8_BAR; PG8_SCHED;
            PG8_LDA(At, 0, 1); PG8_STAGE(PG8_SB(0, 0), b2, voffB); PG8_STAGE(PG8_SB(0, 1), b2 + hstep, voffB); PG8_STAGE_A(PG8_SA(0, 0), a2, 0, last);
            PG8_WAIT_V(8); PG8_WAIT_L(0); PG8_BAR; PG8_MMA(1, 0, At, B0); PG8_MMA(1, 1, At, B1); PG8_BAR; PG8_SCHED;
            PG8_LDB(B0, 1, 0); PG8_LDB(B1, 1, 1); PG8_SCHED; PG8_LDA(At, 1, 0); PG8_STAGE_A(PG8_SA(0, 1), a2, 1, last);
            PG8_WAIT_V(8); PG8_WAIT_L(0); PG8_BAR; PG8_MMA(0, 0, At, B0); PG8_MMA(0, 1, At, B1); PG8_BAR; PG8_SCHED;
            PG8_LDA(At, 1, 1); PG8_STAGE(PG8_SB(1, 0), b3, voffB); PG8_STAGE(PG8_SB(1, 1), b3 + hstep, voffB); PG8_STAGE_A(PG8_SA(1, 0), a3, 0, last);
            PG8_WAIT_V(8); PG8_WAIT_L(0); PG8_BAR; PG8_MMA(1, 0, At, B0); PG8_MMA(1, 1, At, B1); PG8_BAR; PG8_SCHED;
            }
        }
        if constexpr (ALIGN_EPI) { if (wr == 0) PG8_BAR; }
        if constexpr (FP8) asm volatile("s_nop 15\n\ts_nop 15" ::: "memory");
        if constexpr (!Epi::AFTER_DRAIN) { E(acc, cur, wr, wc, fr, fq); S.done(cur); }
        if (!has_next) break;
#pragma unroll
        for (int a = 0; a < 2; ++a)
#pragma unroll
            for (int b = 0; b < 2; ++b)
#pragma unroll
                for (int m = 0; m < 4; ++m)
#pragma unroll
                    for (int n = 0; n < 2; ++n) acc[a][b][m][n] = (f32x4){0.f, 0.f, 0.f, 0.f};
        cur = nxt; cA = nA; cB = nB; ++ui;
        if constexpr (Sched::GATHER) { _Pragma("unroll") for (int _h = 0; _h < 2; ++_h) _Pragma("unroll") for (int _i = 0; _i < 2; ++_i) cvo[_h][_i] = nvo[_h][_i]; }
        if constexpr (ALIGN_EPI) { if (wr == 1) PG8_BAR; }
    }
    PG8_WAIT_V(0);
    if constexpr (!ALIGN_EPI) { if (wr == 0) PG8_BAR; }
    PG8_BAR;
    if constexpr (Epi::AFTER_DRAIN) { E.fused(acc, cur, wr, wc, fr, fq, lds, wid, lane); S.done(cur); }
#undef PG8_SA
#undef PG8_SB
#undef PG8_STAGE
#undef PG8_STAGE_A
#undef PG8_LOADTK
#undef PG8_TK2VO
#undef PG8_LD32
#undef PG8_LDA
#undef PG8_LDB
#undef PG8_MMA
#undef PG8_WAIT_V
#undef PG8_WAIT_L
#undef PG8_BAR
#undef PG8_SCHED
}
}

constexpr int NB = 32, SEQ = 2048, DM = 1024, T = NB * SEQ;
constexpr int EVIN = 2560, CONVC = 512, CONVW = 31, NHEAD = 8, HD = 64, SBW = 512;
constexpr int NEXP = 16, DFF = 512;
constexpr int MOE_ROWS = 2 * T + NEXP * 256;
constexpr int MOE_TILES = MOE_ROWS / 256;
constexpr float EPS = 1e-6f;
constexpr int NWAVES = 8;

constexpr size_t MiB = 1u << 20;
constexpr size_t WS_CTL = 0, CTL_ZERO_BYTES = 64 * 1024;
constexpr size_t WS_MOD = 1 * MiB;
constexpr size_t WS_META = 3 * MiB;
constexpr size_t META_EID = WS_META, META_GATE = WS_META + 512 * 1024, META_SLOT = WS_META + 1024 * 1024, META_BCNT = WS_META + 1536 * 1024,
                 META_TILEE = META_BCNT + 32 * 1024, META_NT = META_BCNT + 64 * 1024, META_TOK = WS_META + 2048 * 1024;
constexpr size_t WS_WEVIN = 6 * MiB, WS_WEVOUT = 11 * MiB, WS_WODIN = 13 * MiB, WS_WODOUT = 17 * MiB, WS_WRG = 19 * MiB, WS_WIG = WS_WRG + 512 * 1024;
constexpr size_t WS_W13 = 20 * MiB;
constexpr size_t WS_W2 = 84 * MiB;
constexpr size_t WS_HA = 116 * MiB;
constexpr size_t WS_R1 = 244 * MiB;
constexpr size_t WS_R2 = 508 * MiB;
constexpr size_t WS_END = 640 * MiB;
constexpr int CW_BAR = 4096;

constexpr int RING_BYTES = 131072, LDS_BYTES = 147456, LDSCTL_OFF = LDS_BYTES - 2048, MISC_OFF = LDSCTL_OFF + 320;

#define GAS __attribute__((address_space(1)))
#define LAS __attribute__((address_space(3)))
typedef unsigned short bf16;
typedef unsigned v4u __attribute__((ext_vector_type(4)));
typedef unsigned v2u __attribute__((ext_vector_type(2)));
typedef float f32x4 __attribute__((ext_vector_type(4)));
typedef float f32x2 __attribute__((ext_vector_type(2)));
typedef float f32x16 __attribute__((ext_vector_type(16)));
typedef short bf16x8 __attribute__((ext_vector_type(8)));
typedef short s16x4 __attribute__((ext_vector_type(4)));
typedef __bf16 bf16x2_t __attribute__((ext_vector_type(2)));
typedef GAS unsigned gu32;
#define RLX_AGENT __ATOMIC_RELAXED, __HIP_MEMORY_SCOPE_AGENT

__device__ __forceinline__ unsigned pk2(float lo, float hi) { f32x2 v = {lo, hi}; bf16x2_t b = __builtin_convertvector(v, bf16x2_t); return __builtin_bit_cast(unsigned, b); }
__device__ __forceinline__ unsigned pk4_fp8(float a, float b, float c, float d) { int r = __builtin_amdgcn_cvt_pk_fp8_f32(a, b, 0, false); r = __builtin_amdgcn_cvt_pk_fp8_f32(c, d, r, true); return (unsigned)r; }
__device__ __forceinline__ v2u bf8x_to_fp8(v4u v);
__device__ __forceinline__ float bflo(unsigned u) { return __uint_as_float(u << 16); }
__device__ __forceinline__ float bfhi(unsigned u) { return __uint_as_float(u & 0xffff0000u); }
__device__ __forceinline__ v2u bf8x_to_fp8(v4u v) { v2u o; o.x = pk4_fp8(bflo(v.x), bfhi(v.x), bflo(v.y), bfhi(v.y)); o.y = pk4_fp8(bflo(v.z), bfhi(v.z), bflo(v.w), bfhi(v.w)); return o; }
__device__ __forceinline__ float bf2f(bf16 b) { return __uint_as_float((unsigned)b << 16); }
__device__ __forceinline__ float fast_exp2(float x) { return __builtin_amdgcn_exp2f(x); }
__device__ __forceinline__ float fast_rcp(float x) { return __builtin_amdgcn_rcpf(x); }
__device__ __forceinline__ float sigmoidf_(float x) { return fast_rcp(1.0f + fast_exp2(-1.4426950408889634f * x)); }
__device__ __forceinline__ float siluf_(float x) { return x * sigmoidf_(x); }
__device__ __forceinline__ float gelu_tanh(float x) { const float u = x + 0.044715f * x * x * x; return x * fast_rcp(1.0f + fast_exp2(-2.3022082f * u)); }
__device__ __forceinline__ float wave_sum(float v) {
#pragma unroll
    for (int o = 1; o < 64; o <<= 1) v += __shfl_xor(v, o);
    return v;
}

#define XB_TMO      128
#define XB_XCNT(j)  (256  + 64 * (j))
#define XB_XSUB(j)  (1280 + 64 * (j))
#define XB_XGEN(j)  (2304 + 64 * (j))
#define XB_TOP      3328
#define XB_TOPGEN   3392
#define XCD_BAR_WORDS 3456
#define XB_SPIN_CAP (1u << 18)

__device__ __forceinline__ unsigned xb_ld(unsigned* p)              { return __hip_atomic_load(p, __ATOMIC_RELAXED, __HIP_MEMORY_SCOPE_AGENT); }
__device__ __forceinline__ unsigned xb_add(unsigned* p, unsigned v) { return __hip_atomic_fetch_add(p, v, __ATOMIC_RELAXED, __HIP_MEMORY_SCOPE_AGENT); }
__device__ __forceinline__ unsigned xb_xcc_id() { return (unsigned)__builtin_amdgcn_s_getreg((3 << 11) | 20) & 0xFu; }
#define XB_SPIN(cond, bar) do { unsigned _sp = 0; while (cond) { __builtin_amdgcn_s_sleep(1); \
    if ((++_sp & 255u) == 0u) { if (xb_ld(&(bar)[XB_TMO])) break; if (_sp > XB_SPIN_CAP) { atomicAdd(&(bar)[XB_TMO], 1u); break; } } } } while (0)

struct XcdBarrier {
    unsigned* bar; unsigned x;
    volatile LAS unsigned* st;
};

__device__ __forceinline__ XcdBarrier xcd_barrier_post(unsigned* bar, volatile LAS unsigned* st) {
    XcdBarrier b; b.bar = bar; b.x = xb_xcc_id(); b.st = st;
    if (threadIdx.x == 0) (void)xb_add(&bar[XB_XCNT(b.x)], 1u);
    return b;
}
__device__ __forceinline__ void xcd_barrier_complete(unsigned* bar, unsigned x, unsigned& nloc, unsigned& nx) {
    const unsigned G = gridDim.x * gridDim.y * gridDim.z;
    unsigned sum, cnt, mine, sp = 0u;
    for (;;) {
        sum = 0u; cnt = 0u; mine = 0u;
#pragma unroll
        for (unsigned j = 0; j < 16; ++j) { const unsigned c = xb_ld(&bar[XB_XCNT(j)]); sum += c; cnt += (c > 0u) ? 1u : 0u; mine = (j == x) ? c : mine; }
        if (sum == G) break;
        __builtin_amdgcn_s_sleep(1);
        if ((++sp & 255u) == 0u) { if (xb_ld(&bar[XB_TMO])) break; if (sp > XB_SPIN_CAP) { atomicAdd(&bar[XB_TMO], 1u); break; } }
    }
    nloc = mine > 0u ? mine : 1u; nx = cnt > 0u ? cnt : 1u;
}

__device__ __forceinline__ void xcd_barrier(const XcdBarrier& b) {
    asm volatile("s_waitcnt vmcnt(0)" ::: "memory");
    __syncthreads();
    if (threadIdx.x == 0) {
        unsigned* bar = b.bar;
        __builtin_amdgcn_s_waitcnt(0);
        unsigned nloc = b.st[0], nx = b.st[1];
        if (nloc == 0u) { xcd_barrier_complete(bar, b.x, nloc, nx); b.st[0] = nloc; b.st[1] = nx; }
        const unsigned old = xb_add(&bar[XB_XSUB(b.x)], 1u);
        const unsigned gen = old / nloc;
        if (old + 1u == (gen + 1u) * nloc) {
            __builtin_amdgcn_fence(__ATOMIC_RELEASE, "agent");
            asm volatile("s_waitcnt vmcnt(0)" ::: "memory");
            const unsigned og = xb_add(&bar[XB_TOP], 1u);
            const unsigned tg = og / nx;
            if (og + 1u == (tg + 1u) * nx) xb_add(&bar[XB_TOPGEN], 1u);
            else XB_SPIN(xb_ld(&bar[XB_TOPGEN]) == tg, bar);
            __builtin_amdgcn_fence(__ATOMIC_ACQUIRE, "agent");
            xb_add(&bar[XB_XGEN(b.x)], 1u);
            asm volatile("s_waitcnt vmcnt(0)" ::: "memory");
        } else {
            XB_SPIN(xb_ld(&bar[XB_XGEN(b.x)]) == gen, bar);
            __builtin_amdgcn_fence(__ATOMIC_ACQUIRE, "agent");
            asm volatile("s_waitcnt vmcnt(0)" ::: "memory");
        }
    }
    __syncthreads();
}


namespace pg8 {
struct EpiEvIn {
    static constexpr bool PERM = true, AFTER_DRAIN = false;
    bf16* U0; bf16* Q; bf16* K; bf16* V; const float* qg; const float* kg;
    __device__ __forceinline__ void operator()(const f32x4 (&acc_)[2][2][4][2], const Unit& u, int wr, int wc, int fr, int fq) const {
        const int row0 = u.pm * BM + wr * 64 + fr;
        f32x4 acc[2][2][4][2];
#pragma unroll
        for (int a = 0; a < 2; ++a)
#pragma unroll
            for (int b = 0; b < 2; ++b)
#pragma unroll
                for (int m = 0; m < 4; ++m)
#pragma unroll
                    for (int n = 0; n < 2; ++n) acc[a][b][m][n] = acc_[a][b][m][n] * (FP8_IN0 ? 1.0f / 32.0f : 1.0f);
        if (u.pn < 4) {
#pragma unroll
            for (int ai = 0; ai < 2; ++ai)
#pragma unroll
                for (int m = 0; m < 4; ++m) {
                    const size_t row = (size_t)(row0 + ai * HALF + m * 16);
                    const f32x4 v0 = acc[ai][0][m][0], v1 = acc[ai][0][m][1], g0 = acc[ai][1][m][0], g1 = acc[ai][1][m][1];
                    u32x4 w;
                    w.x = pk2(v0[0] * sigmoidf_(g0[0]), v0[1] * sigmoidf_(g0[1])); w.y = pk2(v0[2] * sigmoidf_(g0[2]), v0[3] * sigmoidf_(g0[3]));
                    w.z = pk2(v1[0] * sigmoidf_(g1[0]), v1[1] * sigmoidf_(g1[1])); w.w = pk2(v1[2] * sigmoidf_(g1[2]), v1[3] * sigmoidf_(g1[3]));
                    *(u32x4*)(U0 + row * 512 + u.pn * 128 + wc * 32 + 8 * fq) = w;
                }
        } else if (u.pn < 8) {
            const int sec = (u.pn - 4) >> 1, p = (u.pn - 4) & 1, head = 4 * p + wc;
            const float* gp = sec ? kg : qg; bf16* dst = sec ? K : Q;
            const float scl = sec ? 1.0f : 0.125f * 1.4426950408889634f;
            f32x4 gv[2][2];
#pragma unroll
            for (int bj = 0; bj < 2; ++bj)
#pragma unroll
                for (int n = 0; n < 2; ++n) gv[bj][n] = *(const f32x4*)(gp + 32 * bj + 8 * fq + 4 * n) * scl;
#pragma unroll
            for (int ai = 0; ai < 2; ++ai)
#pragma unroll
                for (int m = 0; m < 4; ++m) {
                    const size_t row = (size_t)(row0 + ai * HALF + m * 16);
                    float ss = 0.f;
#pragma unroll
                    for (int bj = 0; bj < 2; ++bj)
#pragma unroll
                        for (int n = 0; n < 2; ++n) { const f32x4 x = acc[ai][bj][m][n]; ss += (x[0] * x[0] + x[1] * x[1]) + (x[2] * x[2] + x[3] * x[3]); }
                    ss += __shfl_xor(ss, 16); ss += __shfl_xor(ss, 32);
                    const float rstd = __builtin_amdgcn_rsqf(ss * (1.0f / 64.0f) + EPS);
#pragma unroll
                    for (int bj = 0; bj < 2; ++bj) {
                        const f32x4 a = acc[ai][bj][m][0] * rstd * gv[bj][0], b = acc[ai][bj][m][1] * rstd * gv[bj][1];
                        u32x4 w; w.x = pk2(a[0], a[1]); w.y = pk2(a[2], a[3]); w.z = pk2(b[0], b[1]); w.w = pk2(b[2], b[3]);
                        *(u32x4*)(dst + row * 512 + head * 64 + 32 * bj + 8 * fq) = w;
                    }
                }
        } else {
#pragma unroll
            for (int ai = 0; ai < 2; ++ai)
#pragma unroll
                for (int m = 0; m < 4; ++m) {
                    const size_t row = (size_t)(row0 + ai * HALF + m * 16);
#pragma unroll
                    for (int bj = 0; bj < 2; ++bj) {
                        const f32x4 a = acc[ai][bj][m][0], b = acc[ai][bj][m][1];
                        u32x4 w; w.x = pk2(a[0], a[1]); w.y = pk2(a[2], a[3]); w.z = pk2(b[0], b[1]); w.w = pk2(b[2], b[3]);
                        *(u32x4*)(V + row * 512 + (u.pn - 8) * 256 + bj * HALF + wc * 32 + 8 * fq) = w;
                    }
                }
        }
    }
};
struct EpiResid {
    static constexpr bool PERM = false, AFTER_DRAIN = false;
    const float* xin; float* xout; const float* gate; float sc;
    __device__ __forceinline__ void operator()(const f32x4 (&acc)[2][2][4][2], const Unit& u, int wr, int wc, int fr, int fq) const {
        const int row0 = u.pm * BM + wr * 64 + fr, col0 = u.pn * BM + wc * 32 + 4 * fq, b = u.pm >> 3;
        f32x4 gv[2][2];
#pragma unroll
        for (int bj = 0; bj < 2; ++bj)
#pragma unroll
            for (int n = 0; n < 2; ++n) gv[bj][n] = *(const f32x4*)(gate + (size_t)b * 6144 + col0 + bj * HALF + n * 16) * sc;
#pragma unroll
        for (int ai = 0; ai < 2; ++ai)
#pragma unroll
            for (int m = 0; m < 4; ++m) {
                const size_t off = (size_t)(row0 + ai * HALF + m * 16) * DM + col0;
#pragma unroll
                for (int bj = 0; bj < 2; ++bj)
#pragma unroll
                    for (int n = 0; n < 2; ++n) { const f32x4 xi = *(const f32x4*)(xin + off + bj * HALF + n * 16); *(f32x4*)(xout + off + bj * HALF + n * 16) = xi + gv[bj][n] * acc[ai][bj][m][n]; }
            }
    }
};
struct EpiOdIn {
    static constexpr bool PERM = true, AFTER_DRAIN = false;
    bf16* GY; bf16* XB;
    __device__ __forceinline__ void operator()(const f32x4 (&acc)[2][2][4][2], const Unit& u, int wr, int wc, int fr, int fq) const {
        const int row0 = u.pm * BM + wr * 64 + fr; const bool isy = u.pn < 4;
        bf16* dst = (isy ? GY : XB) + (size_t)(u.pn & 3) * 256 + wc * 32 + 8 * fq;
#pragma unroll
        for (int ai = 0; ai < 2; ++ai)
#pragma unroll
            for (int m = 0; m < 4; ++m) {
                const size_t row = (size_t)(row0 + ai * HALF + m * 16);
#pragma unroll
                for (int bj = 0; bj < 2; ++bj) {
                    f32x4 a = acc[ai][bj][m][0] * (FP8_IN1 ? 1.0f / 32.0f : 1.0f), b = acc[ai][bj][m][1] * (FP8_IN1 ? 1.0f / 32.0f : 1.0f);
                    if (isy) { a = (f32x4){gelu_tanh(a[0]), gelu_tanh(a[1]), gelu_tanh(a[2]), gelu_tanh(a[3])}; b = (f32x4){gelu_tanh(b[0]), gelu_tanh(b[1]), gelu_tanh(b[2]), gelu_tanh(b[3])}; }
                    u32x4 w; w.x = pk2(a[0], a[1]); w.y = pk2(a[2], a[3]); w.z = pk2(b[0], b[1]); w.w = pk2(b[2], b[3]);
                    *(u32x4*)(dst + row * DM + bj * HALF) = w;
                }
            }
    }
};
struct EpiMoeA {
    static constexpr bool PERM = true, AFTER_DRAIN = false;
    bf16* HID;
    __device__ __forceinline__ void operator()(const f32x4 (&acc)[2][2][4][2], const Unit& u, int wr, int wc, int fr, int fq) const {
        const int row0 = u.pm * BM + wr * 64 + fr;
#pragma unroll
        for (int ai = 0; ai < 2; ++ai)
#pragma unroll
            for (int m = 0; m < 4; ++m) {
                const size_t row = (size_t)(row0 + ai * HALF + m * 16);
                const f32x4 a0 = acc[ai][0][m][0], a1 = acc[ai][0][m][1], b0 = acc[ai][1][m][0], b1 = acc[ai][1][m][1];
                u32x4 w;
                (void)w; constexpr float S = 1.0f / 32.0f, S4 = 4.0f / 32.0f;
                v2u w8; w8.x = pk4_fp8(siluf_(a0[0] * S) * (b0[0] * S4), siluf_(a0[1] * S) * (b0[1] * S4), siluf_(a0[2] * S) * (b0[2] * S4), siluf_(a0[3] * S) * (b0[3] * S4));
                w8.y = pk4_fp8(siluf_(a1[0] * S) * (b1[0] * S4), siluf_(a1[1] * S) * (b1[1] * S4), siluf_(a1[2] * S) * (b1[2] * S4), siluf_(a1[3] * S) * (b1[3] * S4));
                *(v2u*)((unsigned char*)HID + row * DFF + u.pn * 128 + wc * 32 + 8 * fq) = w8;
            }
    }
};
struct EpiMoeB {
    static constexpr bool PERM = true, AFTER_DRAIN = false;
    bf16* Y;
    __device__ __forceinline__ void operator()(const f32x4 (&acc)[2][2][4][2], const Unit& u, int wr, int wc, int fr, int fq) const {
        const int row0 = u.pm * BM + wr * 64 + fr;
#pragma unroll
        for (int ai = 0; ai < 2; ++ai)
#pragma unroll
            for (int m = 0; m < 4; ++m) {
                const size_t row = (size_t)(row0 + ai * HALF + m * 16);
#pragma unroll
                for (int bj = 0; bj < 2; ++bj) {
                    const f32x4 a = acc[ai][bj][m][0] * (1.0f / 128.0f), b = acc[ai][bj][m][1] * (1.0f / 128.0f);
                    u32x4 w; w.x = pk2(a[0], a[1]); w.y = pk2(a[2], a[3]); w.z = pk2(b[0], b[1]); w.w = pk2(b[2], b[3]);
                    *(u32x4*)(Y + row * DM + u.pn * 256 + bj * HALF + wc * 32 + 8 * fq) = w;
                }
            }
    }
};
struct MoeOrder {
    static constexpr bool GATHER = false, LAZY_PB = true; const int* tok;
    StaticOrder base; const int* tile_e;
    __device__ __forceinline__ bool next(int i, Unit& u) const { if (!base.next(i, u)) return false; u.pb = tile_e[u.pm]; return true; }
    __device__ __forceinline__ bool next_nopb(int i, Unit& u) const { return base.next(i, u); }
    __device__ __forceinline__ const int* pb_ptr(const Unit& u) const { return tile_e + u.pm; }
    __device__ __forceinline__ void a_ready(const Unit&) const {}
    __device__ __forceinline__ void done(const Unit&) const {}
};
struct MoeGatherOrder {
    static constexpr bool GATHER = true, LAZY_PB = true; const int* tok;
    StaticOrder base; const int* tile_e;
    __device__ __forceinline__ bool next(int i, Unit& u) const { if (!base.next(i, u)) return false; u.pb = tile_e[u.pm]; return true; }
    __device__ __forceinline__ bool next_nopb(int i, Unit& u) const { return base.next(i, u); }
    __device__ __forceinline__ const int* pb_ptr(const Unit& u) const { return tile_e + u.pm; }
    __device__ __forceinline__ void a_ready(const Unit&) const {}
    __device__ __forceinline__ void done(const Unit&) const {}
};
}

struct Frame {
    LAS unsigned char* lds;
    int tid, lane, wave, vcu, G, bx;
    unsigned char* ws;
};

template <bool OUT8 = false, class RowMap>
__device__ __forceinline__ void p0_transpose_item(const float* W, int K, int N, bf16* WT, LAS float* scr, int item, int lane, RowMap rm) {
    const int nblk = N / 64, kb = item / nblk, nb = item % nblk, k0 = 64 * kb, n0 = 64 * nb;
    f32x4 v[16];
#pragma unroll
    for (int i = 0; i < 16; ++i) v[i] = *(const f32x4*)(W + (size_t)(k0 + 4 * i + (lane >> 4)) * N + n0 + 4 * (lane & 15));
#pragma unroll
    for (int i = 0; i < 16; ++i) { LAS float* d = scr + (4 * i + (lane >> 4)) * 65 + 4 * (lane & 15); d[0] = v[i][0]; d[1] = v[i][1]; d[2] = v[i][2]; d[3] = v[i][3]; }
    asm volatile("s_waitcnt lgkmcnt(0)" ::: "memory");
    const int c = lane & 7;
#pragma unroll
    for (int j = 0; j < 8; ++j) { const int n = (lane >> 3) + 8 * j; const LAS float* sp = scr + (8 * c) * 65 + n;
        if constexpr (OUT8) { v2u o; o.x = pk4_fp8(sp[0 * 65] * 32.f, sp[1 * 65] * 32.f, sp[2 * 65] * 32.f, sp[3 * 65] * 32.f); o.y = pk4_fp8(sp[4 * 65] * 32.f, sp[5 * 65] * 32.f, sp[6 * 65] * 32.f, sp[7 * 65] * 32.f);
            *(GAS v2u*)((unsigned char*)WT + (size_t)rm(n0 + n) * K + k0 + 8 * c) = o; }
        else { v4u o; o.x = pk2(sp[0 * 65], sp[1 * 65]); o.y = pk2(sp[2 * 65], sp[3 * 65]); o.z = pk2(sp[4 * 65], sp[5 * 65]); o.w = pk2(sp[6 * 65], sp[7 * 65]);
            *(GAS v4u*)(WT + (size_t)rm(n0 + n) * K + k0 + 8 * c) = o; } }
    asm volatile("s_waitcnt lgkmcnt(0)" ::: "memory");
}
struct RmId { __device__ __forceinline__ int operator()(int n) const { return n; } };
struct RmEvIn { __device__ __forceinline__ int operator()(int n) const {
    if (n < 512) return 256 * (n >> 7) + (n & 127);
    if (n < 1024) { const int m = n - 512; return 256 * (m >> 7) + 128 + (m & 127); }
    if (n < 2048) { const int m = n - 1024, sec = m >> 9, mm = m & 511, p = mm >> 8, r = mm & 255, wc = r >> 6, d = r & 63, bj = d >> 5, j = d & 31;
        return 256 * (4 + 2 * sec + p) + 128 * bj + 32 * wc + j; }
    return n; } };
struct RmGlu { int half; __device__ __forceinline__ int operator()(int n) const { return 256 * (n >> 7) + 128 * half + (n & 127); } };

template <class KAT> __device__ __forceinline__ void p0_prologue(Frame& F, KAT KA) {
#define in KA->in
    LAS float* sc = (LAS float*)F.lds;
    const int w = F.bx, bg = w & 3;
    const float* c = in[1];
    for (int i = F.tid; i < 8 * 1024; i += 512) { const float v = c[(size_t)bg * 8 * 1024 + i]; sc[i] = v / (1.0f + __expf(-v)); }
    __syncthreads();
    if (F.wave < 6) {
        const int chunk = (w >> 2) * 6 + F.wave, l = chunk / 192, cc = chunk % 192, col = cc * 32 + (F.lane & 31), kh = F.lane >> 5;
        const float* W = in[2] + (size_t)l * 1024 * 6144 + col;
        float acc[8];
#pragma unroll
        for (int bb = 0; bb < 8; ++bb) acc[bb] = 0.f;
        for (int k = kh * 512; k < kh * 512 + 512; k += 16) {
            float wv[16];
#pragma unroll
            for (int q = 0; q < 16; ++q) wv[q] = W[(size_t)(k + q) * 6144];
#pragma unroll
            for (int q4 = 0; q4 < 4; ++q4)
#pragma unroll
                for (int bb = 0; bb < 8; ++bb) { const f32x4 s = *(const LAS f32x4*)(sc + bb * 1024 + k + 4 * q4); acc[bb] += (s[0] * wv[4 * q4] + s[1] * wv[4 * q4 + 1]) + (s[2] * wv[4 * q4 + 2] + s[3] * wv[4 * q4 + 3]); }
        }
        float* mod = (float*)(F.ws + WS_MOD);
#pragma unroll
        for (int bb = 0; bb < 8; ++bb) { const float t = acc[bb] + __shfl_xor(acc[bb], 32);
            if (F.lane < 32) mod[((size_t)l * 32 + bg * 8 + bb) * 6144 + col] = t + in[3][(size_t)l * 6144 + col]; }
    }
    __syncthreads();
    LAS float* scr = (LAS float*)(F.lds + F.wave * 16640);
    const int gw = F.vcu * NWAVES + F.wave, NGW = F.G * NWAVES;
    bf16* WEVIN = (bf16*)(F.ws + WS_WEVIN); bf16* WEVOUT = (bf16*)(F.ws + WS_WEVOUT); bf16* WODIN = (bf16*)(F.ws + WS_WODIN); bf16* WODOUT = (bf16*)(F.ws + WS_WODOUT);
    bf16* WRG = (bf16*)(F.ws + WS_WRG); bf16* WIG = (bf16*)(F.ws + WS_WIG); bf16* W13 = (bf16*)(F.ws + WS_W13); bf16* W2 = (bf16*)(F.ws + WS_W2);
    constexpr int I_EVIN = 16 * 40, I_SQ = 16 * 16, I_ODIN = 16 * 32, I_W1 = 16 * 8, I_W2 = 8 * 16, I_G = 2 * 2;
    constexpr int NITEMS = I_EVIN + 2 * I_SQ + I_ODIN + 32 * I_W1 * 2 + 32 * I_W2 + 16 * I_G;
    for (int it = gw; it < NITEMS; it += NGW) {
        int r = it;
        if (r < I_EVIN) { p0_transpose_item<FP8_IN0 != 0>(in[6], 1024, 2560, WEVIN, scr, r, F.lane, RmEvIn{}); continue; } r -= I_EVIN;
        if (r < I_SQ) { p0_transpose_item<FP8_OUT != 0>(in[13], 1024, 1024, WEVOUT, scr, r, F.lane, RmId{}); continue; } r -= I_SQ;
        if (r < I_ODIN) { p0_transpose_item<FP8_IN1 != 0>(in[14], 1024, 2048, WODIN, scr, r, F.lane, RmId{}); continue; } r -= I_ODIN;
        if (r < I_SQ) { p0_transpose_item<FP8_OUT != 0>(in[22], 1024, 1024, WODOUT, scr, r, F.lane, RmId{}); continue; } r -= I_SQ;
        if (r < 32 * I_W1) { const int mat = r / I_W1; p0_transpose_item<true>(in[25] + (size_t)mat * 1024 * 512, 1024, 512, (bf16*)((unsigned char*)W13 + (size_t)mat * 1024 * 1024), scr, r % I_W1, F.lane, RmGlu{0}); continue; } r -= 32 * I_W1;
        if (r < 32 * I_W1) { const int mat = r / I_W1; p0_transpose_item<true>(in[26] + (size_t)mat * 1024 * 512, 1024, 512, (bf16*)((unsigned char*)W13 + (size_t)mat * 1024 * 1024), scr, r % I_W1, F.lane, RmGlu{1}); continue; } r -= 32 * I_W1;
        if (r < 32 * I_W2) { const int mat = r / I_W2; p0_transpose_item<true>(in[27] + (size_t)mat * 512 * 1024, 512, 1024, (bf16*)((unsigned char*)W2 + (size_t)mat * 1024 * 512), scr, r % I_W2, F.lane, RmId{}); continue; } r -= 32 * I_W2;
        { const int mat = r / I_G, which = mat >> 3, blk = mat & 7;
          p0_transpose_item((which ? in[19] : in[17]) + (size_t)blk * 128 * 128, 128, 128, (which ? WIG : WRG) + (size_t)blk * 128 * 128, scr, r % I_G, F.lane, RmId{}); }
    }
#undef in
}

__device__ __forceinline__ void norm_rows(Frame& F, const float* X, bf16* H, const float* ng, const float* modl, int sh_off, int sc_off) {
    const int gw = F.bx * NWAVES + F.wave;
    const int b = gw >> 6;
    f32x4 gm[4], sh[4];
#pragma unroll
    for (int j = 0; j < 4; ++j) { const int k = 256 * j + 4 * F.lane;
        const f32x4 g = *(const f32x4*)(ng + k), s = *(const f32x4*)(modl + (size_t)b * 6144 + sc_off + k);
        gm[j] = g * (s + 1.0f); sh[j] = *(const f32x4*)(modl + (size_t)b * 6144 + sh_off + k); }
    for (int r = 0; r < 32; r += 4) {
        const size_t row = (size_t)gw * 32 + r;
        f32x4 v[4][4]; float ss[4];
#pragma unroll
        for (int q = 0; q < 4; ++q)
#pragma unroll
            for (int j = 0; j < 4; ++j) v[q][j] = *(const f32x4*)(X + (row + q) * DM + 256 * j + 4 * F.lane);
#pragma unroll
        for (int q = 0; q < 4; ++q) { ss[q] = 0.f;
#pragma unroll
            for (int j = 0; j < 4; ++j) ss[q] += (v[q][j][0] * v[q][j][0] + v[q][j][1] * v[q][j][1]) + (v[q][j][2] * v[q][j][2] + v[q][j][3] * v[q][j][3]); }
#pragma unroll
        for (int q = 0; q < 4; ++q) {
            const float rstd = 1.0f / sqrtf(wave_sum(ss[q]) * (1.0f / DM) + EPS);
#pragma unroll
            for (int j = 0; j < 4; ++j) { const f32x4 o = v[q][j] * rstd * gm[j] + sh[j];
#if FP8_IN0
                *(unsigned*)((unsigned char*)H + (row + q) * DM + 256 * j + 4 * F.lane) = pk4_fp8(o[0], o[1], o[2], o[3]);
#else
                v2u w; w.x = pk2(o[0], o[1]); w.y = pk2(o[2], o[3]); *(v2u*)(H + (row + q) * DM + 256 * j + 4 * F.lane) = w;
#endif
            }
        }
    }
}

namespace sba {
constexpr int SLOTB = 8192, L_K = 0, L_V = 2 * SLOTB, L_FLAG = 4 * SLOTB, L_OST = 4 * SLOTB + 256;
__device__ __forceinline__ s16x4 vtr(const LAS unsigned char* p) { typedef short v4i16_t __attribute__((ext_vector_type(4))); return __builtin_bit_cast(s16x4, __builtin_amdgcn_ds_read_tr16_b64_v4i16((LAS v4i16_t*)p)); }
__device__ __forceinline__ void unit(int b, int h, int qb, const bf16* Q, const bf16* K, const bf16* V, bf16* CAT, LAS unsigned char* lds) {
    const int tid = threadIdx.x, lane = tid & 63, r32 = lane & 31, hi = lane >> 5; const int wid = __builtin_amdgcn_readfirstlane(tid >> 6);
    const long rowbase = (long)b * SEQ; const int q0 = qb * 256;
    const bf16* Qw = Q + (rowbase + q0 + wid * 32) * SBW + h * HD;
    const bf16* Kh = K + rowbase * SBW + h * HD; const bf16* Vh = V + rowbase * SBW + h * HD;
    const bf16* ksrc = Kh + (long)lane * SBW + wid * 8;
    const bf16* vsrc = Vh + (long)(16 * (wid & 3) + (lane >> 2)) * SBW + (wid >> 2) * 32 + (lane & 3) * 8;
    LAS unsigned char* kdst = lds + L_K + wid * 1024; LAS unsigned char* vdst = lds + L_V + wid * 1024;
#define SBA_DMA(t, slot) do { __builtin_amdgcn_global_load_lds((const unsigned*)(ksrc + (long)(t) * 64 * SBW), (LAS unsigned*)(kdst + (slot) * SLOTB), 16, 0, 0); \
                              __builtin_amdgcn_global_load_lds((const unsigned*)(vsrc + (long)(t) * 64 * SBW), (LAS unsigned*)(vdst + (slot) * SLOTB), 16, 0, 0); } while (0)
    const LAS unsigned char* kp0 = lds + L_K + hi * 1024 + r32 * 16;
    const LAS unsigned char* vp0 = lds + L_V + ((lane >> 4) & 1) * 32 + (lane & 3) * 8 + (4 * hi + ((lane & 15) >> 2)) * 64;
    volatile LAS unsigned* flags = (volatile LAS unsigned*)(lds + L_FLAG);
    const int NT = (q0 + 256) / 64;
    SBA_DMA(NT - 1, 0);
    bf16x8 qr[4];
#pragma unroll
    for (int d0 = 0; d0 < 4; ++d0) qr[d0] = *(const bf16x8*)(Qw + (long)r32 * SBW + d0 * 16 + hi * 8);
    f32x16 o0 = {}, o1 = {};
    float carry = 1.0f; bool done_w = false;
    const int qrow = q0 + wid * 32 + r32, qmin = q0 + wid * 32;
    for (int it = 0, t = NT - 1; t >= 0; --t, ++it) {
        const int slot = it & 1;
        __syncthreads();
        if (it > 0) { unsigned all = 1u;
#pragma unroll
            for (int w8 = 0; w8 < 8; ++w8) all &= flags[((it - 1) & 1) * 8 + w8];
            if (all) break; }
        if (t > 0) SBA_DMA(t - 1, slot ^ 1);
        const int kbase = 64 * t;
        if (!done_w && kbase < qmin + 31) {
            const LAS unsigned char* kp = kp0 + slot * SLOTB;
            bf16x8 kf[8];
#pragma unroll
            for (int d0 = 0; d0 < 4; ++d0) { kf[2 * d0] = *(const LAS bf16x8*)(kp + d0 * 2048); kf[2 * d0 + 1] = *(const LAS bf16x8*)(kp + d0 * 2048 + 512); }
            f32x16 C0 = {}, C1 = {};
#pragma unroll
            for (int d0 = 0; d0 < 4; ++d0) { C0 = __builtin_amdgcn_mfma_f32_32x32x16_bf16(kf[2 * d0], qr[d0], C0, 0, 0, 0); C1 = __builtin_amdgcn_mfma_f32_32x32x16_bf16(kf[2 * d0 + 1], qr[d0], C1, 0, 0, 0); }
            f32x16 D0, D1;
            const bool partial = (kbase + 64 > qmin);
#pragma unroll
            for (int r = 0; r < 16; ++r) {
                const float s0 = __builtin_fminf(__builtin_fmaxf(C0[r], -120.f), 120.f), s1 = __builtin_fminf(__builtin_fmaxf(C1[r], -120.f), 120.f);
                float e0 = fast_exp2(s0), e1 = fast_exp2(s1);
                float f0 = fast_rcp(1.0f + e0), f1 = fast_rcp(1.0f + e1);
                if (partial) { const int kp_ = kbase + 4 * hi + (r & 3) + 8 * (r >> 2);
                    if (!(kp_ < qrow)) { e0 = 0.f; f0 = 1.f; }
                    if (!(kp_ + 32 < qrow)) { e1 = 0.f; f1 = 1.f; } }
                C0[r] = e0; C1[r] = e1; D0[r] = f0; D1[r] = f1;
            }
            float own[8], par[8], eg[8];
#pragma unroll
            for (int g = 0; g < 4; ++g) {
                D0[4 * g + 2] *= D0[4 * g + 3]; D0[4 * g + 1] *= D0[4 * g + 2]; D0[4 * g] *= D0[4 * g + 1]; own[g] = D0[4 * g];
                D1[4 * g + 2] *= D1[4 * g + 3]; D1[4 * g + 1] *= D1[4 * g + 2]; D1[4 * g] *= D1[4 * g + 1]; own[4 + g] = D1[4 * g];
            }
#pragma unroll
            for (int j = 0; j < 8; ++j) par[j] = __shfl_xor(own[j], 32);
            float sp = carry;
#pragma unroll
            for (int j = 7; j >= 0; --j) { eg[j] = hi ? sp : sp * par[j]; sp *= own[j] * par[j]; }
            carry = sp;
#pragma unroll
            for (int g = 0; g < 4; ++g)
#pragma unroll
                for (int i = 0; i < 4; ++i) { C0[4 * g + i] = (C0[4 * g + i] * D0[4 * g + i]) * eg[g]; C1[4 * g + i] = (C1[4 * g + i] * D1[4 * g + i]) * eg[4 + g]; }
            v4u pw0, pw1, pw2, pw3;
            pw0 = (v4u){pk2(C0[0], C0[1]), pk2(C0[2], C0[3]), pk2(C0[4], C0[5]), pk2(C0[6], C0[7])};
            pw1 = (v4u){pk2(C0[8], C0[9]), pk2(C0[10], C0[11]), pk2(C0[12], C0[13]), pk2(C0[14], C0[15])};
            pw2 = (v4u){pk2(C1[0], C1[1]), pk2(C1[2], C1[3]), pk2(C1[4], C1[5]), pk2(C1[6], C1[7])};
            pw3 = (v4u){pk2(C1[8], C1[9]), pk2(C1[10], C1[11]), pk2(C1[12], C1[13]), pk2(C1[14], C1[15])};
            const LAS unsigned char* vp = vp0 + slot * SLOTB;
#pragma unroll
            for (int d0 = 0; d0 < 2; ++d0) {
                s16x4 lo[4], hh[4];
#pragma unroll
                for (int ks = 0; ks < 4; ++ks) { lo[ks] = vtr(vp + d0 * 4096 + ks * 1024); hh[ks] = vtr(vp + d0 * 4096 + ks * 1024 + 512); }
#define SBA_VF(k) (bf16x8){lo[k][0], lo[k][1], lo[k][2], lo[k][3], hh[k][0], hh[k][1], hh[k][2], hh[k][3]}
                f32x16 oo = d0 ? o1 : o0;
                oo = __builtin_amdgcn_mfma_f32_32x32x16_bf16(__builtin_bit_cast(bf16x8, pw0), SBA_VF(0), oo, 0, 0, 0);
                oo = __builtin_amdgcn_mfma_f32_32x32x16_bf16(__builtin_bit_cast(bf16x8, pw1), SBA_VF(1), oo, 0, 0, 0);
                oo = __builtin_amdgcn_mfma_f32_32x32x16_bf16(__builtin_bit_cast(bf16x8, pw2), SBA_VF(2), oo, 0, 0, 0);
                oo = __builtin_amdgcn_mfma_f32_32x32x16_bf16(__builtin_bit_cast(bf16x8, pw3), SBA_VF(3), oo, 0, 0, 0);
                if (d0) o1 = oo; else o0 = oo;
#undef SBA_VF
            }
            done_w = __all(carry < 1e-30f);
        }
        if (lane == 0) flags[slot * 8 + wid] = done_w ? 1u : 0u;
    }
    {
        LAS bf16* stg = (LAS bf16*)(lds + L_OST) + wid * 2048;
#pragma unroll
        for (int r = 0; r < 16; ++r) { const int orow = (r & 3) + 8 * (r >> 2) + 4 * hi;
            stg[orow * 64 + r32] = (bf16)(pk2(o0[r], 0.f) & 0xffffu); stg[orow * 64 + 32 + r32] = (bf16)(pk2(o1[r], 0.f) & 0xffffu); }
        asm volatile("s_waitcnt lgkmcnt(0)" ::: "memory");
        bf16* Ow = CAT + (rowbase + q0 + wid * 32) * DM + 512 + h * HD;
#pragma unroll
        for (int i = 0; i < 4; ++i) { const int row = i * 8 + (lane >> 3), ch = lane & 7; const v4u v = *(const LAS v4u*)(stg + row * 64 + ch * 8);
#if FP8_OUT
            *(v2u*)((unsigned char*)CAT + (rowbase + q0 + wid * 32 + row) * DM + 512 + h * HD + ch * 8) = bf8x_to_fp8(v);
#else
            *(v4u*)(Ow + (long)row * DM + ch * 8) = v;
#endif
        }
    }
    __syncthreads();
#undef SBA_DMA
}
}

__device__ __forceinline__ void conv_prefetch(Frame& F, v4u (&pf)[8], int uidx, const bf16* U0) {
    const int b = uidx >> 6, t0 = (uidx & 63) * 32;
#pragma unroll
    for (int i = 0; i < 8; ++i) { const int idx = F.tid + 512 * i; const int ri = idx >> 6, ch = idx & 63, tok = t0 - 30 + ri;
        pf[i] = (v4u){0u, 0u, 0u, 0u};
        if (idx < 62 * 64 && tok >= 0) pf[i] = *(const v4u*)(U0 + ((size_t)b * SEQ + tok) * CONVC + ch * 8); }
}
__device__ __forceinline__ void conv_phase(Frame& F, const bf16* U0, bf16* CAT, const float* dw_w, const float* dw_b, const float* ln_g, const float* ln_b) {
    LAS unsigned char* tile = F.lds;
    LAS float* resl = (LAS float*)(F.lds + 63488);
    v4u pf[8];
    const int nunits = NB * (SEQ / 32);
    if (F.vcu < nunits) conv_prefetch(F, pf, F.vcu, U0);
    for (int uidx = F.vcu; uidx < nunits; uidx += F.G) {
        const int b = uidx >> 6, t0 = (uidx & 63) * 32;
#pragma unroll
        for (int i = 0; i < 8; ++i) { const int idx = F.tid + 512 * i; if (idx < 62 * 64) *(LAS v4u*)(tile + idx * 16) = pf[i]; }
        __syncthreads();
        if (uidx + F.G < nunits) conv_prefetch(F, pf, uidx + F.G, U0);
        {
            const int cp = F.tid & 255, th = F.tid >> 8;
            float w0[31], w1[31];
#pragma unroll
            for (int k = 0; k < 31; ++k) { const f32x2 wv = *(const f32x2*)(dw_w + k * CONVC + 2 * cp); w0[k] = wv[0]; w1[k] = wv[1]; }
            const f32x2 bias = *(const f32x2*)(dw_b + 2 * cp);
#pragma unroll 1
            for (int og = 0; og < 2; ++og) {
                float a0[8], a1[8];
#pragma unroll
                for (int o = 0; o < 8; ++o) { a0[o] = bias[0]; a1[o] = bias[1]; }
                const LAS unsigned char* tp = tile + (16 * th + 8 * og) * 1024 + cp * 4;
#pragma unroll
                for (int j = 0; j < 38; ++j) {
                    const unsigned xin = *(const LAS unsigned*)(tp + j * 1024);
                    const float x0 = bflo(xin), x1 = bfhi(xin);
#pragma unroll
                    for (int o = 0; o < 8; ++o) { const int k = j - o; if (k >= 0 && k <= 30) { a0[o] += w0[k] * x0; a1[o] += w1[k] * x1; } }
                }
#pragma unroll
                for (int o = 0; o < 8; ++o) *(LAS f32x2*)(resl + (16 * th + 8 * og + o) * 512 + 2 * cp) = (f32x2){a0[o], a1[o]};
            }
        }
        __syncthreads();
        {
            const f32x4 lg0 = *(const f32x4*)(ln_g + 8 * F.lane), lg1 = *(const f32x4*)(ln_g + 8 * F.lane + 4), lb0 = *(const f32x4*)(ln_b + 8 * F.lane), lb1 = *(const f32x4*)(ln_b + 8 * F.lane + 4);
#pragma unroll
            for (int i = 0; i < 4; ++i) {
                const int tk = F.wave * 4 + i;
                const f32x4 v0 = *(const LAS f32x4*)(resl + tk * 512 + 8 * F.lane), v1 = *(const LAS f32x4*)(resl + tk * 512 + 8 * F.lane + 4);
                const float sm = wave_sum((v0[0] + v0[1]) + (v0[2] + v0[3]) + (v1[0] + v1[1]) + (v1[2] + v1[3]));
                const float mean = sm * (1.0f / CONVC);
                const f32x4 d0 = v0 - mean, d1 = v1 - mean;
                const float q = wave_sum((d0[0] * d0[0] + d0[1] * d0[1]) + (d0[2] * d0[2] + d0[3] * d0[3]) + (d1[0] * d1[0] + d1[1] * d1[1]) + (d1[2] * d1[2] + d1[3] * d1[3]));
                const float rstd = 1.0f / sqrtf(q * (1.0f / CONVC) + EPS);
                const f32x4 y0 = d0 * rstd * lg0 + lb0, y1 = d1 * rstd * lg1 + lb1;
                v4u pw; pw.x = pk2(siluf_(y0[0]), siluf_(y0[1])); pw.y = pk2(siluf_(y0[2]), siluf_(y0[3])); pw.z = pk2(siluf_(y1[0]), siluf_(y1[1])); pw.w = pk2(siluf_(y1[2]), siluf_(y1[3]));
#if FP8_OUT
                *(v2u*)((unsigned char*)CAT + ((size_t)b * SEQ + t0 + tk) * DM + 8 * F.lane) = bf8x_to_fp8(pw);
#else
                *(v4u*)(CAT + ((size_t)b * SEQ + t0 + tk) * DM + 8 * F.lane) = pw;
#endif
            }
        }
        __syncthreads();
    }
}

__device__ __forceinline__ void lru_unit(Frame& F, int b, int cb, const bf16* GY, const bf16* XB, bf16* CAT2, const bf16* WRG, const bf16* WIG,
                                         const float* conv_w, const float* conv_b, const float* rg_b, const float* ig_b, const float* lam) {
    constexpr int L_XR = 0, L_XC = 17408, L_GY = 34816, L_OUT = 51200;
    LAS unsigned char* lds = F.lds;
    const int lane = F.lane, wv = F.wave, l15 = lane & 15, g4 = lane >> 4;
    const int cl_ = 16 * wv + l15, cglob = cb * 128 + cl_;
    bf16x8 brg[4], big[4];
#pragma unroll
    for (int ks = 0; ks < 4; ++ks) { brg[ks] = *(const bf16x8*)(WRG + ((size_t)cb * 128 + cl_) * 128 + 32 * ks + 8 * g4); big[ks] = *(const bf16x8*)(WIG + ((size_t)cb * 128 + cl_) * 128 + 32 * ks + 8 * g4); }
    const float rb = rg_b[cglob], ib = ig_b[cglob];
    const float lamv = lam[cglob];
    const float cl2 = -8.0f * log1pf(expf(-lamv)) * 1.4426950408889634f;
    const int cp2 = F.tid & 63;
    float cw0[4], cw1[4];
#pragma unroll
    for (int k = 0; k < 4; ++k) { const f32x2 w = *(const f32x2*)(conv_w + k * DM + cb * 128 + 2 * cp2); cw0[k] = w[0]; cw1[k] = w[1]; }
    const f32x2 cbias = *(const f32x2*)(conv_b + cb * 128 + 2 * cp2);
    const size_t rowb = (size_t)b * SEQ;
    v4u px[3], pg[2];
#define LRU_PREFETCH(t0_) do { \
        _Pragma("unroll") for (int i = 0; i < 3; ++i) { const int idx = F.tid + 512 * i; px[i] = (v4u){0u, 0u, 0u, 0u}; \
            if (idx < 67 * 16) { const int ri = idx >> 4, chn = idx & 15, tok = (t0_) - 3 + ri; if (tok >= 0) px[i] = *(const v4u*)(XB + (rowb + tok) * DM + cb * 128 + chn * 8); } } \
        _Pragma("unroll") for (int i = 0; i < 2; ++i) { const int idx = F.tid + 512 * i; const int ri = idx >> 4, chn = idx & 15; pg[i] = *(const v4u*)(GY + (rowb + (t0_) + ri) * DM + cb * 128 + chn * 8); } } while (0)
    LRU_PREFETCH(0);
    float carry = 0.f;
    for (int it = 0; it < SEQ / 64; ++it) {
        const int t0 = it * 64;
#pragma unroll
        for (int i = 0; i < 3; ++i) { const int idx = F.tid + 512 * i; if (idx < 67 * 16) *(LAS v4u*)(lds + L_XR + idx * 16) = px[i]; }
#pragma unroll
        for (int i = 0; i < 2; ++i) { const int idx = F.tid + 512 * i; *(LAS v4u*)(lds + L_GY + idx * 16) = pg[i]; }
        __syncthreads();
        if (it + 1 < SEQ / 64) LRU_PREFETCH(t0 + 64);
        {
            float x0[11], x1[11];
#pragma unroll
            for (int j = 0; j < 11; ++j) { const unsigned xin = *(const LAS unsigned*)(lds + L_XR + (8 * wv + j) * 256 + cp2 * 4); x0[j] = bflo(xin); x1[j] = bfhi(xin); }
#pragma unroll
            for (int o = 0; o < 8; ++o) {
                const float y0 = cbias[0] + (cw0[0] * x0[o] + cw0[1] * x0[o + 1]) + (cw0[2] * x0[o + 2] + cw0[3] * x0[o + 3]);
                const float y1 = cbias[1] + (cw1[0] * x1[o] + cw1[1] * x1[o + 1]) + (cw1[2] * x1[o + 2] + cw1[3] * x1[o + 3]);
                *(LAS unsigned*)(lds + L_XC + (8 * wv + o) * 272 + cp2 * 4) = pk2(y0, y1);
            }
        }
        __syncthreads();
        float av[4][4], bv[4][4], gy[4][4], Ae[4], Be[4], At[4], Bt[4];
#pragma unroll
        for (int m = 0; m < 4; ++m) {
            f32x4 aR = {0.f, 0.f, 0.f, 0.f}, aI = {0.f, 0.f, 0.f, 0.f};
#pragma unroll
            for (int ks = 0; ks < 4; ++ks) { const bf16x8 af = *(const LAS bf16x8*)(lds + L_XC + (16 * m + l15) * 272 + (32 * ks + 8 * g4) * 2);
                aR = __builtin_amdgcn_mfma_f32_16x16x32_bf16(af, brg[ks], aR, 0, 0, 0); aI = __builtin_amdgcn_mfma_f32_16x16x32_bf16(af, big[ks], aI, 0, 0, 0); }
            float A = 1.f, B = 0.f;
#pragma unroll
            for (int r = 0; r < 4; ++r) {
                const int tk = 16 * m + 4 * g4 + r;
                const float xcv = bf2f(*(const LAS bf16*)(lds + L_XC + tk * 272 + cl_ * 2));
                gy[m][r] = bf2f(*(const LAS bf16*)(lds + L_GY + tk * 256 + cl_ * 2));
                const float rr = sigmoidf_(aR[r] + rb), ii = sigmoidf_(aI[r] + ib);
                const float a = fast_exp2(cl2 * rr);
                const float mult = sqrtf(__builtin_fmaxf(1.0f - a * a, 0.f));
                av[m][r] = a; bv[m][r] = mult * ii * xcv;
                B = a * B + bv[m][r]; A = A * a;
            }
            { const float Ap = __shfl_up(A, 16), Bp = __shfl_up(B, 16); if (g4 >= 1) { B = A * Bp + B; A = A * Ap; } }
            { const float Ap = __shfl_up(A, 32), Bp = __shfl_up(B, 32); if (g4 >= 2) { B = A * Bp + B; A = A * Ap; } }
            { const float Ap = __shfl_up(A, 16), Bp = __shfl_up(B, 16); Ae[m] = (g4 == 0) ? 1.f : Ap; Be[m] = (g4 == 0) ? 0.f : Bp; }
            At[m] = __shfl(A, 48 + l15); Bt[m] = __shfl(B, 48 + l15);
        }
#pragma unroll
        for (int m = 0; m < 4; ++m) {
            float hcur = Ae[m] * carry + Be[m];
            carry = At[m] * carry + Bt[m];
#pragma unroll
            for (int r = 0; r < 4; ++r) { hcur = av[m][r] * hcur + bv[m][r]; const int tk = 16 * m + 4 * g4 + r;
                *(LAS bf16*)(lds + L_OUT + tk * 256 + cl_ * 2) = (bf16)(pk2(gy[m][r] * hcur, 0.f) & 0xffffu); }
        }
        __syncthreads();
#pragma unroll
        for (int i = 0; i < 2; ++i) { const int idx = F.tid + 512 * i; const int ri = idx >> 4, chn = idx & 15;
#if FP8_OUT
            *(v2u*)((unsigned char*)CAT2 + (rowb + t0 + ri) * DM + cb * 128 + chn * 8) = bf8x_to_fp8(*(const LAS v4u*)(lds + L_OUT + idx * 16)); }
#else
            *(v4u*)(CAT2 + (rowb + t0 + ri) * DM + cb * 128 + chn * 8) = *(const LAS v4u*)(lds + L_OUT + idx * 16); }
#endif
    }
    __syncthreads();
#undef LRU_PREFETCH
}

__device__ __forceinline__ void router_phase(Frame& F, const float* X, bf16* H, const float* ng, const float* modl, const float* rw, const float* rbias) {
    constexpr int WSTR = 2064;
    LAS unsigned char* whi = F.lds;
    LAS unsigned char* wlo = F.lds + 16 * WSTR;
    LAS float* gml = (LAS float*)(F.lds + 67584);
    LAS float* shl = (LAS float*)(F.lds + 71680);
    LAS float* brl = (LAS float*)(F.lds + 75776);
    LAS int* cnt = (LAS int*)(F.lds + 75776 + 64);
    LAS float* pbr = (LAS float*)(F.lds + 75776 + 128);
    LAS float* exl = (LAS float*)(F.lds + 77824);
    LAS float* exs = (LAS float*)(F.lds + 77824 + 16384);
    const int w = F.bx, b = w >> 3;
    for (int i = F.tid; i < 16 * 1024; i += 512) { const int k = i >> 4, e = i & 15; const float v = rw[i]; const unsigned hb = pk2(v, 0.f) & 0xffffu; const float lo = v - bflo(hb);
        *(LAS bf16*)(whi + e * WSTR + k * 2) = (bf16)hb; *(LAS bf16*)(wlo + e * WSTR + k * 2) = (bf16)(pk2(lo, 0.f) & 0xffffu); }
    for (int k = F.tid; k < 1024; k += 512) { gml[k] = ng[k] * (1.0f + modl[(size_t)b * 6144 + 4 * 1024 + k]); shl[k] = modl[(size_t)b * 6144 + 3 * 1024 + k]; }
    if (F.tid < 16) cnt[F.tid] = 0;
    __syncthreads();
    {
        float acc[16];
#pragma unroll
        for (int e = 0; e < 16; ++e) acc[e] = 0.f;
#pragma unroll
        for (int i = 0; i < 2; ++i) { const int k = 128 * F.wave + 64 * i + F.lane; const float sv = shl[k];
#pragma unroll
            for (int q = 0; q < 4; ++q) { const f32x4 wv = *(const f32x4*)(rw + k * 16 + 4 * q); acc[4 * q] += sv * wv[0]; acc[4 * q + 1] += sv * wv[1]; acc[4 * q + 2] += sv * wv[2]; acc[4 * q + 3] += sv * wv[3]; } }
#pragma unroll
        for (int e = 0; e < 16; ++e) { const float t = wave_sum(acc[e]); if (F.lane == 0) pbr[F.wave * 16 + e] = t; }
    }
    __syncthreads();
    if (F.tid < 16) { float t = 0.f;
#pragma unroll
        for (int q = 0; q < 8; ++q) t += pbr[q * 16 + F.tid]; brl[F.tid] = t; }
    __syncthreads();
    const int r16 = F.lane & 15, kq = F.lane >> 4, g = F.wave >> 2, kp = F.wave & 3;
    int* EID = (int*)(F.ws + META_EID); float* GATE = (float*)(F.ws + META_GATE);
    f32x4 xn[8][2];
    { const size_t row0 = (size_t)w * 256 + 16 * g + r16;
#pragma unroll
      for (int cc = 0; cc < 8; ++cc) { const int col = 256 * kp + 32 * cc + 8 * kq; xn[cc][0] = *(const f32x4*)(X + row0 * DM + col); xn[cc][1] = *(const f32x4*)(X + row0 * DM + col + 4); } }
    for (int pass = 0; pass < 8; ++pass) {
        const int buf = pass & 1;
        const size_t row = (size_t)w * 256 + 32 * pass + 16 * g + r16;
        f32x4 xg[8][2]; float ss = 0.f; f32x4 acc = {0.f, 0.f, 0.f, 0.f};
#pragma unroll
        for (int cc = 0; cc < 8; ++cc) {
            const int col = 256 * kp + 32 * cc + 8 * kq;
            const f32x4 x0 = xn[cc][0], x1 = xn[cc][1];
            ss += (x0[0] * x0[0] + x0[1] * x0[1]) + (x0[2] * x0[2] + x0[3] * x0[3]) + (x1[0] * x1[0] + x1[1] * x1[1]) + (x1[2] * x1[2] + x1[3] * x1[3]);
            const f32x4 a0 = x0 * *(const LAS f32x4*)(gml + col), a1 = x1 * *(const LAS f32x4*)(gml + col + 4);
            xg[cc][0] = a0; xg[cc][1] = a1;
            v4u hi; hi.x = pk2(a0[0], a0[1]); hi.y = pk2(a0[2], a0[3]); hi.z = pk2(a1[0], a1[1]); hi.w = pk2(a1[2], a1[3]);
            v4u lo; lo.x = pk2(a0[0] - bflo(hi.x), a0[1] - bfhi(hi.x)); lo.y = pk2(a0[2] - bflo(hi.y), a0[3] - bfhi(hi.y)); lo.z = pk2(a1[0] - bflo(hi.z), a1[1] - bfhi(hi.z)); lo.w = pk2(a1[2] - bflo(hi.w), a1[3] - bfhi(hi.w));
            const bf16x8 bh = *(const LAS bf16x8*)(whi + r16 * WSTR + col * 2), bl = *(const LAS bf16x8*)(wlo + r16 * WSTR + col * 2);
            acc = __builtin_amdgcn_mfma_f32_16x16x32_bf16(__builtin_bit_cast(bf16x8, hi), bh, acc, 0, 0, 0);
            acc = __builtin_amdgcn_mfma_f32_16x16x32_bf16(__builtin_bit_cast(bf16x8, lo), bh, acc, 0, 0, 0);
            acc = __builtin_amdgcn_mfma_f32_16x16x32_bf16(__builtin_bit_cast(bf16x8, hi), bl, acc, 0, 0, 0);
        }
        {
            const size_t rown = pass < 7 ? row + 32 : row;
#pragma unroll
            for (int cc = 0; cc < 8; ++cc) { const int col = 256 * kp + 32 * cc + 8 * kq; xn[cc][0] = *(const f32x4*)(X + rown * DM + col); xn[cc][1] = *(const f32x4*)(X + rown * DM + col + 4); }
        }
        ss += __shfl_xor(ss, 16); ss += __shfl_xor(ss, 32);
        { LAS float* ep = exl + (((buf * 2 + g) * 4 + kp) * 16) * 16;
#pragma unroll
          for (int rg = 0; rg < 4; ++rg) ep[(4 * kq + rg) * 16 + r16] = acc[rg];
          if (kq == 0) exs[((buf * 2 + g) * 4 + kp) * 16 + r16] = ss; }
        __syncthreads();
        float sst = 0.f;
#pragma unroll
        for (int q = 0; q < 4; ++q) sst += exs[((buf * 2 + g) * 4 + q) * 16 + r16];
        const float rstd = 1.0f / sqrtf(sst * (1.0f / DM) + EPS);
#pragma unroll
        for (int cc = 0; cc < 8; ++cc) { const int col = 256 * kp + 32 * cc + 8 * kq;
            const f32x4 o0 = xg[cc][0] * rstd + *(const LAS f32x4*)(shl + col), o1 = xg[cc][1] * rstd + *(const LAS f32x4*)(shl + col + 4);
            v2u pw; pw.x = pk4_fp8(o0[0], o0[1], o0[2], o0[3]); pw.y = pk4_fp8(o1[0], o1[1], o1[2], o1[3]);
            *(v2u*)((unsigned char*)H + row * DM + col) = pw; }
        if (kp == 0 && kq == 0) {
            float sc[16], bi[16];
#pragma unroll
            for (int e4 = 0; e4 < 4; ++e4) { f32x4 t = {0.f, 0.f, 0.f, 0.f};
#pragma unroll
                for (int q = 0; q < 4; ++q) t += *(const LAS f32x4*)(exl + ((((buf * 2 + g) * 4 + q) * 16) + r16) * 16 + 4 * e4);
#pragma unroll
                for (int i = 0; i < 4; ++i) { const int e = 4 * e4 + i; const float lg = t[i] * rstd + brl[e]; sc[e] = 1.0f / (1.0f + __expf(-lg)); bi[e] = sc[e] + rbias[e]; } }
            int gbest = 0; float gsb = -1e30f;
#pragma unroll
            for (int gg = 0; gg < 4; ++gg) {
                float m1 = bi[4 * gg], m2 = -1e30f;
#pragma unroll
                for (int i = 1; i < 4; ++i) { const float v = bi[4 * gg + i]; if (v > m1) { m2 = m1; m1 = v; } else if (v > m2) m2 = v; }
                const float gs = m1 + m2; if (gs > gsb) { gsb = gs; gbest = gg; }
            }
            float v4[4], s4[4];
#pragma unroll
            for (int i = 0; i < 4; ++i) { v4[i] = gbest == 0 ? bi[i] : gbest == 1 ? bi[4 + i] : gbest == 2 ? bi[8 + i] : bi[12 + i]; s4[i] = gbest == 0 ? sc[i] : gbest == 1 ? sc[4 + i] : gbest == 2 ? sc[8 + i] : sc[12 + i]; }
            int i1 = 0;
#pragma unroll
            for (int i = 1; i < 4; ++i) if (v4[i] > v4[i1]) i1 = i;
            int i2 = (i1 == 0) ? 1 : 0;
#pragma unroll
            for (int i = 0; i < 4; ++i) if (i != i1 && i != i2 && v4[i] > v4[i2]) i2 = i;
            const float se1 = i1 == 0 ? s4[0] : i1 == 1 ? s4[1] : i1 == 2 ? s4[2] : s4[3], se2 = i2 == 0 ? s4[0] : i2 == 1 ? s4[1] : i2 == 2 ? s4[2] : s4[3];
            const int e1 = 4 * gbest + i1, e2 = 4 * gbest + i2; const float inv = 1.0f / (se1 + se2);
            EID[row * 2] = e1; EID[row * 2 + 1] = e2; GATE[row * 2] = se1 * inv; GATE[row * 2 + 1] = se2 * inv;
            atomicAdd((int*)&cnt[e1], 1); atomicAdd((int*)&cnt[e2], 1);
        }
    }
    __syncthreads();
    if (F.tid < 16) ((int*)(F.ws + META_BCNT))[w * 16 + F.tid] = cnt[F.tid];
    __syncthreads();
}

__device__ __forceinline__ void slot_phase(Frame& F) {
    LAS int* cn = (LAS int*)F.lds;
    LAS int* mybase = (LAS int*)(F.lds + 16384);
    LAS int* tot = (LAS int*)(F.lds + 16384 + 64);
    LAS int* cursor = (LAS int*)(F.lds + 16384 + 128);
    LAS int* pstart = (LAS int*)(F.lds + 16384 + 192);
    const int w = F.bx;
    const int* BC = (const int*)(F.ws + META_BCNT);
    int* TOK = (int*)(F.ws + META_TOK);
    for (int i = F.tid; i < 4096; i += 512) cn[i] = BC[i];
    __syncthreads();
    if (F.tid < 16) { int run = 0, mb = 0; for (int j = 0; j < 256; ++j) { if (j == w) mb = run; run += cn[j * 16 + F.tid]; } mybase[F.tid] = mb; tot[F.tid] = run; }
    __syncthreads();
    if (F.tid == 0) {
        int ps = 0; int* TE = (int*)(F.ws + META_TILEE);
        for (int e = 0; e < 16; ++e) { const int padded = (tot[e] + 255) & ~255; cursor[e] = ps + mybase[e]; pstart[e] = ps;
            if (w == 0) for (int tl = ps >> 8; tl < (ps + padded) >> 8; ++tl) TE[tl] = e;
            ps += padded; }
        if (w == 0) *(int*)(F.ws + META_NT) = ps >> 8;
    }
    __syncthreads();
    if (w < 16) { const int s0 = pstart[w] + tot[w], s1 = pstart[w] + ((tot[w] + 255) & ~255); for (int sidx = s0 + F.tid; sidx < s1; sidx += 512) TOK[sidx] = 0; }
    const int* EID = (const int*)(F.ws + META_EID); int* SLOT = (int*)(F.ws + META_SLOT);
    if (F.lane < 32) {
        const size_t t = (size_t)w * 256 + F.wave * 32 + F.lane;
        const v2u ev = *(const v2u*)(EID + t * 2); const int ms0 = atomicAdd((int*)&cursor[ev.x], 1), ms1 = atomicAdd((int*)&cursor[ev.y], 1);
        v2u sv; sv.x = (unsigned)ms0; sv.y = (unsigned)ms1; *(v2u*)(SLOT + t * 2) = sv; TOK[ms0] = (int)t; TOK[ms1] = (int)t;
    }
    __syncthreads();
}

template <bool NEXT>
__device__ __forceinline__ void combine_phase(Frame& F, const float* X, float* XO, const bf16* Y, const float* modl  , bf16* H, const float* ng_next, const float* modn  ) {
    const int gw = F.bx * NWAVES + F.wave, b = gw >> 6;
    const int* SLOT = (const int*)(F.ws + META_SLOT); const float* GATE = (const float*)(F.ws + META_GATE);
    f32x4 g2[4], gm[4], sh[4];
#pragma unroll
    for (int j = 0; j < 4; ++j) { const int k = 256 * j + 4 * F.lane; g2[j] = *(const f32x4*)(modl + (size_t)b * 6144 + 5 * 1024 + k);
        if (NEXT) { const f32x4 g = *(const f32x4*)(ng_next + k), s = *(const f32x4*)(modn + (size_t)b * 6144 + 1 * 1024 + k); gm[j] = g * (s + 1.0f); sh[j] = *(const f32x4*)(modn + (size_t)b * 6144 + k); } }
    const size_t rbase = (size_t)gw * 32;
    int ms0 = 0, ms1 = 0; float mg0 = 0.f, mg1 = 0.f;
    if (F.lane < 32) { const v2u sv = *(const v2u*)(SLOT + (rbase + F.lane) * 2); const f32x2 gv = *(const f32x2*)(GATE + (rbase + F.lane) * 2); ms0 = (int)sv.x; ms1 = (int)sv.y; mg0 = gv[0]; mg1 = gv[1]; }
    for (int r0 = 0; r0 < 32; r0 += 4) {
        f32x4 x[4][4]; v2u ya[4][4], yb[4][4]; float ga[4], gb[4];
#pragma unroll
        for (int q = 0; q < 4; ++q) {
            const int s0 = __builtin_amdgcn_readlane(ms0, r0 + q), s1 = __builtin_amdgcn_readlane(ms1, r0 + q);
            ga[q] = __builtin_bit_cast(float, __builtin_amdgcn_readlane(__builtin_bit_cast(int, mg0), r0 + q)); gb[q] = __builtin_bit_cast(float, __builtin_amdgcn_readlane(__builtin_bit_cast(int, mg1), r0 + q));
#pragma unroll
            for (int j = 0; j < 4; ++j) { const int k = 256 * j + 4 * F.lane;
                x[q][j] = *(const f32x4*)(X + (rbase + r0 + q) * DM + k); ya[q][j] = *(const v2u*)(Y + (size_t)s0 * DM + k); yb[q][j] = *(const v2u*)(Y + (size_t)s1 * DM + k); }
        }
        asm volatile("" ::: "memory");
#pragma unroll
        for (int q = 0; q < 4; ++q) {
            const size_t row = rbase + r0 + q; float ss = 0.f; f32x4 v[4];
#pragma unroll
            for (int j = 0; j < 4; ++j) { const int k = 256 * j + 4 * F.lane;
                f32x4 f; f[0] = ga[q] * bflo(ya[q][j].x) + gb[q] * bflo(yb[q][j].x); f[1] = ga[q] * bfhi(ya[q][j].x) + gb[q] * bfhi(yb[q][j].x); f[2] = ga[q] * bflo(ya[q][j].y) + gb[q] * bflo(yb[q][j].y); f[3] = ga[q] * bfhi(ya[q][j].y) + gb[q] * bfhi(yb[q][j].y);
                v[j] = x[q][j] + g2[j] * f;
                *(f32x4*)(XO + row * DM + k) = v[j];
                ss += (v[j][0] * v[j][0] + v[j][1] * v[j][1]) + (v[j][2] * v[j][2] + v[j][3] * v[j][3]); }
            if (NEXT) {
                const float rstd = 1.0f / sqrtf(wave_sum(ss) * (1.0f / DM) + EPS);
#pragma unroll
                for (int j = 0; j < 4; ++j) { const f32x4 o = v[j] * rstd * gm[j] + sh[j];
#if FP8_IN1
                    *(unsigned*)((unsigned char*)H + row * DM + 256 * j + 4 * F.lane) = pk4_fp8(o[0], o[1], o[2], o[3]);
#else
                    v2u pw; pw.x = pk2(o[0], o[1]); pw.y = pk2(o[2], o[3]); *(v2u*)(H + row * DM + 256 * j + 4 * F.lane) = pw;
#endif
                }
            }
        }
    }
}

constexpr int NPHASE = 18;
struct Args { const float* in[28]; float* out; unsigned char* ws; int ph_lo, ph_hi; };
template <int PLO, int PHI> __global__ void __launch_bounds__(NWAVES * 64, 2) mk_fwd(Args args) {
    extern __shared__ __attribute__((aligned(16))) unsigned char lds_raw[];
    Frame F;
    F.lds = (LAS unsigned char*)lds_raw;
    F.tid = threadIdx.x; F.lane = F.tid & 63; F.wave = __builtin_amdgcn_readfirstlane(F.tid >> 6);
    F.G = gridDim.x; F.bx = blockIdx.x; F.vcu = (F.G % 8 == 0) ? (F.bx % 8) * (F.G / 8) + F.bx / 8 : F.bx;
    F.ws = args.ws;
    volatile LAS unsigned* MISC = (volatile LAS unsigned*)(F.lds + MISC_OFF);
    for (int u = F.tid; u < (LDS_BYTES - LDSCTL_OFF) / 4; u += NWAVES * 64) ((LAS unsigned*)(F.lds + LDSCTL_OFF))[u] = 0u;
    __syncthreads();
#if MK_ONE_LAUNCH
    XcdBarrier bar = xcd_barrier_post((unsigned*)(F.ws + WS_CTL) + CW_BAR, MISC + 8);
#define GRID_BAR() do { XcdBarrier b_ = bar; asm volatile("" : "+s"(b_.bar), "+s"(b_.x)); xcd_barrier(b_); } while (0)
#else
#define GRID_BAR() do {} while (0)
#endif
    constexpr int lo = PLO, hi = PHI;
#ifndef PHASE_MASK
#define PHASE_MASK 0x3ffff
#endif
#define IN(k) ((((PHASE_MASK) >> (k)) & 1) && lo <= (k) && (k) < hi)
#ifndef PROBE_REP
#define PROBE_REP 0
#endif
#define REPN(k) (((PROBE_REP) >> (k)) & 1)
#define SEAM(k) do { if (IN(k) && IN((k) + 1)) GRID_BAR(); } while (0)
    typedef const __attribute__((address_space(4))) Args* KArgs; KArgs KA = (KArgs)__builtin_amdgcn_kernarg_segment_ptr();
#define in KA->in
#define PHASE_ENTER() do { KA = (KArgs)__builtin_amdgcn_kernarg_segment_ptr(); asm volatile("" : "+s"(KA)); F.ws = KA->ws; int tid_o = threadIdx.x; asm volatile("" : "+v"(tid_o)); F.tid = tid_o; F.lane = tid_o & 63; F.wave = __builtin_amdgcn_readfirstlane(tid_o >> 6); } while (0)
#define P_MOD ((float*)(F.ws + WS_MOD))
#define P_HA ((bf16*)(F.ws + WS_HA))
#define P_U0 ((bf16*)(F.ws + WS_R1))
#define P_Q (P_U0 + (size_t)T * 512)
#define P_K (P_U0 + (size_t)2 * T * 512)
#define P_V (P_U0 + (size_t)3 * T * 512)
#define P_GY ((bf16*)(F.ws + WS_R1))
#define P_XB (P_GY + (size_t)T * DM)
#define P_XS ((bf16*)(F.ws + WS_R1))
#define P_Y P_XS
#define P_CAT ((bf16*)(F.ws + WS_R2))
#define P_HID P_CAT

    if (IN(0)) for (int rep_ = 0; rep_ <= REPN(0); ++rep_) { PHASE_ENTER(); p0_prologue(F, KA); } SEAM(0);
    if (IN(1)) for (int rep_ = 0; rep_ <= REPN(1); ++rep_) { PHASE_ENTER(); norm_rows(F, in[0], P_HA, in[4], P_MOD, 0, 1024); } SEAM(1);
    if (IN(2)) for (int rep_ = 0; rep_ <= REPN(2); ++rep_) { PHASE_ENTER();
        pg8::Gemm g{P_HA, (const bf16*)(F.ws + WS_WEVIN), T, EVIN, FP8_IN0 ? DM / 2 : DM, 0}; pg8::StaticOrder S; S.init(T, EVIN, F.G, F.bx);
        pg8::EpiEvIn E{P_U0, P_Q, P_K, P_V, in[11], in[12]};
        pg8::gemm_phase<pg8::EpiEvIn, pg8::StaticOrder, true, true, FP8_IN0 != 0>(F.lds, g, S, E);
    } SEAM(2);
    if (IN(3)) for (int rep_ = 0; rep_ <= REPN(3); ++rep_) { PHASE_ENTER();
#ifndef NO_ATTN
        for (int ra_ = 0; ra_ <= REPN(18); ++ra_) { const int bh = F.vcu; for (int qb = 7; qb >= 0; --qb) sba::unit(bh >> 3, bh & 7, qb, P_Q, P_K, P_V, P_CAT, F.lds); }
#endif
#ifndef NO_CONV
        for (int rc_ = 0; rc_ <= REPN(19); ++rc_) conv_phase(F, P_U0, P_CAT, in[7], in[8], in[9], in[10]);
#endif
    } SEAM(3);
    if (IN(4)) for (int rep_ = 0; rep_ <= REPN(4); ++rep_) { PHASE_ENTER();
        pg8::Gemm g{P_CAT, (const bf16*)(F.ws + WS_WEVOUT), T, DM, FP8_OUT ? DM / 2 : DM, 0}; pg8::StaticOrder S; S.init(T, DM, F.G, F.bx);
        pg8::EpiResid E{in[0], KA->out, P_MOD + 2 * 1024, FP8_OUT ? 1.0f / 32.0f : 1.0f};
        pg8::gemm_phase<pg8::EpiResid, pg8::StaticOrder, true, true, FP8_OUT != 0>(F.lds, g, S, E);
    } SEAM(4);
#define MOE_PHASES(layer, p0) \
    if (IN(p0)) for (int rep_ = 0; rep_ <= REPN(p0); ++rep_) { PHASE_ENTER(); router_phase(F, KA->out, P_HA, in[5] + (layer) * DM, P_MOD + (size_t)(layer) * 32 * 6144, in[23], in[24]); } SEAM(p0); \
    if (IN((p0) + 1)) for (int rep_ = 0; rep_ <= REPN((p0) + 1); ++rep_) { PHASE_ENTER(); slot_phase(F); } SEAM((p0) + 1); \
    if (IN((p0) + 2)) for (int rep_ = 0; rep_ <= REPN((p0) + 2); ++rep_) { PHASE_ENTER(); \
        const int ntl = *(const int*)(F.ws + META_NT); \
        pg8::Gemm g{P_HA, (const bf16*)(F.ws + WS_W13 + (size_t)(layer) * 16 * 1024 * 1024), ntl * 256, 1024, DM / 2, (size_t)1024 * 1024}; \
        pg8::MoeGatherOrder S; S.base.init(ntl * 256, 1024, F.G, F.bx); S.tile_e = (const int*)(F.ws + META_TILEE); S.tok = (const int*)(F.ws + META_TOK); \
        pg8::EpiMoeA E{P_HID}; \
        pg8::gemm_phase<pg8::EpiMoeA, pg8::MoeGatherOrder, true, true, true>(F.lds, g, S, E); \
    } SEAM((p0) + 2); \
    if (IN((p0) + 3)) for (int rep_ = 0; rep_ <= REPN((p0) + 3); ++rep_) { PHASE_ENTER(); \
        const int ntl = *(const int*)(F.ws + META_NT); \
        pg8::Gemm g{P_HID, (const bf16*)(F.ws + WS_W2 + (size_t)(layer) * 16 * 1024 * 512), ntl * 256, 1024, DFF / 2, (size_t)1024 * 512}; \
        pg8::MoeOrder S; S.base.init(ntl * 256, 1024, F.G, F.bx); S.tile_e = (const int*)(F.ws + META_TILEE); \
        pg8::EpiMoeB E{P_Y}; \
        pg8::gemm_phase<pg8::EpiMoeB, pg8::MoeOrder, true, true, true>(F.lds, g, S, E); \
    } SEAM((p0) + 3);

    MOE_PHASES(0, 5)
    if (IN(9)) for (int rep_ = 0; rep_ <= REPN(9); ++rep_) { PHASE_ENTER(); const bool dry = rep_ < REPN(9); combine_phase<true>(F, KA->out, dry ? (float*)(F.ws + WS_END) : KA->out, P_Y, P_MOD, dry ? P_HID : P_HA, in[4] + DM, P_MOD + (size_t)32 * 6144); } SEAM(9);
    if (IN(10)) for (int rep_ = 0; rep_ <= REPN(10); ++rep_) { PHASE_ENTER();
        pg8::Gemm g{P_HA, (const bf16*)(F.ws + WS_WODIN), T, 2048, FP8_IN1 ? DM / 2 : DM, 0}; pg8::StaticOrder S; S.init(T, 2048, F.G, F.bx);
        pg8::EpiOdIn E{P_GY, P_XB};
        pg8::gemm_phase<pg8::EpiOdIn, pg8::StaticOrder, true, true, FP8_IN1 != 0>(F.lds, g, S, E);
    } SEAM(10);
    if (IN(11)) for (int rep_ = 0; rep_ <= REPN(11); ++rep_) { PHASE_ENTER(); const int u = F.vcu; lru_unit(F, u >> 3, u & 7, P_GY, P_XB, P_CAT, (const bf16*)(F.ws + WS_WRG), (const bf16*)(F.ws + WS_WIG), in[15], in[16], in[18], in[20], in[21]); } SEAM(11);
    if (IN(12)) for (int rep_ = 0; rep_ <= REPN(12); ++rep_) { PHASE_ENTER();
        pg8::Gemm g{P_CAT, (const bf16*)(F.ws + WS_WODOUT), T, DM, FP8_OUT ? DM / 2 : DM, 0}; pg8::StaticOrder S; S.init(T, DM, F.G, F.bx);
        pg8::EpiResid E{KA->out, KA->out, P_MOD + (size_t)32 * 6144 + 2 * 1024, FP8_OUT ? 1.0f / 32.0f : 1.0f};
        pg8::gemm_phase<pg8::EpiResid, pg8::StaticOrder, true, true, FP8_OUT != 0>(F.lds, g, S, E);
    } SEAM(12);
    MOE_PHASES(1, 13)
    if (IN(17)) for (int rep_ = 0; rep_ <= REPN(17); ++rep_) { PHASE_ENTER(); const bool dry = rep_ < REPN(17); combine_phase<false>(F, KA->out, dry ? (float*)(F.ws + WS_END) : KA->out, P_Y, P_MOD + (size_t)32 * 6144, P_HA, nullptr, nullptr); }
#undef MOE_PHASES
#undef in
#undef IN
#undef SEAM
}

#if !MK_ONE_LAUNCH
template <int P> static void set_attr_all() { if constexpr (P < NPHASE) { (void)hipFuncSetAttribute((const void*)mk_fwd<P, P + 1>, hipFuncAttributeMaxDynamicSharedMemorySize, LDS_BYTES); set_attr_all<P + 1>(); } }
template <int P> static void launch_all(Args a, int grid, hipStream_t stream) { if constexpr (P < NPHASE) { a.ph_lo = P; a.ph_hi = P + 1; hipLaunchKernelGGL((mk_fwd<P, P + 1>), dim3(grid), dim3(NWAVES * 64), LDS_BYTES, stream, a); launch_all<P + 1>(a, grid, stream); } }
#endif

extern "C" void kernel_launch(void* const* d_in, const int* in_sizes, int n_in, void* d_out, int out_size, void* d_ws, size_t ws_size, hipStream_t stream) {
    static int grid = 0;
    if (grid == 0) {
        if (n_in != 28 || in_sizes[0] != T * DM || out_size != T * DM || ws_size < WS_END + (size_t)T * DM * 4) { fprintf(stderr, "kernel_launch: unexpected shapes (n_in %d, in0 %d, out %d, ws %zu); nothing launched\n", n_in, n_in > 0 ? in_sizes[0] : -1, out_size, ws_size); grid = -1; return; }
        int dev = 0, cus = 0;
        if (hipGetDevice(&dev) != hipSuccess || hipDeviceGetAttribute(&cus, hipDeviceAttributeMultiprocessorCount, dev) != hipSuccess) { grid = -1; return; }
#if MK_ONE_LAUNCH
        if (hipFuncSetAttribute((const void*)mk_fwd<0, NPHASE>, hipFuncAttributeMaxDynamicSharedMemorySize, LDS_BYTES) != hipSuccess) { fprintf(stderr, "kernel_launch: hipFuncSetAttribute failed\n"); grid = -1; return; }
        int per_cu = 0;
        if (hipOccupancyMaxActiveBlocksPerMultiprocessor(&per_cu, (const void*)mk_fwd<0, NPHASE>, NWAVES * 64, LDS_BYTES) != hipSuccess || per_cu < 1) fprintf(stderr, "kernel_launch: occupancy query reports %d\n", per_cu);
#else
        set_attr_all<0>();
#endif
        (void)hipGetLastError();
        grid = cus;
        if (grid != 256) { fprintf(stderr, "kernel_launch: built for 256 CUs, device has %d; nothing launched\n", cus); grid = -1; return; }
    }
    if (grid < 0) return;
    (void)hipMemsetAsync((char*)d_ws + WS_CTL, 0, CTL_ZERO_BYTES, stream);
    Args a{};
    for (int i = 0; i < 28; ++i) a.in[i] = (const float*)d_in[i];
    a.out = (float*)d_out; a.ws = (unsigned char*)d_ws;
#if MK_ONE_LAUNCH
    a.ph_lo = 0; a.ph_hi = NPHASE;
    hipLaunchKernelGGL((mk_fwd<0, NPHASE>), dim3(grid), dim3(NWAVES * 64), LDS_BYTES, stream, a);
#else
    launch_all<0>(a, grid, stream);
#endif
}
```

```cpp
#include <hip/hip_runtime.h>
#include <cstdio>
#include <cstdint>

#ifndef MK_ONE_LAUNCH
#define MK_ONE_LAUNCH 1
#endif
#ifndef STAG_MOE
#define STAG_MOE 0
#endif
#ifndef STAG_OUT
#define STAG_OUT 0
#endif
#ifndef FP8_OUT
#define FP8_OUT 1
#endif
#ifndef U_FP8
#define U_FP8 1
#endif
#ifndef X_FP8
#define X_FP8 1
#endif
#ifndef Y_FP8
#define Y_FP8 1
#endif
#ifndef I8_FIXSCALE
#define I8_FIXSCALE 0
#endif
#ifndef I8_IN
#define I8_IN 1
#endif
#ifndef FP8_IN0
#define FP8_IN0 (I8_IN ? 0 : 1)
#endif
#ifndef FP8_IN1
#define FP8_IN1 (I8_IN ? 0 : 1)
#endif

namespace pg8 {
#define PG8_LAS __attribute__((address_space(3)))
typedef unsigned short bf16_t;
typedef short bf16x8 __attribute__((ext_vector_type(8)));
typedef float f32x4 __attribute__((ext_vector_type(4)));
typedef float v2f_ __attribute__((ext_vector_type(2)));
typedef unsigned u32x4 __attribute__((ext_vector_type(4)));
constexpr int BM = 256, BK = 64, HALF = 128, HTB = HALF * BK * 2  , STAGE_BYTES = 8 * HTB, NXCD = 8, WGM = 8;

__host__ __device__ __forceinline__ int lds_byte(int r, int c) { const int st = (r >> 4) * 2 + (c >> 5), rr = r & 15, cc = c & 31, ob = rr * 64 + cc * 2; return st * 1024 + (ob ^ (((ob >> 9) & 1) << 5)); }
__host__ __device__ __forceinline__ void stage_rc(int b, int& R, int& C) { const int st = b / 1024, sb = b % 1024, swz = sb ^ (((sb >> 9) & 1) << 5); R = (st >> 1) * 16 + swz / 64; C = (st & 1) * 32 + (swz % 64) / 2; }
__host__ __device__ __forceinline__ int perm32(int rho) { const int n = rho >> 4, i = rho & 15; return 8 * (i >> 2) + 4 * n + (i & 3); }

struct Unit { int pm, pn, pb, tk0, nv; };
struct Gemm { const bf16_t* A; const bf16_t* Bt; int M, N, K; size_t bstride; };

struct StaticOrder {
    static constexpr bool GATHER = false, LAZY_PB = false; const int* tok;
    int nM, nN, nwg, G, c;
    __host__ __device__ void init(int M, int N, int G_, int c_) { nM = M / BM; nN = N / BM; nwg = nM * nN; G = G_; c = c_; }
    __host__ __device__ bool next(int i, Unit& u) const {
        const long L = (long)i * G + c; if (L >= nwg) return false;
        int wgid = (int)L; { const int q = nwg / NXCD, r = nwg % NXCD, xcd = wgid % NXCD, off = wgid / NXCD; wgid = (xcd < r ? xcd * (q + 1) : r * (q + 1) + (xcd - r) * q) + off; }
        const int nig = WGM * nN, gid = wgid / nig, fm = gid * WGM, gsz = (nM - fm) < WGM ? (nM - fm) : WGM;
        u.pm = fm + ((wgid % nig) % gsz); u.pn = (wgid % nig) / gsz; u.pb = 0; return true;
    }
    __device__ __forceinline__ void a_ready(const Unit&) const {}
    __device__ __forceinline__ void done(const Unit&) const {}
};

template <class Epi, class Sched, bool ALIGN_EPI = false, bool SP2 = false, bool FP8 = false, bool I8 = false>
__device__ __forceinline__ void gemm_phase(PG8_LAS unsigned char* lds, const Gemm g, const Sched& S, const Epi& E, int stagger_ticks = 0) {
    if (stagger_ticks) { const unsigned long long t_end = __builtin_amdgcn_s_memrealtime() + (unsigned long long)(((blockIdx.x >> 3) & 3) * stagger_ticks);
        while (__builtin_amdgcn_s_memrealtime() < t_end) __builtin_amdgcn_s_sleep(8); }
    int tid_ = threadIdx.x; asm volatile("" : "+v"(tid_));
    const int tid = tid_, wid = __builtin_amdgcn_readfirstlane(tid >> 6), lane = tid & 63, wr = wid >> 2, wc = wid & 3, fr = lane & 15, fq = lane >> 4;
    int K_ = g.K; asm volatile("" : "+s"(K_));
    const int K = K_, nt = K / BK;
    unsigned voffA[2], voffB[2];
#pragma unroll
    for (int i = 0; i < 2; ++i) { int R, C; stage_rc(tid * 16 + i * 8192, R, C); const int Rb = Epi::PERM ? ((R & ~31) + perm32(R & 31)) : R;
        voffA[i] = (unsigned)(R * K + C) * 2u; voffB[i] = (unsigned)(Rb * K + C) * 2u; }
    unsigned cvo[2][2], nvo[2][2]; int rowA[2]; unsigned colA[2];
#pragma unroll
    for (int i = 0; i < 2; ++i) { int R, C; stage_rc(tid * 16 + i * 8192, R, C); rowA[i] = R; colA[i] = (unsigned)C * 2u; }
    int ntk[2][2];
#define PG8_LOADTK(u_, tk_) do { const int* _p00 = S.tok + (u_).tk0 + rowA[0]; const int* _p01 = S.tok + (u_).tk0 + rowA[1]; const int* _p10 = _p00 + HALF; const int* _p11 = _p01 + HALF; \
        asm volatile("global_load_dword %0, %4, off\n\tglobal_load_dword %1, %5, off\n\tglobal_load_dword %2, %6, off\n\tglobal_load_dword %3, %7, off" \
            : "=&v"(tk_[0][0]), "=&v"(tk_[0][1]), "=&v"(tk_[1][0]), "=&v"(tk_[1][1]) : "v"(_p00), "v"(_p01), "v"(_p10), "v"(_p11) : "memory"); } while (0)
#define PG8_TK2VO(tk_, vo_, nv_) do { _Pragma("unroll") for (int _h = 0; _h < 2; ++_h) _Pragma("unroll") for (int _i = 0; _i < 2; ++_i) \
        vo_[_h][_i] = (unsigned)((rowA[_i] + _h * HALF < (nv_)) ? tk_[_h][_i] : 0) * (unsigned)(K * 2) + colA[_i]; } while (0)
    const size_t kstep = (size_t)(BK * 2);
    const size_t hstep = (size_t)HALF * K * 2;
    const size_t tstep = 2 * hstep;
    const unsigned ldsw = (unsigned)wid * 1024u;
    constexpr int PSTR = 1024;
    const int aoff = lds_byte(wr * 64 + fr, fq * 8);
    const int boff = lds_byte(wc * 32 + fr, fq * 8);
#define PG8_SA(b, h) (((b) * 2 + (h)) * HTB)
#define PG8_SB(b, h) ((4 + (b) * 2 + (h)) * HTB)
#define PG8_STAGE(bufoff, gbase, voff) do { _Pragma("unroll") for (int _i = 0; _i < 2; ++_i) \
        __builtin_amdgcn_global_load_lds((const unsigned*)((const char*)(gbase) + (voff)[_i]), (PG8_LAS unsigned*)(lds + (bufoff) + ldsw + _i * 8192), 16, 0, 0); } while (0)
#define PG8_STAGE_A(bufoff, gbase, h, nx) do { if constexpr (Sched::GATHER) { _Pragma("unroll") for (int _i = 0; _i < 2; ++_i) { const unsigned _vo = (nx) ? nvo[h][_i] : cvo[h][_i]; \
        __builtin_amdgcn_global_load_lds((const unsigned*)((const char*)(gbase) + _vo), (PG8_LAS unsigned*)(lds + (bufoff) + ldsw + _i * 8192), 16, 0, 0); } } \
        else { PG8_STAGE(bufoff, (gbase) + (h) * hstep, voffA); } } while (0)
    const PG8_LAS unsigned char* const ldsA = lds + aoff;
    const PG8_LAS unsigned char* const ldsB = lds + 4 * HTB + boff;
#define PG8_LD32(p_) __builtin_shufflevector(*(const PG8_LAS v4i_*)(p_), *(const PG8_LAS v4i_*)((p_) + PSTR), 0, 1, 2, 3, 4, 5, 6, 7)
#define PG8_LDA(dst, b, h) do { if constexpr (FP8) { _Pragma("unroll") for (int m = 0; m < 4; ++m) dst##8[m] = PG8_LD32(ldsA + PG8_SA(b, h) + m * 2048); } \
    else { _Pragma("unroll") for (int m = 0; m < 4; ++m) _Pragma("unroll") for (int k = 0; k < 2; ++k) dst[m][k] = *(const PG8_LAS bf16x8*)(ldsA + PG8_SA(b, h) + m * 2048 + k * PSTR); } } while (0)
#define PG8_LDB(dst, b, h) do { if constexpr (FP8) { _Pragma("unroll") for (int n = 0; n < 2; ++n) dst##8[n] = PG8_LD32(ldsB + (PG8_SB(b, h) - 4 * HTB) + n * 2048); } \
    else { _Pragma("unroll") for (int n = 0; n < 2; ++n) _Pragma("unroll") for (int k = 0; k < 2; ++k) dst[n][k] = *(const PG8_LAS bf16x8*)(ldsB + (PG8_SB(b, h) - 4 * HTB) + n * 2048 + k * PSTR); } } while (0)
#define PG8_MMA(ai, bj, At, Bt) do { __builtin_amdgcn_s_setprio(1); \
        if constexpr (FP8) { _Pragma("unroll") for (int m = 0; m < 4; ++m) _Pragma("unroll") for (int n = 0; n < 2; ++n) \
            asm volatile("v_mfma_scale_f32_16x16x128_f8f6f4 %0, %1, %2, %0, %3, %3 op_sel_hi:[0,0,0]" : "+v"(acc[ai][bj][m][n]) : "v"(Bt##8[n]), "v"(At##8[m]), "v"(sc8)); } \
        else if constexpr (I8) { _Pragma("unroll") for (int k = 0; k < 2; ++k) _Pragma("unroll") for (int m = 0; m < (FP8 ? 1 : 4); ++m) _Pragma("unroll") for (int n = 0; n < 2; ++n) \
            asm volatile("v_mfma_i32_16x16x64_i8 %0, %1, %2, %0" : "+v"(acc[ai][bj][m][n]) : "v"(Bt[n][k]), "v"(At[m][k])); } \
        else { _Pragma("unroll") for (int m = 0; m < (FP8 ? 1 : 4); ++m) _Pragma("unroll") for (int n = 0; n < 2; ++n) _Pragma("unroll") for (int k = 0; k < 2; ++k) \
            acc[ai][bj][m][n] = __builtin_amdgcn_mfma_f32_16x16x32_bf16(Bt[n][k], At[m][k], acc[ai][bj][m][n], 0, 0, 0); } \
        __builtin_amdgcn_s_setprio(0); } while (0)
#define PG8_MMA0(ai, bj, At, Bt) do { __builtin_amdgcn_s_setprio(1); \
        if constexpr (FP8) { _Pragma("unroll") for (int m = 0; m < 4; ++m) _Pragma("unroll") for (int n = 0; n < 2; ++n) \
            asm volatile("v_mfma_scale_f32_16x16x128_f8f6f4 %0, %1, %2, 0, %3, %3 op_sel_hi:[0,0,0]" : "=&v"(acc[ai][bj][m][n]) : "v"(Bt##8[n]), "v"(At##8[m]), "v"(sc8)); } \
        else if constexpr (I8) { _Pragma("unroll") for (int m = 0; m < (FP8 ? 1 : 4); ++m) _Pragma("unroll") for (int n = 0; n < 2; ++n) \
            asm volatile("v_mfma_i32_16x16x64_i8 %0, %1, %2, 0" : "=&v"(acc[ai][bj][m][n]) : "v"(Bt[n][0]), "v"(At[m][0])); \
            _Pragma("unroll") for (int m = 0; m < (FP8 ? 1 : 4); ++m) _Pragma("unroll") for (int n = 0; n < 2; ++n) \
            asm volatile("v_mfma_i32_16x16x64_i8 %0, %1, %2, %0" : "+v"(acc[ai][bj][m][n]) : "v"(Bt[n][1]), "v"(At[m][1])); } \
        else { _Pragma("unroll") for (int m = 0; m < 4; ++m) _Pragma("unroll") for (int n = 0; n < 2; ++n) { \
            acc[ai][bj][m][n] = __builtin_amdgcn_mfma_f32_16x16x32_bf16(Bt[n][0], At[m][0], (f32x4){0.f, 0.f, 0.f, 0.f}, 0, 0, 0); \
            acc[ai][bj][m][n] = __builtin_amdgcn_mfma_f32_16x16x32_bf16(Bt[n][1], At[m][1], acc[ai][bj][m][n], 0, 0, 0); } } \
        __builtin_amdgcn_s_setprio(0); } while (0)
#define PG8_WAIT_V(n) asm volatile("s_waitcnt vmcnt(" #n ")" ::: "memory")
#define PG8_WAIT_L(n) asm volatile("s_waitcnt lgkmcnt(" #n ")" ::: "memory")
#define PG8_BAR __builtin_amdgcn_s_barrier()
#define PG8_SCHED __builtin_amdgcn_sched_barrier(0)
    Unit cur, nxt; int ui = 0;
    if (!S.next(0, cur)) return;
    float sav[8];
    f32x4 acc[2][2][4][2];
#pragma unroll
    for (int a = 0; a < 2; ++a)
#pragma unroll
        for (int b = 0; b < 2; ++b)
#pragma unroll
            for (int m = 0; m < 4; ++m)
#pragma unroll
                for (int n = 0; n < 2; ++n) acc[a][b][m][n] = (f32x4){0.f, 0.f, 0.f, 0.f};
    typedef int v4i_ __attribute__((ext_vector_type(4))); typedef int v8i_ __attribute__((ext_vector_type(8)));
    bf16x8 At[FP8 ? 1 : 4][2], B0[2][2], B1[2][2];
    v8i_ At8[FP8 ? 4 : 1], B08[2], B18[2];
    const int sc8 = 0x7f7f7f7f;
    const char* cA = (const char*)g.A + (Sched::GATHER ? (size_t)0 : (size_t)cur.pm * tstep); const char* cB = (const char*)g.Bt + (size_t)cur.pb * g.bstride + (size_t)cur.pn * tstep;
    S.a_ready(cur);
    if constexpr (Sched::GATHER) { PG8_LOADTK(cur, ntk); asm volatile("s_waitcnt vmcnt(0)" : "+v"(ntk[0][0]), "+v"(ntk[0][1]), "+v"(ntk[1][0]), "+v"(ntk[1][1]) :: "memory"); PG8_TK2VO(ntk, cvo, cur.nv); }
    if constexpr (SP2) {
        PG8_STAGE(PG8_SB(0, 0), cB, voffB); PG8_STAGE(PG8_SB(0, 1), cB + hstep, voffB); PG8_STAGE_A(PG8_SA(0, 0), cA, 0, false); PG8_STAGE_A(PG8_SA(0, 1), cA, 1, false);
        if (wr == 1) PG8_BAR;
        PG8_WAIT_V(2); PG8_BAR;
        PG8_STAGE(PG8_SB(1, 0), cB + kstep, voffB); PG8_STAGE_A(PG8_SA(1, 0), cA + kstep, 0, false); PG8_STAGE(PG8_SB(1, 1), cB + hstep + kstep, voffB);
        PG8_WAIT_V(6); PG8_BAR;
    } else { static_assert(SP2, "only the SP2 loop is kept"); }
    for (;;) {
        bool has_next; int pbv = 0;
        if constexpr (Sched::LAZY_PB) { has_next = S.next_nopb(ui + 1, nxt);
            if (has_next) { const int* _pp = S.pb_ptr(nxt); asm volatile("global_load_dword %0, %1, off" : "=v"(pbv) : "v"(_pp) : "memory"); } }
        else has_next = S.next(ui + 1, nxt);
        const char* nA = (has_next && !Sched::GATHER) ? (const char*)g.A + (size_t)nxt.pm * tstep : cA;
        if constexpr (Sched::GATHER) { _Pragma("unroll") for (int _h = 0; _h < 2; ++_h) _Pragma("unroll") for (int _i = 0; _i < 2; ++_i) nvo[_h][_i] = cvo[_h][_i]; if (has_next) { PG8_LOADTK(nxt, ntk); } }
 const char* nB = (has_next && !Sched::LAZY_PB) ? (const char*)g.Bt + (size_t)nxt.pb * g.bstride + (size_t)nxt.pn * tstep : cB;
        for (int t = 0; t < nt; t += 2) {
            const bool last = (t == nt - 2);
            const char* a1 = cA + (size_t)(t + 1) * kstep;
            if constexpr (Sched::LAZY_PB) { if (last && has_next) { asm volatile("s_waitcnt vmcnt(8)" : "+v"(pbv) :: "memory"); nxt.pb = __builtin_amdgcn_readfirstlane(pbv);
                nB = (const char*)g.Bt + (size_t)nxt.pb * g.bstride + (size_t)nxt.pn * tstep; } }
            const char* a2 = last ? nA : cA + (size_t)(t + 2) * kstep; const char* b2 = last ? nB : cB + (size_t)(t + 2) * kstep;
            const char* a3 = a2 + kstep; const char* b3 = b2 + kstep;
            if (last && has_next) S.a_ready(nxt);
            if constexpr (Epi::PRE_SA) { if (last) { const float* _ps = E.SA + cur.pm * BM + wr * 64 + fr;
                asm volatile("global_load_dword %0, %8, off\n\tglobal_load_dword %1, %8, off offset:64\n\tglobal_load_dword %2, %8, off offset:128\n\tglobal_load_dword %3, %8, off offset:192\n\t"
                             "global_load_dword %4, %8, off offset:512\n\tglobal_load_dword %5, %8, off offset:576\n\tglobal_load_dword %6, %8, off offset:640\n\tglobal_load_dword %7, %8, off offset:704"
                    : "=&v"(sav[0]), "=&v"(sav[1]), "=&v"(sav[2]), "=&v"(sav[3]), "=&v"(sav[4]), "=&v"(sav[5]), "=&v"(sav[6]), "=&v"(sav[7]) : "v"(_ps) : "memory"); } }
            if constexpr (Sched::GATHER) { if (last && has_next) {
                asm volatile("s_waitcnt vmcnt(8)" : "+v"(ntk[0][0]), "+v"(ntk[0][1]), "+v"(ntk[1][0]), "+v"(ntk[1][1]) :: "memory"); PG8_TK2VO(ntk, nvo, nxt.nv); } }
            if constexpr (SP2) {
            PG8_LDB(B0, 0, 0); PG8_LDB(B1, 0, 1); PG8_SCHED; PG8_LDA(At, 0, 0); PG8_STAGE_A(PG8_SA(1, 1), a1, 1, false);
            PG8_WAIT_V(8); PG8_WAIT_L(0); PG8_BAR; if (t == 0) { PG8_MMA0(0, 0, At, B0); PG8_MMA0(0, 1, At, B1); } else { PG8_MMA(0, 0, At, B0); PG8_MMA(0, 1, At, B1); } PG8_BAR; PG8_SCHED;
            PG8_LDA(At, 0, 1); PG8_STAGE(PG8_SB(0, 0), b2, voffB); PG8_STAGE(PG8_SB(0, 1), b2 + hstep, voffB); PG8_STAGE_A(PG8_SA(0, 0), a2, 0, last);
            PG8_WAIT_V(8); PG8_WAIT_L(0); PG8_BAR; if (t == 0) { PG8_MMA0(1, 0, At, B0); PG8_MMA0(1, 1, At, B1); } else { PG8_MMA(1, 0, At, B0); PG8_MMA(1, 1, At, B1); } PG8_BAR; PG8_SCHED;
            PG8_LDB(B0, 1, 0); PG8_LDB(B1, 1, 1); PG8_SCHED; PG8_LDA(At, 1, 0); PG8_STAGE_A(PG8_SA(0, 1), a2, 1, last);
            PG8_WAIT_V(8); PG8_WAIT_L(0); PG8_BAR; PG8_MMA(0, 0, At, B0); PG8_MMA(0, 1, At, B1); PG8_BAR; PG8_SCHED;
            PG8_LDA(At, 1, 1); PG8_STAGE(PG8_SB(1, 0), b3, voffB); PG8_STAGE(PG8_SB(1, 1), b3 + hstep, voffB); PG8_STAGE_A(PG8_SA(1, 0), a3, 0, last);
            PG8_WAIT_V(8); PG8_WAIT_L(0); PG8_BAR; PG8_MMA(1, 0, At, B0); PG8_MMA(1, 1, At, B1); PG8_BAR; PG8_SCHED;
            }
        }
        if constexpr (ALIGN_EPI) { if (wr == 0) PG8_BAR; }
        if constexpr (FP8 || I8) asm volatile("s_nop 15\n\ts_nop 15" ::: "memory");
        if constexpr (Epi::PRE_SA) { asm volatile("s_waitcnt vmcnt(8)" : "+v"(sav[0]), "+v"(sav[1]), "+v"(sav[2]), "+v"(sav[3]), "+v"(sav[4]), "+v"(sav[5]), "+v"(sav[6]), "+v"(sav[7]) :: "memory");
            E(acc, cur, wr, wc, fr, fq, sav); S.done(cur); }
        else if constexpr (!Epi::AFTER_DRAIN) { E(acc, cur, wr, wc, fr, fq); S.done(cur); }
        if (!has_next) break;
#pragma unroll
        for (int a = 0; a < 2; ++a)
#pragma unroll
            for (int b = 0; b < 2; ++b)
#pragma unroll
                for (int m = 0; m < 4; ++m)
#pragma unroll
                    for (int n = 0; n < 2; ++n) asm volatile("" : "=v"(acc[a][b][m][n]));
        cur = nxt; cA = nA; cB = nB; ++ui;
        if constexpr (Sched::GATHER) { _Pragma("unroll") for (int _h = 0; _h < 2; ++_h) _Pragma("unroll") for (int _i = 0; _i < 2; ++_i) cvo[_h][_i] = nvo[_h][_i]; }
        if constexpr (ALIGN_EPI) { if (wr == 1) PG8_BAR; }
    }
    PG8_WAIT_V(0);
    if constexpr (!ALIGN_EPI) { if (wr == 0) PG8_BAR; }
    PG8_BAR;
    if constexpr (Epi::AFTER_DRAIN) { E.fused(acc, cur, wr, wc, fr, fq, lds, wid, lane); S.done(cur); }
#undef PG8_SA
#undef PG8_SB
#undef PG8_STAGE
#undef PG8_STAGE_A
#undef PG8_LOADTK
#undef PG8_TK2VO
#undef PG8_LD32
#undef PG8_LDA
#undef PG8_LDB
#undef PG8_MMA
#undef PG8_MMA0
#undef PG8_WAIT_V
#undef PG8_WAIT_L
#undef PG8_BAR
#undef PG8_SCHED
}
}

constexpr int NB = 32, SEQ = 2048, DM = 1024, T = NB * SEQ;
constexpr int EVIN = 2560, CONVC = 512, CONVW = 31, NHEAD = 8, HD = 64, SBW = 512;
constexpr int NEXP = 16, DFF = 512;
constexpr int MOE_ROWS = 2 * T + NEXP * 256;
constexpr int MOE_TILES = MOE_ROWS / 256;
constexpr float EPS = 1e-6f;
constexpr int NWAVES = 8;

constexpr size_t MiB = 1u << 20;
constexpr size_t WS_CTL = 0, CTL_ZERO_BYTES = 64 * 1024;
constexpr size_t WS_MOD = 1 * MiB;
constexpr size_t WS_META = 3 * MiB;
constexpr size_t META_EID = WS_META, META_GATE = WS_META + 512 * 1024, META_SLOT = WS_META + 1024 * 1024, META_BCNT = WS_META + 1536 * 1024,
                 META_TILEE = META_BCNT + 32 * 1024, META_NT = META_BCNT + 64 * 1024, META_TOK = WS_META + 2048 * 1024, META_SBEVIN = WS_META + 2816 * 1024, META_SBODIN = META_SBEVIN + 16 * 1024, META_WRIMG = META_SBEVIN + 32 * 1024;
constexpr size_t WS_SA = WS_MOD + 1536 * 1024;
constexpr size_t WS_WEVIN = 6 * MiB, WS_WEVOUT = 11 * MiB, WS_WODIN = 13 * MiB, WS_WODOUT = 17 * MiB, WS_WRG = 19 * MiB, WS_WIG = WS_WRG + 512 * 1024;
constexpr size_t WS_W13 = 20 * MiB;
constexpr size_t WS_W2 = 84 * MiB;
constexpr size_t WS_HA = 116 * MiB;
constexpr size_t WS_R1 = 244 * MiB;
constexpr size_t WS_R2 = 508 * MiB;
constexpr size_t WS_XBF = 640 * MiB;
constexpr size_t WS_END = 768 * MiB;
constexpr size_t WS_TOK2 = WS_END;
constexpr size_t WS_DRY = WS_END + 8 * MiB;
constexpr int CW_BAR = 4096;
constexpr int CW_GCNT = 256;
constexpr int L_MOE = 131072;

constexpr int RING_BYTES = 131072, LDS_BYTES = 147456, LDSCTL_OFF = LDS_BYTES - 2048, MISC_OFF = LDSCTL_OFF + 320;

#define GAS __attribute__((address_space(1)))
#define LAS __attribute__((address_space(3)))
typedef unsigned short bf16;
typedef unsigned v4u __attribute__((ext_vector_type(4)));
typedef unsigned v2u __attribute__((ext_vector_type(2)));
typedef float f32x4 __attribute__((ext_vector_type(4)));
typedef float f32x2 __attribute__((ext_vector_type(2)));
typedef float f32x16 __attribute__((ext_vector_type(16)));
typedef short bf16x8 __attribute__((ext_vector_type(8)));
typedef short s16x4 __attribute__((ext_vector_type(4)));
typedef __bf16 bf16x2_t __attribute__((ext_vector_type(2)));
typedef GAS unsigned gu32;
#define RLX_AGENT __ATOMIC_RELAXED, __HIP_MEMORY_SCOPE_AGENT

__device__ __forceinline__ unsigned pk2(float lo, float hi) { f32x2 v = {lo, hi}; bf16x2_t b = __builtin_convertvector(v, bf16x2_t); return __builtin_bit_cast(unsigned, b); }
__device__ __forceinline__ unsigned pk4_fp8(float a, float b, float c, float d) { int r = __builtin_amdgcn_cvt_pk_fp8_f32(a, b, 0, false); r = __builtin_amdgcn_cvt_pk_fp8_f32(c, d, r, true); return (unsigned)r; }
__device__ __forceinline__ v2u bf8x_to_fp8(v4u v);
typedef int i32x4_t __attribute__((ext_vector_type(4)));
__device__ __forceinline__ f32x4 i32_to_f32x4(f32x4 bits) { return __builtin_convertvector(__builtin_bit_cast(i32x4_t, bits), f32x4); }
__device__ __forceinline__ unsigned pk4_i8(float a, float b, float c, float d) {
    const unsigned ua = __float_as_uint(a + 12582912.0f), ub = __float_as_uint(b + 12582912.0f), uc = __float_as_uint(c + 12582912.0f), ud = __float_as_uint(d + 12582912.0f);
    return (ua & 0xffu) | ((ub & 0xffu) << 8) | ((uc & 0xffu) << 16) | (ud << 24);
}
__device__ __forceinline__ float bflo(unsigned u) { return __uint_as_float(u << 16); }
__device__ __forceinline__ float bfhi(unsigned u) { return __uint_as_float(u & 0xffff0000u); }
__device__ __forceinline__ v2u bf8x_to_fp8(v4u v) { v2u o; o.x = pk4_fp8(bflo(v.x), bfhi(v.x), bflo(v.y), bfhi(v.y)); o.y = pk4_fp8(bflo(v.z), bfhi(v.z), bflo(v.w), bfhi(v.w)); return o; }
__device__ __forceinline__ float bf2f(bf16 b) { return __uint_as_float((unsigned)b << 16); }
__device__ __forceinline__ float fast_exp2(float x) { return __builtin_amdgcn_exp2f(x); }
__device__ __forceinline__ float fast_rcp(float x) { return __builtin_amdgcn_rcpf(x); }
__device__ __forceinline__ float sigmoidf_(float x) { return fast_rcp(1.0f + fast_exp2(-1.4426950408889634f * x)); }
__device__ __forceinline__ float siluf_(float x) { return x * sigmoidf_(x); }
__device__ __forceinline__ float gelu_tanh(float x) { const float u = x + 0.044715f * x * x * x; return x * fast_rcp(1.0f + fast_exp2(-2.3022082f * u)); }
__device__ __forceinline__ float wave_sum(float v) {
#pragma unroll
    for (int o = 1; o < 64; o <<= 1) v += __shfl_xor(v, o);
    return v;
}

#define XB_TMO      128
#define XB_XCNT(j)  (256  + 64 * (j))
#define XB_XSUB(j)  (1280 + 64 * (j))
#define XB_XGEN(j)  (2304 + 64 * (j))
#define XB_TOP      3328
#define XB_TOPGEN   3392
#define XCD_BAR_WORDS 3456
#define XB_SPIN_CAP (1u << 18)

__device__ __forceinline__ unsigned xb_ld(unsigned* p)              { return __hip_atomic_load(p, __ATOMIC_RELAXED, __HIP_MEMORY_SCOPE_AGENT); }
__device__ __forceinline__ unsigned xb_add(unsigned* p, unsigned v) { return __hip_atomic_fetch_add(p, v, __ATOMIC_RELAXED, __HIP_MEMORY_SCOPE_AGENT); }
__device__ __forceinline__ unsigned xb_xcc_id() { return (unsigned)__builtin_amdgcn_s_getreg((3 << 11) | 20) & 0xFu; }
#define XB_SPIN(cond, bar) do { unsigned _sp = 0; while (cond) { __builtin_amdgcn_s_sleep(1); \
    if ((++_sp & 255u) == 0u) { if (xb_ld(&(bar)[XB_TMO])) break; if (_sp > XB_SPIN_CAP) { atomicAdd(&(bar)[XB_TMO], 1u); break; } } } } while (0)

struct XcdBarrier {
    unsigned* bar; unsigned x;
    volatile LAS unsigned* st;
};

__device__ __forceinline__ XcdBarrier xcd_barrier_post(unsigned* bar, volatile LAS unsigned* st) {
    XcdBarrier b; b.bar = bar; b.x = xb_xcc_id(); b.st = st;
    if (threadIdx.x == 0) (void)xb_add(&bar[XB_XCNT(b.x)], 1u);
    return b;
}
__device__ __forceinline__ void xcd_barrier_complete(unsigned* bar, unsigned x, unsigned& nloc, unsigned& nx) {
    const unsigned G = gridDim.x * gridDim.y * gridDim.z;
    unsigned sum, cnt, mine, sp = 0u;
    for (;;) {
        sum = 0u; cnt = 0u; mine = 0u;
#pragma unroll
        for (unsigned j = 0; j < 16; ++j) { const unsigned c = xb_ld(&bar[XB_XCNT(j)]); sum += c; cnt += (c > 0u) ? 1u : 0u; mine = (j == x) ? c : mine; }
        if (sum == G) break;
        __builtin_amdgcn_s_sleep(1);
        if ((++sp & 255u) == 0u) { if (xb_ld(&bar[XB_TMO])) break; if (sp > XB_SPIN_CAP) { atomicAdd(&bar[XB_TMO], 1u); break; } }
    }
    nloc = mine > 0u ? mine : 1u; nx = cnt > 0u ? cnt : 1u;
}

__device__ __forceinline__ void xcd_barrier(const XcdBarrier& b) {
    asm volatile("s_waitcnt vmcnt(0)" ::: "memory");
    __syncthreads();
    if (threadIdx.x == 0) {
        unsigned* bar = b.bar;
        __builtin_amdgcn_s_waitcnt(0);
        unsigned nloc = b.st[0], nx = b.st[1];
        if (nloc == 0u) { xcd_barrier_complete(bar, b.x, nloc, nx); b.st[0] = nloc; b.st[1] = nx; }
        const unsigned old = xb_add(&bar[XB_XSUB(b.x)], 1u);
        const unsigned gen = old / nloc;
        if (old + 1u == (gen + 1u) * nloc) {
            __builtin_amdgcn_fence(__ATOMIC_RELEASE, "agent");
            asm volatile("s_waitcnt vmcnt(0)" ::: "memory");
            const unsigned og = xb_add(&bar[XB_TOP], 1u);
            const unsigned tg = og / nx;
            if (og + 1u == (tg + 1u) * nx) xb_add(&bar[XB_TOPGEN], 1u);
            else XB_SPIN(xb_ld(&bar[XB_TOPGEN]) == tg, bar);
            __builtin_amdgcn_fence(__ATOMIC_ACQUIRE, "agent");
            xb_add(&bar[XB_XGEN(b.x)], 1u);
            asm volatile("s_waitcnt vmcnt(0)" ::: "memory");
        } else {
            XB_SPIN(xb_ld(&bar[XB_XGEN(b.x)]) == gen, bar);
            __builtin_amdgcn_fence(__ATOMIC_ACQUIRE, "agent");
            asm volatile("s_waitcnt vmcnt(0)" ::: "memory");
        }
    }
    __syncthreads();
}


namespace pg8 {
__device__ __forceinline__ v2f_ glu2(v2f_ v, v2f_ g) {
    const v2f_ t = g * -1.4426950408889634f;
    v2f_ e; e[0] = __builtin_amdgcn_exp2f(t[0]); e[1] = __builtin_amdgcn_exp2f(t[1]);
    const v2f_ d = e + 1.0f;
    v2f_ r; r[0] = __builtin_amdgcn_rcpf(d[0]); r[1] = __builtin_amdgcn_rcpf(d[1]);
    return v * r;
}
__device__ __forceinline__ v2f_ gelu2(v2f_ x) {
    const v2f_ q = x * x, p = q * (0.044715f * -2.3022082f) + -2.3022082f, t = p * x;
    v2f_ e; e[0] = __builtin_amdgcn_exp2f(t[0]); e[1] = __builtin_amdgcn_exp2f(t[1]);
    const v2f_ d = e + 1.0f;
    v2f_ r; r[0] = __builtin_amdgcn_rcpf(d[0]); r[1] = __builtin_amdgcn_rcpf(d[1]);
    return x * r;
}
struct EpiEvIn {
    static constexpr bool PERM = true, AFTER_DRAIN = false, PRE_SA = I8_IN != 0;
    bf16* U0; bf16* Q; bf16* K; bf16* V; const float* qg; const float* kg; const float* SA; const PG8_LAS float* SB;
    __device__ __forceinline__ void operator()(const f32x4 (&acc_)[2][2][4][2], const Unit& u, int wr, int wc, int fr, int fq, const float (&sav)[8]) const {
        const int row0 = u.pm * BM + wr * 64 + fr;
        f32x4 acc[2][2][4][2];
#pragma unroll
        for (int a = 0; a < 2; ++a)
#pragma unroll
            for (int b = 0; b < 2; ++b)
#pragma unroll
                for (int m = 0; m < 4; ++m)
#pragma unroll
                    for (int n = 0; n < 2; ++n) {
#if I8_IN
                        const float sa = I8_FIXSCALE ? 8.0f / 127.0f : sav[4 * a + m]; const f32x4 sb = I8_FIXSCALE ? (f32x4){0.25f / 127.0f, 0.25f / 127.0f, 0.25f / 127.0f, 0.25f / 127.0f} : *(const PG8_LAS f32x4*)(SB + u.pn * BM + 128 * b + 32 * wc + 8 * fq + 4 * n);
                        const f32x4 ai_ = acc_[a][b][m][n];
                        acc[a][b][m][n] = i32_to_f32x4(ai_) * sb * sa;
#else
                        acc[a][b][m][n] = acc_[a][b][m][n] * (FP8_IN0 ? 1.0f / 32.0f : 1.0f);
#endif
                    }
        if (u.pn < 4) {
#pragma unroll
            for (int ai = 0; ai < 2; ++ai)
#pragma unroll
                for (int m = 0; m < 4; ++m) {
                    const size_t row = (size_t)(row0 + ai * HALF + m * 16);
                    const f32x4 v0 = acc[ai][0][m][0], v1 = acc[ai][0][m][1], g0 = acc[ai][1][m][0], g1 = acc[ai][1][m][1];
                    static_assert(U_FP8, "the GLU branch stores fp8");
                    const v2f_ h00 = glu2(__builtin_shufflevector(v0, v0, 0, 1), __builtin_shufflevector(g0, g0, 0, 1)), h01 = glu2(__builtin_shufflevector(v0, v0, 2, 3), __builtin_shufflevector(g0, g0, 2, 3));
                    const v2f_ h10 = glu2(__builtin_shufflevector(v1, v1, 0, 1), __builtin_shufflevector(g1, g1, 0, 1)), h11 = glu2(__builtin_shufflevector(v1, v1, 2, 3), __builtin_shufflevector(g1, g1, 2, 3));
                    v2u w8; w8.x = pk4_fp8(h00[0], h00[1], h01[0], h01[1]); w8.y = pk4_fp8(h10[0], h10[1], h11[0], h11[1]);
                    *(v2u*)((unsigned char*)U0 + row * 512 + u.pn * 128 + wc * 32 + 8 * fq) = w8;
                }
        } else if (u.pn < 8) {
            const int sec = (u.pn - 4) >> 1, p = (u.pn - 4) & 1, head = 4 * p + wc;
            const float* gp = sec ? kg : qg; bf16* dst = sec ? K : Q;
            const float scl = sec ? 1.0f : 0.125f * 1.4426950408889634f;
            f32x4 gv[2][2];
#pragma unroll
            for (int bj = 0; bj < 2; ++bj)
#pragma unroll
                for (int n = 0; n < 2; ++n) gv[bj][n] = *(const f32x4*)(gp + 32 * bj + 8 * fq + 4 * n) * scl;
#pragma unroll
            for (int ai = 0; ai < 2; ++ai)
#pragma unroll
                for (int m = 0; m < 4; ++m) {
                    const size_t row = (size_t)(row0 + ai * HALF + m * 16);
                    float ss = 0.f;
#pragma unroll
                    for (int bj = 0; bj < 2; ++bj)
#pragma unroll
                        for (int n = 0; n < 2; ++n) { const f32x4 x = acc[ai][bj][m][n]; ss += (x[0] * x[0] + x[1] * x[1]) + (x[2] * x[2] + x[3] * x[3]); }
                    ss += __shfl_xor(ss, 16); ss += __shfl_xor(ss, 32);
                    const float rstd = __builtin_amdgcn_rsqf(ss * (1.0f / 64.0f) + EPS);
#pragma unroll
                    for (int bj = 0; bj < 2; ++bj) {
                        const f32x4 a = acc[ai][bj][m][0] * rstd * gv[bj][0], b = acc[ai][bj][m][1] * rstd * gv[bj][1];
                        u32x4 w; w.x = pk2(a[0], a[1]); w.y = pk2(a[2], a[3]); w.z = pk2(b[0], b[1]); w.w = pk2(b[2], b[3]);
                        *(u32x4*)(dst + row * 512 + head * 64 + 32 * bj + 8 * fq) = w;
                    }
                }
        } else {
#pragma unroll
            for (int ai = 0; ai < 2; ++ai)
#pragma unroll
                for (int m = 0; m < 4; ++m) {
                    const size_t row = (size_t)(row0 + ai * HALF + m * 16);
#pragma unroll
                    for (int bj = 0; bj < 2; ++bj) {
                        const f32x4 a = acc[ai][bj][m][0], b = acc[ai][bj][m][1];
                        u32x4 w; w.x = pk2(a[0], a[1]); w.y = pk2(a[2], a[3]); w.z = pk2(b[0], b[1]); w.w = pk2(b[2], b[3]);
                        *(u32x4*)(V + row * 512 + (u.pn - 8) * 256 + wc * 64 + bj * 32 + 8 * fq) = w;
                    }
                }
        }
    }
};
template <bool XIN32>
struct EpiResid {
    static constexpr bool PERM = true, AFTER_DRAIN = false, PRE_SA = false;
    const void* xin; bf16* xout; const float* gate; float sc;
    __device__ __forceinline__ void operator()(const f32x4 (&acc)[2][2][4][2], const Unit& u, int wr, int wc, int fr, int fq) const {
        const int row0 = u.pm * BM + wr * 64 + fr, col0 = u.pn * BM + wc * 64 + 8 * fq, b = u.pm >> 3;
        f32x4 gv[2][2];
#pragma unroll
        for (int bj = 0; bj < 2; ++bj)
#pragma unroll
            for (int n = 0; n < 2; ++n) gv[bj][n] = *(const f32x4*)(gate + (size_t)b * 6144 + col0 + bj * 32 + 4 * n) * sc;
#pragma unroll
        for (int ab = 0; ab < (XIN32 ? 2 : 1); ++ab) {
            f32x4 xa[4][2][2]; u32x4 xb[2][4][2];
#pragma unroll
            for (int ai = 0; ai < 2; ++ai)
#pragma unroll
                for (int m = 0; m < 4; ++m) { const unsigned off = (unsigned)(row0 + ai * HALF + m * 16) * DM + col0;
#pragma unroll
                    for (int bj = 0; bj < 2; ++bj) {
                        if (XIN32) { if (ai == ab) { xa[m][bj][0] = *(const f32x4*)((const float*)xin + off + bj * 32); xa[m][bj][1] = *(const f32x4*)((const float*)xin + off + bj * 32 + 4); } }
                        else xb[ai][m][bj] = *(const u32x4*)((const bf16*)xin + off + bj * 32); } }
            asm volatile("" ::: "memory");
#pragma unroll
            for (int ai = 0; ai < 2; ++ai)
#pragma unroll
                for (int m = 0; m < 4; ++m) { const unsigned off = (unsigned)(row0 + ai * HALF + m * 16) * DM + col0;
                    if (XIN32 && ai != ab) continue;
#pragma unroll
                    for (int bj = 0; bj < 2; ++bj) {
                        f32x4 x0, x1;
                        if (XIN32) { x0 = xa[m][bj][0]; x1 = xa[m][bj][1]; }
                        else { const u32x4 q = xb[ai][m][bj]; x0 = (f32x4){bflo(q.x), bfhi(q.x), bflo(q.y), bfhi(q.y)}; x1 = (f32x4){bflo(q.z), bfhi(q.z), bflo(q.w), bfhi(q.w)}; }
                        const f32x4 av = x0 + gv[bj][0] * acc[ai][bj][m][0], cv = x1 + gv[bj][1] * acc[ai][bj][m][1];
                        u32x4 w; w.x = pk2(av[0], av[1]); w.y = pk2(av[2], av[3]); w.z = pk2(cv[0], cv[1]); w.w = pk2(cv[2], cv[3]);
                        *(u32x4*)(xout + off + bj * 32) = w;
                    } }
            asm volatile("" ::: "memory");
        }
    }
};
struct EpiOdIn {
    static constexpr bool PERM = true, AFTER_DRAIN = false, PRE_SA = I8_IN != 0;
    bf16* GY; bf16* XB; const float* SA; const PG8_LAS float* SB;
    __device__ __forceinline__ void operator()(const f32x4 (&acc)[2][2][4][2], const Unit& u, int wr, int wc, int fr, int fq, const float (&sav_)[8]) const {
        const int row0 = u.pm * BM + wr * 64 + fr; const bool isy = u.pn < 4;
        bf16* dst = (isy ? GY : XB) + (size_t)(u.pn & 3) * 256 + wc * 64 + 8 * fq;
#if I8_IN
        float sav[2][4]; f32x4 sbv[2][2];
#pragma unroll
        for (int ai = 0; ai < 2; ++ai)
#pragma unroll
            for (int m = 0; m < 4; ++m) sav[ai][m] = sav_[4 * ai + m];
#pragma unroll
        for (int bj = 0; bj < 2; ++bj) { sbv[bj][0] = *(const PG8_LAS f32x4*)(SB + u.pn * BM + 128 * bj + 32 * wc + 8 * fq); sbv[bj][1] = *(const PG8_LAS f32x4*)(SB + u.pn * BM + 128 * bj + 32 * wc + 8 * fq + 4); }
        asm volatile("" ::: "memory");
#endif
#pragma unroll
        for (int ai = 0; ai < 2; ++ai)
#pragma unroll
            for (int m = 0; m < 4; ++m) {
                const size_t row = (size_t)(row0 + ai * HALF + m * 16);
                unsigned xw8[4] = {0u, 0u, 0u, 0u};
#pragma unroll
                for (int bj = 0; bj < 2; ++bj) {
#if I8_IN
                    const float sa = sav[ai][m]; const f32x4 sb0 = sbv[bj][0], sb1 = sbv[bj][1];
                    const f32x4 i0 = acc[ai][bj][m][0], i1 = acc[ai][bj][m][1];
                    f32x4 a = i32_to_f32x4(i0) * sb0 * sa;
                    f32x4 b = i32_to_f32x4(i1) * sb1 * sa;
#else
                    f32x4 a = acc[ai][bj][m][0] * (FP8_IN1 ? 1.0f / 32.0f : 1.0f), b = acc[ai][bj][m][1] * (FP8_IN1 ? 1.0f / 32.0f : 1.0f);
#endif
                    if (isy) { const v2f_ a01 = gelu2(__builtin_shufflevector(a, a, 0, 1)), a23 = gelu2(__builtin_shufflevector(a, a, 2, 3)), b01 = gelu2(__builtin_shufflevector(b, b, 0, 1)), b23 = gelu2(__builtin_shufflevector(b, b, 2, 3));
                        a = __builtin_shufflevector(a01, a23, 0, 1, 2, 3); b = __builtin_shufflevector(b01, b23, 0, 1, 2, 3); }
#if X_FP8
                    if (!isy) { xw8[2 * bj] = pk4_fp8(a[0], a[1], a[2], a[3]); xw8[2 * bj + 1] = pk4_fp8(b[0], b[1], b[2], b[3]);
                        if (bj == 1) *(v4u*)((unsigned char*)XB + row * DM + (size_t)(u.pn & 3) * 256 + wc * 64 + 16 * fq) = (v4u){xw8[0], xw8[1], xw8[2], xw8[3]};
                        continue; }
#endif
                    u32x4 w; w.x = pk2(a[0], a[1]); w.y = pk2(a[2], a[3]); w.z = pk2(b[0], b[1]); w.w = pk2(b[2], b[3]);
                    *(u32x4*)(dst + row * DM + bj * 32) = w;
                }
            }
    }
};
__device__ __forceinline__ v2f_ silu_mul2(v2f_ a, v2f_ b) {
    const v2f_ t = a * (-1.4426950408889634f / 32.0f);
    v2f_ e; e[0] = __builtin_amdgcn_exp2f(t[0]); e[1] = __builtin_amdgcn_exp2f(t[1]);
    const v2f_ d = e * 256.0f + 256.0f;
    v2f_ r; r[0] = __builtin_amdgcn_rcpf(d[0]); r[1] = __builtin_amdgcn_rcpf(d[1]);
    return (a * b) * r;
}
struct EpiMoeA {
    static constexpr bool PERM = true, AFTER_DRAIN = false, PRE_SA = false;
    bf16* HID; bool dry;
    __device__ __forceinline__ void operator()(const f32x4 (&acc)[2][2][4][2], const Unit& u, int wr, int wc, int fr, int fq) const {
        const int row0 = u.pm * BM + wr * 64 + fr;
#pragma unroll
        for (int ai = 0; ai < 2; ++ai)
#pragma unroll
            for (int m = 0; m < 4; ++m) {
                const size_t row = (size_t)(row0 + ai * HALF + m * 16);
                const f32x4 a0 = acc[ai][0][m][0], a1 = acc[ai][0][m][1], b0 = acc[ai][1][m][0], b1 = acc[ai][1][m][1];
                const v2f_ h00 = silu_mul2(__builtin_shufflevector(a0, a0, 0, 1), __builtin_shufflevector(b0, b0, 0, 1)), h01 = silu_mul2(__builtin_shufflevector(a0, a0, 2, 3), __builtin_shufflevector(b0, b0, 2, 3));
                const v2f_ h10 = silu_mul2(__builtin_shufflevector(a1, a1, 0, 1), __builtin_shufflevector(b1, b1, 0, 1)), h11 = silu_mul2(__builtin_shufflevector(a1, a1, 2, 3), __builtin_shufflevector(b1, b1, 2, 3));
                v2u w8; w8.x = pk4_fp8(h00[0], h00[1], h01[0], h01[1]); w8.y = pk4_fp8(h10[0], h10[1], h11[0], h11[1]);
                if (!dry) *(v2u*)((unsigned char*)HID + row * DFF + u.pn * 128 + wc * 32 + 8 * fq) = w8; else asm volatile("" :: "v"(w8));
            }
    }
};
struct EpiMoeB {
    static constexpr bool PERM = true, AFTER_DRAIN = false, PRE_SA = false;
    bf16* Y; bool dry;
    __device__ __forceinline__ void operator()(const f32x4 (&acc)[2][2][4][2], const Unit& u, int wr, int wc, int fr, int fq) const {
        const int row0 = u.pm * BM + wr * 64 + fr;
#pragma unroll
        for (int ai = 0; ai < 2; ++ai)
#pragma unroll
            for (int m = 0; m < 4; ++m) {
                const size_t row = (size_t)(row0 + ai * HALF + m * 16);
                const f32x4 a0 = acc[ai][0][m][0] * (1.0f / 128.0f), a1 = acc[ai][0][m][1] * (1.0f / 128.0f), b0 = acc[ai][1][m][0] * (1.0f / 128.0f), b1 = acc[ai][1][m][1] * (1.0f / 128.0f);
                v4u w8; w8.x = pk4_fp8(a0[0], a0[1], a0[2], a0[3]); w8.y = pk4_fp8(a1[0], a1[1], a1[2], a1[3]); w8.z = pk4_fp8(b0[0], b0[1], b0[2], b0[3]); w8.w = pk4_fp8(b1[0], b1[1], b1[2], b1[3]);
                if (!dry) *(v4u*)((unsigned char*)Y + ((size_t)(u.pm * 4 + u.pn) * 256 + (size_t)(wr * 64 + ai * HALF + m * 16 + fr)) * 256 + wc * 64 + 16 * fq) = w8; else asm volatile("" :: "v"(w8));
            }
    }
};
constexpr int TOKSTR = 65536;
struct MoeOrder {
    static constexpr bool GATHER = false, LAZY_PB = false; const int* tok;
    StaticOrder base; const PG8_LAS int* te; const PG8_LAS int* tb; const PG8_LAS int* cl;
    __device__ __forceinline__ bool next(int i, Unit& u) const { if (!base.next(i, u)) return false; u.pb = __builtin_amdgcn_readfirstlane(te[u.pm]); return true; }
    __device__ __forceinline__ bool next_nopb(int i, Unit& u) const { return base.next(i, u); }
    __device__ __forceinline__ const int* pb_ptr(const Unit&) const { return nullptr; }
    __device__ __forceinline__ void a_ready(const Unit&) const {}
    __device__ __forceinline__ void done(const Unit&) const {}
};
struct MoeGatherOrder {
    static constexpr bool GATHER = true, LAZY_PB = false; const int* tok;
    StaticOrder base; const PG8_LAS int* te; const PG8_LAS int* tb; const PG8_LAS int* cl;
    __device__ __forceinline__ bool next(int i, Unit& u) const { if (!base.next(i, u)) return false; u.pb = __builtin_amdgcn_readfirstlane(te[u.pm]);
        const int r0 = (u.pm - __builtin_amdgcn_readfirstlane(tb[u.pb])) * BM; u.tk0 = u.pb * TOKSTR + r0; u.nv = __builtin_amdgcn_readfirstlane(cl[u.pb]) - r0; return true; }
    __device__ __forceinline__ bool next_nopb(int i, Unit& u) const { return base.next(i, u); }
    __device__ __forceinline__ const int* pb_ptr(const Unit&) const { return nullptr; }
    __device__ __forceinline__ void a_ready(const Unit&) const {}
    __device__ __forceinline__ void done(const Unit&) const {}
};
}

struct Frame {
    LAS unsigned char* lds;
    int tid, lane, wave, vcu, G, bx;
    unsigned char* ws;
};

template <bool OUT8 = false, class RowMap>
__device__ __forceinline__ void p0_transpose_item(const float* W, int K, int N, bf16* WT, LAS float* scr, int item, int lane, RowMap rm) {
    const int nblk = N / 64, kb = item / nblk, nb = item % nblk, k0 = 64 * kb, n0 = 64 * nb;
    f32x4 v[16];
#pragma unroll
    for (int i = 0; i < 16; ++i) v[i] = *(const f32x4*)(W + (size_t)(k0 + 4 * i + (lane >> 4)) * N + n0 + 4 * (lane & 15));
#pragma unroll
    for (int i = 0; i < 16; ++i) { LAS float* d = scr + (4 * i + (lane >> 4)) * 65 + 4 * (lane & 15); d[0] = v[i][0]; d[1] = v[i][1]; d[2] = v[i][2]; d[3] = v[i][3]; }
    asm volatile("s_waitcnt lgkmcnt(0)" ::: "memory");
    const int c = lane & 7;
#pragma unroll
    for (int j = 0; j < 8; ++j) { const int n = (lane >> 3) + 8 * j; const LAS float* sp = scr + (8 * c) * 65 + n;
        if constexpr (OUT8) { v2u o; o.x = pk4_fp8(sp[0 * 65] * 32.f, sp[1 * 65] * 32.f, sp[2 * 65] * 32.f, sp[3 * 65] * 32.f); o.y = pk4_fp8(sp[4 * 65] * 32.f, sp[5 * 65] * 32.f, sp[6 * 65] * 32.f, sp[7 * 65] * 32.f);
            *(GAS v2u*)((unsigned char*)WT + (size_t)rm(n0 + n) * K + k0 + 8 * c) = o; }
        else { v4u o; o.x = pk2(sp[0 * 65], sp[1 * 65]); o.y = pk2(sp[2 * 65], sp[3 * 65]); o.z = pk2(sp[4 * 65], sp[5 * 65]); o.w = pk2(sp[6 * 65], sp[7 * 65]);
            *(GAS v4u*)(WT + (size_t)rm(n0 + n) * K + k0 + 8 * c) = o; } }
    asm volatile("s_waitcnt lgkmcnt(0)" ::: "memory");
}
struct RmId { __device__ __forceinline__ int operator()(int n) const { return n; } };
struct RmW16 { __device__ __forceinline__ int operator()(int n) const { const int r = n & 255, wc = r >> 6, fq = (r >> 4) & 3, bj = (r >> 3) & 1, j = r & 7; return (n & ~255) + 128 * bj + 32 * wc + 8 * fq + j; } };
struct RmW64 { __device__ __forceinline__ int operator()(int n) const { const int r = n & 255, wc = r >> 6, bj = (r >> 5) & 1, j = r & 31; return (n & ~255) + 128 * bj + 32 * wc + j; } };
struct RmEvIn { __device__ __forceinline__ int operator()(int n) const {
    if (n < 512) return 256 * (n >> 7) + (n & 127);
    if (n < 1024) { const int m = n - 512; return 256 * (m >> 7) + 128 + (m & 127); }
    if (n < 2048) { const int m = n - 1024, sec = m >> 9, mm = m & 511, p = mm >> 8, r = mm & 255, wc = r >> 6, d = r & 63, bj = d >> 5, j = d & 31;
        return 256 * (4 + 2 * sec + p) + 128 * bj + 32 * wc + j; }
    return RmW64{}(n); } };
struct RmOdIn { __device__ __forceinline__ int operator()(int n) const { return (X_FP8 && n >= 1024) ? RmW16{}(n) : RmW64{}(n); } };
struct RmGlu { int half; __device__ __forceinline__ int operator()(int n) const { return 256 * (n >> 7) + 128 * half + (n & 127); } };

template <class KAT> __device__ __forceinline__ void p0_prologue(Frame& F, KAT KA) {
#define in KA->in
    static_assert(I8_IN, "the prologue prepares int8 input-projection weights only");
    const int w = F.bx;
    if (w < 192) {
        constexpr int ASTR = 2064;
        LAS unsigned char* ah = F.lds; LAS unsigned char* al = F.lds + 32 * ASTR;
        const float* c = in[1];
        for (int i = F.tid; i < 32 * 512; i += 512) { const int b = i >> 9, k = (i & 511) * 2; const f32x2 v = *(const f32x2*)(c + b * 1024 + k);
            const float s0 = v[0] / (1.0f + __expf(-v[0])), s1 = v[1] / (1.0f + __expf(-v[1]));
            const unsigned h = pk2(s0, s1), lo = pk2(s0 - bflo(h), s1 - bfhi(h));
            *(LAS unsigned*)(ah + b * ASTR + k * 2) = h; *(LAS unsigned*)(al + b * ASTR + k * 2) = lo; }
        __syncthreads();
        const int ch = F.wave >> 2, kq = F.wave & 3, colg = w * 64 + ch * 32, l = colg / 6144, col = colg % 6144 + (F.lane & 31), kg = F.lane >> 5, m = F.lane & 31;
        const float* W = in[2] + (size_t)l * 1024 * 6144 + col + (size_t)(kq * 256 + 8 * kg) * 6144;
        float wv[16][8];
#pragma unroll
        for (int st = 0; st < 16; ++st)
#pragma unroll
            for (int j = 0; j < 8; ++j) wv[st][j] = W[(size_t)(16 * st + j) * 6144];
        f32x16 acc;
#pragma unroll
        for (int r = 0; r < 16; ++r) acc[r] = 0.f;
#pragma unroll
        for (int st = 0; st < 16; ++st) {
            v4u bh, bl;
            bh.x = pk2(wv[st][0], wv[st][1]); bh.y = pk2(wv[st][2], wv[st][3]); bh.z = pk2(wv[st][4], wv[st][5]); bh.w = pk2(wv[st][6], wv[st][7]);
            bl.x = pk2(wv[st][0] - bflo(bh.x), wv[st][1] - bfhi(bh.x)); bl.y = pk2(wv[st][2] - bflo(bh.y), wv[st][3] - bfhi(bh.y));
            bl.z = pk2(wv[st][4] - bflo(bh.z), wv[st][5] - bfhi(bh.z)); bl.w = pk2(wv[st][6] - bflo(bh.w), wv[st][7] - bfhi(bh.w));
            const int ko = (kq * 256 + 16 * st + 8 * kg) * 2;
            const bf16x8 a_hi = *(const LAS bf16x8*)(ah + m * ASTR + ko), a_lo = *(const LAS bf16x8*)(al + m * ASTR + ko);
            acc = __builtin_amdgcn_mfma_f32_32x32x16_bf16(a_hi, __builtin_bit_cast(bf16x8, bh), acc, 0, 0, 0);
            acc = __builtin_amdgcn_mfma_f32_32x32x16_bf16(a_lo, __builtin_bit_cast(bf16x8, bh), acc, 0, 0, 0);
            acc = __builtin_amdgcn_mfma_f32_32x32x16_bf16(a_hi, __builtin_bit_cast(bf16x8, bl), acc, 0, 0, 0);
        }
        __syncthreads();
        LAS float* red = (LAS float*)F.lds;
#pragma unroll
        for (int r = 0; r < 16; ++r) red[(F.wave * 16 + r) * 64 + F.lane] = acc[r];
        __syncthreads();
        float* mod = (float*)(F.ws + WS_MOD);
        for (int o = F.tid; o < 2048; o += 512) { const int ch2 = o >> 10, bm = (o >> 5) & 31, n = o & 31;
            const int r = (bm & 3) + 4 * (bm >> 3), ln = n + 32 * ((bm >> 2) & 1);
            float t = 0.f;
#pragma unroll
            for (int q = 0; q < 4; ++q) t += red[((ch2 * 4 + q) * 16 + r) * 64 + ln];
            const int cg = w * 64 + ch2 * 32 + n, l2 = cg / 6144, c2 = cg % 6144;
            mod[((size_t)l2 * 32 + bm) * 6144 + c2] = t + in[3][(size_t)l2 * 6144 + c2]; }
        __syncthreads();
    }
    if (w >= 192) for (int cbk = w - 192; cbk < 72; cbk += 64) {
        LAS float* scr8 = (LAS float*)(F.lds + F.wave * 16640);
        LAS float* pm = (LAS float*)(F.lds + 133120);
        const int kq = F.wave;
        const bool isev = cbk < 40;
        const float* W8s = isev ? in[6] : in[14]; const int N8 = isev ? 2560 : 2048, n0 = 64 * (isev ? cbk : cbk - 40);
        unsigned char* WT8 = F.ws + (isev ? WS_WEVIN : WS_WODIN); float* SBp = (float*)(F.ws + (isev ? META_SBEVIN : META_SBODIN));
        float mx[4] = {0.f, 0.f, 0.f, 0.f};
        for (int kb = 0; kb < 2; ++kb) {
#pragma unroll
            for (int i = 0; i < 16; ++i) { const f32x4 v = *(const f32x4*)(W8s + (size_t)(128 * kq + 64 * kb + 4 * i + (F.lane >> 4)) * N8 + n0 + 4 * (F.lane & 15));
                mx[0] = __builtin_fmaxf(mx[0], __builtin_fabsf(v[0])); mx[1] = __builtin_fmaxf(mx[1], __builtin_fabsf(v[1])); mx[2] = __builtin_fmaxf(mx[2], __builtin_fabsf(v[2])); mx[3] = __builtin_fmaxf(mx[3], __builtin_fabsf(v[3])); }
        }
#pragma unroll
        for (int e = 0; e < 4; ++e) { mx[e] = __builtin_fmaxf(mx[e], __shfl_xor(mx[e], 16)); mx[e] = __builtin_fmaxf(mx[e], __shfl_xor(mx[e], 32)); }
        if (F.lane < 16) *(LAS f32x4*)(pm + F.wave * 64 + 4 * F.lane) = (f32x4){mx[0], mx[1], mx[2], mx[3]};
        __syncthreads();
        float inv[8];
#pragma unroll
        for (int j = 0; j < 8; ++j) { const int n = (F.lane >> 3) + 8 * j;
            float cm = pm[n];
#pragma unroll
            for (int q = 1; q < 8; ++q) cm = __builtin_fmaxf(cm, pm[q * 64 + n]);
            inv[j] = I8_FIXSCALE ? 127.0f / 0.25f : (cm > 0.f ? 127.0f / cm : 0.f);
            if (kq == 0 && (F.lane & 7) == 0) SBp[isev ? RmEvIn{}(n0 + n) : RmOdIn{}(n0 + n)] = cm > 0.f ? cm * (1.0f / 127.0f) : 1.0f; }
        for (int kb = 0; kb < 2; ++kb) {
            const int k0 = 128 * kq + 64 * kb;
            f32x4 v[16];
#pragma unroll
            for (int i = 0; i < 16; ++i) v[i] = *(const f32x4*)(W8s + (size_t)(k0 + 4 * i + (F.lane >> 4)) * N8 + n0 + 4 * (F.lane & 15));
#pragma unroll
            for (int i = 0; i < 16; ++i) { LAS float* d = scr8 + (4 * i + (F.lane >> 4)) * 65 + 4 * (F.lane & 15); d[0] = v[i][0]; d[1] = v[i][1]; d[2] = v[i][2]; d[3] = v[i][3]; }
            asm volatile("s_waitcnt lgkmcnt(0)" ::: "memory");
            const int c = F.lane & 7;
#pragma unroll
            for (int j = 0; j < 8; ++j) { const int n = (F.lane >> 3) + 8 * j; const LAS float* sp = scr8 + (8 * c) * 65 + n; const float iv = inv[j];
                v2u o; o.x = pk4_i8(sp[0 * 65] * iv, sp[1 * 65] * iv, sp[2 * 65] * iv, sp[3 * 65] * iv); o.y = pk4_i8(sp[4 * 65] * iv, sp[5 * 65] * iv, sp[6 * 65] * iv, sp[7 * 65] * iv);
                *(GAS v2u*)(WT8 + (size_t)(isev ? RmEvIn{}(n0 + n) : RmOdIn{}(n0 + n)) * 1024 + k0 + 8 * c) = o; }
            asm volatile("s_waitcnt lgkmcnt(0)" ::: "memory");
        }
        __syncthreads();
    }
    if (w >= 36 && w < 40) {
        unsigned char* img = F.ws + META_WRIMG; const float* rw = in[23];
        for (int i = (w - 36) * 4096 + F.tid; i < (w - 35) * 4096; i += 512) { const int k = i >> 4, e = i & 15; const float v = rw[i]; const unsigned hb = pk2(v, 0.f) & 0xffffu; const float lo = v - bflo(hb);
            *(bf16*)(img + e * 2064 + k * 2) = (bf16)hb; *(bf16*)(img + 16 * 2064 + e * 2064 + k * 2) = (bf16)(pk2(lo, 0.f) & 0xffffu); }
    }
    LAS float* scr = (LAS float*)(F.lds + F.wave * 16640);
    bf16* WEVOUT = (bf16*)(F.ws + WS_WEVOUT); bf16* WODOUT = (bf16*)(F.ws + WS_WODOUT);
    bf16* WRG = (bf16*)(F.ws + WS_WRG); bf16* WIG = (bf16*)(F.ws + WS_WIG); bf16* W13 = (bf16*)(F.ws + WS_W13); bf16* W2 = (bf16*)(F.ws + WS_W2);
    constexpr int I_SQ = 16 * 16, I_W1 = 16 * 8, I_W2 = 8 * 16, I_G = 2 * 2;
    constexpr int NITEMS = 2 * I_SQ + 32 * I_W1 * 2 + 32 * I_W2 + 16 * I_G, NV = 192 * 8 + 8 * 3 + 56 * 6, NROUND = (NITEMS + NV - 1) / NV;
    const int share = w < 192 ? 8 : (w < 200 ? 3 : 6), slot0 = w < 192 ? 8 * w : (w < 200 ? 1536 + 3 * (w - 192) : 1560 + 6 * (w - 200));
    for (int q = F.wave; q < share * NROUND; q += NWAVES) {
        const int it = slot0 + q % share + NV * (q / share);
        if (it >= NITEMS) continue;
        int r = it;
        if (r < I_SQ) { p0_transpose_item<FP8_OUT != 0>(in[13], 1024, 1024, WEVOUT, scr, r, F.lane, RmW64{}); continue; } r -= I_SQ;
        if (r < I_SQ) { p0_transpose_item<FP8_OUT != 0>(in[22], 1024, 1024, WODOUT, scr, r, F.lane, RmW64{}); continue; } r -= I_SQ;
        if (r < 32 * I_W1) { const int mat = r / I_W1; p0_transpose_item<true>(in[25] + (size_t)mat * 1024 * 512, 1024, 512, (bf16*)((unsigned char*)W13 + (size_t)mat * 1024 * 1024), scr, r % I_W1, F.lane, RmGlu{0}); continue; } r -= 32 * I_W1;
        if (r < 32 * I_W1) { const int mat = r / I_W1; p0_transpose_item<true>(in[26] + (size_t)mat * 1024 * 512, 1024, 512, (bf16*)((unsigned char*)W13 + (size_t)mat * 1024 * 1024), scr, r % I_W1, F.lane, RmGlu{1}); continue; } r -= 32 * I_W1;
        if (r < 32 * I_W2) { const int mat = r / I_W2; p0_transpose_item<true>(in[27] + (size_t)mat * 512 * 1024, 512, 1024, (bf16*)((unsigned char*)W2 + (size_t)mat * 1024 * 512), scr, r % I_W2, F.lane, RmW16{}); continue; } r -= 32 * I_W2;
        { const int mat = r / I_G, which = mat >> 3, blk = mat & 7;
          p0_transpose_item((which ? in[19] : in[17]) + (size_t)blk * 128 * 128, 128, 128, (which ? WIG : WRG) + (size_t)blk * 128 * 128, scr, r % I_G, F.lane, RmId{}); }
    }
#undef in
}

__device__ __forceinline__ void norm_rows(Frame& F, const float* X, bf16* H, const float* ng, const float* modl, int sh_off, int sc_off) {
    const int gw = F.bx * NWAVES + F.wave;
    const int b = gw >> 6;
    f32x4 gm[4], sh[4];
#pragma unroll
    for (int j = 0; j < 4; ++j) { const int k = 256 * j + 4 * F.lane;
        const f32x4 g = *(const f32x4*)(ng + k), s = *(const f32x4*)(modl + (size_t)b * 6144 + sc_off + k);
        gm[j] = g * (s + 1.0f); sh[j] = *(const f32x4*)(modl + (size_t)b * 6144 + sh_off + k); }
    for (int r = 0; r < 32; r += 4) {
        const size_t row = (size_t)gw * 32 + r;
        f32x4 v[4][4]; float ss[4];
#pragma unroll
        for (int q = 0; q < 4; ++q)
#pragma unroll
            for (int j = 0; j < 4; ++j) v[q][j] = *(const f32x4*)(X + (row + q) * DM + 256 * j + 4 * F.lane);
#pragma unroll
        for (int q = 0; q < 4; ++q) { ss[q] = 0.f;
#pragma unroll
            for (int j = 0; j < 4; ++j) ss[q] += (v[q][j][0] * v[q][j][0] + v[q][j][1] * v[q][j][1]) + (v[q][j][2] * v[q][j][2] + v[q][j][3] * v[q][j][3]); }
#pragma unroll
        for (int q = 0; q < 4; ++q) {
            const float rstd = 1.0f / sqrtf(wave_sum(ss[q]) * (1.0f / DM) + EPS);
#if I8_IN
            { float am = 0.f; f32x4 o[4];
#pragma unroll
              for (int j = 0; j < 4; ++j) { o[j] = v[q][j] * rstd * gm[j] + sh[j]; am = __builtin_fmaxf(am, __builtin_fmaxf(__builtin_fmaxf(__builtin_fabsf(o[j][0]), __builtin_fabsf(o[j][1])), __builtin_fmaxf(__builtin_fabsf(o[j][2]), __builtin_fabsf(o[j][3])))); }
#pragma unroll
              for (int of = 1; of < 64; of <<= 1) am = __builtin_fmaxf(am, __shfl_xor(am, of));
              if (I8_FIXSCALE) am = 8.0f;
              const float iv = am > 0.f ? 127.0f / am : 0.f;
              if (F.lane == 0) ((float*)(F.ws + WS_SA))[row + q] = am > 0.f ? am * (1.0f / 127.0f) : 1.0f;
#pragma unroll
              for (int j = 0; j < 4; ++j) *(unsigned*)((unsigned char*)H + (row + q) * DM + 256 * j + 4 * F.lane) = pk4_i8(o[j][0] * iv, o[j][1] * iv, o[j][2] * iv, o[j][3] * iv); }
            continue;
#endif
#pragma unroll
            for (int j = 0; j < 4; ++j) { const f32x4 o = v[q][j] * rstd * gm[j] + sh[j];
#if FP8_IN0
                *(unsigned*)((unsigned char*)H + (row + q) * DM + 256 * j + 4 * F.lane) = pk4_fp8(o[0], o[1], o[2], o[3]);
#else
                v2u w; w.x = pk2(o[0], o[1]); w.y = pk2(o[2], o[3]); *(v2u*)(H + (row + q) * DM + 256 * j + 4 * F.lane) = w;
#endif
            }
        }
    }
}

namespace sba {
constexpr int SLOTB = 8192, L_K = 0, L_V = 2 * SLOTB, L_FLAG = 4 * SLOTB, L_OST = 4 * SLOTB + 256;
__device__ __forceinline__ s16x4 vtr(const LAS unsigned char* p) { typedef short v4i16_t __attribute__((ext_vector_type(4))); return __builtin_bit_cast(s16x4, __builtin_amdgcn_ds_read_tr16_b64_v4i16((LAS v4i16_t*)p)); }
__device__ __forceinline__ void unit(int b, int h, int qb, const bf16* Q, const bf16* K, const bf16* V, bf16* CAT, LAS unsigned char* lds) {
    const int tid = threadIdx.x, lane = tid & 63, r32 = lane & 31, hi = lane >> 5; const int wid = __builtin_amdgcn_readfirstlane(tid >> 6);
    const long rowbase = (long)b * SEQ; const int q0 = qb * 256;
    const bf16* Qw = Q + (rowbase + q0 + wid * 32) * SBW + h * HD;
    const bf16* Kh = K + rowbase * SBW + h * HD; const bf16* Vh = V + rowbase * SBW + h * HD;
    const bf16* ksrc = Kh + (long)lane * SBW + wid * 8;
    const bf16* vsrc = Vh + (long)(16 * (wid & 3) + (lane >> 2)) * SBW + (wid >> 2) * 32 + (lane & 3) * 8;
    LAS unsigned char* kdst = lds + L_K + wid * 1024; LAS unsigned char* vdst = lds + L_V + wid * 1024;
#define SBA_DMA(t, slot) do { __builtin_amdgcn_global_load_lds((const unsigned*)(ksrc + (long)(t) * 64 * SBW), (LAS unsigned*)(kdst + (slot) * SLOTB), 16, 0, 0); \
                              __builtin_amdgcn_global_load_lds((const unsigned*)(vsrc + (long)(t) * 64 * SBW), (LAS unsigned*)(vdst + (slot) * SLOTB), 16, 0, 0); } while (0)
    const LAS unsigned char* kp0 = lds + L_K + hi * 1024 + r32 * 16;
    const LAS unsigned char* vp0 = lds + L_V + ((lane >> 4) & 1) * 32 + (lane & 3) * 8 + (4 * hi + ((lane & 15) >> 2)) * 64;
    volatile LAS unsigned* flags = (volatile LAS unsigned*)(lds + L_FLAG);
    const int NT = (q0 + 256) / 64;
    SBA_DMA(NT - 1, 0);
    bf16x8 qr[4];
#pragma unroll
    for (int d0 = 0; d0 < 4; ++d0) qr[d0] = *(const bf16x8*)(Qw + (long)r32 * SBW + d0 * 16 + hi * 8);
    f32x16 o0 = {}, o1 = {};
    float carry = 1.0f; bool done_w = false;
    const int qrow = q0 + wid * 32 + r32, qmin = q0 + wid * 32;
    for (int it = 0, t = NT - 1; t >= 0; --t, ++it) {
        const int slot = it & 1;
        __syncthreads();
        if (it > 0) { unsigned all = 1u;
#pragma unroll
            for (int w8 = 0; w8 < 8; ++w8) all &= flags[((it - 1) & 1) * 8 + w8];
            if (all) break; }
        if (t > 0) SBA_DMA(t - 1, slot ^ 1);
        const int kbase = 64 * t;
        if (!done_w && kbase < qmin + 31) {
            const LAS unsigned char* kp = kp0 + slot * SLOTB;
            bf16x8 kf[8];
#pragma unroll
            for (int d0 = 0; d0 < 4; ++d0) { kf[2 * d0] = *(const LAS bf16x8*)(kp + d0 * 2048); kf[2 * d0 + 1] = *(const LAS bf16x8*)(kp + d0 * 2048 + 512); }
            f32x16 C0 = {}, C1 = {};
#pragma unroll
            for (int d0 = 0; d0 < 4; ++d0) { C0 = __builtin_amdgcn_mfma_f32_32x32x16_bf16(kf[2 * d0], qr[d0], C0, 0, 0, 0); C1 = __builtin_amdgcn_mfma_f32_32x32x16_bf16(kf[2 * d0 + 1], qr[d0], C1, 0, 0, 0); }
            f32x16 D0, D1;
            const bool partial = (kbase + 64 > qmin);
            if (partial) {
#pragma unroll
                for (int r = 0; r < 16; ++r) {
                    float f0 = fast_rcp(1.0f + fast_exp2(C0[r])), f1 = fast_rcp(1.0f + fast_exp2(C1[r]));
                    const int kp_ = kbase + 4 * hi + (r & 3) + 8 * (r >> 2);
                    if (!(kp_ < qrow)) f0 = 1.f;
                    if (!(kp_ + 32 < qrow)) f1 = 1.f;
                    D0[r] = f0; D1[r] = f1;
                }
            } else {
#pragma unroll
                for (int r = 0; r < 16; r += 2) {
                    f32x2 e0, e1; e0[0] = fast_exp2(C0[r]); e0[1] = fast_exp2(C0[r + 1]); e1[0] = fast_exp2(C1[r]); e1[1] = fast_exp2(C1[r + 1]);
                    const f32x2 d0 = e0 + 1.0f, d1 = e1 + 1.0f;
                    D0[r] = fast_rcp(d0[0]); D0[r + 1] = fast_rcp(d0[1]); D1[r] = fast_rcp(d1[0]); D1[r + 1] = fast_rcp(d1[1]);
                }
                asm volatile("" ::: "memory");
            }
            float own[8], par[8], eg[8];
#pragma unroll
            for (int g = 0; g < 4; ++g) {
                { const float p3 = D0[4 * g + 3], p2 = D0[4 * g + 2] * p3, p1 = D0[4 * g + 1] * p2, p0 = D0[4 * g] * p1; own[g] = p0;
                  C0[4 * g + 3] = 1.0f - p3; C0[4 * g + 2] = p3 - p2; C0[4 * g + 1] = p2 - p1; C0[4 * g] = p1 - p0; }
                { const float p3 = D1[4 * g + 3], p2 = D1[4 * g + 2] * p3, p1 = D1[4 * g + 1] * p2, p0 = D1[4 * g] * p1; own[4 + g] = p0;
                  C1[4 * g + 3] = 1.0f - p3; C1[4 * g + 2] = p3 - p2; C1[4 * g + 1] = p2 - p1; C1[4 * g] = p1 - p0; }
            }
#pragma unroll
            for (int j = 0; j < 8; ++j) { const auto rr = __builtin_amdgcn_permlane32_swap(__float_as_uint(own[j]), __float_as_uint(own[j]), false, false);
                par[j] = __uint_as_float(hi ? rr[0] : rr[1]); }
            float sp = carry;
#pragma unroll
            for (int j = 7; j >= 0; --j) { eg[j] = hi ? sp : sp * par[j]; sp *= own[j] * par[j]; }
            carry = sp;
#pragma unroll
            for (int g = 0; g < 4; ++g)
#pragma unroll
                for (int i = 0; i < 4; ++i) { C0[4 * g + i] *= eg[g]; C1[4 * g + i] *= eg[4 + g]; }
            v4u pw0, pw1, pw2, pw3;
            pw0 = (v4u){pk2(C0[0], C0[1]), pk2(C0[2], C0[3]), pk2(C0[4], C0[5]), pk2(C0[6], C0[7])};
            pw1 = (v4u){pk2(C0[8], C0[9]), pk2(C0[10], C0[11]), pk2(C0[12], C0[13]), pk2(C0[14], C0[15])};
            pw2 = (v4u){pk2(C1[0], C1[1]), pk2(C1[2], C1[3]), pk2(C1[4], C1[5]), pk2(C1[6], C1[7])};
            pw3 = (v4u){pk2(C1[8], C1[9]), pk2(C1[10], C1[11]), pk2(C1[12], C1[13]), pk2(C1[14], C1[15])};
            const LAS unsigned char* vp = vp0 + slot * SLOTB;
#pragma unroll
            for (int d0 = 0; d0 < 2; ++d0) {
                s16x4 lo[4], hh[4];
#pragma unroll
                for (int ks = 0; ks < 4; ++ks) { lo[ks] = vtr(vp + d0 * 4096 + ks * 1024); hh[ks] = vtr(vp + d0 * 4096 + ks * 1024 + 512); }
#define SBA_VF(k) (bf16x8){lo[k][0], lo[k][1], lo[k][2], lo[k][3], hh[k][0], hh[k][1], hh[k][2], hh[k][3]}
                f32x16 oo = d0 ? o1 : o0;
                oo = __builtin_amdgcn_mfma_f32_32x32x16_bf16(__builtin_bit_cast(bf16x8, pw0), SBA_VF(0), oo, 0, 0, 0);
                oo = __builtin_amdgcn_mfma_f32_32x32x16_bf16(__builtin_bit_cast(bf16x8, pw1), SBA_VF(1), oo, 0, 0, 0);
                oo = __builtin_amdgcn_mfma_f32_32x32x16_bf16(__builtin_bit_cast(bf16x8, pw2), SBA_VF(2), oo, 0, 0, 0);
                oo = __builtin_amdgcn_mfma_f32_32x32x16_bf16(__builtin_bit_cast(bf16x8, pw3), SBA_VF(3), oo, 0, 0, 0);
                if (d0) o1 = oo; else o0 = oo;
#undef SBA_VF
            }
            done_w = __all(carry < 1e-30f);
        }
        if (lane == 0) flags[slot * 8 + wid] = done_w ? 1u : 0u;
    }
    {
        LAS bf16* stg = (LAS bf16*)(lds + L_OST) + wid * 2048;
#pragma unroll
        for (int r = 0; r < 16; ++r) { const int orow = (r & 3) + 8 * (r >> 2) + 4 * hi;
            stg[orow * 64 + r32] = (bf16)(pk2(o0[r], 0.f) & 0xffffu); stg[orow * 64 + 32 + r32] = (bf16)(pk2(o1[r], 0.f) & 0xffffu); }
        asm volatile("s_waitcnt lgkmcnt(0)" ::: "memory");
        bf16* Ow = CAT + (rowbase + q0 + wid * 32) * DM + 512 + h * HD;
#pragma unroll
        for (int i = 0; i < 4; ++i) { const int row = i * 8 + (lane >> 3), ch = lane & 7; const v4u v = *(const LAS v4u*)(stg + row * 64 + ch * 8);
#if FP8_OUT
            *(v2u*)((unsigned char*)CAT + (rowbase + q0 + wid * 32 + row) * DM + 512 + h * HD + ch * 8) = bf8x_to_fp8(v);
#else
            *(v4u*)(Ow + (long)row * DM + ch * 8) = v;
#endif
        }
    }
    __syncthreads();
#undef SBA_DMA
}
}

__device__ __forceinline__ void conv_prefetch(Frame& F, v4u (&pf)[8], int uidx, const bf16* U0) {
    const int b = uidx >> 6, t0 = (uidx & 63) * 32;
#pragma unroll
#if U_FP8
    for (int i = 0; i < 4; ++i) { const int idx = F.tid + 512 * i; const int ri = idx >> 5, ch = idx & 31, tok = t0 - 30 + ri;
        pf[i] = (v4u){0u, 0u, 0u, 0u};
        if (idx < 62 * 32 && tok >= 0) pf[i] = *(const v4u*)((const unsigned char*)U0 + ((size_t)b * SEQ + tok) * CONVC + ch * 16); }
#else
    for (int i = 0; i < 8; ++i) { const int idx = F.tid + 512 * i; const int ri = idx >> 6, ch = idx & 63, tok = t0 - 30 + ri;
        pf[i] = (v4u){0u, 0u, 0u, 0u};
        if (idx < 62 * 64 && tok >= 0) pf[i] = *(const v4u*)(U0 + ((size_t)b * SEQ + tok) * CONVC + ch * 8); }
#endif
}
__device__ __forceinline__ void conv_phase(Frame& F, const bf16* U0, bf16* CAT, const float* dw_w, const float* dw_b, const float* ln_g, const float* ln_b) {
    LAS unsigned char* tile = F.lds;
    LAS float* resl = (LAS float*)(F.lds + 63488);
    v4u pf[8];
    const int nunits = NB * (SEQ / 32);
    if (F.vcu < nunits) conv_prefetch(F, pf, F.vcu, U0);
    const int cp = F.tid & 255, th = F.tid >> 8;
    float w0[31], w1[31];
#pragma unroll
    for (int k = 0; k < 31; ++k) { const f32x2 wv = *(const f32x2*)(dw_w + k * CONVC + 2 * cp); w0[k] = wv[0]; w1[k] = wv[1]; }
    const f32x2 bias = *(const f32x2*)(dw_b + 2 * cp);
    for (int uidx = F.vcu; uidx < nunits; uidx += F.G) {
        const int b = uidx >> 6, t0 = (uidx & 63) * 32;
#pragma unroll
#if U_FP8
        for (int i = 0; i < 4; ++i) { const int idx = F.tid + 512 * i; if (idx < 62 * 32) *(LAS v4u*)(tile + idx * 16) = pf[i]; }
#else
        for (int i = 0; i < 8; ++i) { const int idx = F.tid + 512 * i; if (idx < 62 * 64) *(LAS v4u*)(tile + idx * 16) = pf[i]; }
#endif
        __syncthreads();
        if (uidx + F.G < nunits) conv_prefetch(F, pf, uidx + F.G, U0);
        {
#pragma unroll 1
            for (int og = 0; og < 2; ++og) {
                float a0[8], a1[8];
#pragma unroll
                for (int o = 0; o < 8; ++o) { a0[o] = bias[0]; a1[o] = bias[1]; }
#if U_FP8
                const LAS unsigned char* tp = tile + (16 * th + 8 * og) * 512 + cp * 2;
#else
                const LAS unsigned char* tp = tile + (16 * th + 8 * og) * 1024 + cp * 4;
#endif
#if U_FP8
                unsigned xr[38];
#pragma unroll
                for (int j = 0; j < 38; ++j) xr[j] = *(const LAS unsigned short*)(tp + j * 512);
                asm volatile("" ::: "memory");
#endif
#pragma unroll
                for (int j = 0; j < 38; ++j) {
#if U_FP8
                    const f32x2 xp = __builtin_amdgcn_cvt_pk_f32_fp8((int)xr[j], false);
                    const float x0 = xp[0], x1 = xp[1];
#else
                    const unsigned xin = *(const LAS unsigned*)(tp + j * 1024);
                    const float x0 = bflo(xin), x1 = bfhi(xin);
#endif
#pragma unroll
                    for (int o = 0; o < 8; ++o) { const int k = j - o; if (k >= 0 && k <= 30) { a0[o] += w0[k] * x0; a1[o] += w1[k] * x1; } }
                }
#pragma unroll
                for (int o = 0; o < 8; ++o) *(LAS f32x2*)(resl + (16 * th + 8 * og + o) * 512 + 2 * cp) = (f32x2){a0[o], a1[o]};
            }
        }
        __syncthreads();
        {
            const f32x4 lg0 = *(const f32x4*)(ln_g + 8 * F.lane), lg1 = *(const f32x4*)(ln_g + 8 * F.lane + 4), lb0 = *(const f32x4*)(ln_b + 8 * F.lane), lb1 = *(const f32x4*)(ln_b + 8 * F.lane + 4);
#pragma unroll
            for (int i = 0; i < 4; ++i) {
                const int tk = F.wave * 4 + i;
                const f32x4 v0 = *(const LAS f32x4*)(resl + tk * 512 + 8 * F.lane), v1 = *(const LAS f32x4*)(resl + tk * 512 + 8 * F.lane + 4);
                const float c = __builtin_bit_cast(float, __builtin_amdgcn_readfirstlane(__builtin_bit_cast(int, v0[0])));
                const f32x4 u0 = v0 - c, u1 = v1 - c;
                float s1 = (u0[0] + u0[1]) + (u0[2] + u0[3]) + (u1[0] + u1[1]) + (u1[2] + u1[3]);
                float s2 = (u0[0] * u0[0] + u0[1] * u0[1]) + (u0[2] * u0[2] + u0[3] * u0[3]) + (u1[0] * u1[0] + u1[1] * u1[1]) + (u1[2] * u1[2] + u1[3] * u1[3]);
#pragma unroll
                for (int o = 1; o < 64; o <<= 1) { s1 += __shfl_xor(s1, o); s2 += __shfl_xor(s2, o); }
                const float mu = s1 * (1.0f / CONVC), mean = mu + c;
                const f32x4 d0 = v0 - mean, d1 = v1 - mean;
                const float q = __builtin_fmaxf(s2 * (1.0f / CONVC) - mu * mu, 0.f) * CONVC;
                const float rstd = 1.0f / sqrtf(q * (1.0f / CONVC) + EPS);
                const f32x4 y0 = d0 * rstd * lg0 + lb0, y1 = d1 * rstd * lg1 + lb1;
                v4u pw; pw.x = pk2(siluf_(y0[0]), siluf_(y0[1])); pw.y = pk2(siluf_(y0[2]), siluf_(y0[3])); pw.z = pk2(siluf_(y1[0]), siluf_(y1[1])); pw.w = pk2(siluf_(y1[2]), siluf_(y1[3]));
#if FP8_OUT
                *(v2u*)((unsigned char*)CAT + ((size_t)b * SEQ + t0 + tk) * DM + 8 * F.lane) = bf8x_to_fp8(pw);
#else
                *(v4u*)(CAT + ((size_t)b * SEQ + t0 + tk) * DM + 8 * F.lane) = pw;
#endif
            }
        }
        __syncthreads();
    }
}

__device__ __forceinline__ void lru_unit(Frame& F, int b, int cb, const bf16* GY, const bf16* XB, bf16* CAT2, const bf16* WRG, const bf16* WIG,
                                         const float* conv_w, const float* conv_b, const float* rg_b, const float* ig_b, const float* lam) {
    constexpr int L_XR = 0, L_XC = 17408, L_GY = 34816, L_OUT = 51200;
    LAS unsigned char* lds = F.lds;
    const int lane = F.lane, wv = F.wave, l15 = lane & 15, g4 = lane >> 4;
    const int cl_ = 16 * wv + l15, cglob = cb * 128 + cl_;
    bf16x8 brg[4], big[4];
#pragma unroll
    for (int ks = 0; ks < 4; ++ks) { brg[ks] = *(const bf16x8*)(WRG + ((size_t)cb * 128 + cl_) * 128 + 32 * ks + 8 * g4); big[ks] = *(const bf16x8*)(WIG + ((size_t)cb * 128 + cl_) * 128 + 32 * ks + 8 * g4); }
    const float rb2 = -1.4426950408889634f * rg_b[cglob], ib2 = -1.4426950408889634f * ig_b[cglob];
    const float lamv = lam[cglob];
    const float cl2 = -8.0f * log1pf(expf(-lamv)) * 1.4426950408889634f;
    const int cp2 = F.tid & 63;
    float cw0[4], cw1[4];
#pragma unroll
    for (int k = 0; k < 4; ++k) { const f32x2 w = *(const f32x2*)(conv_w + k * DM + cb * 128 + 2 * cp2); cw0[k] = w[0]; cw1[k] = w[1]; }
    const f32x2 cbias = *(const f32x2*)(conv_b + cb * 128 + 2 * cp2);
    const size_t rowb = (size_t)b * SEQ;
#if X_FP8
    constexpr int L_CW = 67584;
    for (int i = F.tid; i < 5 * 128; i += 512) { const int k = i >> 7, c = i & 127; ((LAS float*)(lds + L_CW))[i] = (k < 4) ? conv_w[k * DM + cb * 128 + c] : conv_b[cb * 128 + c]; }
    const int c8 = F.tid & 7, rr_ = F.tid >> 3;
    v4u px[4], pg[2];
#define LRU_PREFETCH(t0_) do { \
        _Pragma("unroll") for (int k = 0; k < 4; ++k) { const int tok = (t0_) - 3 + rr_ + k; px[k] = (v4u){0u, 0u, 0u, 0u}; \
            if (tok >= 0) px[k] = *(const v4u*)((const unsigned char*)XB + (rowb + tok) * DM + cb * 128 + c8 * 16); } \
        _Pragma("unroll") for (int i = 0; i < 2; ++i) { const int idx = F.tid + 512 * i; const int ri = idx >> 4, chn = idx & 15; pg[i] = *(const v4u*)(GY + (rowb + (t0_) + ri) * DM + cb * 128 + chn * 8); } } while (0)
    LRU_PREFETCH(0);
    float carry = 0.f;
    __syncthreads();
    for (int it = 0; it < SEQ / 64; ++it) {
        const int t0 = it * 64;
        {
            f32x4 ac[4];
#pragma unroll
            for (int q = 0; q < 4; ++q) ac[q] = *(const LAS f32x4*)(lds + L_CW + 4 * 512 + c8 * 64 + q * 16);
#pragma unroll
            for (int k = 0; k < 4; ++k) {
                const unsigned wsrc[4] = {px[k].x, px[k].y, px[k].z, px[k].w};
#pragma unroll
                for (int q = 0; q < 4; ++q) { const f32x4 wk = *(const LAS f32x4*)(lds + L_CW + k * 512 + c8 * 64 + q * 16);
                    const f32x2 lo = __builtin_amdgcn_cvt_pk_f32_fp8((int)wsrc[q], false), hi2 = __builtin_amdgcn_cvt_pk_f32_fp8((int)wsrc[q], true);
                    ac[q][0] += wk[0] * lo[0]; ac[q][1] += wk[1] * lo[1]; ac[q][2] += wk[2] * hi2[0]; ac[q][3] += wk[3] * hi2[1]; }
            }
            *(LAS v4u*)(lds + L_XC + rr_ * 272 + c8 * 32) = (v4u){pk2(ac[0][0], ac[0][1]), pk2(ac[0][2], ac[0][3]), pk2(ac[1][0], ac[1][1]), pk2(ac[1][2], ac[1][3])};
            *(LAS v4u*)(lds + L_XC + rr_ * 272 + c8 * 32 + 16) = (v4u){pk2(ac[2][0], ac[2][1]), pk2(ac[2][2], ac[2][3]), pk2(ac[3][0], ac[3][1]), pk2(ac[3][2], ac[3][3])};
        }
#pragma unroll
        for (int i = 0; i < 2; ++i) { const int idx = F.tid + 512 * i; *(LAS v4u*)(lds + L_GY + idx * 16) = pg[i]; }
        __syncthreads();
        if (it + 1 < SEQ / 64) LRU_PREFETCH(t0 + 64);
#else
    v4u px[3], pg[2];
#define LRU_PREFETCH(t0_) do { \
        _Pragma("unroll") for (int i = 0; i < (X_FP8 ? 2 : 3); ++i) { const int idx = F.tid + 512 * i; px[i] = (v4u){0u, 0u, 0u, 0u}; \
            if (X_FP8) { if (idx < 67 * 8) { const int ri = idx >> 3, chn = idx & 7, tok = (t0_) - 3 + ri; if (tok >= 0) px[i] = *(const v4u*)((const unsigned char*)XB + (rowb + tok) * DM + cb * 128 + chn * 16); } } \
            else if (idx < 67 * 16) { const int ri = idx >> 4, chn = idx & 15, tok = (t0_) - 3 + ri; if (tok >= 0) px[i] = *(const v4u*)(XB + (rowb + tok) * DM + cb * 128 + chn * 8); } } \
        _Pragma("unroll") for (int i = 0; i < 2; ++i) { const int idx = F.tid + 512 * i; const int ri = idx >> 4, chn = idx & 15; pg[i] = *(const v4u*)(GY + (rowb + (t0_) + ri) * DM + cb * 128 + chn * 8); } } while (0)
    LRU_PREFETCH(0);
    float carry = 0.f;
    for (int it = 0; it < SEQ / 64; ++it) {
        const int t0 = it * 64;
#pragma unroll
#if X_FP8
        for (int i = 0; i < 2; ++i) { const int idx = F.tid + 512 * i; if (idx < 67 * 8) {
            const f32x2 c0 = __builtin_amdgcn_cvt_pk_f32_fp8((int)px[i].x, false), c1 = __builtin_amdgcn_cvt_pk_f32_fp8((int)px[i].x, true), c2 = __builtin_amdgcn_cvt_pk_f32_fp8((int)px[i].y, false), c3 = __builtin_amdgcn_cvt_pk_f32_fp8((int)px[i].y, true);
            const f32x2 c4 = __builtin_amdgcn_cvt_pk_f32_fp8((int)px[i].z, false), c5 = __builtin_amdgcn_cvt_pk_f32_fp8((int)px[i].z, true), c6 = __builtin_amdgcn_cvt_pk_f32_fp8((int)px[i].w, false), c7 = __builtin_amdgcn_cvt_pk_f32_fp8((int)px[i].w, true);
            *(LAS v4u*)(lds + L_XR + idx * 32) = (v4u){pk2(c0[0], c0[1]), pk2(c1[0], c1[1]), pk2(c2[0], c2[1]), pk2(c3[0], c3[1])};
            *(LAS v4u*)(lds + L_XR + idx * 32 + 16) = (v4u){pk2(c4[0], c4[1]), pk2(c5[0], c5[1]), pk2(c6[0], c6[1]), pk2(c7[0], c7[1])}; } }
#else
        for (int i = 0; i < 3; ++i) { const int idx = F.tid + 512 * i; if (idx < 67 * 16) *(LAS v4u*)(lds + L_XR + idx * 16) = px[i]; }
#endif
#pragma unroll
        for (int i = 0; i < 2; ++i) { const int idx = F.tid + 512 * i; *(LAS v4u*)(lds + L_GY + idx * 16) = pg[i]; }
        __syncthreads();
        if (it + 1 < SEQ / 64) LRU_PREFETCH(t0 + 64);
        {
            float x0[11], x1[11];
#pragma unroll
            for (int j = 0; j < 11; ++j) { const unsigned xin = *(const LAS unsigned*)(lds + L_XR + (8 * wv + j) * 256 + cp2 * 4); x0[j] = bflo(xin); x1[j] = bfhi(xin); }
#pragma unroll
            for (int o = 0; o < 8; ++o) {
                const float y0 = cbias[0] + (cw0[0] * x0[o] + cw0[1] * x0[o + 1]) + (cw0[2] * x0[o + 2] + cw0[3] * x0[o + 3]);
                const float y1 = cbias[1] + (cw1[0] * x1[o] + cw1[1] * x1[o + 1]) + (cw1[2] * x1[o + 2] + cw1[3] * x1[o + 3]);
                *(LAS unsigned*)(lds + L_XC + (8 * wv + o) * 272 + cp2 * 4) = pk2(y0, y1);
            }
        }
        __syncthreads();
#endif
        float av[4][4], bv[4][4], gy[4][4], Ae[4], Be[4], At[4], Bt[4];
        unsigned short xcr[4][4], gyr[4][4];
#pragma unroll
        for (int m = 0; m < 4; ++m)
#pragma unroll
            for (int r = 0; r < 4; ++r) { const int tk = 16 * m + 4 * g4 + r; xcr[m][r] = *(const LAS bf16*)(lds + L_XC + tk * 272 + cl_ * 2); gyr[m][r] = *(const LAS bf16*)(lds + L_GY + tk * 256 + cl_ * 2); }
        asm volatile("" ::: "memory");
#pragma unroll
        for (int m = 0; m < 4; ++m) {
            f32x4 aR = {0.f, 0.f, 0.f, 0.f}, aI = {0.f, 0.f, 0.f, 0.f};
#pragma unroll
            for (int ks = 0; ks < 4; ++ks) { const bf16x8 af = *(const LAS bf16x8*)(lds + L_XC + (16 * m + l15) * 272 + (32 * ks + 8 * g4) * 2);
                aR = __builtin_amdgcn_mfma_f32_16x16x32_bf16(af, brg[ks], aR, 0, 0, 0); aI = __builtin_amdgcn_mfma_f32_16x16x32_bf16(af, big[ks], aI, 0, 0, 0); }
            float A = 1.f, B = 0.f;
#pragma unroll
            for (int r = 0; r < 4; ++r) {
                const float xcv = bf2f(xcr[m][r]);
                gy[m][r] = bf2f(gyr[m][r]);
                const float rr = fast_rcp(1.0f + fast_exp2(__builtin_fmaf(aR[r], -1.4426950408889634f, rb2))), ii = fast_rcp(1.0f + fast_exp2(__builtin_fmaf(aI[r], -1.4426950408889634f, ib2)));
                const float a = fast_exp2(cl2 * rr);
                const float mult = __builtin_amdgcn_sqrtf(__builtin_fmaf(-a, a, 1.0f));
                av[m][r] = a; bv[m][r] = mult * ii * xcv;
                B = a * B + bv[m][r]; A = A * a;
            }
            { const float Ap = __shfl_up(A, 16), Bp = __shfl_up(B, 16); if (g4 >= 1) { B = A * Bp + B; A = A * Ap; } }
            { const float Ap = __shfl_up(A, 32), Bp = __shfl_up(B, 32); if (g4 >= 2) { B = A * Bp + B; A = A * Ap; } }
            { const float Ap = __shfl_up(A, 16), Bp = __shfl_up(B, 16); Ae[m] = (g4 == 0) ? 1.f : Ap; Be[m] = (g4 == 0) ? 0.f : Bp; }
            At[m] = __shfl(A, 48 + l15); Bt[m] = __shfl(B, 48 + l15);
        }
#pragma unroll
        for (int m = 0; m < 4; ++m) {
            float hcur = Ae[m] * carry + Be[m];
            carry = At[m] * carry + Bt[m];
#pragma unroll
            for (int r = 0; r < 4; ++r) { hcur = av[m][r] * hcur + bv[m][r]; const int tk = 16 * m + 4 * g4 + r;
                *(LAS bf16*)(lds + L_OUT + tk * 256 + cl_ * 2) = (bf16)(pk2(gy[m][r] * hcur, 0.f) & 0xffffu); }
        }
        __syncthreads();
#pragma unroll
        for (int i = 0; i < 2; ++i) { const int idx = F.tid + 512 * i; const int ri = idx >> 4, chn = idx & 15;
#if FP8_OUT
            *(v2u*)((unsigned char*)CAT2 + (rowb + t0 + ri) * DM + cb * 128 + chn * 8) = bf8x_to_fp8(*(const LAS v4u*)(lds + L_OUT + idx * 16)); }
#else
            *(v4u*)(CAT2 + (rowb + t0 + ri) * DM + cb * 128 + chn * 8) = *(const LAS v4u*)(lds + L_OUT + idx * 16); }
#endif
    }
    __syncthreads();
#undef LRU_PREFETCH
}

__device__ __forceinline__ void router_phase(Frame& F, const bf16* X, bf16* H, const float* ng, const float* modl, const float* rw, const float* rbias, int layer) {
    constexpr int WSTR = 2064;
    LAS unsigned char* whi = F.lds;
    LAS unsigned char* wlo = F.lds + 16 * WSTR;
    LAS float* gml = (LAS float*)(F.lds + 67584);
    LAS float* shl = (LAS float*)(F.lds + 71680);
    LAS float* brl = (LAS float*)(F.lds + 75776);
    LAS int* cnt = (LAS int*)(F.lds + 75776 + 64);
    LAS float* pbr = (LAS float*)(F.lds + 75776 + 128);
    LAS float* exl = (LAS float*)(F.lds + 78848);
    LAS float* exs = (LAS float*)(F.lds + 78848 + 16384);
    LAS float* lgl = (LAS float*)(F.lds + 97280);
    const int w = F.bx, b = w >> 3;
    { const v4u* img = (const v4u*)(F.ws + META_WRIMG);
      for (int i = F.tid; i < 2 * 16 * WSTR / 16; i += 512) *(LAS v4u*)(whi + i * 16) = img[i]; }
    for (int k = F.tid; k < 1024; k += 512) { gml[k] = ng[k] * (1.0f + modl[(size_t)b * 6144 + 4 * 1024 + k]); shl[k] = modl[(size_t)b * 6144 + 3 * 1024 + k]; }
    if (F.tid < 16) cnt[F.tid] = 0;
    __syncthreads();
    {
        const int e = F.tid & 15, part = F.tid >> 4; float t = 0.f;
#pragma unroll 8
        for (int kk = 0; kk < 32; ++kk) { const int k = 32 * part + kk; t += shl[k] * rw[k * 16 + e]; }
        pbr[part * 16 + e] = t;
    }
    __syncthreads();
    if (F.tid < 16) { float t = 0.f;
#pragma unroll
        for (int q = 0; q < 32; ++q) t += pbr[q * 16 + F.tid]; brl[F.tid] = t; }
    __syncthreads();
    const int r16 = F.lane & 15, kq = F.lane >> 4, g = F.wave >> 2, kp = F.wave & 3;
    float* GATE = (float*)(F.ws + META_GATE);
    v4u xn[8];
    { const size_t row0 = (size_t)w * 256 + 16 * g + r16;
#pragma unroll
      for (int cc = 0; cc < 8; ++cc) { const int col = 256 * kp + 32 * cc + 8 * kq; xn[cc] = *(const v4u*)(X + row0 * DM + col); } }
    for (int pass = 0; pass < 8; ++pass) {
        const int buf = pass & 1;
        const size_t row = (size_t)w * 256 + 32 * pass + 16 * g + r16;
        f32x4 xg[8][2]; float ss = 0.f; f32x4 acc = {0.f, 0.f, 0.f, 0.f};
#pragma unroll
        for (int cc = 0; cc < 8; ++cc) {
            const int col = 256 * kp + 32 * cc + 8 * kq;
            const f32x4 x0 = {bflo(xn[cc].x), bfhi(xn[cc].x), bflo(xn[cc].y), bfhi(xn[cc].y)}, x1 = {bflo(xn[cc].z), bfhi(xn[cc].z), bflo(xn[cc].w), bfhi(xn[cc].w)};
            ss += (x0[0] * x0[0] + x0[1] * x0[1]) + (x0[2] * x0[2] + x0[3] * x0[3]) + (x1[0] * x1[0] + x1[1] * x1[1]) + (x1[2] * x1[2] + x1[3] * x1[3]);
            const f32x4 a0 = x0 * *(const LAS f32x4*)(gml + col), a1 = x1 * *(const LAS f32x4*)(gml + col + 4);
            xg[cc][0] = a0; xg[cc][1] = a1;
            v4u hi; hi.x = pk2(a0[0], a0[1]); hi.y = pk2(a0[2], a0[3]); hi.z = pk2(a1[0], a1[1]); hi.w = pk2(a1[2], a1[3]);
            v4u lo; lo.x = pk2(a0[0] - bflo(hi.x), a0[1] - bfhi(hi.x)); lo.y = pk2(a0[2] - bflo(hi.y), a0[3] - bfhi(hi.y)); lo.z = pk2(a1[0] - bflo(hi.z), a1[1] - bfhi(hi.z)); lo.w = pk2(a1[2] - bflo(hi.w), a1[3] - bfhi(hi.w));
            const bf16x8 bh = *(const LAS bf16x8*)(whi + r16 * WSTR + col * 2), bl = *(const LAS bf16x8*)(wlo + r16 * WSTR + col * 2);
            acc = __builtin_amdgcn_mfma_f32_16x16x32_bf16(__builtin_bit_cast(bf16x8, hi), bh, acc, 0, 0, 0);
            acc = __builtin_amdgcn_mfma_f32_16x16x32_bf16(__builtin_bit_cast(bf16x8, lo), bh, acc, 0, 0, 0);
            acc = __builtin_amdgcn_mfma_f32_16x16x32_bf16(__builtin_bit_cast(bf16x8, hi), bl, acc, 0, 0, 0);
        }
        {
            const size_t rown = pass < 7 ? row + 32 : row;
#pragma unroll
            for (int cc = 0; cc < 8; ++cc) { const int col = 256 * kp + 32 * cc + 8 * kq; xn[cc] = *(const v4u*)(X + rown * DM + col); }
        }
        ss += __shfl_xor(ss, 16); ss += __shfl_xor(ss, 32);
        { LAS float* ep = exl + (((buf * 2 + g) * 4 + kp) * 16) * 16;
#pragma unroll
          for (int rg = 0; rg < 4; ++rg) ep[(4 * kq + rg) * 16 + r16] = acc[rg];
          if (kq == 0) exs[((buf * 2 + g) * 4 + kp) * 16 + r16] = ss; }
        __syncthreads();
        float sst = 0.f;
#pragma unroll
        for (int q = 0; q < 4; ++q) sst += exs[((buf * 2 + g) * 4 + q) * 16 + r16];
        const float rstd = 1.0f / sqrtf(sst * (1.0f / DM) + EPS);
#pragma unroll
        for (int cc = 0; cc < 8; ++cc) { const int col = 256 * kp + 32 * cc + 8 * kq;
            const f32x4 o0 = xg[cc][0] * rstd + *(const LAS f32x4*)(shl + col), o1 = xg[cc][1] * rstd + *(const LAS f32x4*)(shl + col + 4);
            v2u pw; pw.x = pk4_fp8(o0[0], o0[1], o0[2], o0[3]); pw.y = pk4_fp8(o1[0], o1[1], o1[2], o1[3]);
            *(v2u*)((unsigned char*)H + row * DM + col) = pw; }
        if (kp == 0 && kq == 0) {
            const int rl = 32 * pass + 16 * g + r16;
#pragma unroll
            for (int e4 = 0; e4 < 4; ++e4) { f32x4 t = {0.f, 0.f, 0.f, 0.f};
#pragma unroll
                for (int q = 0; q < 4; ++q) t += *(const LAS f32x4*)(exl + ((((buf * 2 + g) * 4 + q) * 16) + r16) * 16 + 4 * e4);
                *(LAS f32x4*)(lgl + rl * 16 + 4 * e4) = t * rstd; }
        }
    }
    __syncthreads();
    int e1 = 0, e2 = 0, r1 = 0, r2 = 0;
    if (F.tid < 256) {
        const int rl = F.tid; const size_t row = (size_t)w * 256 + rl;
        float sc[16], bi[16];
#pragma unroll
        for (int e4 = 0; e4 < 4; ++e4) { const f32x4 t = *(const LAS f32x4*)(lgl + rl * 16 + 4 * e4);
#pragma unroll
            for (int i = 0; i < 4; ++i) { const int e = 4 * e4 + i; const float lg = t[i] + brl[e]; sc[e] = 1.0f / (1.0f + __expf(-lg)); bi[e] = sc[e] + rbias[e]; } }
        int gbest = 0; float gsb = -1e30f;
#pragma unroll
        for (int gg = 0; gg < 4; ++gg) {
            float m1 = bi[4 * gg], m2 = -1e30f;
#pragma unroll
            for (int i = 1; i < 4; ++i) { const float v = bi[4 * gg + i]; if (v > m1) { m2 = m1; m1 = v; } else if (v > m2) m2 = v; }
            const float gs = m1 + m2; if (gs > gsb) { gsb = gs; gbest = gg; }
        }
        float v4[4], s4[4];
#pragma unroll
        for (int i = 0; i < 4; ++i) { v4[i] = gbest == 0 ? bi[i] : gbest == 1 ? bi[4 + i] : gbest == 2 ? bi[8 + i] : bi[12 + i]; s4[i] = gbest == 0 ? sc[i] : gbest == 1 ? sc[4 + i] : gbest == 2 ? sc[8 + i] : sc[12 + i]; }
        int i1 = 0;
#pragma unroll
        for (int i = 1; i < 4; ++i) if (v4[i] > v4[i1]) i1 = i;
        int i2 = (i1 == 0) ? 1 : 0;
#pragma unroll
        for (int i = 0; i < 4; ++i) if (i != i1 && i != i2 && v4[i] > v4[i2]) i2 = i;
        const float se1 = i1 == 0 ? s4[0] : i1 == 1 ? s4[1] : i1 == 2 ? s4[2] : s4[3], se2 = i2 == 0 ? s4[0] : i2 == 1 ? s4[1] : i2 == 2 ? s4[2] : s4[3];
        e1 = 4 * gbest + i1; e2 = 4 * gbest + i2; const float inv = 1.0f / (se1 + se2);
        *(f32x2*)(GATE + row * 2) = (f32x2){se1 * inv, se2 * inv};
        r1 = atomicAdd((int*)&cnt[e1], 1); r2 = atomicAdd((int*)&cnt[e2], 1);
    }
    __syncthreads();
    LAS int* gbl = (LAS int*)pbr;
    if (F.tid < 16) gbl[F.tid] = (int)xb_add((unsigned*)(F.ws + WS_CTL) + CW_GCNT + layer * 64 + F.tid, (unsigned)cnt[F.tid]);
    __syncthreads();
    if (F.tid < 256) {
        const int row = w * 256 + F.tid; int* TOK2 = (int*)(F.ws + WS_TOK2);
        const int q1 = gbl[e1] + r1, q2 = gbl[e2] + r2;
        TOK2[e1 * pg8::TOKSTR + q1] = row; TOK2[e2 * pg8::TOKSTR + q2] = row;
        *(v2u*)((int*)(F.ws + META_SLOT) + (size_t)row * 2) = (v2u){(unsigned)(e1 << 20 | q1), (unsigned)(e2 << 20 | q2)};
    }
    __syncthreads();
}

__device__ __forceinline__ int moe_tables(Frame& F, int layer) {
    LAS int* te = (LAS int*)(F.lds + L_MOE); LAS int* tb = te + 544; LAS int* cl = tb + 32;
    const unsigned* GC = (const unsigned*)(F.ws + WS_CTL) + CW_GCNT + layer * 64;
    if (F.tid < 64) {
        const int c = F.tid < 16 ? (int)GC[F.tid] : 0, nt = (c + 255) >> 8; int incl = nt;
#pragma unroll
        for (int of = 1; of < 16; of <<= 1) { const int v = __shfl_up(incl, of); if (F.tid >= of) incl += v; }
        if (F.tid < 16) { tb[F.tid] = incl - nt; cl[F.tid] = c; }
        if (F.tid == 15) tb[16] = incl;
    }
    __syncthreads();
    const int ntl = tb[16];
    for (int tl = F.tid; tl < ntl; tl += 512) { int e = 0;
#pragma unroll
        for (int q = 1; q < 16; ++q) e += (tb[q] <= tl) ? 1 : 0;
        te[tl] = e; }
    __syncthreads();
    return ntl;
}

template <bool NEXT>
__device__ __forceinline__ void combine_phase(Frame& F, const bf16* X, void* XO, const bf16* Y, const float* modl  , bf16* H, const float* ng_next, const float* modn  , int layer) {
    (void)moe_tables(F, layer); const LAS int* tbl = (const LAS int*)(F.lds + L_MOE) + 544;
    const int gw = F.bx * NWAVES + F.wave, b = gw >> 6;
    const int* SLOT = (const int*)(F.ws + META_SLOT); const float* GATE = (const float*)(F.ws + META_GATE);
    f32x4 g2[4], gm[4], sh[4];
#pragma unroll
    for (int j = 0; j < 4; ++j) { const int k = 256 * j + 4 * F.lane; g2[j] = *(const f32x4*)(modl + (size_t)b * 6144 + 5 * 1024 + k);
        if (NEXT) { const f32x4 g = *(const f32x4*)(ng_next + k), s = *(const f32x4*)(modn + (size_t)b * 6144 + 1 * 1024 + k); gm[j] = g * (s + 1.0f); sh[j] = *(const f32x4*)(modn + (size_t)b * 6144 + k); } }
    const size_t rbase = (size_t)gw * 32;
    int ms0 = 0, ms1 = 0; float mg0 = 0.f, mg1 = 0.f;
    if (F.lane < 32) { const v2u sv = *(const v2u*)(SLOT + (rbase + F.lane) * 2); const f32x2 gv = *(const f32x2*)(GATE + (rbase + F.lane) * 2); ms0 = tbl[sv.x >> 20] * 256 + (int)(sv.x & 0xFFFFFu); ms1 = tbl[sv.y >> 20] * 256 + (int)(sv.y & 0xFFFFFu); mg0 = gv[0]; mg1 = gv[1]; }
    for (int r0 = 0; r0 < 32; r0 += 4) {
#if Y_FP8
        v2u x[4][4]; unsigned ya[4][4], yb[4][4]; float ga[4], gb[4];
#else
        v2u x[4][4]; v2u ya[4][4], yb[4][4]; float ga[4], gb[4];
#endif
#pragma unroll
        for (int q = 0; q < 4; ++q) {
            const int s0 = __builtin_amdgcn_readlane(ms0, r0 + q), s1 = __builtin_amdgcn_readlane(ms1, r0 + q);
            ga[q] = __builtin_bit_cast(float, __builtin_amdgcn_readlane(__builtin_bit_cast(int, mg0), r0 + q)); gb[q] = __builtin_bit_cast(float, __builtin_amdgcn_readlane(__builtin_bit_cast(int, mg1), r0 + q));
#pragma unroll
            for (int j = 0; j < 4; ++j) { const int k = 256 * j + 4 * F.lane;
                x[q][j] = *(const v2u*)(X + (rbase + r0 + q) * DM + k);
#if Y_FP8
                ya[q][j] = *(const unsigned*)((const unsigned char*)Y + ((size_t)((s0 >> 8) * 4 + j) * 256 + (s0 & 255)) * 256 + 4 * F.lane);
                yb[q][j] = *(const unsigned*)((const unsigned char*)Y + ((size_t)((s1 >> 8) * 4 + j) * 256 + (s1 & 255)) * 256 + 4 * F.lane); }
#else
                ya[q][j] = *(const v2u*)(Y + (size_t)s0 * DM + k); yb[q][j] = *(const v2u*)(Y + (size_t)s1 * DM + k); }
#endif
        }
        asm volatile("" ::: "memory");
#pragma unroll
        for (int q = 0; q < 4; ++q) {
            const size_t row = rbase + r0 + q; float ss = 0.f; f32x4 v[4];
#pragma unroll
            for (int j = 0; j < 4; ++j) { const int k = 256 * j + 4 * F.lane;
#if Y_FP8
                const f32x2 a01 = __builtin_amdgcn_cvt_pk_f32_fp8((int)ya[q][j], false), a23 = __builtin_amdgcn_cvt_pk_f32_fp8((int)ya[q][j], true), b01 = __builtin_amdgcn_cvt_pk_f32_fp8((int)yb[q][j], false), b23 = __builtin_amdgcn_cvt_pk_f32_fp8((int)yb[q][j], true);
                f32x4 f; f[0] = ga[q] * a01[0] + gb[q] * b01[0]; f[1] = ga[q] * a01[1] + gb[q] * b01[1]; f[2] = ga[q] * a23[0] + gb[q] * b23[0]; f[3] = ga[q] * a23[1] + gb[q] * b23[1];
#else
                f32x4 f; f[0] = ga[q] * bflo(ya[q][j].x) + gb[q] * bflo(yb[q][j].x); f[1] = ga[q] * bfhi(ya[q][j].x) + gb[q] * bfhi(yb[q][j].x); f[2] = ga[q] * bflo(ya[q][j].y) + gb[q] * bflo(yb[q][j].y); f[3] = ga[q] * bfhi(ya[q][j].y) + gb[q] * bfhi(yb[q][j].y);
#endif
                v[j] = (f32x4){bflo(x[q][j].x), bfhi(x[q][j].x), bflo(x[q][j].y), bfhi(x[q][j].y)} + g2[j] * f;
                if (NEXT) { v2u xw; xw.x = pk2(v[j][0], v[j][1]); xw.y = pk2(v[j][2], v[j][3]); *(v2u*)((bf16*)XO + row * DM + k) = xw; }
                else *(f32x4*)((float*)XO + row * DM + k) = v[j];
                ss += (v[j][0] * v[j][0] + v[j][1] * v[j][1]) + (v[j][2] * v[j][2] + v[j][3] * v[j][3]); }
            if (NEXT) {
                const float rstd = 1.0f / sqrtf(wave_sum(ss) * (1.0f / DM) + EPS);
#if I8_IN
                { float am = 0.f; f32x4 o[4];
#pragma unroll
                  for (int j = 0; j < 4; ++j) { o[j] = v[j] * rstd * gm[j] + sh[j]; am = __builtin_fmaxf(am, __builtin_fmaxf(__builtin_fmaxf(__builtin_fabsf(o[j][0]), __builtin_fabsf(o[j][1])), __builtin_fmaxf(__builtin_fabsf(o[j][2]), __builtin_fabsf(o[j][3])))); }
#pragma unroll
                  for (int of = 1; of < 64; of <<= 1) am = __builtin_fmaxf(am, __shfl_xor(am, of));
                  if (I8_FIXSCALE) am = 8.0f;
                  const float iv = am > 0.f ? 127.0f / am : 0.f;
                  if (F.lane == 0) ((float*)(F.ws + WS_SA))[row] = am > 0.f ? am * (1.0f / 127.0f) : 1.0f;
#pragma unroll
                  for (int j = 0; j < 4; ++j) *(unsigned*)((unsigned char*)H + row * DM + 256 * j + 4 * F.lane) = pk4_i8(o[j][0] * iv, o[j][1] * iv, o[j][2] * iv, o[j][3] * iv); }
                if (false)
#endif
#pragma unroll
                for (int j = 0; j < 4; ++j) { const f32x4 o = v[j] * rstd * gm[j] + sh[j];
#if FP8_IN1
                    *(unsigned*)((unsigned char*)H + row * DM + 256 * j + 4 * F.lane) = pk4_fp8(o[0], o[1], o[2], o[3]);
#else
                    v2u pw; pw.x = pk2(o[0], o[1]); pw.y = pk2(o[2], o[3]); *(v2u*)(H + row * DM + 256 * j + 4 * F.lane) = pw;
#endif
                }
            }
        }
    }
}

constexpr int NPHASE = 18;
struct Args { const float* in[28]; float* out; unsigned char* ws; int ph_lo, ph_hi; };
template <int PLO, int PHI> __global__ void __launch_bounds__(NWAVES * 64, 2) mk_fwd(Args args) {
    extern __shared__ __attribute__((aligned(16))) unsigned char lds_raw[];
    Frame F;
    F.lds = (LAS unsigned char*)lds_raw;
    F.tid = threadIdx.x; F.lane = F.tid & 63; F.wave = __builtin_amdgcn_readfirstlane(F.tid >> 6);
    F.G = gridDim.x; F.bx = blockIdx.x; F.vcu = (F.G % 8 == 0) ? (F.bx % 8) * (F.G / 8) + F.bx / 8 : F.bx;
    F.ws = args.ws;
    volatile LAS unsigned* MISC = (volatile LAS unsigned*)(F.lds + MISC_OFF);
    for (int u = F.tid; u < (LDS_BYTES - LDSCTL_OFF) / 4; u += NWAVES * 64) ((LAS unsigned*)(F.lds + LDSCTL_OFF))[u] = 0u;
    __syncthreads();
#if MK_ONE_LAUNCH
    XcdBarrier bar = xcd_barrier_post((unsigned*)(F.ws + WS_CTL) + CW_BAR, MISC + 8);
#define GRID_BAR() do { XcdBarrier b_ = bar; asm volatile("" : "+s"(b_.bar), "+s"(b_.x)); xcd_barrier(b_); } while (0)
#else
#define GRID_BAR() do {} while (0)
#endif
    constexpr int lo = PLO, hi = PHI;
#ifndef PHASE_MASK
#define PHASE_MASK 0x3ffff
#endif
#define IN(k) ((((PHASE_MASK) >> (k)) & 1) && lo <= (k) && (k) < hi)
#ifndef PROBE_REP
#define PROBE_REP 0
#endif
#ifndef PROBE_DRYB
#define PROBE_DRYB 0
#endif
#define REPN(k) (((PROBE_REP) >> (k)) & 1)
#define SEAM(k) do { if (IN(k) && IN((k) + 1)) GRID_BAR(); } while (0)
    typedef const __attribute__((address_space(4))) Args* KArgs; KArgs KA = (KArgs)__builtin_amdgcn_kernarg_segment_ptr();
#define in KA->in
#define PHASE_ENTER() do { KA = (KArgs)__builtin_amdgcn_kernarg_segment_ptr(); asm volatile("" : "+s"(KA)); F.ws = KA->ws; int tid_o = threadIdx.x; asm volatile("" : "+v"(tid_o)); F.tid = tid_o; F.lane = tid_o & 63; F.wave = __builtin_amdgcn_readfirstlane(tid_o >> 6); } while (0)
#define P_MOD ((float*)(F.ws + WS_MOD))
#define P_HA ((bf16*)(F.ws + WS_HA))
#define P_U0 ((bf16*)(F.ws + WS_R1))
#define P_Q (P_U0 + (size_t)T * 512)
#define P_K (P_U0 + (size_t)2 * T * 512)
#define P_V (P_U0 + (size_t)3 * T * 512)
#define P_GY ((bf16*)(F.ws + WS_R1))
#define P_XB (P_GY + (size_t)T * DM)
#define P_XS ((bf16*)(F.ws + WS_R1))
#define P_Y P_XS
#define P_CAT ((bf16*)(F.ws + WS_R2))
#define P_HID P_CAT
#define P_XBF ((bf16*)(F.ws + WS_XBF))

    if (IN(0)) for (int rep_ = 0; rep_ <= REPN(0); ++rep_) { PHASE_ENTER(); p0_prologue(F, KA); } SEAM(0);
    if (IN(1)) for (int rep_ = 0; rep_ <= REPN(1); ++rep_) { PHASE_ENTER(); norm_rows(F, in[0], P_HA, in[4], P_MOD, 0, 1024); } SEAM(1);
    if (IN(2)) for (int rep_ = 0; rep_ <= REPN(2); ++rep_) { PHASE_ENTER();
        pg8::Gemm g{P_HA, (const bf16*)(F.ws + WS_WEVIN), T, EVIN, (FP8_IN0 || I8_IN) ? DM / 2 : DM, 0}; pg8::StaticOrder S; S.init(T, EVIN, F.G, F.bx);
        { const f32x4* sbg = (const f32x4*)(F.ws + META_SBEVIN); for (int i = F.tid; i < EVIN / 4; i += NWAVES * 64) ((LAS f32x4*)(F.lds + L_MOE))[i] = sbg[i]; __syncthreads(); }
        pg8::EpiEvIn E{P_U0, P_Q, P_K, P_V, in[11], in[12], (const float*)(F.ws + WS_SA), (const LAS float*)(F.lds + L_MOE)};
        pg8::gemm_phase<pg8::EpiEvIn, pg8::StaticOrder, true, true, FP8_IN0 != 0, I8_IN != 0>(F.lds, g, S, E);
    } SEAM(2);
    if (IN(3)) for (int rep_ = 0; rep_ <= REPN(3); ++rep_) { PHASE_ENTER();
#ifndef NO_ATTN
        for (int ra_ = 0; ra_ <= REPN(18); ++ra_) { const int bh = F.vcu; for (int qb = 7; qb >= 0; --qb) sba::unit(bh >> 3, bh & 7, qb, P_Q, P_K, P_V, P_CAT, F.lds); }
#endif
#ifndef NO_CONV
        for (int rc_ = 0; rc_ <= REPN(19); ++rc_) conv_phase(F, P_U0, P_CAT, in[7], in[8], in[9], in[10]);
#endif
    } SEAM(3);
    if (IN(4)) for (int rep_ = 0; rep_ <= REPN(4); ++rep_) { PHASE_ENTER();
        pg8::Gemm g{P_CAT, (const bf16*)(F.ws + WS_WEVOUT), T, DM, FP8_OUT ? DM / 2 : DM, 0}; pg8::StaticOrder S; S.init(T, DM, F.G, F.bx);
        pg8::EpiResid<true> E{in[0], P_XBF, P_MOD + 2 * 1024, FP8_OUT ? 1.0f / 32.0f : 1.0f};
        pg8::gemm_phase<pg8::EpiResid<true>, pg8::StaticOrder, true, true, FP8_OUT != 0>(F.lds, g, S, E, STAG_OUT);
    } SEAM(4);
#define MOE_PHASES(layer, p0) \
    if (IN(p0)) for (int rep_ = 0; rep_ <= REPN(p0); ++rep_) { PHASE_ENTER(); router_phase(F, P_XBF, P_HA, in[5] + (layer) * DM, P_MOD + (size_t)(layer) * 32 * 6144, in[23], in[24], layer); } \
    do { if (IN(p0) && IN((p0) + 2)) GRID_BAR(); } while (0);     \
    if (IN((p0) + 2)) for (int rep_ = 0; rep_ <= REPN((p0) + 2); ++rep_) { PHASE_ENTER(); \
        const int ntl = moe_tables(F, layer); const LAS int* te_ = (const LAS int*)(F.lds + L_MOE); \
        pg8::Gemm g{P_HA, (const bf16*)(F.ws + WS_W13 + (size_t)(layer) * 16 * 1024 * 1024), ntl * 256, 1024, DM / 2, (size_t)1024 * 1024}; \
        pg8::MoeGatherOrder S; S.base.init(ntl * 256, 1024, F.G, F.bx); S.te = te_; S.tb = te_ + 544; S.cl = te_ + 576; S.tok = (const int*)(F.ws + WS_TOK2); \
        pg8::EpiMoeA E{P_HID, PROBE_DRYB && rep_ < REPN((p0) + 2)}; \
        pg8::gemm_phase<pg8::EpiMoeA, pg8::MoeGatherOrder, true, true, true>(F.lds, g, S, E, STAG_MOE); \
    } SEAM((p0) + 2); \
    if (IN((p0) + 3)) for (int rep_ = 0; rep_ <= REPN((p0) + 3); ++rep_) { PHASE_ENTER(); \
        const int ntl = moe_tables(F, layer); const LAS int* te_ = (const LAS int*)(F.lds + L_MOE); \
        pg8::Gemm g{P_HID, (const bf16*)(F.ws + WS_W2 + (size_t)(layer) * 16 * 1024 * 512), ntl * 256, 1024, DFF / 2, (size_t)1024 * 512}; \
        pg8::MoeOrder S; S.base.init(ntl * 256, 1024, F.G, F.bx); S.te = te_; S.tb = te_ + 544; S.cl = te_ + 576; S.tok = nullptr; \
        pg8::EpiMoeB E{P_Y, PROBE_DRYB && rep_ < REPN((p0) + 3)}; \
        pg8::gemm_phase<pg8::EpiMoeB, pg8::MoeOrder, true, true, true>(F.lds, g, S, E, STAG_MOE); \
    } SEAM((p0) + 3);

    MOE_PHASES(0, 5)
    if (IN(9)) for (int rep_ = 0; rep_ <= REPN(9); ++rep_) { PHASE_ENTER(); const bool dry = rep_ < REPN(9); combine_phase<true>(F, P_XBF, dry ? (void*)(F.ws + WS_DRY) : (void*)P_XBF, P_Y, P_MOD, dry ? P_HID : P_HA, in[4] + DM, P_MOD + (size_t)32 * 6144, 0); } SEAM(9);
    if (IN(10)) for (int rep_ = 0; rep_ <= REPN(10); ++rep_) { PHASE_ENTER();
        pg8::Gemm g{P_HA, (const bf16*)(F.ws + WS_WODIN), T, 2048, (FP8_IN1 || I8_IN) ? DM / 2 : DM, 0}; pg8::StaticOrder S; S.init(T, 2048, F.G, F.bx);
        { const f32x4* sbg = (const f32x4*)(F.ws + META_SBODIN); for (int i = F.tid; i < 2048 / 4; i += NWAVES * 64) ((LAS f32x4*)(F.lds + L_MOE))[i] = sbg[i]; __syncthreads(); }
        pg8::EpiOdIn E{P_GY, P_XB, (const float*)(F.ws + WS_SA), (const LAS float*)(F.lds + L_MOE)};
        pg8::gemm_phase<pg8::EpiOdIn, pg8::StaticOrder, true, true, FP8_IN1 != 0, I8_IN != 0>(F.lds, g, S, E);
    } SEAM(10);
    if (IN(11)) for (int rep_ = 0; rep_ <= REPN(11); ++rep_) { PHASE_ENTER(); const int u = F.vcu; lru_unit(F, u >> 3, u & 7, P_GY, P_XB, P_CAT, (const bf16*)(F.ws + WS_WRG), (const bf16*)(F.ws + WS_WIG), in[15], in[16], in[18], in[20], in[21]); } SEAM(11);
    if (IN(12)) for (int rep_ = 0; rep_ <= REPN(12); ++rep_) { PHASE_ENTER();
        pg8::Gemm g{P_CAT, (const bf16*)(F.ws + WS_WODOUT), T, DM, FP8_OUT ? DM / 2 : DM, 0}; pg8::StaticOrder S; S.init(T, DM, F.G, F.bx);
        pg8::EpiResid<false> E{P_XBF, P_XBF, P_MOD + (size_t)32 * 6144 + 2 * 1024, FP8_OUT ? 1.0f / 32.0f : 1.0f};
        pg8::gemm_phase<pg8::EpiResid<false>, pg8::StaticOrder, true, true, FP8_OUT != 0>(F.lds, g, S, E, STAG_OUT);
    } SEAM(12);
    MOE_PHASES(1, 13)
    if (IN(17)) for (int rep_ = 0; rep_ <= REPN(17); ++rep_) { PHASE_ENTER(); const bool dry = rep_ < REPN(17); combine_phase<false>(F, P_XBF, dry ? (void*)(F.ws + WS_DRY) : (void*)KA->out, P_Y, P_MOD + (size_t)32 * 6144, P_HA, nullptr, nullptr, 1); }
#undef MOE_PHASES
#undef in
#undef IN
#undef SEAM
}

#if !MK_ONE_LAUNCH
template <int P> static void set_attr_all() { if constexpr (P < NPHASE) { (void)hipFuncSetAttribute((const void*)mk_fwd<P, P + 1>, hipFuncAttributeMaxDynamicSharedMemorySize, LDS_BYTES); set_attr_all<P + 1>(); } }
template <int P> static void launch_all(Args a, int grid, hipStream_t stream) { if constexpr (P < NPHASE) { a.ph_lo = P; a.ph_hi = P + 1; hipLaunchKernelGGL((mk_fwd<P, P + 1>), dim3(grid), dim3(NWAVES * 64), LDS_BYTES, stream, a); launch_all<P + 1>(a, grid, stream); } }
#endif

extern "C" void kernel_launch(void* const* d_in, const int* in_sizes, int n_in, void* d_out, int out_size, void* d_ws, size_t ws_size, hipStream_t stream) {
    static int grid = 0;
    if (grid == 0) {
        if (n_in != 28 || in_sizes[0] != T * DM || out_size != T * DM || ws_size < WS_END + (size_t)T * DM * 4) { fprintf(stderr, "kernel_launch: unexpected shapes (n_in %d, in0 %d, out %d, ws %zu); nothing launched\n", n_in, n_in > 0 ? in_sizes[0] : -1, out_size, ws_size); grid = -1; return; }
        int dev = 0, cus = 0;
        if (hipGetDevice(&dev) != hipSuccess || hipDeviceGetAttribute(&cus, hipDeviceAttributeMultiprocessorCount, dev) != hipSuccess) { grid = -1; return; }
#if MK_ONE_LAUNCH
        if (hipFuncSetAttribute((const void*)mk_fwd<0, NPHASE>, hipFuncAttributeMaxDynamicSharedMemorySize, LDS_BYTES) != hipSuccess) { fprintf(stderr, "kernel_launch: hipFuncSetAttribute failed\n"); grid = -1; return; }
        int per_cu = 0;
        if (hipOccupancyMaxActiveBlocksPerMultiprocessor(&per_cu, (const void*)mk_fwd<0, NPHASE>, NWAVES * 64, LDS_BYTES) != hipSuccess || per_cu < 1) fprintf(stderr, "kernel_launch: occupancy query reports %d\n", per_cu);
#else
        set_attr_all<0>();
#endif
        (void)hipGetLastError();
        grid = cus;
        if (grid != 256) { fprintf(stderr, "kernel_launch: built for 256 CUs, device has %d; nothing launched\n", cus); grid = -1; return; }
    }
    if (grid < 0) return;
    (void)hipMemsetAsync((char*)d_ws + WS_CTL, 0, CTL_ZERO_BYTES, stream);
    Args a{};
    for (int i = 0; i < 28; ++i) a.in[i] = (const float*)d_in[i];
    a.out = (float*)d_out; a.ws = (unsigned char*)d_ws;
#if MK_ONE_LAUNCH
    a.ph_lo = 0; a.ph_hi = NPHASE;
    hipLaunchKernelGGL((mk_fwd<0, NPHASE>), dim3(grid), dim3(NWAVES * 64), LDS_BYTES, stream, a);
#else
    launch_all<0>(a, grid, stream);
#endif
}
```

```cpp
#include <hip/hip_runtime.h>
#include <cstdio>
#include <cstdint>

#ifndef MK_ONE_LAUNCH
#define MK_ONE_LAUNCH 1
#endif
#ifndef STAG_MOE
#define STAG_MOE 0
#endif
#ifndef STAG_OUT
#define STAG_OUT 0
#endif
#ifndef FP8_OUT
#define FP8_OUT 1
#endif
#ifndef U_FP8
#define U_FP8 1
#endif
#ifndef X_FP8
#define X_FP8 1
#endif
#ifndef Y_FP8
#define Y_FP8 1
#endif
#ifndef I8_FIXSCALE
#define I8_FIXSCALE 0
#endif
#ifndef I8_IN
#define I8_IN 1
#endif
#ifndef FP8_IN0
#define FP8_IN0 (I8_IN ? 0 : 1)
#endif
#ifndef FP8_IN1
#define FP8_IN1 (I8_IN ? 0 : 1)
#endif

namespace pg8 {
#define PG8_LAS __attribute__((address_space(3)))
typedef unsigned short bf16_t;
typedef short bf16x8 __attribute__((ext_vector_type(8)));
typedef float f32x4 __attribute__((ext_vector_type(4)));
typedef float v2f_ __attribute__((ext_vector_type(2)));
typedef unsigned u32x4 __attribute__((ext_vector_type(4)));
constexpr int BM = 256, BK = 64, HALF = 128, HTB = HALF * BK * 2  , STAGE_BYTES = 8 * HTB, NXCD = 8, WGM = 8;

__host__ __device__ __forceinline__ int lds_byte(int r, int c) { const int st = (r >> 4) * 2 + (c >> 5), rr = r & 15, cc = c & 31, ob = rr * 64 + cc * 2; return st * 1024 + (ob ^ (((ob >> 9) & 1) << 5)); }
__host__ __device__ __forceinline__ void stage_rc(int b, int& R, int& C) { const int st = b / 1024, sb = b % 1024, swz = sb ^ (((sb >> 9) & 1) << 5); R = (st >> 1) * 16 + swz / 64; C = (st & 1) * 32 + (swz % 64) / 2; }
__host__ __device__ __forceinline__ int perm32(int rho) { const int n = rho >> 4, i = rho & 15; return 8 * (i >> 2) + 4 * n + (i & 3); }

struct Unit { int pm, pn, pb, tk0, nv; };
struct Gemm { const bf16_t* A; const bf16_t* Bt; int M, N, K; size_t bstride; };

struct StaticOrder {
    static constexpr bool GATHER = false, LAZY_PB = false, A_BLK = false; const int* tok;
    int nM, nN, nwg, G, c;
    __host__ __device__ void init(int M, int N, int G_, int c_) { nM = M / BM; nN = N / BM; nwg = nM * nN; G = G_; c = c_; }
    __host__ __device__ bool next(int i, Unit& u) const {
        const long L = (long)i * G + c; if (L >= nwg) return false;
        int wgid = (int)L; { const int q = nwg / NXCD, r = nwg % NXCD, xcd = wgid % NXCD, off = wgid / NXCD; wgid = (xcd < r ? xcd * (q + 1) : r * (q + 1) + (xcd - r) * q) + off; }
        const int nig = WGM * nN, gid = wgid / nig, fm = gid * WGM, gsz = (nM - fm) < WGM ? (nM - fm) : WGM;
        u.pm = fm + ((wgid % nig) % gsz); u.pn = (wgid % nig) / gsz; u.pb = 0; return true;
    }
    __device__ __forceinline__ void a_ready(const Unit&) const {}
    __device__ __forceinline__ void done(const Unit&) const {}
};

template <class Epi, class Sched, bool ALIGN_EPI = false, bool SP2 = false, bool FP8 = false, bool I8 = false>
__device__ __forceinline__ void gemm_phase(PG8_LAS unsigned char* lds, const Gemm g, const Sched& S, const Epi& E, int stagger_ticks = 0) {
    if (stagger_ticks) { const unsigned long long t_end = __builtin_amdgcn_s_memrealtime() + (unsigned long long)(((blockIdx.x >> 3) & 3) * stagger_ticks);
        while (__builtin_amdgcn_s_memrealtime() < t_end) __builtin_amdgcn_s_sleep(8); }
    int tid_ = threadIdx.x; asm volatile("" : "+v"(tid_));
    const int tid = tid_, wid = __builtin_amdgcn_readfirstlane(tid >> 6), lane = tid & 63, wr = wid >> 2, wc = wid & 3, fr = lane & 15, fq = lane >> 4;
    int K_ = g.K; asm volatile("" : "+s"(K_));
    const int K = K_, nt = K / BK;
    unsigned voffA[2], voffB[2];
#pragma unroll
    for (int i = 0; i < 2; ++i) { int R, C; stage_rc(tid * 16 + i * 8192, R, C); const int Rb = Epi::PERM ? ((R & ~31) + perm32(R & 31)) : R;
        voffA[i] = (unsigned)(R * K + C) * 2u; voffB[i] = (unsigned)(Rb * K + C) * 2u;
        if constexpr (Sched::A_BLK) {
            const int b_ = tid * 16 + i * 8192, q_ = b_ >> 12, r_ = (b_ & 4095) >> 5, s_ = (b_ >> 4) & 1;
            voffA[i] = (unsigned)(q_ * 8192 + r_ * 32 + ((s_ ^ (q_ & 1)) * 16)); } }
    unsigned cvo[2][2], nvo[2][2]; int rowA[2]; unsigned colA[2];
#pragma unroll
    for (int i = 0; i < 2; ++i) { int R, C; stage_rc(tid * 16 + i * 8192, R, C); rowA[i] = R; colA[i] = (unsigned)C * 2u; }
    int ntk[2][2];
#define PG8_LOADTK(u_, tk_) do { const int* _p00 = S.tok + (u_).tk0 + rowA[0]; const int* _p01 = S.tok + (u_).tk0 + rowA[1]; const int* _p10 = _p00 + HALF; const int* _p11 = _p01 + HALF; \
        asm volatile("global_load_dword %0, %4, off\n\tglobal_load_dword %1, %5, off\n\tglobal_load_dword %2, %6, off\n\tglobal_load_dword %3, %7, off" \
            : "=&v"(tk_[0][0]), "=&v"(tk_[0][1]), "=&v"(tk_[1][0]), "=&v"(tk_[1][1]) : "v"(_p00), "v"(_p01), "v"(_p10), "v"(_p11) : "memory"); } while (0)
#define PG8_TK2VO(tk_, vo_, nv_) do { _Pragma("unroll") for (int _h = 0; _h < 2; ++_h) _Pragma("unroll") for (int _i = 0; _i < 2; ++_i) \
        vo_[_h][_i] = (unsigned)((rowA[_i] + _h * HALF < (nv_)) ? tk_[_h][_i] : 0) * (unsigned)(K * 2) + colA[_i]; } while (0)
    const size_t kstep = (size_t)(BK * 2);
    const size_t hstep = (size_t)HALF * K * 2;
    const size_t tstep = 2 * hstep;
    const size_t kstepA = Sched::A_BLK ? (size_t)32768 : kstep, hstepA = Sched::A_BLK ? (size_t)4096 : hstep;
    const unsigned ldsw = (unsigned)wid * 1024u;
    constexpr int PSTR = 1024;
    const int aoff = lds_byte(wr * 64 + fr, fq * 8);
    const int boff = lds_byte(wc * 32 + fr, fq * 8);
#define PG8_SA(b, h) (((b) * 2 + (h)) * HTB)
#define PG8_SB(b, h) ((4 + (b) * 2 + (h)) * HTB)
#define PG8_STAGE(bufoff, gbase, voff) do { _Pragma("unroll") for (int _i = 0; _i < 2; ++_i) \
        __builtin_amdgcn_global_load_lds((const unsigned*)((const char*)(gbase) + (voff)[_i]), (PG8_LAS unsigned*)(lds + (bufoff) + ldsw + _i * 8192), 16, 0, 0); } while (0)
#define PG8_STAGE_A(bufoff, gbase, h, nx) do { if constexpr (Sched::GATHER) { _Pragma("unroll") for (int _i = 0; _i < 2; ++_i) { const unsigned _vo = (nx) ? nvo[h][_i] : cvo[h][_i]; \
        __builtin_amdgcn_global_load_lds((const unsigned*)((const char*)(gbase) + _vo), (PG8_LAS unsigned*)(lds + (bufoff) + ldsw + _i * 8192), 16, 0, 0); } } \
        else { PG8_STAGE(bufoff, (gbase) + (h) * hstepA, voffA); } } while (0)
    const PG8_LAS unsigned char* const ldsA = lds + aoff;
    const PG8_LAS unsigned char* const ldsA0 = lds + fq * 4096 + (wr * 64 + fr) * 32 + (fq & 1) * 16;
    const PG8_LAS unsigned char* const ldsA1 = lds + fq * 4096 + (wr * 64 + fr) * 32 + ((fq & 1) ^ 1) * 16;
    const PG8_LAS unsigned char* const ldsB = lds + 4 * HTB + boff;
#define PG8_LD32(p_) __builtin_shufflevector(*(const PG8_LAS v4i_*)(p_), *(const PG8_LAS v4i_*)((p_) + PSTR), 0, 1, 2, 3, 4, 5, 6, 7)
#define PG8_LDA(dst, b, h) do { if constexpr (FP8 && Sched::A_BLK) { _Pragma("unroll") for (int m = 0; m < 4; ++m) \
            dst##8[m] = __builtin_shufflevector(*(const PG8_LAS v4i_*)(ldsA0 + PG8_SA(b, h) + m * 512), *(const PG8_LAS v4i_*)(ldsA1 + PG8_SA(b, h) + m * 512), 0, 1, 2, 3, 4, 5, 6, 7); } \
    else if constexpr (FP8) { _Pragma("unroll") for (int m = 0; m < 4; ++m) dst##8[m] = PG8_LD32(ldsA + PG8_SA(b, h) + m * 2048); } \
    else { _Pragma("unroll") for (int m = 0; m < 4; ++m) _Pragma("unroll") for (int k = 0; k < 2; ++k) dst[m][k] = *(const PG8_LAS bf16x8*)(ldsA + PG8_SA(b, h) + m * 2048 + k * PSTR); } } while (0)
#define PG8_LDB(dst, b, h) do { if constexpr (FP8) { _Pragma("unroll") for (int n = 0; n < 2; ++n) dst##8[n] = PG8_LD32(ldsB + (PG8_SB(b, h) - 4 * HTB) + n * 2048); } \
    else { _Pragma("unroll") for (int n = 0; n < 2; ++n) _Pragma("unroll") for (int k = 0; k < 2; ++k) dst[n][k] = *(const PG8_LAS bf16x8*)(ldsB + (PG8_SB(b, h) - 4 * HTB) + n * 2048 + k * PSTR); } } while (0)
#define PG8_MMA(ai, bj, At, Bt) do { __builtin_amdgcn_s_setprio(1); \
        if constexpr (FP8) { _Pragma("unroll") for (int m = 0; m < 4; ++m) _Pragma("unroll") for (int n = 0; n < 2; ++n) \
            asm volatile("v_mfma_scale_f32_16x16x128_f8f6f4 %0, %1, %2, %0, %3, %3 op_sel_hi:[0,0,0]" : "+v"(acc[ai][bj][m][n]) : "v"(Bt##8[n]), "v"(At##8[m]), "v"(sc8)); } \
        else if constexpr (I8) { _Pragma("unroll") for (int k = 0; k < 2; ++k) _Pragma("unroll") for (int m = 0; m < (FP8 ? 1 : 4); ++m) _Pragma("unroll") for (int n = 0; n < 2; ++n) \
            asm volatile("v_mfma_i32_16x16x64_i8 %0, %1, %2, %0" : "+v"(acc[ai][bj][m][n]) : "v"(Bt[n][k]), "v"(At[m][k])); } \
        else { _Pragma("unroll") for (int m = 0; m < (FP8 ? 1 : 4); ++m) _Pragma("unroll") for (int n = 0; n < 2; ++n) _Pragma("unroll") for (int k = 0; k < 2; ++k) \
            acc[ai][bj][m][n] = __builtin_amdgcn_mfma_f32_16x16x32_bf16(Bt[n][k], At[m][k], acc[ai][bj][m][n], 0, 0, 0); } \
        __builtin_amdgcn_s_setprio(0); } while (0)
#define PG8_MMA0(ai, bj, At, Bt) do { __builtin_amdgcn_s_setprio(1); \
        if constexpr (FP8) { _Pragma("unroll") for (int m = 0; m < 4; ++m) _Pragma("unroll") for (int n = 0; n < 2; ++n) \
            asm volatile("v_mfma_scale_f32_16x16x128_f8f6f4 %0, %1, %2, 0, %3, %3 op_sel_hi:[0,0,0]" : "=&v"(acc[ai][bj][m][n]) : "v"(Bt##8[n]), "v"(At##8[m]), "v"(sc8)); } \
        else if constexpr (I8) { _Pragma("unroll") for (int m = 0; m < (FP8 ? 1 : 4); ++m) _Pragma("unroll") for (int n = 0; n < 2; ++n) \
            asm volatile("v_mfma_i32_16x16x64_i8 %0, %1, %2, 0" : "=&v"(acc[ai][bj][m][n]) : "v"(Bt[n][0]), "v"(At[m][0])); \
            _Pragma("unroll") for (int m = 0; m < (FP8 ? 1 : 4); ++m) _Pragma("unroll") for (int n = 0; n < 2; ++n) \
            asm volatile("v_mfma_i32_16x16x64_i8 %0, %1, %2, %0" : "+v"(acc[ai][bj][m][n]) : "v"(Bt[n][1]), "v"(At[m][1])); } \
        else { _Pragma("unroll") for (int m = 0; m < 4; ++m) _Pragma("unroll") for (int n = 0; n < 2; ++n) { \
            acc[ai][bj][m][n] = __builtin_amdgcn_mfma_f32_16x16x32_bf16(Bt[n][0], At[m][0], (f32x4){0.f, 0.f, 0.f, 0.f}, 0, 0, 0); \
            acc[ai][bj][m][n] = __builtin_amdgcn_mfma_f32_16x16x32_bf16(Bt[n][1], At[m][1], acc[ai][bj][m][n], 0, 0, 0); } } \
        __builtin_amdgcn_s_setprio(0); } while (0)
#define PG8_WAIT_V(n) asm volatile("s_waitcnt vmcnt(" #n ")" ::: "memory")
#define PG8_WAIT_L(n) asm volatile("s_waitcnt lgkmcnt(" #n ")" ::: "memory")
#define PG8_BAR __builtin_amdgcn_s_barrier()
#define PG8_SCHED __builtin_amdgcn_sched_barrier(0)
    Unit cur, nxt; int ui = 0;
    if (!S.next(0, cur)) return;
    float sav[8];
    f32x4 acc[2][2][4][2];
#pragma unroll
    for (int a = 0; a < 2; ++a)
#pragma unroll
        for (int b = 0; b < 2; ++b)
#pragma unroll
            for (int m = 0; m < 4; ++m)
#pragma unroll
                for (int n = 0; n < 2; ++n) acc[a][b][m][n] = (f32x4){0.f, 0.f, 0.f, 0.f};
    typedef int v4i_ __attribute__((ext_vector_type(4))); typedef int v8i_ __attribute__((ext_vector_type(8)));
    bf16x8 At[FP8 ? 1 : 4][2], B0[2][2], B1[2][2];
    v8i_ At8[FP8 ? 4 : 1], B08[2], B18[2];
    const int sc8 = 0x7f7f7f7f;
    const char* cA = (const char*)g.A + (Sched::GATHER ? (size_t)0 : (size_t)cur.pm * tstep); const char* cB = (const char*)g.Bt + (size_t)cur.pb * g.bstride + (size_t)cur.pn * tstep;
    S.a_ready(cur);
    if constexpr (Sched::GATHER) { PG8_LOADTK(cur, ntk); asm volatile("s_waitcnt vmcnt(0)" : "+v"(ntk[0][0]), "+v"(ntk[0][1]), "+v"(ntk[1][0]), "+v"(ntk[1][1]) :: "memory"); PG8_TK2VO(ntk, cvo, cur.nv); }
    if constexpr (SP2) {
        PG8_STAGE(PG8_SB(0, 0), cB, voffB); PG8_STAGE(PG8_SB(0, 1), cB + hstep, voffB); PG8_STAGE_A(PG8_SA(0, 0), cA, 0, false); PG8_STAGE_A(PG8_SA(0, 1), cA, 1, false);
        if (wr == 1) PG8_BAR;
        PG8_WAIT_V(2); PG8_BAR;
        PG8_STAGE(PG8_SB(1, 0), cB + kstep, voffB); PG8_STAGE_A(PG8_SA(1, 0), cA + kstepA, 0, false); PG8_STAGE(PG8_SB(1, 1), cB + hstep + kstep, voffB);
        PG8_WAIT_V(6); PG8_BAR;
    } else { static_assert(SP2, "only the SP2 loop is kept"); }
    for (;;) {
        bool has_next; int pbv = 0;
        if constexpr (Sched::LAZY_PB) { has_next = S.next_nopb(ui + 1, nxt);
            if (has_next) { const int* _pp = S.pb_ptr(nxt); asm volatile("global_load_dword %0, %1, off" : "=v"(pbv) : "v"(_pp) : "memory"); } }
        else has_next = S.next(ui + 1, nxt);
        const char* nA = (has_next && !Sched::GATHER) ? (const char*)g.A + (size_t)nxt.pm * tstep : cA;
        if constexpr (Sched::GATHER) { _Pragma("unroll") for (int _h = 0; _h < 2; ++_h) _Pragma("unroll") for (int _i = 0; _i < 2; ++_i) nvo[_h][_i] = cvo[_h][_i]; if (has_next) { PG8_LOADTK(nxt, ntk); } }
 const char* nB = (has_next && !Sched::LAZY_PB) ? (const char*)g.Bt + (size_t)nxt.pb * g.bstride + (size_t)nxt.pn * tstep : cB;
        for (int t = 0; t < nt; t += 2) {
            const bool last = (t == nt - 2);
            const char* a1 = cA + (size_t)(t + 1) * kstepA;
            if constexpr (Sched::LAZY_PB) { if (last && has_next) { asm volatile("s_waitcnt vmcnt(8)" : "+v"(pbv) :: "memory"); nxt.pb = __builtin_amdgcn_readfirstlane(pbv);
                nB = (const char*)g.Bt + (size_t)nxt.pb * g.bstride + (size_t)nxt.pn * tstep; } }
            const char* a2 = last ? nA : cA + (size_t)(t + 2) * kstepA; const char* b2 = last ? nB : cB + (size_t)(t + 2) * kstep;
            const char* a3 = a2 + kstepA; const char* b3 = b2 + kstep;
            if (last && has_next) S.a_ready(nxt);
            if constexpr (Epi::PRE_SA) { if (last) { const float* _ps = E.SA + cur.pm * BM + wr * 64 + fr;
                asm volatile("global_load_dword %0, %8, off\n\tglobal_load_dword %1, %8, off offset:64\n\tglobal_load_dword %2, %8, off offset:128\n\tglobal_load_dword %3, %8, off offset:192\n\t"
                             "global_load_dword %4, %8, off offset:512\n\tglobal_load_dword %5, %8, off offset:576\n\tglobal_load_dword %6, %8, off offset:640\n\tglobal_load_dword %7, %8, off offset:704"
                    : "=&v"(sav[0]), "=&v"(sav[1]), "=&v"(sav[2]), "=&v"(sav[3]), "=&v"(sav[4]), "=&v"(sav[5]), "=&v"(sav[6]), "=&v"(sav[7]) : "v"(_ps) : "memory"); } }
            if constexpr (Sched::GATHER) { if (last && has_next) {
                asm volatile("s_waitcnt vmcnt(8)" : "+v"(ntk[0][0]), "+v"(ntk[0][1]), "+v"(ntk[1][0]), "+v"(ntk[1][1]) :: "memory"); PG8_TK2VO(ntk, nvo, nxt.nv); } }
            if constexpr (SP2) {
            PG8_LDB(B0, 0, 0); PG8_LDB(B1, 0, 1); PG8_SCHED; PG8_LDA(At, 0, 0); PG8_STAGE_A(PG8_SA(1, 1), a1, 1, false);
            PG8_WAIT_V(8); PG8_WAIT_L(0); PG8_BAR; if (t == 0) { PG8_MMA0(0, 0, At, B0); PG8_MMA0(0, 1, At, B1); } else { PG8_MMA(0, 0, At, B0); PG8_MMA(0, 1, At, B1); } PG8_BAR; PG8_SCHED;
            PG8_LDA(At, 0, 1); PG8_STAGE(PG8_SB(0, 0), b2, voffB); PG8_STAGE(PG8_SB(0, 1), b2 + hstep, voffB); PG8_STAGE_A(PG8_SA(0, 0), a2, 0, last);
            PG8_WAIT_V(8); PG8_WAIT_L(0); PG8_BAR; if (t == 0) { PG8_MMA0(1, 0, At, B0); PG8_MMA0(1, 1, At, B1); } else { PG8_MMA(1, 0, At, B0); PG8_MMA(1, 1, At, B1); } PG8_BAR; PG8_SCHED;
            PG8_LDB(B0, 1, 0); PG8_LDB(B1, 1, 1); PG8_SCHED; PG8_LDA(At, 1, 0); PG8_STAGE_A(PG8_SA(0, 1), a2, 1, last);
            PG8_WAIT_V(8); PG8_WAIT_L(0); PG8_BAR; PG8_MMA(0, 0, At, B0); PG8_MMA(0, 1, At, B1); PG8_BAR; PG8_SCHED;
            PG8_LDA(At, 1, 1); PG8_STAGE(PG8_SB(1, 0), b3, voffB); PG8_STAGE(PG8_SB(1, 1), b3 + hstep, voffB); PG8_STAGE_A(PG8_SA(1, 0), a3, 0, last);
            PG8_WAIT_V(8); PG8_WAIT_L(0); PG8_BAR; PG8_MMA(1, 0, At, B0); PG8_MMA(1, 1, At, B1); PG8_BAR; PG8_SCHED;
            }
        }
        if constexpr (ALIGN_EPI) { if (wr == 0) PG8_BAR; }
        if constexpr (FP8 || I8) asm volatile("s_nop 15\n\ts_nop 15" ::: "memory");
        if constexpr (Epi::PRE_SA) { asm volatile("s_waitcnt vmcnt(8)" : "+v"(sav[0]), "+v"(sav[1]), "+v"(sav[2]), "+v"(sav[3]), "+v"(sav[4]), "+v"(sav[5]), "+v"(sav[6]), "+v"(sav[7]) :: "memory");
            E(acc, cur, wr, wc, fr, fq, sav); S.done(cur); }
        else if constexpr (!Epi::AFTER_DRAIN) { E(acc, cur, wr, wc, fr, fq); S.done(cur); }
        if (!has_next) break;
#pragma unroll
        for (int a = 0; a < 2; ++a)
#pragma unroll
            for (int b = 0; b < 2; ++b)
#pragma unroll
                for (int m = 0; m < 4; ++m)
#pragma unroll
                    for (int n = 0; n < 2; ++n) asm volatile("" : "=v"(acc[a][b][m][n]));
        cur = nxt; cA = nA; cB = nB; ++ui;
        if constexpr (Sched::GATHER) { _Pragma("unroll") for (int _h = 0; _h < 2; ++_h) _Pragma("unroll") for (int _i = 0; _i < 2; ++_i) cvo[_h][_i] = nvo[_h][_i]; }
        if constexpr (ALIGN_EPI) { if (wr == 1) PG8_BAR; }
    }
    PG8_WAIT_V(0);
    if constexpr (!ALIGN_EPI) { if (wr == 0) PG8_BAR; }
    PG8_BAR;
    if constexpr (Epi::AFTER_DRAIN) { E.fused(acc, cur, wr, wc, fr, fq, lds, wid, lane); S.done(cur); }
#undef PG8_SA
#undef PG8_SB
#undef PG8_STAGE
#undef PG8_STAGE_A
#undef PG8_LOADTK
#undef PG8_TK2VO
#undef PG8_LD32
#undef PG8_LDA
#undef PG8_LDB
#undef PG8_MMA
#undef PG8_MMA0
#undef PG8_WAIT_V
#undef PG8_WAIT_L
#undef PG8_BAR
#undef PG8_SCHED
}
}

constexpr int NB = 32, SEQ = 2048, DM = 1024, T = NB * SEQ;
constexpr int EVIN = 2560, CONVC = 512, CONVW = 31, NHEAD = 8, HD = 64, SBW = 512;
constexpr int NEXP = 16, DFF = 512;
constexpr int MOE_ROWS = 2 * T + NEXP * 256;
constexpr int MOE_TILES = MOE_ROWS / 256;
constexpr float EPS = 1e-6f;
constexpr int NWAVES = 8;

constexpr size_t MiB = 1u << 20;
constexpr size_t WS_CTL = 0, CTL_ZERO_BYTES = 64 * 1024;
constexpr size_t WS_MOD = 1 * MiB;
constexpr size_t WS_META = 3 * MiB;
constexpr size_t META_EID = WS_META, META_GATE = WS_META + 512 * 1024, META_SLOT = WS_META + 1024 * 1024, META_BCNT = WS_META + 1536 * 1024,
                 META_TILEE = META_BCNT + 32 * 1024, META_NT = META_BCNT + 64 * 1024, META_TOK = WS_META + 2048 * 1024, META_SBEVIN = WS_META + 2816 * 1024, META_SBODIN = META_SBEVIN + 16 * 1024, META_WRIMG = META_SBEVIN + 32 * 1024;
constexpr size_t WS_SA = WS_MOD + 1536 * 1024;
constexpr size_t WS_WEVIN = 6 * MiB, WS_WEVOUT = 11 * MiB, WS_WODIN = 13 * MiB, WS_WODOUT = 17 * MiB, WS_WRG = 19 * MiB, WS_WIG = WS_WRG + 512 * 1024;
constexpr size_t WS_W13 = 20 * MiB;
constexpr size_t WS_W2 = 84 * MiB;
constexpr size_t WS_HA = 116 * MiB;
constexpr size_t WS_R1 = 244 * MiB;
constexpr size_t WS_R2 = 508 * MiB;
constexpr size_t WS_XBF = 640 * MiB;
constexpr size_t WS_END = 768 * MiB;
constexpr size_t WS_TOK2 = WS_END;
constexpr size_t WS_DRY = WS_END + 8 * MiB;
constexpr int CW_BAR = 4096;
constexpr int CW_GCNT = 256;
constexpr int L_MOE = 131072;

constexpr int RING_BYTES = 131072, LDS_BYTES = 163840, LDSCTL_OFF = LDS_BYTES - 2048, MISC_OFF = LDSCTL_OFF + 320;

#define GAS __attribute__((address_space(1)))
#define LAS __attribute__((address_space(3)))
typedef unsigned short bf16;
typedef unsigned v4u __attribute__((ext_vector_type(4)));
typedef unsigned v2u __attribute__((ext_vector_type(2)));
typedef float f32x4 __attribute__((ext_vector_type(4)));
typedef float f32x2 __attribute__((ext_vector_type(2)));
typedef float f32x16 __attribute__((ext_vector_type(16)));
typedef short bf16x8 __attribute__((ext_vector_type(8)));
typedef short s16x4 __attribute__((ext_vector_type(4)));
typedef __bf16 bf16x2_t __attribute__((ext_vector_type(2)));
typedef GAS unsigned gu32;
#define RLX_AGENT __ATOMIC_RELAXED, __HIP_MEMORY_SCOPE_AGENT

__device__ __forceinline__ unsigned pk2(float lo, float hi) { f32x2 v = {lo, hi}; bf16x2_t b = __builtin_convertvector(v, bf16x2_t); return __builtin_bit_cast(unsigned, b); }
__device__ __forceinline__ unsigned pk4_fp8(float a, float b, float c, float d) { int r = __builtin_amdgcn_cvt_pk_fp8_f32(a, b, 0, false); r = __builtin_amdgcn_cvt_pk_fp8_f32(c, d, r, true); return (unsigned)r; }
__device__ __forceinline__ v2u bf8x_to_fp8(v4u v);
typedef int i32x4_t __attribute__((ext_vector_type(4)));
__device__ __forceinline__ f32x4 i32_to_f32x4(f32x4 bits) { return __builtin_convertvector(__builtin_bit_cast(i32x4_t, bits), f32x4); }
__device__ __forceinline__ unsigned pk4_i8(float a, float b, float c, float d) {
    const unsigned ua = __float_as_uint(a + 12582912.0f), ub = __float_as_uint(b + 12582912.0f), uc = __float_as_uint(c + 12582912.0f), ud = __float_as_uint(d + 12582912.0f);
    return (ua & 0xffu) | ((ub & 0xffu) << 8) | ((uc & 0xffu) << 16) | (ud << 24);
}
__device__ __forceinline__ float bflo(unsigned u) { return __uint_as_float(u << 16); }
__device__ __forceinline__ float bfhi(unsigned u) { return __uint_as_float(u & 0xffff0000u); }
__device__ __forceinline__ v2u bf8x_to_fp8(v4u v) { v2u o; o.x = pk4_fp8(bflo(v.x), bfhi(v.x), bflo(v.y), bfhi(v.y)); o.y = pk4_fp8(bflo(v.z), bfhi(v.z), bflo(v.w), bfhi(v.w)); return o; }
__device__ __forceinline__ float bf2f(bf16 b) { return __uint_as_float((unsigned)b << 16); }
__device__ __forceinline__ float fast_exp2(float x) { return __builtin_amdgcn_exp2f(x); }
__device__ __forceinline__ float fast_rcp(float x) { return __builtin_amdgcn_rcpf(x); }
__device__ __forceinline__ float sigmoidf_(float x) { return fast_rcp(1.0f + fast_exp2(-1.4426950408889634f * x)); }
__device__ __forceinline__ float siluf_(float x) { return x * sigmoidf_(x); }
__device__ __forceinline__ float gelu_tanh(float x) { const float u = x + 0.044715f * x * x * x; return x * fast_rcp(1.0f + fast_exp2(-2.3022082f * u)); }
__device__ __forceinline__ float wave_sum(float v) {
#pragma unroll
    for (int o = 1; o < 64; o <<= 1) v += __shfl_xor(v, o);
    return v;
}

#define XB_TMO      128
#define XB_XCNT(j)  (256  + 64 * (j))
#define XB_XSUB(j)  (1280 + 64 * (j))
#define XB_XGEN(j)  (2304 + 64 * (j))
#define XB_TOP      3328
#define XB_TOPGEN   3392
#define XCD_BAR_WORDS 3456
#define XB_SPIN_CAP (1u << 18)

__device__ __forceinline__ unsigned xb_ld(unsigned* p)              { return __hip_atomic_load(p, __ATOMIC_RELAXED, __HIP_MEMORY_SCOPE_AGENT); }
__device__ __forceinline__ unsigned xb_add(unsigned* p, unsigned v) { return __hip_atomic_fetch_add(p, v, __ATOMIC_RELAXED, __HIP_MEMORY_SCOPE_AGENT); }
__device__ __forceinline__ unsigned xb_xcc_id() { return (unsigned)__builtin_amdgcn_s_getreg((3 << 11) | 20) & 0xFu; }
#define XB_SPIN(cond, bar) do { unsigned _sp = 0; while (cond) { __builtin_amdgcn_s_sleep(1); \
    if ((++_sp & 255u) == 0u) { if (xb_ld(&(bar)[XB_TMO])) break; if (_sp > XB_SPIN_CAP) { atomicAdd(&(bar)[XB_TMO], 1u); break; } } } } while (0)

struct XcdBarrier {
    unsigned* bar; unsigned x;
    volatile LAS unsigned* st;
};

__device__ __forceinline__ XcdBarrier xcd_barrier_post(unsigned* bar, volatile LAS unsigned* st) {
    XcdBarrier b; b.bar = bar; b.x = xb_xcc_id(); b.st = st;
    if (threadIdx.x == 0) (void)xb_add(&bar[XB_XCNT(b.x)], 1u);
    return b;
}
__device__ __forceinline__ void xcd_barrier_complete(unsigned* bar, unsigned x, unsigned& nloc, unsigned& nx) {
    const unsigned G = gridDim.x * gridDim.y * gridDim.z;
    unsigned sum, cnt, mine, sp = 0u;
    for (;;) {
        sum = 0u; cnt = 0u; mine = 0u;
#pragma unroll
        for (unsigned j = 0; j < 16; ++j) { const unsigned c = xb_ld(&bar[XB_XCNT(j)]); sum += c; cnt += (c > 0u) ? 1u : 0u; mine = (j == x) ? c : mine; }
        if (sum == G) break;
        __builtin_amdgcn_s_sleep(1);
        if ((++sp & 255u) == 0u) { if (xb_ld(&bar[XB_TMO])) break; if (sp > XB_SPIN_CAP) { atomicAdd(&bar[XB_TMO], 1u); break; } }
    }
    nloc = mine > 0u ? mine : 1u; nx = cnt > 0u ? cnt : 1u;
}

__device__ __forceinline__ void xcd_barrier(const XcdBarrier& b) {
    asm volatile("s_waitcnt vmcnt(0)" ::: "memory");
    __syncthreads();
    if (threadIdx.x == 0) {
        unsigned* bar = b.bar;
        __builtin_amdgcn_s_waitcnt(0);
        unsigned nloc = b.st[0], nx = b.st[1];
        if (nloc == 0u) { xcd_barrier_complete(bar, b.x, nloc, nx); b.st[0] = nloc; b.st[1] = nx; }
        const unsigned old = xb_add(&bar[XB_XSUB(b.x)], 1u);
        const unsigned gen = old / nloc;
        if (old + 1u == (gen + 1u) * nloc) {
            __builtin_amdgcn_fence(__ATOMIC_RELEASE, "agent");
            asm volatile("s_waitcnt vmcnt(0)" ::: "memory");
            const unsigned og = xb_add(&bar[XB_TOP], 1u);
            const unsigned tg = og / nx;
            if (og + 1u == (tg + 1u) * nx) xb_add(&bar[XB_TOPGEN], 1u);
            else XB_SPIN(xb_ld(&bar[XB_TOPGEN]) == tg, bar);
            __builtin_amdgcn_fence(__ATOMIC_ACQUIRE, "agent");
            xb_add(&bar[XB_XGEN(b.x)], 1u);
            asm volatile("s_waitcnt vmcnt(0)" ::: "memory");
        } else {
            XB_SPIN(xb_ld(&bar[XB_XGEN(b.x)]) == gen, bar);
            __builtin_amdgcn_fence(__ATOMIC_ACQUIRE, "agent");
            asm volatile("s_waitcnt vmcnt(0)" ::: "memory");
        }
    }
    __syncthreads();
}


namespace pg8 {
__device__ __forceinline__ v2f_ glu2(v2f_ v, v2f_ g) {
    const v2f_ t = g * -1.4426950408889634f;
    v2f_ e; e[0] = __builtin_amdgcn_exp2f(t[0]); e[1] = __builtin_amdgcn_exp2f(t[1]);
    const v2f_ d = e + 1.0f;
    v2f_ r; r[0] = __builtin_amdgcn_rcpf(d[0]); r[1] = __builtin_amdgcn_rcpf(d[1]);
    return v * r;
}
__device__ __forceinline__ v2f_ gelu2(v2f_ x) {
    const v2f_ q = x * x, p = q * (0.044715f * -2.3022082f) + -2.3022082f, t = p * x;
    v2f_ e; e[0] = __builtin_amdgcn_exp2f(t[0]); e[1] = __builtin_amdgcn_exp2f(t[1]);
    const v2f_ d = e + 1.0f;
    v2f_ r; r[0] = __builtin_amdgcn_rcpf(d[0]); r[1] = __builtin_amdgcn_rcpf(d[1]);
    return x * r;
}
struct EpiEvIn {
    static constexpr bool PERM = true, AFTER_DRAIN = false, PRE_SA = I8_IN != 0;
    bf16* U0; bf16* Q; bf16* K; bf16* V; const float* qg; const float* kg; const float* SA; const PG8_LAS float* SB;
    __device__ __forceinline__ void operator()(const f32x4 (&acc_)[2][2][4][2], const Unit& u, int wr, int wc, int fr, int fq, const float (&sav)[8]) const {
        const int row0 = u.pm * BM + wr * 64 + fr;
        f32x4 acc[2][2][4][2];
#pragma unroll
        for (int a = 0; a < 2; ++a)
#pragma unroll
            for (int b = 0; b < 2; ++b)
#pragma unroll
                for (int m = 0; m < 4; ++m)
#pragma unroll
                    for (int n = 0; n < 2; ++n) {
#if I8_IN
                        const float sa = I8_FIXSCALE ? 8.0f / 127.0f : sav[4 * a + m]; const f32x4 sb = I8_FIXSCALE ? (f32x4){0.25f / 127.0f, 0.25f / 127.0f, 0.25f / 127.0f, 0.25f / 127.0f} : *(const PG8_LAS f32x4*)(SB + u.pn * BM + 128 * b + 32 * wc + 8 * fq + 4 * n);
                        const f32x4 ai_ = acc_[a][b][m][n];
                        acc[a][b][m][n] = i32_to_f32x4(ai_) * sb * sa;
#else
                        acc[a][b][m][n] = acc_[a][b][m][n] * (FP8_IN0 ? 1.0f / 32.0f : 1.0f);
#endif
                    }
        if (u.pn < 4) {
#pragma unroll
            for (int ai = 0; ai < 2; ++ai)
#pragma unroll
                for (int m = 0; m < 4; ++m) {
                    const size_t row = (size_t)(row0 + ai * HALF + m * 16);
                    const f32x4 v0 = acc[ai][0][m][0], v1 = acc[ai][0][m][1], g0 = acc[ai][1][m][0], g1 = acc[ai][1][m][1];
                    static_assert(U_FP8, "the GLU branch stores fp8");
                    const v2f_ h00 = glu2(__builtin_shufflevector(v0, v0, 0, 1), __builtin_shufflevector(g0, g0, 0, 1)), h01 = glu2(__builtin_shufflevector(v0, v0, 2, 3), __builtin_shufflevector(g0, g0, 2, 3));
                    const v2f_ h10 = glu2(__builtin_shufflevector(v1, v1, 0, 1), __builtin_shufflevector(g1, g1, 0, 1)), h11 = glu2(__builtin_shufflevector(v1, v1, 2, 3), __builtin_shufflevector(g1, g1, 2, 3));
                    v2u w8; w8.x = pk4_fp8(h00[0], h00[1], h01[0], h01[1]); w8.y = pk4_fp8(h10[0], h10[1], h11[0], h11[1]);
                    (void)row; *(v2u*)((unsigned char*)U0 + (size_t)((u.pm * 4 + u.pn) * 4 + wc) * 8192 + wr * 2048 + ai * 4096 + m * 512 + fr * 32 + 8 * fq) = w8;
                }
        } else if (u.pn < 8) {
            const int sec = (u.pn - 4) >> 1, p = (u.pn - 4) & 1, head = 4 * p + wc;
            const float* gp = sec ? kg : qg; bf16* dst = sec ? K : Q;
            const float scl = sec ? 1.0f : 0.125f * 1.4426950408889634f;
            f32x4 gv[2][2];
#pragma unroll
            for (int bj = 0; bj < 2; ++bj)
#pragma unroll
                for (int n = 0; n < 2; ++n) gv[bj][n] = *(const f32x4*)(gp + 32 * bj + 8 * fq + 4 * n) * scl;
#pragma unroll
            for (int ai = 0; ai < 2; ++ai)
#pragma unroll
                for (int m = 0; m < 4; ++m) {
                    const size_t row = (size_t)(row0 + ai * HALF + m * 16);
                    float ss = 0.f;
#pragma unroll
                    for (int bj = 0; bj < 2; ++bj)
#pragma unroll
                        for (int n = 0; n < 2; ++n) { const f32x4 x = acc[ai][bj][m][n]; ss += (x[0] * x[0] + x[1] * x[1]) + (x[2] * x[2] + x[3] * x[3]); }
                    ss += __shfl_xor(ss, 16); ss += __shfl_xor(ss, 32);
                    const float rstd = __builtin_amdgcn_rsqf(ss * (1.0f / 64.0f) + EPS);
#pragma unroll
                    for (int bj = 0; bj < 2; ++bj) {
                        const f32x4 a = acc[ai][bj][m][0] * rstd * gv[bj][0], b = acc[ai][bj][m][1] * rstd * gv[bj][1];
                        u32x4 w; w.x = pk2(a[0], a[1]); w.y = pk2(a[2], a[3]); w.z = pk2(b[0], b[1]); w.w = pk2(b[2], b[3]);
                        *(u32x4*)(dst + row * 512 + head * 64 + 32 * bj + 8 * fq) = w;
                    }
                }
        } else {
#pragma unroll
            for (int ai = 0; ai < 2; ++ai)
#pragma unroll
                for (int m = 0; m < 4; ++m) {
                    const size_t row = (size_t)(row0 + ai * HALF + m * 16);
#pragma unroll
                    for (int bj = 0; bj < 2; ++bj) {
                        const f32x4 a = acc[ai][bj][m][0], b = acc[ai][bj][m][1];
                        u32x4 w; w.x = pk2(a[0], a[1]); w.y = pk2(a[2], a[3]); w.z = pk2(b[0], b[1]); w.w = pk2(b[2], b[3]);
                        *(u32x4*)(V + row * 512 + (u.pn - 8) * 256 + wc * 64 + bj * 32 + 8 * fq) = w;
                    }
                }
        }
    }
};
template <bool XIN32>
struct EpiResid {
    static constexpr bool PERM = true, AFTER_DRAIN = false, PRE_SA = false;
    const void* xin; bf16* xout; const float* gate; float sc;
    __device__ __forceinline__ void operator()(const f32x4 (&acc)[2][2][4][2], const Unit& u, int wr, int wc, int fr, int fq) const {
        const int row0 = u.pm * BM + wr * 64 + fr, col0 = u.pn * BM + wc * 64 + 8 * fq, b = u.pm >> 3;
        f32x4 gv[2][2];
#pragma unroll
        for (int bj = 0; bj < 2; ++bj)
#pragma unroll
            for (int n = 0; n < 2; ++n) gv[bj][n] = *(const f32x4*)(gate + (size_t)b * 6144 + col0 + bj * 32 + 4 * n) * sc;
#pragma unroll
        for (int ab = 0; ab < (XIN32 ? 2 : 1); ++ab) {
            f32x4 xa[4][2][2]; u32x4 xb[2][4][2];
#pragma unroll
            for (int ai = 0; ai < 2; ++ai)
#pragma unroll
                for (int m = 0; m < 4; ++m) { const unsigned off = (unsigned)(row0 + ai * HALF + m * 16) * DM + col0;
#pragma unroll
                    for (int bj = 0; bj < 2; ++bj) {
                        if (XIN32) { if (ai == ab) { xa[m][bj][0] = *(const f32x4*)((const float*)xin + off + bj * 32); xa[m][bj][1] = *(const f32x4*)((const float*)xin + off + bj * 32 + 4); } }
                        else xb[ai][m][bj] = *(const u32x4*)((const bf16*)xin + off + bj * 32); } }
            asm volatile("" ::: "memory");
#pragma unroll
            for (int ai = 0; ai < 2; ++ai)
#pragma unroll
                for (int m = 0; m < 4; ++m) { const unsigned off = (unsigned)(row0 + ai * HALF + m * 16) * DM + col0;
                    if (XIN32 && ai != ab) continue;
#pragma unroll
                    for (int bj = 0; bj < 2; ++bj) {
                        f32x4 x0, x1;
                        if (XIN32) { x0 = xa[m][bj][0]; x1 = xa[m][bj][1]; }
                        else { const u32x4 q = xb[ai][m][bj]; x0 = (f32x4){bflo(q.x), bfhi(q.x), bflo(q.y), bfhi(q.y)}; x1 = (f32x4){bflo(q.z), bfhi(q.z), bflo(q.w), bfhi(q.w)}; }
                        const f32x4 av = x0 + gv[bj][0] * acc[ai][bj][m][0], cv = x1 + gv[bj][1] * acc[ai][bj][m][1];
                        u32x4 w; w.x = pk2(av[0], av[1]); w.y = pk2(av[2], av[3]); w.z = pk2(cv[0], cv[1]); w.w = pk2(cv[2], cv[3]);
                        *(u32x4*)(xout + off + bj * 32) = w;
                    } }
            asm volatile("" ::: "memory");
        }
    }
};
struct EpiOdIn {
    static constexpr bool PERM = true, AFTER_DRAIN = false, PRE_SA = I8_IN != 0;
    bf16* GY; bf16* XB; const float* SA; const PG8_LAS float* SB;
    __device__ __forceinline__ void operator()(const f32x4 (&acc)[2][2][4][2], const Unit& u, int wr, int wc, int fr, int fq, const float (&sav_)[8]) const {
        const int row0 = u.pm * BM + wr * 64 + fr; const bool isy = u.pn < 4;
        bf16* dst = (isy ? GY : XB) + (size_t)(u.pn & 3) * 256 + wc * 64 + 8 * fq;
        unsigned char* xbb = (unsigned char*)XB + (size_t)((u.pm * 4 + (u.pn & 3)) * 4 + wc) * 16384 + wr * 4096;
        const unsigned xlo = (unsigned)(fr * 64 + 16 * fq);
#if I8_IN
        float sav[2][4]; f32x4 sbv[2][2];
#pragma unroll
        for (int ai = 0; ai < 2; ++ai)
#pragma unroll
            for (int m = 0; m < 4; ++m) sav[ai][m] = sav_[4 * ai + m];
#pragma unroll
        for (int bj = 0; bj < 2; ++bj) { sbv[bj][0] = *(const PG8_LAS f32x4*)(SB + u.pn * BM + 128 * bj + 32 * wc + 8 * fq); sbv[bj][1] = *(const PG8_LAS f32x4*)(SB + u.pn * BM + 128 * bj + 32 * wc + 8 * fq + 4); }
        asm volatile("" ::: "memory");
#endif
#pragma unroll
        for (int ai = 0; ai < 2; ++ai)
#pragma unroll
            for (int m = 0; m < 4; ++m) {
                const size_t row = (size_t)(row0 + ai * HALF + m * 16);
                unsigned xw8[4] = {0u, 0u, 0u, 0u};
#pragma unroll
                for (int bj = 0; bj < 2; ++bj) {
#if I8_IN
                    const float sa = sav[ai][m]; const f32x4 sb0 = sbv[bj][0], sb1 = sbv[bj][1];
                    const f32x4 i0 = acc[ai][bj][m][0], i1 = acc[ai][bj][m][1];
                    f32x4 a = i32_to_f32x4(i0) * sb0 * sa;
                    f32x4 b = i32_to_f32x4(i1) * sb1 * sa;
#else
                    f32x4 a = acc[ai][bj][m][0] * (FP8_IN1 ? 1.0f / 32.0f : 1.0f), b = acc[ai][bj][m][1] * (FP8_IN1 ? 1.0f / 32.0f : 1.0f);
#endif
                    if (isy) { const v2f_ a01 = gelu2(__builtin_shufflevector(a, a, 0, 1)), a23 = gelu2(__builtin_shufflevector(a, a, 2, 3)), b01 = gelu2(__builtin_shufflevector(b, b, 0, 1)), b23 = gelu2(__builtin_shufflevector(b, b, 2, 3));
                        a = __builtin_shufflevector(a01, a23, 0, 1, 2, 3); b = __builtin_shufflevector(b01, b23, 0, 1, 2, 3); }
#if X_FP8
                    if (!isy) { xw8[2 * bj] = pk4_fp8(a[0], a[1], a[2], a[3]); xw8[2 * bj + 1] = pk4_fp8(b[0], b[1], b[2], b[3]);
                        if (bj == 1) *(v4u*)(xbb + ai * 8192 + m * 1024 + xlo) = (v4u){xw8[0], xw8[1], xw8[2], xw8[3]};
                        continue; }
#endif
                    u32x4 w; w.x = pk2(a[0], a[1]); w.y = pk2(a[2], a[3]); w.z = pk2(b[0], b[1]); w.w = pk2(b[2], b[3]);
                    *(u32x4*)(dst + row * DM + bj * 32) = w;
                }
            }
    }
};
__device__ __forceinline__ v2f_ silu_mul2(v2f_ a, v2f_ b) {
    const v2f_ t = a * (-1.4426950408889634f / 32.0f);
    v2f_ e; e[0] = __builtin_amdgcn_exp2f(t[0]); e[1] = __builtin_amdgcn_exp2f(t[1]);
    const v2f_ d = e * 256.0f + 256.0f;
    v2f_ r; r[0] = __builtin_amdgcn_rcpf(d[0]); r[1] = __builtin_amdgcn_rcpf(d[1]);
    return (a * b) * r;
}
struct EpiMoeA {
    static constexpr bool PERM = true, AFTER_DRAIN = false, PRE_SA = false;
    bf16* HID; bool dry;
    __device__ __forceinline__ void operator()(const f32x4 (&acc)[2][2][4][2], const Unit& u, int wr, int wc, int fr, int fq) const {
        const int row0 = u.pm * BM + wr * 64 + fr;
        unsigned char* hb = (unsigned char*)HID + (size_t)u.pm * 131072 + (size_t)u.pn * 32768 + wc * 8192 + wr * 2048;
        const unsigned lo = (unsigned)(fr * 32 + 8 * fq);
#pragma unroll
        for (int ai = 0; ai < 2; ++ai)
#pragma unroll
            for (int m = 0; m < 4; ++m) {
                const size_t row = (size_t)(row0 + ai * HALF + m * 16);
                const f32x4 a0 = acc[ai][0][m][0], a1 = acc[ai][0][m][1], b0 = acc[ai][1][m][0], b1 = acc[ai][1][m][1];
                const v2f_ h00 = silu_mul2(__builtin_shufflevector(a0, a0, 0, 1), __builtin_shufflevector(b0, b0, 0, 1)), h01 = silu_mul2(__builtin_shufflevector(a0, a0, 2, 3), __builtin_shufflevector(b0, b0, 2, 3));
                const v2f_ h10 = silu_mul2(__builtin_shufflevector(a1, a1, 0, 1), __builtin_shufflevector(b1, b1, 0, 1)), h11 = silu_mul2(__builtin_shufflevector(a1, a1, 2, 3), __builtin_shufflevector(b1, b1, 2, 3));
                v2u w8; w8.x = pk4_fp8(h00[0], h00[1], h01[0], h01[1]); w8.y = pk4_fp8(h10[0], h10[1], h11[0], h11[1]);
                (void)row; if (!dry) *(v2u*)(hb + ai * 4096 + m * 512 + lo) = w8; else asm volatile("" :: "v"(w8));
            }
    }
};
struct EpiMoeB {
    static constexpr bool PERM = true, AFTER_DRAIN = false, PRE_SA = false;
    bf16* Y; bool dry;
    __device__ __forceinline__ void operator()(const f32x4 (&acc)[2][2][4][2], const Unit& u, int wr, int wc, int fr, int fq) const {
        const int row0 = u.pm * BM + wr * 64 + fr;
#pragma unroll
        for (int ai = 0; ai < 2; ++ai)
#pragma unroll
            for (int m = 0; m < 4; ++m) {
                const size_t row = (size_t)(row0 + ai * HALF + m * 16);
                const f32x4 a0 = acc[ai][0][m][0] * (1.0f / 128.0f), a1 = acc[ai][0][m][1] * (1.0f / 128.0f), b0 = acc[ai][1][m][0] * (1.0f / 128.0f), b1 = acc[ai][1][m][1] * (1.0f / 128.0f);
                v4u w8; w8.x = pk4_fp8(a0[0], a0[1], a0[2], a0[3]); w8.y = pk4_fp8(a1[0], a1[1], a1[2], a1[3]); w8.z = pk4_fp8(b0[0], b0[1], b0[2], b0[3]); w8.w = pk4_fp8(b1[0], b1[1], b1[2], b1[3]);
                if (!dry) *(v4u*)((unsigned char*)Y + row * DM + u.pn * 256 + wc * 64 + 16 * fq) = w8; else asm volatile("" :: "v"(w8));
            }
    }
};
constexpr int TOKSTR = 65536;
struct MoeOrder {
    static constexpr bool GATHER = false, LAZY_PB = false, A_BLK = true; const int* tok;
    StaticOrder base; const PG8_LAS int* te; const PG8_LAS int* tb; const PG8_LAS int* cl;
    __device__ __forceinline__ bool next(int i, Unit& u) const { if (!base.next(i, u)) return false; u.pb = __builtin_amdgcn_readfirstlane(te[u.pm]); return true; }
    __device__ __forceinline__ bool next_nopb(int i, Unit& u) const { return base.next(i, u); }
    __device__ __forceinline__ const int* pb_ptr(const Unit&) const { return nullptr; }
    __device__ __forceinline__ void a_ready(const Unit&) const {}
    __device__ __forceinline__ void done(const Unit&) const {}
};
struct MoeGatherOrder {
    static constexpr bool GATHER = true, LAZY_PB = false, A_BLK = false; const int* tok;
    StaticOrder base; const PG8_LAS int* te; const PG8_LAS int* tb; const PG8_LAS int* cl;
    __device__ __forceinline__ bool next(int i, Unit& u) const { if (!base.next(i, u)) return false; u.pb = __builtin_amdgcn_readfirstlane(te[u.pm]);
        const int r0 = (u.pm - __builtin_amdgcn_readfirstlane(tb[u.pb])) * BM; u.tk0 = u.pb * TOKSTR + r0; u.nv = __builtin_amdgcn_readfirstlane(cl[u.pb]) - r0; return true; }
    __device__ __forceinline__ bool next_nopb(int i, Unit& u) const { return base.next(i, u); }
    __device__ __forceinline__ const int* pb_ptr(const Unit&) const { return nullptr; }
    __device__ __forceinline__ void a_ready(const Unit&) const {}
    __device__ __forceinline__ void done(const Unit&) const {}
};
}

struct Frame {
    LAS unsigned char* lds;
    int tid, lane, wave, vcu, G, bx;
    unsigned char* ws;
};

template <bool OUT8 = false, bool KPERM = false, class RowMap>
__device__ __forceinline__ void p0_transpose_item(const float* W, int K, int N, bf16* WT, LAS float* scr, int item, int lane, RowMap rm) {
    const int nblk = N / 32, kb = item / nblk, nb = item % nblk, k0 = 128 * kb, n0 = 32 * nb;
    f32x4 v[16];
#pragma unroll
    for (int i = 0; i < 16; ++i) v[i] = __builtin_nontemporal_load((const f32x4*)(W + (size_t)(k0 + 8 * i + (lane >> 3)) * N + n0 + 4 * (lane & 7)));
#pragma unroll
    for (int i = 0; i < 16; ++i) { LAS float* d = scr + (8 * i + (lane >> 3)) * 33 + 4 * (lane & 7); d[0] = v[i][0]; d[1] = v[i][1]; d[2] = v[i][2]; d[3] = v[i][3]; }
    asm volatile("s_waitcnt lgkmcnt(0)" ::: "memory");
    const int c = lane & 15;
#pragma unroll
    for (int j = 0; j < 8; ++j) { const int n = (lane >> 4) + 4 * j; const LAS float* sp = scr + (8 * c) * 33 + n;
        if constexpr (OUT8) { v2u o; o.x = pk4_fp8(sp[0 * 33] * 32.f, sp[1 * 33] * 32.f, sp[2 * 33] * 32.f, sp[3 * 33] * 32.f); o.y = pk4_fp8(sp[4 * 33] * 32.f, sp[5 * 33] * 32.f, sp[6 * 33] * 32.f, sp[7 * 33] * 32.f);
            const int kd = KPERM ? k0 + 64 * ((c >> 1) & 1) + 16 * (c >> 2) + 8 * (c & 1) : k0 + 8 * c;
            __builtin_nontemporal_store(o, (GAS v2u*)((unsigned char*)WT + (size_t)rm(n0 + n) * K + kd)); }
        else { v4u o; o.x = pk2(sp[0 * 33], sp[1 * 33]); o.y = pk2(sp[2 * 33], sp[3 * 33]); o.z = pk2(sp[4 * 33], sp[5 * 33]); o.w = pk2(sp[6 * 33], sp[7 * 33]);
            __builtin_nontemporal_store(o, (GAS v4u*)(WT + (size_t)rm(n0 + n) * K + k0 + 8 * c)); } }
    asm volatile("s_waitcnt lgkmcnt(0)" ::: "memory");
}
struct RmId { __device__ __forceinline__ int operator()(int n) const { return n; } };
struct RmW16 { __device__ __forceinline__ int operator()(int n) const { const int r = n & 255, wc = r >> 6, fq = (r >> 4) & 3, bj = (r >> 3) & 1, j = r & 7; return (n & ~255) + 128 * bj + 32 * wc + 8 * fq + j; } };
struct RmW64 { __device__ __forceinline__ int operator()(int n) const { const int r = n & 255, wc = r >> 6, bj = (r >> 5) & 1, j = r & 31; return (n & ~255) + 128 * bj + 32 * wc + j; } };
struct RmEvIn { __device__ __forceinline__ int operator()(int n) const {
    if (n < 512) return 256 * (n >> 7) + (n & 127);
    if (n < 1024) { const int m = n - 512; return 256 * (m >> 7) + 128 + (m & 127); }
    if (n < 2048) { const int m = n - 1024, sec = m >> 9, mm = m & 511, p = mm >> 8, r = mm & 255, wc = r >> 6, d = r & 63, bj = d >> 5, j = d & 31;
        return 256 * (4 + 2 * sec + p) + 128 * bj + 32 * wc + j; }
    return RmW64{}(n); } };
struct RmOdIn { __device__ __forceinline__ int operator()(int n) const { return (X_FP8 && n >= 1024) ? RmW16{}(n) : RmW64{}(n); } };
struct RmGlu { int half; __device__ __forceinline__ int operator()(int n) const { return 256 * (n >> 7) + 128 * half + (n & 127); } };

template <class KAT> __device__ __forceinline__ void p0_prologue(Frame& F, KAT KA) {
#define in KA->in
    static_assert(I8_IN, "the prologue prepares int8 input-projection weights only");
    const int w = F.bx;
    if (w < 192) {
        constexpr int ASTR = 2064;
        LAS unsigned char* ah = F.lds; LAS unsigned char* al = F.lds + 32 * ASTR;
        const float* c = in[1];
        for (int i = F.tid; i < 32 * 512; i += 512) { const int b = i >> 9, k = (i & 511) * 2; const f32x2 v = *(const f32x2*)(c + b * 1024 + k);
            const float s0 = v[0] / (1.0f + __expf(-v[0])), s1 = v[1] / (1.0f + __expf(-v[1]));
            const unsigned h = pk2(s0, s1), lo = pk2(s0 - bflo(h), s1 - bfhi(h));
            *(LAS unsigned*)(ah + b * ASTR + k * 2) = h; *(LAS unsigned*)(al + b * ASTR + k * 2) = lo; }
        __syncthreads();
        const int ch = F.wave >> 2, kq = F.wave & 3, colg = w * 64 + ch * 32, l = colg / 6144, col = colg % 6144 + (F.lane & 31), kg = F.lane >> 5, m = F.lane & 31;
        const float* W = in[2] + (size_t)l * 1024 * 6144 + col + (size_t)(kq * 256 + 8 * kg) * 6144;
        float wv[16][8];
#pragma unroll
        for (int st = 0; st < 16; ++st)
#pragma unroll
            for (int j = 0; j < 8; ++j) wv[st][j] = W[(size_t)(16 * st + j) * 6144];
        f32x16 acc;
#pragma unroll
        for (int r = 0; r < 16; ++r) acc[r] = 0.f;
#pragma unroll
        for (int st = 0; st < 16; ++st) {
            v4u bh, bl;
            bh.x = pk2(wv[st][0], wv[st][1]); bh.y = pk2(wv[st][2], wv[st][3]); bh.z = pk2(wv[st][4], wv[st][5]); bh.w = pk2(wv[st][6], wv[st][7]);
            bl.x = pk2(wv[st][0] - bflo(bh.x), wv[st][1] - bfhi(bh.x)); bl.y = pk2(wv[st][2] - bflo(bh.y), wv[st][3] - bfhi(bh.y));
            bl.z = pk2(wv[st][4] - bflo(bh.z), wv[st][5] - bfhi(bh.z)); bl.w = pk2(wv[st][6] - bflo(bh.w), wv[st][7] - bfhi(bh.w));
            const int ko = (kq * 256 + 16 * st + 8 * kg) * 2;
            const bf16x8 a_hi = *(const LAS bf16x8*)(ah + m * ASTR + ko), a_lo = *(const LAS bf16x8*)(al + m * ASTR + ko);
            acc = __builtin_amdgcn_mfma_f32_32x32x16_bf16(a_hi, __builtin_bit_cast(bf16x8, bh), acc, 0, 0, 0);
            acc = __builtin_amdgcn_mfma_f32_32x32x16_bf16(a_lo, __builtin_bit_cast(bf16x8, bh), acc, 0, 0, 0);
            acc = __builtin_amdgcn_mfma_f32_32x32x16_bf16(a_hi, __builtin_bit_cast(bf16x8, bl), acc, 0, 0, 0);
        }
        __syncthreads();
        LAS float* red = (LAS float*)F.lds;
#pragma unroll
        for (int r = 0; r < 16; ++r) red[(F.wave * 16 + r) * 64 + F.lane] = acc[r];
        __syncthreads();
        float* mod = (float*)(F.ws + WS_MOD);
        for (int o = F.tid; o < 2048; o += 512) { const int ch2 = o >> 10, bm = (o >> 5) & 31, n = o & 31;
            const int r = (bm & 3) + 4 * (bm >> 3), ln = n + 32 * ((bm >> 2) & 1);
            float t = 0.f;
#pragma unroll
            for (int q = 0; q < 4; ++q) t += red[((ch2 * 4 + q) * 16 + r) * 64 + ln];
            const int cg = w * 64 + ch2 * 32 + n, l2 = cg / 6144, c2 = cg % 6144;
            mod[((size_t)l2 * 32 + bm) * 6144 + c2] = t + in[3][(size_t)l2 * 6144 + c2]; }
        __syncthreads();
    }
    if (w >= 192) for (int cbk = w - 192; cbk < 72; cbk += 64) {
        LAS float* scr8 = (LAS float*)(F.lds + F.wave * 16640);
        LAS float* pm = (LAS float*)(F.lds + 133120);
        const int kq = F.wave;
        const bool isev = cbk < 40;
        const float* W8s = isev ? in[6] : in[14]; const int N8 = isev ? 2560 : 2048, n0 = 64 * (isev ? cbk : cbk - 40);
        unsigned char* WT8 = F.ws + (isev ? WS_WEVIN : WS_WODIN); float* SBp = (float*)(F.ws + (isev ? META_SBEVIN : META_SBODIN));
        float mx[4] = {0.f, 0.f, 0.f, 0.f};
        for (int kb = 0; kb < 2; ++kb) {
#pragma unroll
            for (int i = 0; i < 16; ++i) { const f32x4 v = *(const f32x4*)(W8s + (size_t)(128 * kq + 64 * kb + 4 * i + (F.lane >> 4)) * N8 + n0 + 4 * (F.lane & 15));
                mx[0] = __builtin_fmaxf(mx[0], __builtin_fabsf(v[0])); mx[1] = __builtin_fmaxf(mx[1], __builtin_fabsf(v[1])); mx[2] = __builtin_fmaxf(mx[2], __builtin_fabsf(v[2])); mx[3] = __builtin_fmaxf(mx[3], __builtin_fabsf(v[3])); }
        }
#pragma unroll
        for (int e = 0; e < 4; ++e) { mx[e] = __builtin_fmaxf(mx[e], __shfl_xor(mx[e], 16)); mx[e] = __builtin_fmaxf(mx[e], __shfl_xor(mx[e], 32)); }
        if (F.lane < 16) *(LAS f32x4*)(pm + F.wave * 64 + 4 * F.lane) = (f32x4){mx[0], mx[1], mx[2], mx[3]};
        __syncthreads();
        float inv[8];
#pragma unroll
        for (int j = 0; j < 8; ++j) { const int n = (F.lane >> 3) + 8 * j;
            float cm = pm[n];
#pragma unroll
            for (int q = 1; q < 8; ++q) cm = __builtin_fmaxf(cm, pm[q * 64 + n]);
            inv[j] = I8_FIXSCALE ? 127.0f / 0.25f : (cm > 0.f ? 127.0f / cm : 0.f);
            if (kq == 0 && (F.lane & 7) == 0) SBp[isev ? RmEvIn{}(n0 + n) : RmOdIn{}(n0 + n)] = cm > 0.f ? cm * (1.0f / 127.0f) : 1.0f; }
        for (int kb = 0; kb < 2; ++kb) {
            const int k0 = 128 * kq + 64 * kb;
            f32x4 v[16];
#pragma unroll
            for (int i = 0; i < 16; ++i) v[i] = *(const f32x4*)(W8s + (size_t)(k0 + 4 * i + (F.lane >> 4)) * N8 + n0 + 4 * (F.lane & 15));
#pragma unroll
            for (int i = 0; i < 16; ++i) { LAS float* d = scr8 + (4 * i + (F.lane >> 4)) * 65 + 4 * (F.lane & 15); d[0] = v[i][0]; d[1] = v[i][1]; d[2] = v[i][2]; d[3] = v[i][3]; }
            asm volatile("s_waitcnt lgkmcnt(0)" ::: "memory");
            const int c = F.lane & 7;
#pragma unroll
            for (int j = 0; j < 8; ++j) { const int n = (F.lane >> 3) + 8 * j; const LAS float* sp = scr8 + (8 * c) * 65 + n; const float iv = inv[j];
                v2u o; o.x = pk4_i8(sp[0 * 65] * iv, sp[1 * 65] * iv, sp[2 * 65] * iv, sp[3 * 65] * iv); o.y = pk4_i8(sp[4 * 65] * iv, sp[5 * 65] * iv, sp[6 * 65] * iv, sp[7 * 65] * iv);
                *(GAS v2u*)(WT8 + (size_t)(isev ? RmEvIn{}(n0 + n) : RmOdIn{}(n0 + n)) * 1024 + k0 + 8 * c) = o; }
            asm volatile("s_waitcnt lgkmcnt(0)" ::: "memory");
        }
        __syncthreads();
    }
    if (w >= 36 && w < 40) {
        unsigned char* img = F.ws + META_WRIMG; const float* rw = in[23];
        for (int i = (w - 36) * 4096 + F.tid; i < (w - 35) * 4096; i += 512) { const int k = i >> 4, e = i & 15; const float v = rw[i]; const unsigned hb = pk2(v, 0.f) & 0xffffu; const float lo = v - bflo(hb);
            *(bf16*)(img + e * 2064 + k * 2) = (bf16)hb; *(bf16*)(img + 16 * 2064 + e * 2064 + k * 2) = (bf16)(pk2(lo, 0.f) & 0xffffu); }
    }
    LAS float* scr = (LAS float*)(F.lds + F.wave * 16896);
    bf16* WEVOUT = (bf16*)(F.ws + WS_WEVOUT); bf16* WODOUT = (bf16*)(F.ws + WS_WODOUT);
    bf16* WRG = (bf16*)(F.ws + WS_WRG); bf16* WIG = (bf16*)(F.ws + WS_WIG); bf16* W13 = (bf16*)(F.ws + WS_W13); bf16* W2 = (bf16*)(F.ws + WS_W2);
    constexpr int I_SQ = 16 * 16, I_W1 = 16 * 8, I_W2 = 8 * 16, I_G = 2 * 2;
    constexpr int NITEMS = 2 * I_SQ + 32 * I_W1 * 2 + 32 * I_W2 + 16 * I_G, NV = 192 * 8 + 8 * 3 + 56 * 6, NROUND = (NITEMS + NV - 1) / NV;
    (void)NV; (void)NROUND;
    unsigned* pc = (unsigned*)(F.ws + WS_CTL) + 1280 + 64 * (w & 7);
    int kq_ = 0; if (F.lane == 0) kq_ = (int)xb_add(pc, 1u);
    kq_ = __builtin_amdgcn_readfirstlane(kq_);
    for (;;) {
        const int it = 8 * kq_ + (w & 7);
        if (it >= NITEMS) break;
        int kn_ = 0; if (F.lane == 0) kn_ = (int)xb_add(pc, 1u);
        struct Adv { int& k; int& n; __device__ ~Adv() { k = __builtin_amdgcn_readfirstlane(n); } } adv_{kq_, kn_};
        int r = it;
        if (r < I_SQ) { p0_transpose_item<FP8_OUT != 0>(in[13], 1024, 1024, WEVOUT, scr, r, F.lane, RmW64{}); continue; } r -= I_SQ;
        if (r < I_SQ) { p0_transpose_item<FP8_OUT != 0>(in[22], 1024, 1024, WODOUT, scr, r, F.lane, RmW64{}); continue; } r -= I_SQ;
        if (r < 32 * I_W1) { const int mat = r / I_W1; p0_transpose_item<true>(in[25] + (size_t)mat * 1024 * 512, 1024, 512, (bf16*)((unsigned char*)W13 + (size_t)mat * 1024 * 1024), scr, r % I_W1, F.lane, RmGlu{0}); continue; } r -= 32 * I_W1;
        if (r < 32 * I_W1) { const int mat = r / I_W1; p0_transpose_item<true>(in[26] + (size_t)mat * 1024 * 512, 1024, 512, (bf16*)((unsigned char*)W13 + (size_t)mat * 1024 * 1024), scr, r % I_W1, F.lane, RmGlu{1}); continue; } r -= 32 * I_W1;
        if (r < 32 * I_W2) { const int mat = r / I_W2; p0_transpose_item<true, true>(in[27] + (size_t)mat * 512 * 1024, 512, 1024, (bf16*)((unsigned char*)W2 + (size_t)mat * 1024 * 512), scr, r % I_W2, F.lane, RmW16{}); continue; } r -= 32 * I_W2;
        { const int mat = r / I_G, which = mat >> 3, blk = mat & 7;
          p0_transpose_item((which ? in[19] : in[17]) + (size_t)blk * 128 * 128, 128, 128, (which ? WIG : WRG) + (size_t)blk * 128 * 128, scr, r % I_G, F.lane, RmId{}); }
    }
#undef in
}

__device__ __forceinline__ void norm_rows(Frame& F, const float* X, bf16* H, const float* ng, const float* modl, int sh_off, int sc_off) {
    const int gw = F.bx * NWAVES + F.wave;
    const int b = gw >> 6;
    f32x4 gm[4], sh[4];
#pragma unroll
    for (int j = 0; j < 4; ++j) { const int k = 256 * j + 4 * F.lane;
        const f32x4 g = *(const f32x4*)(ng + k), s = *(const f32x4*)(modl + (size_t)b * 6144 + sc_off + k);
        gm[j] = g * (s + 1.0f); sh[j] = *(const f32x4*)(modl + (size_t)b * 6144 + sh_off + k); }
    unsigned* qn = (unsigned*)(F.ws + WS_CTL) + 2048 + 16 * b;
    int cq = 0; if (F.lane == 0) cq = (int)xb_add(qn, 1u); cq = __builtin_amdgcn_readfirstlane(cq);
    while (cq < 512) {
        int cn = 0; if (F.lane == 0) cn = (int)xb_add(qn, 1u);
        struct Adv { int& k; int& n; __device__ ~Adv() { k = __builtin_amdgcn_readfirstlane(n); } } adv_{cq, cn};
        const size_t row = (size_t)b * 2048 + 4 * cq;
        f32x4 v[4][4]; float ss[4];
#pragma unroll
        for (int q = 0; q < 4; ++q)
#pragma unroll
            for (int j = 0; j < 4; ++j) v[q][j] = __builtin_nontemporal_load((const f32x4*)(X + (row + q) * DM + 256 * j + 4 * F.lane));
#pragma unroll
        for (int q = 0; q < 4; ++q) { ss[q] = 0.f;
#pragma unroll
            for (int j = 0; j < 4; ++j) ss[q] += (v[q][j][0] * v[q][j][0] + v[q][j][1] * v[q][j][1]) + (v[q][j][2] * v[q][j][2] + v[q][j][3] * v[q][j][3]); }
#pragma unroll
        for (int q = 0; q < 4; ++q) {
            const float rstd = 1.0f / sqrtf(wave_sum(ss[q]) * (1.0f / DM) + EPS);
#if I8_IN
            { float am = 0.f; f32x4 o[4];
#pragma unroll
              for (int j = 0; j < 4; ++j) { o[j] = v[q][j] * rstd * gm[j] + sh[j]; am = __builtin_fmaxf(am, __builtin_fmaxf(__builtin_fmaxf(__builtin_fabsf(o[j][0]), __builtin_fabsf(o[j][1])), __builtin_fmaxf(__builtin_fabsf(o[j][2]), __builtin_fabsf(o[j][3])))); }
#pragma unroll
              for (int of = 1; of < 64; of <<= 1) am = __builtin_fmaxf(am, __shfl_xor(am, of));
              if (I8_FIXSCALE) am = 8.0f;
              const float iv = am > 0.f ? 127.0f / am : 0.f;
              if (F.lane == 0) ((float*)(F.ws + WS_SA))[row + q] = am > 0.f ? am * (1.0f / 127.0f) : 1.0f;
#pragma unroll
              for (int j = 0; j < 4; ++j) *(unsigned*)((unsigned char*)H + (row + q) * DM + 256 * j + 4 * F.lane) = pk4_i8(o[j][0] * iv, o[j][1] * iv, o[j][2] * iv, o[j][3] * iv); }
            continue;
#endif
#pragma unroll
            for (int j = 0; j < 4; ++j) { const f32x4 o = v[q][j] * rstd * gm[j] + sh[j];
#if FP8_IN0
                *(unsigned*)((unsigned char*)H + (row + q) * DM + 256 * j + 4 * F.lane) = pk4_fp8(o[0], o[1], o[2], o[3]);
#else
                v2u w; w.x = pk2(o[0], o[1]); w.y = pk2(o[2], o[3]); *(v2u*)(H + (row + q) * DM + 256 * j + 4 * F.lane) = w;
#endif
            }
        }
    }
}

namespace sba {
constexpr int SLOTB = 8192, NSLOT = 7, L_K = 0, L_V = NSLOT * SLOTB, L_FLAG = 2 * NSLOT * SLOTB, L_OST = 2 * NSLOT * SLOTB + 256;
__device__ __forceinline__ s16x4 vtr(const LAS unsigned char* p) { typedef short v4i16_t __attribute__((ext_vector_type(4))); return __builtin_bit_cast(s16x4, __builtin_amdgcn_ds_read_tr16_b64_v4i16((LAS v4i16_t*)p)); }
__device__ __forceinline__ void unit(int b, int h, int qb, const bf16* Q, const bf16* K, const bf16* V, bf16* CAT, LAS unsigned char* lds, bool first) {
    const int tid = threadIdx.x, lane = tid & 63, r32 = lane & 31, hi = lane >> 5; const int wid = __builtin_amdgcn_readfirstlane(tid >> 6);
    const long rowbase = (long)b * SEQ; const int q0 = qb * 256;
    const bf16* Qw = Q + (rowbase + q0 + wid * 32) * SBW + h * HD;
    const bf16* Kh = K + rowbase * SBW + h * HD; const bf16* Vh = V + rowbase * SBW + h * HD;
    const bf16* ksrc = Kh + (long)lane * SBW + wid * 8;
    const bf16* vsrc = Vh + (long)(16 * (wid & 3) + (lane >> 2)) * SBW + (wid >> 2) * 32 + (lane & 3) * 8;
    LAS unsigned char* kdst = lds + L_K + wid * 1024; LAS unsigned char* vdst = lds + L_V + wid * 1024;
#define SBA_DMA(t, slot) do { __builtin_amdgcn_global_load_lds((const unsigned*)(ksrc + (long)(t) * 64 * SBW), (LAS unsigned*)(kdst + SBA_SOFF(slot)), 16, 0, 0); \
                              __builtin_amdgcn_global_load_lds((const unsigned*)(vsrc + (long)(t) * 64 * SBW), (LAS unsigned*)(vdst + SBA_SOFF(slot)), 16, 0, 0); } while (0)
    const LAS unsigned char* kp0 = lds + L_K + hi * 1024 + r32 * 16;
    const LAS unsigned char* vp0 = lds + L_V + ((lane >> 4) & 1) * 32 + (lane & 3) * 8 + (4 * hi + ((lane & 15) >> 2)) * 64;
    volatile LAS unsigned* flags = (volatile LAS unsigned*)(lds + L_FLAG);
    const int NTq = 4 * qb, pr = wid >> 1;
#define SBA_SOFF(t_) (((t_) % NSLOT) * SLOTB)
    if (first) { SBA_DMA(NTq + 3, NTq + 3); SBA_DMA(NTq + 2, NTq + 2); SBA_DMA(NTq + 1, NTq + 1); SBA_DMA(NTq, NTq); if (NTq > 0) SBA_DMA(NTq - 1, NTq - 1); }
    bf16x8 qr[4];
#pragma unroll
    for (int d0 = 0; d0 < 4; ++d0) qr[d0] = *(const bf16x8*)(Qw + (long)r32 * SBW + d0 * 16 + hi * 8);
    f32x16 o0 = {}, o1 = {};
    float carry = 1.0f; bool done_w = false;
    const int qrow = q0 + wid * 32 + r32, qmin = q0 + wid * 32;
    int it = 0;
    for (;; ++it) {
        const int slot = it & 1; const int t = NTq + pr - it; const int rslot = t;
        __syncthreads();
        if (it > 0) { unsigned all = 1u;
#pragma unroll
            for (int w8 = 0; w8 < 8; ++w8) all &= flags[((it - 1) & 1) * 8 + w8];
            if (all) break; }
        if (NTq - it - 2 >= 0) SBA_DMA(NTq - it - 2, NTq - it - 2);
        if (t < 0) done_w = true;
        const int kbase = 64 * t;
        if (!done_w) {
            const LAS unsigned char* kp = kp0 + SBA_SOFF(rslot);
            bf16x8 kf[8];
#pragma unroll
            for (int d0 = 0; d0 < 4; ++d0) { kf[2 * d0] = *(const LAS bf16x8*)(kp + d0 * 2048); kf[2 * d0 + 1] = *(const LAS bf16x8*)(kp + d0 * 2048 + 512); }
            f32x16 C0 = {}, C1 = {};
#pragma unroll
            for (int d0 = 0; d0 < 4; ++d0) { C0 = __builtin_amdgcn_mfma_f32_32x32x16_bf16(kf[2 * d0], qr[d0], C0, 0, 0, 0); C1 = __builtin_amdgcn_mfma_f32_32x32x16_bf16(kf[2 * d0 + 1], qr[d0], C1, 0, 0, 0); }
            f32x16 D0, D1;
            const bool partial = (kbase + 64 > qmin);
            if (partial) {
#pragma unroll
                for (int r = 0; r < 16; ++r) {
                    float f0 = fast_rcp(1.0f + fast_exp2(C0[r])), f1 = fast_rcp(1.0f + fast_exp2(C1[r]));
                    const int kp_ = kbase + 4 * hi + (r & 3) + 8 * (r >> 2);
                    if (!(kp_ < qrow)) f0 = 1.f;
                    if (!(kp_ + 32 < qrow)) f1 = 1.f;
                    D0[r] = f0; D1[r] = f1;
                }
            } else {
#pragma unroll
                for (int r = 0; r < 16; r += 2) {
                    f32x2 e0, e1; e0[0] = fast_exp2(C0[r]); e0[1] = fast_exp2(C0[r + 1]); e1[0] = fast_exp2(C1[r]); e1[1] = fast_exp2(C1[r + 1]);
                    const f32x2 d0 = e0 + 1.0f, d1 = e1 + 1.0f;
                    D0[r] = fast_rcp(d0[0]); D0[r + 1] = fast_rcp(d0[1]); D1[r] = fast_rcp(d1[0]); D1[r + 1] = fast_rcp(d1[1]);
                }
                asm volatile("" ::: "memory");
            }
            float own[8], par[8], eg[8];
#pragma unroll
            for (int g = 0; g < 4; ++g) {
                { const float p3 = D0[4 * g + 3], p2 = D0[4 * g + 2] * p3, p1 = D0[4 * g + 1] * p2, p0 = D0[4 * g] * p1; own[g] = p0;
                  C0[4 * g + 3] = 1.0f - p3; C0[4 * g + 2] = p3 - p2; C0[4 * g + 1] = p2 - p1; C0[4 * g] = p1 - p0; }
                { const float p3 = D1[4 * g + 3], p2 = D1[4 * g + 2] * p3, p1 = D1[4 * g + 1] * p2, p0 = D1[4 * g] * p1; own[4 + g] = p0;
                  C1[4 * g + 3] = 1.0f - p3; C1[4 * g + 2] = p3 - p2; C1[4 * g + 1] = p2 - p1; C1[4 * g] = p1 - p0; }
            }
#pragma unroll
            for (int j = 0; j < 8; ++j) { const auto rr = __builtin_amdgcn_permlane32_swap(__float_as_uint(own[j]), __float_as_uint(own[j]), false, false);
                par[j] = __uint_as_float(hi ? rr[0] : rr[1]); }
            float sp = carry;
#pragma unroll
            for (int j = 7; j >= 0; --j) { eg[j] = hi ? sp : sp * par[j]; sp *= own[j] * par[j]; }
            carry = sp;
#pragma unroll
            for (int g = 0; g < 4; ++g)
#pragma unroll
                for (int i = 0; i < 4; ++i) { C0[4 * g + i] *= eg[g]; C1[4 * g + i] *= eg[4 + g]; }
            v4u pw0, pw1, pw2, pw3;
            pw0 = (v4u){pk2(C0[0], C0[1]), pk2(C0[2], C0[3]), pk2(C0[4], C0[5]), pk2(C0[6], C0[7])};
            pw1 = (v4u){pk2(C0[8], C0[9]), pk2(C0[10], C0[11]), pk2(C0[12], C0[13]), pk2(C0[14], C0[15])};
            pw2 = (v4u){pk2(C1[0], C1[1]), pk2(C1[2], C1[3]), pk2(C1[4], C1[5]), pk2(C1[6], C1[7])};
            pw3 = (v4u){pk2(C1[8], C1[9]), pk2(C1[10], C1[11]), pk2(C1[12], C1[13]), pk2(C1[14], C1[15])};
            const LAS unsigned char* vp = vp0 + SBA_SOFF(rslot);
#pragma unroll
            for (int d0 = 0; d0 < 2; ++d0) {
                s16x4 lo[4], hh[4];
#pragma unroll
                for (int ks = 0; ks < 4; ++ks) { lo[ks] = vtr(vp + d0 * 4096 + ks * 1024); hh[ks] = vtr(vp + d0 * 4096 + ks * 1024 + 512); }
#define SBA_VF(k) (bf16x8){lo[k][0], lo[k][1], lo[k][2], lo[k][3], hh[k][0], hh[k][1], hh[k][2], hh[k][3]}
                f32x16 oo = d0 ? o1 : o0;
                oo = __builtin_amdgcn_mfma_f32_32x32x16_bf16(__builtin_bit_cast(bf16x8, pw0), SBA_VF(0), oo, 0, 0, 0);
                oo = __builtin_amdgcn_mfma_f32_32x32x16_bf16(__builtin_bit_cast(bf16x8, pw1), SBA_VF(1), oo, 0, 0, 0);
                oo = __builtin_amdgcn_mfma_f32_32x32x16_bf16(__builtin_bit_cast(bf16x8, pw2), SBA_VF(2), oo, 0, 0, 0);
                oo = __builtin_amdgcn_mfma_f32_32x32x16_bf16(__builtin_bit_cast(bf16x8, pw3), SBA_VF(3), oo, 0, 0, 0);
                if (d0) o1 = oo; else o0 = oo;
#undef SBA_VF
            }
            done_w = __all(carry < 1e-30f);
        }
        if (lane == 0) flags[slot * 8 + wid] = done_w ? 1u : 0u;
    }
    for (int tn = NTq - it - 2; tn >= NTq - 5 && tn >= 0; --tn) SBA_DMA(tn, tn);
    {
        LAS bf16* stg = (LAS bf16*)(lds + L_OST) + wid * 2048;
#pragma unroll
        for (int r = 0; r < 16; ++r) { const int orow = (r & 3) + 8 * (r >> 2) + 4 * hi;
            stg[orow * 64 + r32] = (bf16)(pk2(o0[r], 0.f) & 0xffffu); stg[orow * 64 + 32 + r32] = (bf16)(pk2(o1[r], 0.f) & 0xffffu); }
        asm volatile("s_waitcnt lgkmcnt(0)" ::: "memory");
        bf16* Ow = CAT + (rowbase + q0 + wid * 32) * DM + 512 + h * HD;
#pragma unroll
        for (int i = 0; i < 4; ++i) { const int row = i * 8 + (lane >> 3), ch = lane & 7; const v4u v = *(const LAS v4u*)(stg + row * 64 + ch * 8);
#if FP8_OUT
            *(v2u*)((unsigned char*)CAT + (rowbase + q0 + wid * 32 + row) * DM + 512 + h * HD + ch * 8) = bf8x_to_fp8(v);
#else
            *(v4u*)(Ow + (long)row * DM + ch * 8) = v;
#endif
        }
    }
    __syncthreads();
#undef SBA_DMA
#undef SBA_SOFF
}
}

__device__ __forceinline__ void conv_prefetch(Frame& F, v4u (&pf)[8], int uidx, const bf16* U0) {
    const int b = uidx >> 6, t0 = (uidx & 63) * 32;
#pragma unroll
#if U_FP8
    for (int i = 0; i < 4; ++i) { const int idx = F.tid + 512 * i;
        const int W_ = idx >> 6, l_ = idx & 63, blk = (W_ & 1) * 8 + (l_ >> 3), ri = (W_ >> 1) * 4 + ((l_ >> 1) & 3), hf = l_ & 1, tok = t0 - 32 + ri;
        pf[i] = (v4u){0u, 0u, 0u, 0u};
        const size_t R_ = (size_t)b * SEQ + (tok >= 0 ? tok : 0);
        if (tok >= 0) pf[i] = *(const v4u*)((const unsigned char*)U0 + ((size_t)((R_ >> 8) * 16 + blk) * 256 + (R_ & 255)) * 32 + hf * 16); }
#else
    for (int i = 0; i < 8; ++i) { const int idx = F.tid + 512 * i; const int ri = idx >> 6, ch = idx & 63, tok = t0 - 30 + ri;
        pf[i] = (v4u){0u, 0u, 0u, 0u};
        if (idx < 62 * 64 && tok >= 0) pf[i] = *(const v4u*)(U0 + ((size_t)b * SEQ + tok) * CONVC + ch * 8); }
#endif
}
__device__ __forceinline__ void conv_phase(Frame& F, const bf16* U0, bf16* CAT, const float* dw_w, const float* dw_b, const float* ln_g, const float* ln_b) {
    LAS unsigned char* tile = F.lds;
    LAS float* resl = (LAS float*)(F.lds + 63488);
    v4u pf[8];
    const int nunits = NB * (SEQ / 32);
    unsigned* qc = (unsigned*)(F.ws + WS_CTL) + 1024;
    LAS int* nxw = (LAS int*)(F.lds + 129024);
    if (F.tid == 0) { nxw[0] = (int)xb_add(qc, 1u); nxw[1] = (int)xb_add(qc, 1u); }
    __syncthreads();
    int cur = __builtin_amdgcn_readfirstlane(nxw[0]), nxt = __builtin_amdgcn_readfirstlane(nxw[1]);
    __syncthreads();
    if (cur < nunits) conv_prefetch(F, pf, cur, U0);
    const int cp = F.tid & 255, th = F.tid >> 8;
    float w0[31], w1[31];
#pragma unroll
    for (int k = 0; k < 31; ++k) { const f32x2 wv = *(const f32x2*)(dw_w + k * CONVC + 2 * cp); w0[k] = wv[0]; w1[k] = wv[1]; }
    const f32x2 bias = *(const f32x2*)(dw_b + 2 * cp);
    while (cur < nunits) {
        const int uidx = cur;
        const int b = uidx >> 6, t0 = (uidx & 63) * 32;
#pragma unroll
#if U_FP8
        for (int i = 0; i < 4; ++i) { const int idx = F.tid + 512 * i; const int W_ = idx >> 6, l_ = idx & 63, blk = (W_ & 1) * 8 + (l_ >> 3), ri = (W_ >> 1) * 4 + ((l_ >> 1) & 3), hf = l_ & 1;
            *(LAS v4u*)(tile + ri * 544 + blk * 32 + hf * 16) = pf[i]; }
#else
        for (int i = 0; i < 8; ++i) { const int idx = F.tid + 512 * i; if (idx < 62 * 64) *(LAS v4u*)(tile + idx * 16) = pf[i]; }
#endif
        __syncthreads();
        if (nxt < nunits) conv_prefetch(F, pf, nxt, U0);
        int grabbed = 0; if (F.tid == 0) grabbed = (int)xb_add(qc, 1u);
        {
#pragma unroll 1
            for (int og = 0; og < 2; ++og) {
                float a0[8], a1[8];
#pragma unroll
                for (int o = 0; o < 8; ++o) { a0[o] = bias[0]; a1[o] = bias[1]; }
#if U_FP8
                const LAS unsigned char* tp = tile + (2 + 16 * th + 8 * og) * 544 + cp * 2;
#else
                const LAS unsigned char* tp = tile + (16 * th + 8 * og) * 1024 + cp * 4;
#endif
#if U_FP8
                unsigned xr[38];
#pragma unroll
                for (int j = 0; j < 38; ++j) xr[j] = *(const LAS unsigned short*)(tp + j * 544);
                asm volatile("" ::: "memory");
#endif
#pragma unroll
                for (int j = 0; j < 38; ++j) {
#if U_FP8
                    const f32x2 xp = __builtin_amdgcn_cvt_pk_f32_fp8((int)xr[j], false);
                    const float x0 = xp[0], x1 = xp[1];
#else
                    const unsigned xin = *(const LAS unsigned*)(tp + j * 1024);
                    const float x0 = bflo(xin), x1 = bfhi(xin);
#endif
#pragma unroll
                    for (int o = 0; o < 8; ++o) { const int k = j - o; if (k >= 0 && k <= 30) { a0[o] += w0[k] * x0; a1[o] += w1[k] * x1; } }
                }
#pragma unroll
                for (int o = 0; o < 8; ++o) *(LAS f32x2*)(resl + (16 * th + 8 * og + o) * 512 + 2 * cp) = (f32x2){a0[o], a1[o]};
            }
        }
        __syncthreads();
        {
            const f32x4 lg0 = *(const f32x4*)(ln_g + 8 * F.lane), lg1 = *(const f32x4*)(ln_g + 8 * F.lane + 4), lb0 = *(const f32x4*)(ln_b + 8 * F.lane), lb1 = *(const f32x4*)(ln_b + 8 * F.lane + 4);
#pragma unroll
            for (int i = 0; i < 4; ++i) {
                const int tk = F.wave * 4 + i;
                const f32x4 v0 = *(const LAS f32x4*)(resl + tk * 512 + 8 * F.lane), v1 = *(const LAS f32x4*)(resl + tk * 512 + 8 * F.lane + 4);
                const float c = __builtin_bit_cast(float, __builtin_amdgcn_readfirstlane(__builtin_bit_cast(int, v0[0])));
                const f32x4 u0 = v0 - c, u1 = v1 - c;
                float s1 = (u0[0] + u0[1]) + (u0[2] + u0[3]) + (u1[0] + u1[1]) + (u1[2] + u1[3]);
                float s2 = (u0[0] * u0[0] + u0[1] * u0[1]) + (u0[2] * u0[2] + u0[3] * u0[3]) + (u1[0] * u1[0] + u1[1] * u1[1]) + (u1[2] * u1[2] + u1[3] * u1[3]);
#pragma unroll
                for (int o = 1; o < 64; o <<= 1) { s1 += __shfl_xor(s1, o); s2 += __shfl_xor(s2, o); }
                const float mu = s1 * (1.0f / CONVC), mean = mu + c;
                const f32x4 d0 = v0 - mean, d1 = v1 - mean;
                const float q = __builtin_fmaxf(s2 * (1.0f / CONVC) - mu * mu, 0.f) * CONVC;
                const float rstd = 1.0f / sqrtf(q * (1.0f / CONVC) + EPS);
                const f32x4 y0 = d0 * rstd * lg0 + lb0, y1 = d1 * rstd * lg1 + lb1;
                v4u pw; pw.x = pk2(siluf_(y0[0]), siluf_(y0[1])); pw.y = pk2(siluf_(y0[2]), siluf_(y0[3])); pw.z = pk2(siluf_(y1[0]), siluf_(y1[1])); pw.w = pk2(siluf_(y1[2]), siluf_(y1[3]));
#if FP8_OUT
                *(v2u*)((unsigned char*)CAT + ((size_t)b * SEQ + t0 + tk) * DM + 8 * F.lane) = bf8x_to_fp8(pw);
#else
                *(v4u*)(CAT + ((size_t)b * SEQ + t0 + tk) * DM + 8 * F.lane) = pw;
#endif
            }
        }
        if (F.tid == 0) nxw[0] = grabbed;
        __syncthreads();
        cur = nxt; nxt = __builtin_amdgcn_readfirstlane(nxw[0]);
    }
}

__device__ __forceinline__ void lru_unit(Frame& F, int b, int cb, const bf16* GY, const bf16* XB, bf16* CAT2, const bf16* WRG, const bf16* WIG,
                                         const float* conv_w, const float* conv_b, const float* rg_b, const float* ig_b, const float* lam) {
    constexpr int L_XR = 0, L_XC = 17408, L_GY = 34816, L_OUT = 51200;
    LAS unsigned char* lds = F.lds;
    const int lane = F.lane, wv = F.wave, l15 = lane & 15, g4 = lane >> 4;
    const int cl_ = 16 * wv + l15, cglob = cb * 128 + cl_;
    bf16x8 brg[4], big[4];
#pragma unroll
    for (int ks = 0; ks < 4; ++ks) { brg[ks] = *(const bf16x8*)(WRG + ((size_t)cb * 128 + cl_) * 128 + 32 * ks + 8 * g4); big[ks] = *(const bf16x8*)(WIG + ((size_t)cb * 128 + cl_) * 128 + 32 * ks + 8 * g4); }
    const float rb2 = -1.4426950408889634f * rg_b[cglob], ib2 = -1.4426950408889634f * ig_b[cglob];
    const float lamv = lam[cglob];
    const float cl2 = -8.0f * log1pf(expf(-lamv)) * 1.4426950408889634f;
    const int cp2 = F.tid & 63;
    float cw0[4], cw1[4];
#pragma unroll
    for (int k = 0; k < 4; ++k) { const f32x2 w = *(const f32x2*)(conv_w + k * DM + cb * 128 + 2 * cp2); cw0[k] = w[0]; cw1[k] = w[1]; }
    const f32x2 cbias = *(const f32x2*)(conv_b + cb * 128 + 2 * cp2);
    const size_t rowb = (size_t)b * SEQ;
#if X_FP8
    constexpr int L_CW = 67584;
    for (int i = F.tid; i < 5 * 128; i += 512) { const int k = i >> 7, c = i & 127; ((LAS float*)(lds + L_CW))[i] = (k < 4) ? conv_w[k * DM + cb * 128 + c] : conv_b[cb * 128 + c]; }
    const int c8 = ((F.lane >> 5) << 2) | (F.lane & 3), rr_ = 8 * F.wave + ((F.lane >> 2) & 7);
    v4u px[4], pg[2];
#define LRU_PREFETCH(t0_) do { \
        _Pragma("unroll") for (int k = 0; k < 4; ++k) { const int tok = (t0_) - 3 + rr_ + k; px[k] = (v4u){0u, 0u, 0u, 0u}; \
            const size_t R_ = rowb + (tok >= 0 ? tok : 0); \
            if (tok >= 0) px[k] = *(const v4u*)((const unsigned char*)XB + ((size_t)(((R_ >> 8) * 4 + (cb >> 1)) * 4 + ((cb & 1) << 1 | (c8 >> 2))) * 256 + (R_ & 255)) * 64 + (c8 & 3) * 16); } \
        _Pragma("unroll") for (int i = 0; i < 2; ++i) { const int idx = F.tid + 512 * i; const int ri = idx >> 4, chn = idx & 15; pg[i] = *(const v4u*)(GY + (rowb + (t0_) + ri) * DM + cb * 128 + chn * 8); } } while (0)
    LRU_PREFETCH(0);
    float carry = 0.f;
    __syncthreads();
    for (int it = 0; it < SEQ / 64; ++it) {
        const int t0 = it * 64;
        {
            f32x4 ac[4];
#pragma unroll
            for (int q = 0; q < 4; ++q) ac[q] = *(const LAS f32x4*)(lds + L_CW + 4 * 512 + c8 * 64 + q * 16);
#pragma unroll
            for (int k = 0; k < 4; ++k) {
                const unsigned wsrc[4] = {px[k].x, px[k].y, px[k].z, px[k].w};
#pragma unroll
                for (int q = 0; q < 4; ++q) { const f32x4 wk = *(const LAS f32x4*)(lds + L_CW + k * 512 + c8 * 64 + q * 16);
                    const f32x2 lo = __builtin_amdgcn_cvt_pk_f32_fp8((int)wsrc[q], false), hi2 = __builtin_amdgcn_cvt_pk_f32_fp8((int)wsrc[q], true);
                    ac[q][0] += wk[0] * lo[0]; ac[q][1] += wk[1] * lo[1]; ac[q][2] += wk[2] * hi2[0]; ac[q][3] += wk[3] * hi2[1]; }
            }
            *(LAS v4u*)(lds + L_XC + rr_ * 272 + c8 * 32) = (v4u){pk2(ac[0][0], ac[0][1]), pk2(ac[0][2], ac[0][3]), pk2(ac[1][0], ac[1][1]), pk2(ac[1][2], ac[1][3])};
            *(LAS v4u*)(lds + L_XC + rr_ * 272 + c8 * 32 + 16) = (v4u){pk2(ac[2][0], ac[2][1]), pk2(ac[2][2], ac[2][3]), pk2(ac[3][0], ac[3][1]), pk2(ac[3][2], ac[3][3])};
        }
#pragma unroll
        for (int i = 0; i < 2; ++i) { const int idx = F.tid + 512 * i; *(LAS v4u*)(lds + L_GY + idx * 16) = pg[i]; }
        __syncthreads();
        if (it + 1 < SEQ / 64) LRU_PREFETCH(t0 + 64);
#else
    v4u px[3], pg[2];
#define LRU_PREFETCH(t0_) do { \
        _Pragma("unroll") for (int i = 0; i < (X_FP8 ? 2 : 3); ++i) { const int idx = F.tid + 512 * i; px[i] = (v4u){0u, 0u, 0u, 0u}; \
            if (X_FP8) { if (idx < 67 * 8) { const int ri = idx >> 3, chn = idx & 7, tok = (t0_) - 3 + ri; if (tok >= 0) px[i] = *(const v4u*)((const unsigned char*)XB + (rowb + tok) * DM + cb * 128 + chn * 16); } } \
            else if (idx < 67 * 16) { const int ri = idx >> 4, chn = idx & 15, tok = (t0_) - 3 + ri; if (tok >= 0) px[i] = *(const v4u*)(XB + (rowb + tok) * DM + cb * 128 + chn * 8); } } \
        _Pragma("unroll") for (int i = 0; i < 2; ++i) { const int idx = F.tid + 512 * i; const int ri = idx >> 4, chn = idx & 15; pg[i] = *(const v4u*)(GY + (rowb + (t0_) + ri) * DM + cb * 128 + chn * 8); } } while (0)
    LRU_PREFETCH(0);
    float carry = 0.f;
    for (int it = 0; it < SEQ / 64; ++it) {
        const int t0 = it * 64;
#pragma unroll
#if X_FP8
        for (int i = 0; i < 2; ++i) { const int idx = F.tid + 512 * i; if (idx < 67 * 8) {
            const f32x2 c0 = __builtin_amdgcn_cvt_pk_f32_fp8((int)px[i].x, false), c1 = __builtin_amdgcn_cvt_pk_f32_fp8((int)px[i].x, true), c2 = __builtin_amdgcn_cvt_pk_f32_fp8((int)px[i].y, false), c3 = __builtin_amdgcn_cvt_pk_f32_fp8((int)px[i].y, true);
            const f32x2 c4 = __builtin_amdgcn_cvt_pk_f32_fp8((int)px[i].z, false), c5 = __builtin_amdgcn_cvt_pk_f32_fp8((int)px[i].z, true), c6 = __builtin_amdgcn_cvt_pk_f32_fp8((int)px[i].w, false), c7 = __builtin_amdgcn_cvt_pk_f32_fp8((int)px[i].w, true);
            *(LAS v4u*)(lds + L_XR + idx * 32) = (v4u){pk2(c0[0], c0[1]), pk2(c1[0], c1[1]), pk2(c2[0], c2[1]), pk2(c3[0], c3[1])};
            *(LAS v4u*)(lds + L_XR + idx * 32 + 16) = (v4u){pk2(c4[0], c4[1]), pk2(c5[0], c5[1]), pk2(c6[0], c6[1]), pk2(c7[0], c7[1])}; } }
#else
        for (int i = 0; i < 3; ++i) { const int idx = F.tid + 512 * i; if (idx < 67 * 16) *(LAS v4u*)(lds + L_XR + idx * 16) = px[i]; }
#endif
#pragma unroll
        for (int i = 0; i < 2; ++i) { const int idx = F.tid + 512 * i; *(LAS v4u*)(lds + L_GY + idx * 16) = pg[i]; }
        __syncthreads();
        if (it + 1 < SEQ / 64) LRU_PREFETCH(t0 + 64);
        {
            float x0[11], x1[11];
#pragma unroll
            for (int j = 0; j < 11; ++j) { const unsigned xin = *(const LAS unsigned*)(lds + L_XR + (8 * wv + j) * 256 + cp2 * 4); x0[j] = bflo(xin); x1[j] = bfhi(xin); }
#pragma unroll
            for (int o = 0; o < 8; ++o) {
                const float y0 = cbias[0] + (cw0[0] * x0[o] + cw0[1] * x0[o + 1]) + (cw0[2] * x0[o + 2] + cw0[3] * x0[o + 3]);
                const float y1 = cbias[1] + (cw1[0] * x1[o] + cw1[1] * x1[o + 1]) + (cw1[2] * x1[o + 2] + cw1[3] * x1[o + 3]);
                *(LAS unsigned*)(lds + L_XC + (8 * wv + o) * 272 + cp2 * 4) = pk2(y0, y1);
            }
        }
        __syncthreads();
#endif
        float av[4][4], bv[4][4], gy[4][4], Ae[4], Be[4], At[4], Bt[4];
        unsigned short xcr[4][4], gyr[4][4];
#pragma unroll
        for (int m = 0; m < 4; ++m)
#pragma unroll
            for (int r = 0; r < 4; ++r) { const int tk = 16 * m + 4 * g4 + r; xcr[m][r] = *(const LAS bf16*)(lds + L_XC + tk * 272 + cl_ * 2); gyr[m][r] = *(const LAS bf16*)(lds + L_GY + tk * 256 + cl_ * 2); }
        asm volatile("" ::: "memory");
#pragma unroll
        for (int m = 0; m < 4; ++m) {
            f32x4 aR = {0.f, 0.f, 0.f, 0.f}, aI = {0.f, 0.f, 0.f, 0.f};
#pragma unroll
            for (int ks = 0; ks < 4; ++ks) { const bf16x8 af = *(const LAS bf16x8*)(lds + L_XC + (16 * m + l15) * 272 + (32 * ks + 8 * g4) * 2);
                aR = __builtin_amdgcn_mfma_f32_16x16x32_bf16(af, brg[ks], aR, 0, 0, 0); aI = __builtin_amdgcn_mfma_f32_16x16x32_bf16(af, big[ks], aI, 0, 0, 0); }
            float A = 1.f, B = 0.f;
#pragma unroll
            for (int r = 0; r < 4; ++r) {
                const float xcv = bf2f(xcr[m][r]);
                gy[m][r] = bf2f(gyr[m][r]);
                const float rr = fast_rcp(1.0f + fast_exp2(__builtin_fmaf(aR[r], -1.4426950408889634f, rb2))), ii = fast_rcp(1.0f + fast_exp2(__builtin_fmaf(aI[r], -1.4426950408889634f, ib2)));
                const float a = fast_exp2(cl2 * rr);
                const float mult = __builtin_amdgcn_sqrtf(__builtin_fmaf(-a, a, 1.0f));
                av[m][r] = a; bv[m][r] = mult * ii * xcv;
                B = a * B + bv[m][r]; A = A * a;
            }
            { const float Ap = __shfl_up(A, 16), Bp = __shfl_up(B, 16); if (g4 >= 1) { B = A * Bp + B; A = A * Ap; } }
            { const float Ap = __shfl_up(A, 32), Bp = __shfl_up(B, 32); if (g4 >= 2) { B = A * Bp + B; A = A * Ap; } }
            { const float Ap = __shfl_up(A, 16), Bp = __shfl_up(B, 16); Ae[m] = (g4 == 0) ? 1.f : Ap; Be[m] = (g4 == 0) ? 0.f : Bp; }
            At[m] = __shfl(A, 48 + l15); Bt[m] = __shfl(B, 48 + l15);
        }
#pragma unroll
        for (int m = 0; m < 4; ++m) {
            float hcur = Ae[m] * carry + Be[m];
            carry = At[m] * carry + Bt[m];
#pragma unroll
            for (int r = 0; r < 4; ++r) { hcur = av[m][r] * hcur + bv[m][r]; const int tk = 16 * m + 4 * g4 + r;
                *(LAS bf16*)(lds + L_OUT + tk * 256 + cl_ * 2) = (bf16)(pk2(gy[m][r] * hcur, 0.f) & 0xffffu); }
        }
        __syncthreads();
#pragma unroll
        for (int i = 0; i < 2; ++i) { const int idx = F.tid + 512 * i; const int ri = idx >> 4, chn = idx & 15;
#if FP8_OUT
            *(v2u*)((unsigned char*)CAT2 + (rowb + t0 + ri) * DM + cb * 128 + chn * 8) = bf8x_to_fp8(*(const LAS v4u*)(lds + L_OUT + idx * 16)); }
#else
            *(v4u*)(CAT2 + (rowb + t0 + ri) * DM + cb * 128 + chn * 8) = *(const LAS v4u*)(lds + L_OUT + idx * 16); }
#endif
    }
    __syncthreads();
#undef LRU_PREFETCH
}

__device__ __forceinline__ void router_phase(Frame& F, const bf16* X, bf16* H, const float* ng, const float* modl, const float* rw, const float* rbias, int layer) {
    constexpr int WSTR = 2064;
    LAS unsigned char* whi = F.lds;
    LAS unsigned char* wlo = F.lds + 16 * WSTR;
    LAS float* gml = (LAS float*)(F.lds + 67584);
    LAS float* shl = (LAS float*)(F.lds + 71680);
    LAS float* brl = (LAS float*)(F.lds + 75776);
    LAS int* cnt = (LAS int*)(F.lds + 75776 + 64);
    LAS float* pbr = (LAS float*)(F.lds + 75776 + 128);
    LAS float* exl = (LAS float*)(F.lds + 78848);
    LAS float* exs = (LAS float*)(F.lds + 78848 + 16384);
    LAS float* lgl = (LAS float*)(F.lds + 97280);
    LAS unsigned char* stg = F.lds + 113664 + F.wave * 4352;
    const int w = F.bx, b = w >> 3;
    { const v4u* img = (const v4u*)(F.ws + META_WRIMG);
      for (int i = F.tid; i < 2 * 16 * WSTR / 16; i += 512) *(LAS v4u*)(whi + i * 16) = img[i]; }
    for (int k = F.tid; k < 1024; k += 512) { gml[k] = ng[k] * (1.0f + modl[(size_t)b * 6144 + 4 * 1024 + k]); shl[k] = modl[(size_t)b * 6144 + 3 * 1024 + k]; }
    if (F.tid < 16) cnt[F.tid] = 0;
    __syncthreads();
    {
        const int e = F.tid & 15, part = F.tid >> 4; float t = 0.f;
#pragma unroll 8
        for (int kk = 0; kk < 32; ++kk) { const int k = 32 * part + kk; t += shl[k] * rw[k * 16 + e]; }
        pbr[part * 16 + e] = t;
    }
    __syncthreads();
    if (F.tid < 16) { float t = 0.f;
#pragma unroll
        for (int q = 0; q < 32; ++q) t += pbr[q * 16 + F.tid]; brl[F.tid] = t; }
    __syncthreads();
    const int r16 = F.lane & 15, kq = F.lane >> 4, g = F.wave >> 2, kp = F.wave & 3;
    float* GATE = (float*)(F.ws + META_GATE);
    v4u xn[8];
    { const size_t row0 = (size_t)w * 256 + 16 * g + r16;
#pragma unroll
      for (int cc = 0; cc < 8; ++cc) { const int col = 256 * kp + 32 * cc + 8 * kq; xn[cc] = __builtin_nontemporal_load((const v4u*)(X + row0 * DM + col)); } }
    for (int pass = 0; pass < 8; ++pass) {
        const int buf = pass & 1;
        const size_t row = (size_t)w * 256 + 32 * pass + 16 * g + r16;
        f32x4 xg[8][2]; float ss = 0.f; f32x4 acc = {0.f, 0.f, 0.f, 0.f};
#pragma unroll
        for (int cc = 0; cc < 8; ++cc) {
            const int col = 256 * kp + 32 * cc + 8 * kq;
            const f32x4 x0 = {bflo(xn[cc].x), bfhi(xn[cc].x), bflo(xn[cc].y), bfhi(xn[cc].y)}, x1 = {bflo(xn[cc].z), bfhi(xn[cc].z), bflo(xn[cc].w), bfhi(xn[cc].w)};
            ss += (x0[0] * x0[0] + x0[1] * x0[1]) + (x0[2] * x0[2] + x0[3] * x0[3]) + (x1[0] * x1[0] + x1[1] * x1[1]) + (x1[2] * x1[2] + x1[3] * x1[3]);
            const f32x4 a0 = x0 * *(const LAS f32x4*)(gml + col), a1 = x1 * *(const LAS f32x4*)(gml + col + 4);
            xg[cc][0] = a0; xg[cc][1] = a1;
            v4u hi; hi.x = pk2(a0[0], a0[1]); hi.y = pk2(a0[2], a0[3]); hi.z = pk2(a1[0], a1[1]); hi.w = pk2(a1[2], a1[3]);
            v4u lo; lo.x = pk2(a0[0] - bflo(hi.x), a0[1] - bfhi(hi.x)); lo.y = pk2(a0[2] - bflo(hi.y), a0[3] - bfhi(hi.y)); lo.z = pk2(a1[0] - bflo(hi.z), a1[1] - bfhi(hi.z)); lo.w = pk2(a1[2] - bflo(hi.w), a1[3] - bfhi(hi.w));
            const bf16x8 bh = *(const LAS bf16x8*)(whi + r16 * WSTR + col * 2), bl = *(const LAS bf16x8*)(wlo + r16 * WSTR + col * 2);
            acc = __builtin_amdgcn_mfma_f32_16x16x32_bf16(__builtin_bit_cast(bf16x8, hi), bh, acc, 0, 0, 0);
            acc = __builtin_amdgcn_mfma_f32_16x16x32_bf16(__builtin_bit_cast(bf16x8, lo), bh, acc, 0, 0, 0);
            acc = __builtin_amdgcn_mfma_f32_16x16x32_bf16(__builtin_bit_cast(bf16x8, hi), bl, acc, 0, 0, 0);
        }
        {
            const size_t rown = pass < 7 ? row + 32 : row;
#pragma unroll
            for (int cc = 0; cc < 8; ++cc) { const int col = 256 * kp + 32 * cc + 8 * kq; xn[cc] = __builtin_nontemporal_load((const v4u*)(X + rown * DM + col)); }
        }
        ss += __shfl_xor(ss, 16); ss += __shfl_xor(ss, 32);
        { LAS float* ep = exl + (((buf * 2 + g) * 4 + kp) * 16) * 16;
#pragma unroll
          for (int rg = 0; rg < 4; ++rg) ep[(4 * kq + rg) * 16 + r16] = acc[rg];
          if (kq == 0) exs[((buf * 2 + g) * 4 + kp) * 16 + r16] = ss; }
        __syncthreads();
        float sst = 0.f;
#pragma unroll
        for (int q = 0; q < 4; ++q) sst += exs[((buf * 2 + g) * 4 + q) * 16 + r16];
        const float rstd = 1.0f / sqrtf(sst * (1.0f / DM) + EPS);
#pragma unroll
        for (int cc = 0; cc < 8; ++cc) { const int col = 256 * kp + 32 * cc + 8 * kq;
            const f32x4 o0 = xg[cc][0] * rstd + *(const LAS f32x4*)(shl + col), o1 = xg[cc][1] * rstd + *(const LAS f32x4*)(shl + col + 4);
            v2u pw; pw.x = pk4_fp8(o0[0], o0[1], o0[2], o0[3]); pw.y = pk4_fp8(o1[0], o1[1], o1[2], o1[3]);
            *(LAS v2u*)(stg + r16 * 272 + 32 * cc + 8 * kq) = pw; }
        asm volatile("s_waitcnt lgkmcnt(0)" ::: "memory");
        {
            const size_t rowb = (size_t)w * 256 + 32 * pass + 16 * g;
#pragma unroll
            for (int q = 0; q < 4; ++q) { const int rr = 4 * q + (F.lane >> 4);
                *(v4u*)((unsigned char*)H + (rowb + rr) * DM + 256 * kp + 16 * (F.lane & 15)) = *(const LAS v4u*)(stg + rr * 272 + 16 * (F.lane & 15)); }
        }
        asm volatile("s_waitcnt lgkmcnt(0)" ::: "memory");
        if (kp == 0 && kq == 0) {
            const int rl = 32 * pass + 16 * g + r16;
#pragma unroll
            for (int e4 = 0; e4 < 4; ++e4) { f32x4 t = {0.f, 0.f, 0.f, 0.f};
#pragma unroll
                for (int q = 0; q < 4; ++q) t += *(const LAS f32x4*)(exl + ((((buf * 2 + g) * 4 + q) * 16) + r16) * 16 + 4 * e4);
                *(LAS f32x4*)(lgl + rl * 16 + 4 * e4) = t * rstd; }
        }
    }
    __syncthreads();
    int e1 = 0, e2 = 0, r1 = 0, r2 = 0;
    if (F.tid < 256) {
        const int rl = F.tid; const size_t row = (size_t)w * 256 + rl;
        float sc[16], bi[16];
#pragma unroll
        for (int e4 = 0; e4 < 4; ++e4) { const f32x4 t = *(const LAS f32x4*)(lgl + rl * 16 + 4 * e4);
#pragma unroll
            for (int i = 0; i < 4; ++i) { const int e = 4 * e4 + i; const float lg = t[i] + brl[e]; sc[e] = 1.0f / (1.0f + __expf(-lg)); bi[e] = sc[e] + rbias[e]; } }
        int gbest = 0; float gsb = -1e30f;
#pragma unroll
        for (int gg = 0; gg < 4; ++gg) {
            float m1 = bi[4 * gg], m2 = -1e30f;
#pragma unroll
            for (int i = 1; i < 4; ++i) { const float v = bi[4 * gg + i]; if (v > m1) { m2 = m1; m1 = v; } else if (v > m2) m2 = v; }
            const float gs = m1 + m2; if (gs > gsb) { gsb = gs; gbest = gg; }
        }
        float v4[4], s4[4];
#pragma unroll
        for (int i = 0; i < 4; ++i) { v4[i] = gbest == 0 ? bi[i] : gbest == 1 ? bi[4 + i] : gbest == 2 ? bi[8 + i] : bi[12 + i]; s4[i] = gbest == 0 ? sc[i] : gbest == 1 ? sc[4 + i] : gbest == 2 ? sc[8 + i] : sc[12 + i]; }
        int i1 = 0;
#pragma unroll
        for (int i = 1; i < 4; ++i) if (v4[i] > v4[i1]) i1 = i;
        int i2 = (i1 == 0) ? 1 : 0;
#pragma unroll
        for (int i = 0; i < 4; ++i) if (i != i1 && i != i2 && v4[i] > v4[i2]) i2 = i;
        const float se1 = i1 == 0 ? s4[0] : i1 == 1 ? s4[1] : i1 == 2 ? s4[2] : s4[3], se2 = i2 == 0 ? s4[0] : i2 == 1 ? s4[1] : i2 == 2 ? s4[2] : s4[3];
        e1 = 4 * gbest + i1; e2 = 4 * gbest + i2; const float inv = 1.0f / (se1 + se2);
        *(f32x2*)(GATE + row * 2) = (f32x2){se1 * inv, se2 * inv};
        r1 = atomicAdd((int*)&cnt[e1], 1); r2 = atomicAdd((int*)&cnt[e2], 1);
    }
    __syncthreads();
    LAS int* gbl = (LAS int*)pbr;
    if (F.tid < 16) gbl[F.tid] = (int)xb_add((unsigned*)(F.ws + WS_CTL) + CW_GCNT + layer * 64 + F.tid, (unsigned)cnt[F.tid]);
    __syncthreads();
    if (F.tid < 256) {
        const int row = w * 256 + F.tid; int* TOK2 = (int*)(F.ws + WS_TOK2);
        const int q1 = gbl[e1] + r1, q2 = gbl[e2] + r2;
        TOK2[e1 * pg8::TOKSTR + q1] = row; TOK2[e2 * pg8::TOKSTR + q2] = row;
        *(v2u*)((int*)(F.ws + META_SLOT) + (size_t)row * 2) = (v2u){(unsigned)(e1 << 20 | q1), (unsigned)(e2 << 20 | q2)};
    }
    __syncthreads();
}

__device__ __forceinline__ int moe_tables(Frame& F, int layer) {
    LAS int* te = (LAS int*)(F.lds + L_MOE); LAS int* tb = te + 544; LAS int* cl = tb + 32;
    const unsigned* GC = (const unsigned*)(F.ws + WS_CTL) + CW_GCNT + layer * 64;
    if (F.tid < 64) {
        const int c = F.tid < 16 ? (int)GC[F.tid] : 0, nt = (c + 255) >> 8; int incl = nt;
#pragma unroll
        for (int of = 1; of < 16; of <<= 1) { const int v = __shfl_up(incl, of); if (F.tid >= of) incl += v; }
        if (F.tid < 16) { tb[F.tid] = incl - nt; cl[F.tid] = c; }
        if (F.tid == 15) tb[16] = incl;
    }
    __syncthreads();
    const int ntl = tb[16];
    for (int tl = F.tid; tl < ntl; tl += 512) { int e = 0;
#pragma unroll
        for (int q = 1; q < 16; ++q) e += (tb[q] <= tl) ? 1 : 0;
        te[tl] = e; }
    __syncthreads();
    return ntl;
}

template <bool NEXT>
__device__ __forceinline__ void combine_phase(Frame& F, const bf16* X, void* XO, const bf16* Y, const float* modl  , bf16* H, const float* ng_next, const float* modn  , int layer) {
    (void)layer; const LAS int* tbl = (const LAS int*)(F.lds + L_MOE) + 544;
    const int gw = F.bx * NWAVES + F.wave, b = gw >> 6;
    const int* SLOT = (const int*)(F.ws + META_SLOT); const float* GATE = (const float*)(F.ws + META_GATE);
    f32x4 g2[4], gm[4], sh[4];
#pragma unroll
    for (int j = 0; j < 4; ++j) { const int k = 256 * j + 4 * F.lane; g2[j] = *(const f32x4*)(modl + (size_t)b * 6144 + 5 * 1024 + k);
        if (NEXT) { const f32x4 g = *(const f32x4*)(ng_next + k), s = *(const f32x4*)(modn + (size_t)b * 6144 + 1 * 1024 + k); gm[j] = g * (s + 1.0f); sh[j] = *(const f32x4*)(modn + (size_t)b * 6144 + k); } }
    const size_t rbase = (size_t)gw * 32;
    int ms0 = 0, ms1 = 0; float mg0 = 0.f, mg1 = 0.f;
    if (F.lane < 32) { const v2u sv = *(const v2u*)(SLOT + (rbase + F.lane) * 2); const f32x2 gv = *(const f32x2*)(GATE + (rbase + F.lane) * 2); ms0 = tbl[sv.x >> 20] * 256 + (int)(sv.x & 0xFFFFFu); ms1 = tbl[sv.y >> 20] * 256 + (int)(sv.y & 0xFFFFFu); mg0 = gv[0]; mg1 = gv[1]; }
    for (int r0 = 0; r0 < 32; r0 += 4) {
#if Y_FP8
        v2u x[4][4]; unsigned ya[4][4], yb[4][4]; float ga[4], gb[4];
#else
        v2u x[4][4]; v2u ya[4][4], yb[4][4]; float ga[4], gb[4];
#endif
#pragma unroll
        for (int q = 0; q < 4; ++q) {
            const int s0 = __builtin_amdgcn_readlane(ms0, r0 + q), s1 = __builtin_amdgcn_readlane(ms1, r0 + q);
            ga[q] = __builtin_bit_cast(float, __builtin_amdgcn_readlane(__builtin_bit_cast(int, mg0), r0 + q)); gb[q] = __builtin_bit_cast(float, __builtin_amdgcn_readlane(__builtin_bit_cast(int, mg1), r0 + q));
#pragma unroll
            for (int j = 0; j < 4; ++j) { const int k = 256 * j + 4 * F.lane;
                x[q][j] = __builtin_nontemporal_load((const v2u*)(X + (rbase + r0 + q) * DM + k));
#if Y_FP8
                ya[q][j] = __builtin_nontemporal_load((const unsigned*)((const unsigned char*)Y + (size_t)s0 * DM + k)); yb[q][j] = __builtin_nontemporal_load((const unsigned*)((const unsigned char*)Y + (size_t)s1 * DM + k)); }
#else
                ya[q][j] = *(const v2u*)(Y + (size_t)s0 * DM + k); yb[q][j] = *(const v2u*)(Y + (size_t)s1 * DM + k); }
#endif
        }
        asm volatile("" ::: "memory");
#pragma unroll
        for (int q = 0; q < 4; ++q) {
            const size_t row = rbase + r0 + q; float ss = 0.f; f32x4 v[4];
#pragma unroll
            for (int j = 0; j < 4; ++j) { const int k = 256 * j + 4 * F.lane;
#if Y_FP8
                const f32x2 a01 = __builtin_amdgcn_cvt_pk_f32_fp8((int)ya[q][j], false), a23 = __builtin_amdgcn_cvt_pk_f32_fp8((int)ya[q][j], true), b01 = __builtin_amdgcn_cvt_pk_f32_fp8((int)yb[q][j], false), b23 = __builtin_amdgcn_cvt_pk_f32_fp8((int)yb[q][j], true);
                f32x4 f; f[0] = ga[q] * a01[0] + gb[q] * b01[0]; f[1] = ga[q] * a01[1] + gb[q] * b01[1]; f[2] = ga[q] * a23[0] + gb[q] * b23[0]; f[3] = ga[q] * a23[1] + gb[q] * b23[1];
#else
                f32x4 f; f[0] = ga[q] * bflo(ya[q][j].x) + gb[q] * bflo(yb[q][j].x); f[1] = ga[q] * bfhi(ya[q][j].x) + gb[q] * bfhi(yb[q][j].x); f[2] = ga[q] * bflo(ya[q][j].y) + gb[q] * bflo(yb[q][j].y); f[3] = ga[q] * bfhi(ya[q][j].y) + gb[q] * bfhi(yb[q][j].y);
#endif
                v[j] = (f32x4){bflo(x[q][j].x), bfhi(x[q][j].x), bflo(x[q][j].y), bfhi(x[q][j].y)} + g2[j] * f;
                if (NEXT) { v2u xw; xw.x = pk2(v[j][0], v[j][1]); xw.y = pk2(v[j][2], v[j][3]); *(v2u*)((bf16*)XO + row * DM + k) = xw; }
                else *(f32x4*)((float*)XO + row * DM + k) = v[j];
                ss += (v[j][0] * v[j][0] + v[j][1] * v[j][1]) + (v[j][2] * v[j][2] + v[j][3] * v[j][3]); }
            if (NEXT) {
                const float rstd = 1.0f / sqrtf(wave_sum(ss) * (1.0f / DM) + EPS);
#if I8_IN
                { float am = 0.f; f32x4 o[4];
#pragma unroll
                  for (int j = 0; j < 4; ++j) { o[j] = v[j] * rstd * gm[j] + sh[j]; am = __builtin_fmaxf(am, __builtin_fmaxf(__builtin_fmaxf(__builtin_fabsf(o[j][0]), __builtin_fabsf(o[j][1])), __builtin_fmaxf(__builtin_fabsf(o[j][2]), __builtin_fabsf(o[j][3])))); }
#pragma unroll
                  for (int of = 1; of < 64; of <<= 1) am = __builtin_fmaxf(am, __shfl_xor(am, of));
                  if (I8_FIXSCALE) am = 8.0f;
                  const float iv = am > 0.f ? 127.0f / am : 0.f;
                  if (F.lane == 0) ((float*)(F.ws + WS_SA))[row] = am > 0.f ? am * (1.0f / 127.0f) : 1.0f;
#pragma unroll
                  for (int j = 0; j < 4; ++j) *(unsigned*)((unsigned char*)H + row * DM + 256 * j + 4 * F.lane) = pk4_i8(o[j][0] * iv, o[j][1] * iv, o[j][2] * iv, o[j][3] * iv); }
                if (false)
#endif
#pragma unroll
                for (int j = 0; j < 4; ++j) { const f32x4 o = v[j] * rstd * gm[j] + sh[j];
#if FP8_IN1
                    *(unsigned*)((unsigned char*)H + row * DM + 256 * j + 4 * F.lane) = pk4_fp8(o[0], o[1], o[2], o[3]);
#else
                    v2u pw; pw.x = pk2(o[0], o[1]); pw.y = pk2(o[2], o[3]); *(v2u*)(H + row * DM + 256 * j + 4 * F.lane) = pw;
#endif
                }
            }
        }
    }
}

constexpr int NPHASE = 18;
struct Args { const float* in[28]; float* out; unsigned char* ws; int ph_lo, ph_hi; };
template <int PLO, int PHI> __global__ void __launch_bounds__(NWAVES * 64, 2) mk_fwd(Args args) {
    extern __shared__ __attribute__((aligned(16))) unsigned char lds_raw[];
    Frame F;
    F.lds = (LAS unsigned char*)lds_raw;
    F.tid = threadIdx.x; F.lane = F.tid & 63; F.wave = __builtin_amdgcn_readfirstlane(F.tid >> 6);
    F.G = gridDim.x; F.bx = blockIdx.x; F.vcu = (F.G % 8 == 0) ? (F.bx % 8) * (F.G / 8) + F.bx / 8 : F.bx;
    F.ws = args.ws;
    volatile LAS unsigned* MISC = (volatile LAS unsigned*)(F.lds + MISC_OFF);
    for (int u = F.tid; u < (LDS_BYTES - LDSCTL_OFF) / 4; u += NWAVES * 64) ((LAS unsigned*)(F.lds + LDSCTL_OFF))[u] = 0u;
    __syncthreads();
#if MK_ONE_LAUNCH
    XcdBarrier bar = xcd_barrier_post((unsigned*)(F.ws + WS_CTL) + CW_BAR, MISC + 8);
#define GRID_BAR() do { XcdBarrier b_ = bar; asm volatile("" : "+s"(b_.bar), "+s"(b_.x)); xcd_barrier(b_); } while (0)
#else
#define GRID_BAR() do {} while (0)
#endif
    constexpr int lo = PLO, hi = PHI;
#ifndef PHASE_MASK
#define PHASE_MASK 0x3ffff
#endif
#define IN(k) ((((PHASE_MASK) >> (k)) & 1) && lo <= (k) && (k) < hi)
#ifndef PROBE_REP
#define PROBE_REP 0
#endif
#ifndef PROBE_DRYB
#define PROBE_DRYB 0
#endif
#define REPN(k) (((PROBE_REP) >> (k)) & 1)
#define SEAM(k) do { if (IN(k) && IN((k) + 1)) GRID_BAR(); } while (0)
    typedef const __attribute__((address_space(4))) Args* KArgs; KArgs KA = (KArgs)__builtin_amdgcn_kernarg_segment_ptr();
#define in KA->in
#define PHASE_ENTER() do { KA = (KArgs)__builtin_amdgcn_kernarg_segment_ptr(); asm volatile("" : "+s"(KA)); F.ws = KA->ws; int tid_o = threadIdx.x; asm volatile("" : "+v"(tid_o)); F.tid = tid_o; F.lane = tid_o & 63; F.wave = __builtin_amdgcn_readfirstlane(tid_o >> 6); } while (0)
#define P_MOD ((float*)(F.ws + WS_MOD))
#define P_HA ((bf16*)(F.ws + WS_HA))
#define P_U0 ((bf16*)(F.ws + WS_R1))
#define P_Q (P_U0 + (size_t)T * 512)
#define P_K (P_U0 + (size_t)2 * T * 512)
#define P_V (P_U0 + (size_t)3 * T * 512)
#define P_GY ((bf16*)(F.ws + WS_R1))
#define P_XB (P_GY + (size_t)T * DM)
#define P_XS ((bf16*)(F.ws + WS_R1))
#define P_Y P_XS
#define P_CAT ((bf16*)(F.ws + WS_R2))
#define P_HID P_CAT
#define P_XBF ((bf16*)(F.ws + WS_XBF))

    if (IN(0)) for (int rep_ = 0; rep_ <= REPN(0); ++rep_) { PHASE_ENTER(); p0_prologue(F, KA); } SEAM(0);
    if (IN(1)) for (int rep_ = 0; rep_ <= REPN(1); ++rep_) { PHASE_ENTER(); norm_rows(F, in[0], P_HA, in[4], P_MOD, 0, 1024); } SEAM(1);
    if (IN(2)) for (int rep_ = 0; rep_ <= REPN(2); ++rep_) { PHASE_ENTER();
        pg8::Gemm g{P_HA, (const bf16*)(F.ws + WS_WEVIN), T, EVIN, (FP8_IN0 || I8_IN) ? DM / 2 : DM, 0}; pg8::StaticOrder S; S.init(T, EVIN, F.G, F.bx);
        { const f32x4* sbg = (const f32x4*)(F.ws + META_SBEVIN); for (int i = F.tid; i < EVIN / 4; i += NWAVES * 64) ((LAS f32x4*)(F.lds + L_MOE))[i] = sbg[i]; __syncthreads(); }
        pg8::EpiEvIn E{P_U0, P_Q, P_K, P_V, in[11], in[12], (const float*)(F.ws + WS_SA), (const LAS float*)(F.lds + L_MOE)};
        pg8::gemm_phase<pg8::EpiEvIn, pg8::StaticOrder, true, true, FP8_IN0 != 0, I8_IN != 0>(F.lds, g, S, E);
    } SEAM(2);
    if (IN(3)) for (int rep_ = 0; rep_ <= REPN(3); ++rep_) { PHASE_ENTER();
#ifndef NO_ATTN
        for (int ra_ = 0; ra_ <= REPN(18); ++ra_) { const int bh = F.vcu; for (int qb = 7; qb >= 0; --qb) sba::unit(bh >> 3, bh & 7, qb, P_Q, P_K, P_V, P_CAT, F.lds, qb == 7); }
#endif
#ifndef NO_CONV
        for (int rc_ = 0; rc_ <= REPN(19); ++rc_) conv_phase(F, P_U0, P_CAT, in[7], in[8], in[9], in[10]);
#endif
    } SEAM(3);
    if (IN(4)) for (int rep_ = 0; rep_ <= REPN(4); ++rep_) { PHASE_ENTER();
        pg8::Gemm g{P_CAT, (const bf16*)(F.ws + WS_WEVOUT), T, DM, FP8_OUT ? DM / 2 : DM, 0}; pg8::StaticOrder S; S.init(T, DM, F.G, F.bx);
        pg8::EpiResid<true> E{in[0], P_XBF, P_MOD + 2 * 1024, FP8_OUT ? 1.0f / 32.0f : 1.0f};
        pg8::gemm_phase<pg8::EpiResid<true>, pg8::StaticOrder, true, true, FP8_OUT != 0>(F.lds, g, S, E, STAG_OUT);
    } SEAM(4);
#define MOE_PHASES(layer, p0) \
    if (IN(p0)) for (int rep_ = 0; rep_ <= REPN(p0); ++rep_) { PHASE_ENTER(); router_phase(F, P_XBF, P_HA, in[5] + (layer) * DM, P_MOD + (size_t)(layer) * 32 * 6144, in[23], in[24], layer); } \
    do { if (IN(p0) && IN((p0) + 2)) GRID_BAR(); } while (0);     \
    if (IN((p0) + 2)) for (int rep_ = 0; rep_ <= REPN((p0) + 2); ++rep_) { PHASE_ENTER(); \
        const int ntl = moe_tables(F, layer); const LAS int* te_ = (const LAS int*)(F.lds + L_MOE); \
        pg8::Gemm g{P_HA, (const bf16*)(F.ws + WS_W13 + (size_t)(layer) * 16 * 1024 * 1024), ntl * 256, 1024, DM / 2, (size_t)1024 * 1024}; \
        pg8::MoeGatherOrder S; S.base.init(ntl * 256, 1024, F.G, F.bx); S.te = te_; S.tb = te_ + 544; S.cl = te_ + 576; S.tok = (const int*)(F.ws + WS_TOK2); \
        pg8::EpiMoeA E{P_HID, PROBE_DRYB && rep_ < REPN((p0) + 2)}; \
        pg8::gemm_phase<pg8::EpiMoeA, pg8::MoeGatherOrder, true, true, true>(F.lds, g, S, E, STAG_MOE); \
    } SEAM((p0) + 2); \
    if (IN((p0) + 3)) for (int rep_ = 0; rep_ <= REPN((p0) + 3); ++rep_) { PHASE_ENTER(); \
        const int ntl = moe_tables(F, layer); const LAS int* te_ = (const LAS int*)(F.lds + L_MOE); \
        pg8::Gemm g{P_HID, (const bf16*)(F.ws + WS_W2 + (size_t)(layer) * 16 * 1024 * 512), ntl * 256, 1024, DFF / 2, (size_t)1024 * 512}; \
        pg8::MoeOrder S; S.base.init(ntl * 256, 1024, F.G, F.bx); S.te = te_; S.tb = te_ + 544; S.cl = te_ + 576; S.tok = nullptr; \
        pg8::EpiMoeB E{P_Y, PROBE_DRYB && rep_ < REPN((p0) + 3)}; \
        pg8::gemm_phase<pg8::EpiMoeB, pg8::MoeOrder, true, true, true>(F.lds, g, S, E, STAG_MOE); \
    } SEAM((p0) + 3);

    MOE_PHASES(0, 5)
    if (IN(9)) for (int rep_ = 0; rep_ <= REPN(9); ++rep_) { PHASE_ENTER(); const bool dry = rep_ < REPN(9); combine_phase<true>(F, P_XBF, dry ? (void*)(F.ws + WS_DRY) : (void*)P_XBF, P_Y, P_MOD, dry ? P_HID : P_HA, in[4] + DM, P_MOD + (size_t)32 * 6144, 0); } SEAM(9);
    if (IN(10)) for (int rep_ = 0; rep_ <= REPN(10); ++rep_) { PHASE_ENTER();
        pg8::Gemm g{P_HA, (const bf16*)(F.ws + WS_WODIN), T, 2048, (FP8_IN1 || I8_IN) ? DM / 2 : DM, 0}; pg8::StaticOrder S; S.init(T, 2048, F.G, F.bx);
        { const f32x4* sbg = (const f32x4*)(F.ws + META_SBODIN); for (int i = F.tid; i < 2048 / 4; i += NWAVES * 64) ((LAS f32x4*)(F.lds + L_MOE))[i] = sbg[i]; __syncthreads(); }
        pg8::EpiOdIn E{P_GY, P_XB, (const float*)(F.ws + WS_SA), (const LAS float*)(F.lds + L_MOE)};
        pg8::gemm_phase<pg8::EpiOdIn, pg8::StaticOrder, true, true, FP8_IN1 != 0, I8_IN != 0>(F.lds, g, S, E);
    } SEAM(10);
    if (IN(11)) for (int rep_ = 0; rep_ <= REPN(11); ++rep_) { PHASE_ENTER(); const int u = F.vcu; lru_unit(F, u >> 3, u & 7, P_GY, P_XB, P_CAT, (const bf16*)(F.ws + WS_WRG), (const bf16*)(F.ws + WS_WIG), in[15], in[16], in[18], in[20], in[21]); } SEAM(11);
    if (IN(12)) for (int rep_ = 0; rep_ <= REPN(12); ++rep_) { PHASE_ENTER();
        pg8::Gemm g{P_CAT, (const bf16*)(F.ws + WS_WODOUT), T, DM, FP8_OUT ? DM / 2 : DM, 0}; pg8::StaticOrder S; S.init(T, DM, F.G, F.bx);
        pg8::EpiResid<false> E{P_XBF, P_XBF, P_MOD + (size_t)32 * 6144 + 2 * 1024, FP8_OUT ? 1.0f / 32.0f : 1.0f};
        pg8::gemm_phase<pg8::EpiResid<false>, pg8::StaticOrder, true, true, FP8_OUT != 0>(F.lds, g, S, E, STAG_OUT);
    } SEAM(12);
    MOE_PHASES(1, 13)
    if (IN(17)) for (int rep_ = 0; rep_ <= REPN(17); ++rep_) { PHASE_ENTER(); const bool dry = rep_ < REPN(17); combine_phase<false>(F, P_XBF, dry ? (void*)(F.ws + WS_DRY) : (void*)KA->out, P_Y, P_MOD + (size_t)32 * 6144, P_HA, nullptr, nullptr, 1); }
#undef MOE_PHASES
#undef in
#undef IN
#undef SEAM
}

#if !MK_ONE_LAUNCH
template <int P> static void set_attr_all() { if constexpr (P < NPHASE) { (void)hipFuncSetAttribute((const void*)mk_fwd<P, P + 1>, hipFuncAttributeMaxDynamicSharedMemorySize, LDS_BYTES); set_attr_all<P + 1>(); } }
template <int P> static void launch_all(Args a, int grid, hipStream_t stream) { if constexpr (P < NPHASE) { a.ph_lo = P; a.ph_hi = P + 1; hipLaunchKernelGGL((mk_fwd<P, P + 1>), dim3(grid), dim3(NWAVES * 64), LDS_BYTES, stream, a); launch_all<P + 1>(a, grid, stream); } }
#endif

extern "C" void kernel_launch(void* const* d_in, const int* in_sizes, int n_in, void* d_out, int out_size, void* d_ws, size_t ws_size, hipStream_t stream) {
    static int grid = 0;
    if (grid == 0) {
        if (n_in != 28 || in_sizes[0] != T * DM || out_size != T * DM || ws_size < WS_END + (size_t)T * DM * 4) { fprintf(stderr, "kernel_launch: unexpected shapes (n_in %d, in0 %d, out %d, ws %zu); nothing launched\n", n_in, n_in > 0 ? in_sizes[0] : -1, out_size, ws_size); grid = -1; return; }
        int dev = 0, cus = 0;
        if (hipGetDevice(&dev) != hipSuccess || hipDeviceGetAttribute(&cus, hipDeviceAttributeMultiprocessorCount, dev) != hipSuccess) { grid = -1; return; }
#if MK_ONE_LAUNCH
        if (hipFuncSetAttribute((const void*)mk_fwd<0, NPHASE>, hipFuncAttributeMaxDynamicSharedMemorySize, LDS_BYTES) != hipSuccess) { fprintf(stderr, "kernel_launch: hipFuncSetAttribute failed\n"); grid = -1; return; }
        int per_cu = 0;
        if (hipOccupancyMaxActiveBlocksPerMultiprocessor(&per_cu, (const void*)mk_fwd<0, NPHASE>, NWAVES * 64, LDS_BYTES) != hipSuccess || per_cu < 1) fprintf(stderr, "kernel_launch: occupancy query reports %d\n", per_cu);
#else
        set_attr_all<0>();
#endif
        (void)hipGetLastError();
        grid = cus;
        if (grid != 256) { fprintf(stderr, "kernel_launch: built for 256 CUs, device has %d; nothing launched\n", cus); grid = -1; return; }
    }
    if (grid < 0) return;
    (void)hipMemsetAsync((char*)d_ws + WS_CTL, 0, CTL_ZERO_BYTES, stream);
    Args a{};
    for (int i = 0; i < 28; ++i) a.in[i] = (const float*)d_in[i];
    a.out = (float*)d_out; a.ws = (unsigned char*)d_ws;
#if MK_ONE_LAUNCH
    a.ph_lo = 0; a.ph_hi = NPHASE;
    hipLaunchKernelGGL((mk_fwd<0, NPHASE>), dim3(grid), dim3(NWAVES * 64), LDS_BYTES, stream, a);
#else
    launch_all<0>(a, grid, stream);
#endif
}
```
